# Optimizing an MI355X kernel written in HIP

```python
import math
import jax, jax.numpy as jnp
from jax import lax
import numpy as np

D_MODEL = 1024
BATCH = 4
SEQ = 8192
DEPTH = 2

CHUNK = 64
SB_BLOCK = 128
RET_HEADS = 4
RET_DIM = 128
SB_HEADS = 4
SB_DIM = 128
SSM_HEADS = 8
SSM_HEAD_DIM = 64
SSM_STATE = 128
SSM_GROUPS = 2
SSM_CONV = 4
D_FF = 2816
ROPE_BASE = 10000.0
NORM_EPS = 1e-6
N_SUB = 3

RET_W = RET_HEADS * RET_DIM
SB_W = SB_HEADS * SB_DIM
SSM_W = SSM_HEADS * SSM_HEAD_DIM
MIX_W = RET_W + SB_W + SSM_W
SSM_XBC = SSM_W + 2 * SSM_GROUPS * SSM_STATE
IN_W = 4 * RET_W + 3 * SB_W + SSM_W + SSM_XBC + SSM_HEADS

kernel_name = "hybrid_ret_sb_ssd_macaron_adaln"


def rmsnorm(x, gain):
    xf = x.astype(jnp.float32)
    y = xf * lax.rsqrt(jnp.mean(xf * xf, axis=-1, keepdims=True) + NORM_EPS)
    return (y * gain.astype(jnp.float32)).astype(x.dtype)


def modulate(h, shift, scale):
    return h * (1.0 + scale) + shift


def swiglu(u, wg, wu, wd):
    return (jax.nn.silu(u @ wg) * (u @ wu)) @ wd


def rope(x, pos):
    half = x.shape[-1] // 2
    inv_freq = ROPE_BASE ** (-jnp.arange(half, dtype=jnp.float32) / half)
    ang = pos[:, None] * inv_freq[None, :]
    cos = jnp.cos(ang)[None, :, None, :]
    sin = jnp.sin(ang)[None, :, None, :]
    x1 = x[..., :half].astype(jnp.float32)
    x2 = x[..., half:].astype(jnp.float32)
    return jnp.concatenate([x1 * cos - x2 * sin, x1 * sin + x2 * cos], axis=-1)


def retention(q, k, v, g, gn_gain):
    B, S, _ = q.shape
    nc = S // CHUNK
    H, Dh = RET_HEADS, RET_DIM
    pos = jnp.arange(S, dtype=jnp.float32)
    q = rope(q.reshape(B, S, H, Dh), pos)
    k = rope(k.reshape(B, S, H, Dh), pos) * (Dh ** -0.5)
    v = v.reshape(B, S, H, Dh).astype(jnp.float32)
    log_gamma = jnp.log1p(-(2.0 ** (-5.0 - jnp.arange(H, dtype=jnp.float32))))
    idx = jnp.arange(CHUNK, dtype=jnp.float32)
    dmat = jnp.exp(log_gamma[:, None, None] * jnp.abs(idx[:, None] - idx[None, :]))
    qc = q.reshape(B, nc, CHUNK, H, Dh)
    kc = k.reshape(B, nc, CHUNK, H, Dh)
    vc = v.reshape(B, nc, CHUNK, H, Dh)
    scores = jnp.einsum('bclhd,bcshd->bchls', qc, kc) * dmat[None, None]
    y_intra = jnp.einsum('bchls,bcshe->bclhe', scores, vc)
    k_decay = jnp.exp(log_gamma[:, None] * (CHUNK - 1 - idx)[None, :])
    kv = jnp.einsum('bcshd,hs,bcshe->bchde', kc, k_decay, vc).astype(jnp.float32)
    chunk_decay = jnp.exp(log_gamma * CHUNK)[None, :, None, None]

    def step(state, kv_c):
        return state * chunk_decay + kv_c, state

    _, s_prev = lax.scan(step, jnp.zeros((B, H, Dh, Dh), jnp.float32), jnp.moveaxis(kv, 1, 0))
    s_prev = jnp.moveaxis(s_prev, 0, 1)
    q_decay = jnp.exp(log_gamma[:, None] * (idx + 1.0)[None, :])
    y_cross = jnp.einsum('bclhd,hl,bchde->bclhe', qc, q_decay, s_prev)
    y = (y_intra + y_cross).reshape(B, S, H, Dh)
    y = rmsnorm(y, gn_gain.reshape(H, Dh)).reshape(B, S, RET_W)
    return y * jax.nn.silu(g.astype(jnp.float32))


def stick_breaking(q, k, v):
    B, S, _ = q.shape
    H, Dh = SB_HEADS, SB_DIM
    q = q.reshape(B, S, H, Dh).transpose(0, 2, 1, 3)
    k = k.reshape(B, S, H, Dh).transpose(0, 2, 1, 3)
    v = v.reshape(B, S, H, Dh).transpose(0, 2, 1, 3)
    scale = Dh ** -0.5
    outs = []
    for i in range(S // SB_BLOCK):
        q0 = i * SB_BLOCK
        kend = q0 + SB_BLOCK
        qb = q[:, :, q0:kend]
        kb = k[:, :, :kend]
        vb = v[:, :, :kend]
        z = jnp.einsum('bhtd,bhsd->bhts', qb, kb).astype(jnp.float32) * scale
        t_pos = q0 + jnp.arange(SB_BLOCK)
        s_pos = jnp.arange(kend)
        visible = s_pos[None, :] < t_pos[:, None]
        log_beta = jax.nn.log_sigmoid(z)
        log_keep = jnp.where(visible, jax.nn.log_sigmoid(-z), 0.0)
        tail = lax.cumsum(log_keep, axis=3, reverse=True) - log_keep
        w = jnp.where(visible, jnp.exp(log_beta + tail), 0.0)
        outs.append(jnp.einsum('bhts,bhsd->bhtd', w, vb.astype(jnp.float32)))
    y = jnp.concatenate(outs, axis=2)
    return y.transpose(0, 2, 1, 3).reshape(B, S, SB_W)


def mamba2(z, xbc, dt_raw, conv_w, conv_b, dt_bias, a_log, d_skip, norm_gain):
    B, S, _ = xbc.shape
    G, Hg, P, N = SSM_GROUPS, SSM_HEADS // SSM_GROUPS, SSM_HEAD_DIM, SSM_STATE
    nc = S // CHUNK
    xbc = lax.conv_general_dilated(
        xbc, conv_w[:, None, :], window_strides=(1,), padding=[(SSM_CONV - 1, 0)],
        dimension_numbers=('NWC', 'WIO', 'NWC'), feature_group_count=SSM_XBC) + conv_b
    xbc = jax.nn.silu(xbc).astype(jnp.float32)
    xs = xbc[..., :SSM_W].reshape(B, nc, CHUNK, G, Hg, P)
    bm = xbc[..., SSM_W:SSM_W + G * N].reshape(B, nc, CHUNK, G, N)
    cm = xbc[..., SSM_W + G * N:].reshape(B, nc, CHUNK, G, N)
    dt = jax.nn.softplus(dt_raw.astype(jnp.float32) + dt_bias).reshape(B, nc, CHUNK, G, Hg)
    a = -jnp.exp(a_log.astype(jnp.float32)).reshape(G, Hg)
    acum = jnp.cumsum(dt * a, axis=2)
    xdt = xs * dt[..., None]
    causal = jnp.tril(jnp.ones((CHUNK, CHUNK), dtype=bool))[None, None, :, :, None, None]
    seg = acum[:, :, :, None] - acum[:, :, None, :]
    decay = jnp.exp(jnp.where(causal, seg, -jnp.inf))
    cb = jnp.einsum('bclgn,bcsgn->bcgls', cm, bm)
    y_intra = jnp.einsum('bcgls,bclsgh,bcsghp->bclghp', cb, decay, xdt)
    decay_end = jnp.exp(acum[:, :, -1:] - acum)
    states = jnp.einsum('bcsgn,bcsgh,bcsghp->bcghpn', bm, decay_end, xdt)
    chunk_decay = jnp.exp(acum[:, :, -1])

    def step(h, inp):
        st, dec = inp
        return h * dec[..., None, None] + st, h

    _, h_prev = lax.scan(step, jnp.zeros((B, G, Hg, P, N), jnp.float32),
                         (jnp.moveaxis(states, 1, 0), jnp.moveaxis(chunk_decay, 1, 0)))
    h_prev = jnp.moveaxis(h_prev, 0, 1)
    y_inter = jnp.einsum('bclgn,bcghpn,bclgh->bclghp', cm, h_prev, jnp.exp(acum))
    y = y_intra + y_inter + xs * d_skip.astype(jnp.float32).reshape(G, Hg)[..., None]
    y = y.reshape(B, S, SSM_W)
    return rmsnorm(y * jax.nn.silu(z.astype(jnp.float32)), norm_gain)


def setup_inputs(seed: int = 0) -> dict:
    key = jax.random.key(seed)
    ks = jax.random.split(key, 32)
    f32 = jnp.float32
    nrm = lambda k, shape, s: jax.random.normal(k, shape, f32) * s
    gain = lambda k, shape: 1.0 + 0.01 * jax.random.normal(k, shape, f32)
    dt0 = jnp.exp(jax.random.uniform(ks[11], (DEPTH, SSM_HEADS), f32, math.log(1e-3), math.log(1e-1)))
    return {
        "x": nrm(ks[0], (BATCH, SEQ, D_MODEL), 1.0),
        "c": nrm(ks[1], (BATCH, D_MODEL), 1.0),
        "ada_w": nrm(ks[2], (DEPTH, D_MODEL, 3 * N_SUB * D_MODEL), 0.1 * D_MODEL ** -0.5),
        "ada_b": nrm(ks[3], (DEPTH, 3 * N_SUB * D_MODEL), 0.01),
        "norm_ffn1": gain(ks[4], (DEPTH, D_MODEL)),
        "ffn1_wg": nrm(ks[5], (DEPTH, D_MODEL, D_FF), D_MODEL ** -0.5),
        "ffn1_wu": nrm(ks[6], (DEPTH, D_MODEL, D_FF), D_MODEL ** -0.5),
        "ffn1_wd": nrm(ks[7], (DEPTH, D_FF, D_MODEL), D_FF ** -0.5),
        "norm_mix": gain(ks[8], (DEPTH, D_MODEL)),
        "w_in": nrm(ks[9], (DEPTH, D_MODEL, IN_W), D_MODEL ** -0.5),
        "conv_w": nrm(ks[10], (DEPTH, SSM_CONV, SSM_XBC), SSM_CONV ** -0.5),
        "conv_b": nrm(ks[12], (DEPTH, SSM_XBC), 0.01),
        "dt_bias": dt0 + jnp.log(-jnp.expm1(-dt0)),
        "a_log": jnp.log(jax.random.uniform(ks[13], (DEPTH, SSM_HEADS), f32, 1.0, 16.0)),
        "d_skip": gain(ks[14], (DEPTH, SSM_HEADS)),
        "ret_gn": gain(ks[15], (DEPTH, RET_W)),
        "ssm_norm": gain(ks[16], (DEPTH, SSM_W)),
        "w_out": nrm(ks[17], (DEPTH, MIX_W, D_MODEL), MIX_W ** -0.5),
        "norm_ffn2": gain(ks[18], (DEPTH, D_MODEL)),
        "ffn2_wg": nrm(ks[19], (DEPTH, D_MODEL, D_FF), D_MODEL ** -0.5),
        "ffn2_wu": nrm(ks[20], (DEPTH, D_MODEL, D_FF), D_MODEL ** -0.5),
        "ffn2_wd": nrm(ks[21], (DEPTH, D_FF, D_MODEL), D_FF ** -0.5),
        "final_ada_w": nrm(ks[22], (D_MODEL, 2 * D_MODEL), 0.1 * D_MODEL ** -0.5),
        "final_ada_b": nrm(ks[23], (2 * D_MODEL,), 0.01),
        "final_norm": gain(ks[24], (D_MODEL,)),
    }


def reference(x, c, ada_w, ada_b, norm_ffn1, ffn1_wg, ffn1_wu, ffn1_wd, norm_mix, w_in,
              conv_w, conv_b, dt_bias, a_log, d_skip, ret_gn, ssm_norm, w_out,
              norm_ffn2, ffn2_wg, ffn2_wu, ffn2_wd, final_ada_w, final_ada_b, final_norm):
    B, S, _ = x.shape
    cond = jax.nn.silu(c)
    splits = [RET_W, 2 * RET_W, 3 * RET_W, 4 * RET_W,
              4 * RET_W + SB_W, 4 * RET_W + 2 * SB_W, 4 * RET_W + 3 * SB_W,
              4 * RET_W + 3 * SB_W + SSM_W, 4 * RET_W + 3 * SB_W + SSM_W + SSM_XBC]
    h = x
    for l in range(DEPTH):
        mod = (cond @ ada_w[l] + ada_b[l]).reshape(B, 3 * N_SUB, D_MODEL)[:, None]
        u = modulate(rmsnorm(h, norm_ffn1[l]), mod[:, :, 0], mod[:, :, 1])
        h = h + 0.5 * (1.0 + mod[:, :, 2]) * swiglu(u, ffn1_wg[l], ffn1_wu[l], ffn1_wd[l])
        u = modulate(rmsnorm(h, norm_mix[l]), mod[:, :, 3], mod[:, :, 4])
        proj = u @ w_in[l]
        rq, rk, rv, rg, sq, sk, sv, mz, mxbc, mdt = jnp.split(proj, splits, axis=-1)
        y_ret = retention(rq, rk, rv, rg, ret_gn[l]).astype(x.dtype)
        y_sb = stick_breaking(sq, sk, sv).astype(x.dtype)
        y_ssm = mamba2(mz, mxbc, mdt, conv_w[l], conv_b[l], dt_bias[l], a_log[l],
                       d_skip[l], ssm_norm[l]).astype(x.dtype)
        mixed = jnp.concatenate([y_ret, y_sb, y_ssm], axis=-1) @ w_out[l]
        h = h + (1.0 + mod[:, :, 5]) * mixed
        u = modulate(rmsnorm(h, norm_ffn2[l]), mod[:, :, 6], mod[:, :, 7])
        h = h + 0.5 * (1.0 + mod[:, :, 8]) * swiglu(u, ffn2_wg[l], ffn2_wu[l], ffn2_wd[l])
    fmod = (cond @ final_ada_w + final_ada_b).reshape(B, 2, D_MODEL)[:, None]
    return modulate(rmsnorm(h, final_norm), fmod[:, :, 0], fmod[:, :, 1])
```

```cpp
#include <hip/hip_runtime.h>
#include <hip/hip_cooperative_groups.h>
#include <cstdint>
#include <cstdio>
namespace cg = cooperative_groups;

#ifndef ONE_LAUNCH
#define ONE_LAUNCH 1
#endif

#ifndef EN_ALL
#define EN_ALL 1
#endif
#ifndef EN_PRO
#define EN_PRO EN_ALL
#endif
#ifndef EN_FIN
#define EN_FIN EN_ALL
#endif
#ifndef EN_NORM
#define EN_NORM EN_ALL
#endif
#ifndef EN_CONV
#define EN_CONV EN_ALL
#endif
#ifndef EN_G1
#define EN_G1 EN_ALL
#endif
#ifndef EN_G2
#define EN_G2 EN_ALL
#endif
#ifndef EN_G3
#define EN_G3 EN_ALL
#endif
#ifndef EN_DT
#define EN_DT EN_ALL
#endif
#ifndef EN_SB
#define EN_SB EN_ALL
#endif
#ifndef EN_RKV
#define EN_RKV EN_ALL
#endif
#ifndef EN_SST
#define EN_SST EN_ALL
#endif
#ifndef EN_SCAN
#define EN_SCAN EN_ALL
#endif
#ifndef EN_ROUT
#define EN_ROUT EN_ALL
#endif
#ifndef EN_SOUT
#define EN_SOUT EN_ALL
#endif
#ifndef EN_SINTER
#define EN_SINTER 1
#endif
#define LAS __attribute__((address_space(3)))
typedef unsigned short bf16_t;
typedef short bf16x8 __attribute__((ext_vector_type(8)));
typedef float f32x4 __attribute__((ext_vector_type(4)));
typedef float f32x2 __attribute__((ext_vector_type(2)));
typedef unsigned u32x4 __attribute__((ext_vector_type(4)));
typedef unsigned u32x2 __attribute__((ext_vector_type(2)));

constexpr int T_TOK = 32768, SEQ = 8192, DM = 1024, DFF = 2816, INW = 5128, PW = 5120;
constexpr int NTHR = 512, NWAVE = 8;
constexpr float EPS = 1e-6f;
constexpr int C_RQ = 0, C_SQ = 512, C_MZ = 1024, C_RK = 1536, C_RV = 2048, C_RG = 2560, C_SK = 3072, C_SV = 3584, C_XBC = 4096;

constexpr size_t MiB = 1u << 20;
constexpr size_t WS_MOD = 1 * MiB, WS_ROPE = 2 * MiB, WS_DT = 6 * MiB, WS_CD = 7 * MiB;
constexpr size_t WS_WFU = 8 * MiB, WS_WFD = 19 * MiB, WS_WIN = 25 * MiB, WS_WOUT = 35 * MiB;
constexpr size_t WS_U = 38 * MiB, WS_RST = 38 * MiB, WS_SST = 102 * MiB, WS_PROJ = 166 * MiB, WS_END = 486 * MiB;
constexpr int FMOD_OFF = 2 * 4 * 9 * 1024;

constexpr int LDS_BYTES = 147456;

struct Params {
    const float* in[25];
    float* out;
    unsigned char* ws;
    int ph_lo, ph_hi;
};

typedef __bf16 bf16x2_t __attribute__((ext_vector_type(2)));
__device__ __forceinline__ unsigned cvt_pk_bf16(float lo, float hi) { const f32x2 v = {lo, hi}; const bf16x2_t b = __builtin_convertvector(v, bf16x2_t); return __builtin_bit_cast(unsigned, b); }
__device__ __forceinline__ float bf_lo(unsigned u) { return __uint_as_float(u << 16); }
__device__ __forceinline__ float bf_hi(unsigned u) { return __uint_as_float(u & 0xffff0000u); }
__device__ __forceinline__ float bf2f(bf16_t x) { return __uint_as_float(((unsigned)x) << 16); }
__device__ __forceinline__ bf16_t f2bf(float f) { return (bf16_t)(cvt_pk_bf16(f, 0.f) & 0xffffu); }
__device__ __forceinline__ float wave_sum(float v) {
#pragma unroll
    for (int o = 1; o < 64; o <<= 1) v += __shfl_xor(v, o);
    return v;
}
__device__ __forceinline__ float wave_max(float v) {
#pragma unroll
    for (int o = 1; o < 64; o <<= 1) v = fmaxf(v, __shfl_xor(v, o));
    return v;
}
__device__ __forceinline__ float silu_f(float g) { return g * __builtin_amdgcn_rcpf(1.0f + __builtin_amdgcn_exp2f(-1.44269504f * g)); }
__device__ __forceinline__ f32x4 mfma16(bf16x8 a, bf16x8 b, f32x4 c) { return __builtin_amdgcn_mfma_f32_16x16x32_bf16(a, b, c, 0, 0, 0); }
__device__ __forceinline__ bf16x8 ldsfrag(const LAS unsigned char* p) { return *(const LAS bf16x8*)p; }
__device__ __forceinline__ u32x2 pack4(f32x4 v) { u32x2 w; w.x = cvt_pk_bf16(v[0], v[1]); w.y = cvt_pk_bf16(v[2], v[3]); return w; }
__device__ __forceinline__ void unpack8(u32x4 v, float* f) {
    f[0] = bf_lo(v.x); f[1] = bf_hi(v.x); f[2] = bf_lo(v.y); f[3] = bf_hi(v.y); f[4] = bf_lo(v.z); f[5] = bf_hi(v.z); f[6] = bf_lo(v.w); f[7] = bf_hi(v.w);
}
__device__ __forceinline__ float log2gamma(int h) { return h == 0 ? -0.04580368961312479f : (h == 1 ? -0.02272007650008353f : (h == 2 ? -0.011315313227834146f : -0.005646563141142063f)); }

namespace pg8 {
constexpr int BM = 256, BK = 64, HALF = 128, HTB = HALF * BK * 2, STAGE_BYTES = 8 * HTB, NXCD = 8, WGM = 8;
__host__ __device__ __forceinline__ int lds_byte(int r, int c) { const int st = (r >> 4) * 2 + (c >> 5), rr = r & 15, cc = c & 31, ob = rr * 64 + cc * 2; return st * 1024 + (ob ^ (((ob >> 9) & 1) << 5)); }
__host__ __device__ __forceinline__ void stage_rc(int b, int& R, int& C) { const int st = b / 1024, sb = b % 1024, swz = sb ^ (((sb >> 9) & 1) << 5); R = (st >> 1) * 16 + swz / 64; C = (st & 1) * 32 + (swz % 64) / 2; }
__host__ __device__ __forceinline__ int perm32(int rho) { const int n = rho >> 4, i = rho & 15; return 8 * (i >> 2) + 4 * n + (i & 3); }
struct Unit { int pm, pn; };
struct Gemm { const bf16_t* A; const bf16_t* Bt; int M, N, K, lda; };
struct StaticOrder {
    int nM, nN, nwg, G, c;
    __device__ void init(int M, int N, int G_, int c_) { nM = M / BM; nN = N / BM; nwg = nM * nN; G = G_; c = c_; }
    __device__ bool next(int i, Unit& u) const {
        const long L = (long)i * G + c; if (L >= nwg) return false;
        int wgid = (int)L; { const int q = nwg / NXCD, r = nwg % NXCD, xcd = wgid % NXCD, off = wgid / NXCD; wgid = (xcd < r ? xcd * (q + 1) : r * (q + 1) + (xcd - r) * q) + off; }
        const int nig = WGM * nN, gid = wgid / nig, fm = gid * WGM, gsz = (nM - fm) < WGM ? (nM - fm) : WGM;
        u.pm = fm + ((wgid % nig) % gsz); u.pn = (wgid % nig) / gsz; return true;
    }
};
struct EpiBf16 {
    bf16_t* O; int ldc;
    __device__ __forceinline__ void operator()(const f32x4 (&acc)[2][2][4][2], const Unit& u, int wr, int wc, int fr, int fq) const {
        const int row0 = u.pm * BM + wr * 64 + fr, col0 = u.pn * BM + wc * 32 + 8 * fq;
#pragma unroll
        for (int ai = 0; ai < 2; ++ai)
#pragma unroll
            for (int m = 0; m < 4; ++m) { bf16_t* rowp = O + (size_t)(row0 + ai * HALF + m * 16) * ldc + col0;
#pragma unroll
                for (int bj = 0; bj < 2; ++bj) { const f32x4 v0 = acc[ai][bj][m][0], v1 = acc[ai][bj][m][1];
                    u32x4 w; w.x = cvt_pk_bf16(v0[0], v0[1]); w.y = cvt_pk_bf16(v0[2], v0[3]); w.z = cvt_pk_bf16(v1[0], v1[1]); w.w = cvt_pk_bf16(v1[2], v1[3]);
                    *(u32x4*)(rowp + bj * HALF) = w; } }
    }
};
struct EpiSwiGLU {
    bf16_t* O; int ldo;
    __device__ __forceinline__ void operator()(const f32x4 (&acc)[2][2][4][2], const Unit& u, int wr, int wc, int fr, int fq) const {
        const int row0 = u.pm * BM + wr * 64 + fr, col0 = u.pn * HALF + wc * 32 + 8 * fq;
#pragma unroll
        for (int ai = 0; ai < 2; ++ai)
#pragma unroll
            for (int m = 0; m < 4; ++m) { bf16_t* rowp = O + (size_t)(row0 + ai * HALF + m * 16) * ldo + col0;
                float hv[8];
#pragma unroll
                for (int n = 0; n < 2; ++n)
#pragma unroll
                    for (int i = 0; i < 4; ++i) hv[4 * n + i] = silu_f(acc[ai][0][m][n][i]) * acc[ai][1][m][n][i];
                u32x4 w; w.x = cvt_pk_bf16(hv[0], hv[1]); w.y = cvt_pk_bf16(hv[2], hv[3]); w.z = cvt_pk_bf16(hv[4], hv[5]); w.w = cvt_pk_bf16(hv[6], hv[7]);
                *(u32x4*)rowp = w; }
    }
};
struct EpiResid {
    const float* hin; float* hout; const float* gate; float cmul;
    __device__ __forceinline__ void operator()(const f32x4 (&acc)[2][2][4][2], const Unit& u, int wr, int wc, int fr, int fq) const {
        const int row0 = u.pm * BM + wr * 64 + fr, col0 = u.pn * BM + wc * 32 + 8 * fq;
        const int b = (u.pm * BM) >> 13;
        f32x4 gm[2][2];
#pragma unroll
        for (int bj = 0; bj < 2; ++bj)
#pragma unroll
            for (int n = 0; n < 2; ++n) { const f32x4 g = *(const f32x4*)(gate + (size_t)b * 9216 + col0 + bj * HALF + 4 * n); gm[bj][n] = (g + 1.0f) * cmul; }
#pragma unroll
        for (int ai = 0; ai < 2; ++ai)
#pragma unroll
            for (int m = 0; m < 4; ++m) { const size_t off = (size_t)(row0 + ai * HALF + m * 16) * DM + col0;
#pragma unroll
                for (int bj = 0; bj < 2; ++bj)
#pragma unroll
                    for (int n = 0; n < 2; ++n) { const f32x4 hv = *(const f32x4*)(hin + off + bj * HALF + 4 * n);
                        *(f32x4*)(hout + off + bj * HALF + 4 * n) = hv + gm[bj][n] * acc[ai][bj][m][n]; } }
    }
};

template <class Epi>
__device__ __forceinline__ void gemm_phase(LAS unsigned char* lds, const int tid, const Gemm g, const StaticOrder& S, const Epi& E) {
    const int wid = __builtin_amdgcn_readfirstlane(tid >> 6), lane = tid & 63, wr = wid >> 2, wc = wid & 3, fr = lane & 15, fq = lane >> 4;
    const int K = g.K, nt = K / BK, lda = g.lda;
    unsigned voffA[2], voffB[2];
#pragma unroll
    for (int i = 0; i < 2; ++i) { int R, C; stage_rc(tid * 16 + i * 8192, R, C); const int Rb = (R & ~31) + perm32(R & 31);
        voffA[i] = (unsigned)(R * lda + C) * 2u; voffB[i] = (unsigned)(Rb * K + C) * 2u; }
    const size_t kstep = (size_t)(BK * 2);
    const size_t hstepA = (size_t)HALF * lda * 2, hstepB = (size_t)HALF * K * 2;
    const size_t tstepA = 2 * hstepA, tstepB = 2 * hstepB;
    const unsigned ldsw = (unsigned)wid * 1024u;
    const int aoff = lds_byte(wr * 64 + fr, fq * 8), boff = lds_byte(wc * 32 + fr, fq * 8);
#define PG8_SA(b, h) (((b) * 2 + (h)) * HTB)
#define PG8_SB(b, h) ((4 + (b) * 2 + (h)) * HTB)
#define PG8_STAGE(bufoff, gbase, voff) do { _Pragma("unroll") for (int _i = 0; _i < 2; ++_i) \
        __builtin_amdgcn_global_load_lds((const unsigned*)((const char*)(gbase) + (voff)[_i]), (LAS unsigned*)(lds + (bufoff) + ldsw + _i * 8192), 16, 0, 0); } while (0)
#define PG8_LDA(dst, b, h) do { _Pragma("unroll") for (int m = 0; m < 4; ++m) _Pragma("unroll") for (int k = 0; k < 2; ++k) dst[m][k] = *(const LAS bf16x8*)(lds + PG8_SA(b, h) + aoff + m * 2048 + k * 1024); } while (0)
#define PG8_LDB(dst, b, h) do { _Pragma("unroll") for (int n = 0; n < 2; ++n) _Pragma("unroll") for (int k = 0; k < 2; ++k) dst[n][k] = *(const LAS bf16x8*)(lds + PG8_SB(b, h) + boff + n * 2048 + k * 1024); } while (0)
#define PG8_MMA(ai, bj, At, Bt) do { __builtin_amdgcn_s_setprio(1); _Pragma("unroll") for (int m = 0; m < 4; ++m) _Pragma("unroll") for (int n = 0; n < 2; ++n) _Pragma("unroll") for (int k = 0; k < 2; ++k) \
        acc[ai][bj][m][n] = __builtin_amdgcn_mfma_f32_16x16x32_bf16(Bt[n][k], At[m][k], acc[ai][bj][m][n], 0, 0, 0); __builtin_amdgcn_s_setprio(0); } while (0)
#define PG8_WAIT_V(n) asm volatile("s_waitcnt vmcnt(" #n ")" ::: "memory")
#define PG8_WAIT_L(n) asm volatile("s_waitcnt lgkmcnt(" #n ")" ::: "memory")
#define PG8_BAR __builtin_amdgcn_s_barrier()
#define PG8_SCHED __builtin_amdgcn_sched_barrier(0)
    Unit cur, nxt; int ui = 0;
    if (!S.next(0, cur)) return;
    f32x4 acc[2][2][4][2];
#pragma unroll
    for (int a = 0; a < 2; ++a)
#pragma unroll
        for (int b = 0; b < 2; ++b)
#pragma unroll
            for (int m = 0; m < 4; ++m)
#pragma unroll
                for (int n = 0; n < 2; ++n) acc[a][b][m][n] = (f32x4){0.f, 0.f, 0.f, 0.f};
    bf16x8 At[4][2], B0[2][2], B1[2][2];
    const char* cA = (const char*)g.A + (size_t)cur.pm * tstepA; const char* cB = (const char*)g.Bt + (size_t)cur.pn * tstepB;
    PG8_STAGE(PG8_SB(0, 0), cB, voffB); PG8_STAGE(PG8_SB(0, 1), cB + hstepB, voffB); PG8_STAGE(PG8_SA(0, 0), cA, voffA); PG8_STAGE(PG8_SA(0, 1), cA + hstepA, voffA);
    if (wr == 1) PG8_BAR;
    PG8_WAIT_V(2); PG8_BAR;
    PG8_STAGE(PG8_SB(1, 0), cB + kstep, voffB); PG8_STAGE(PG8_SA(1, 0), cA + kstep, voffA); PG8_STAGE(PG8_SB(1, 1), cB + hstepB + kstep, voffB);
    PG8_WAIT_V(6); PG8_BAR;
    for (;;) {
        const bool has_next = S.next(ui + 1, nxt);
        const char* nA = has_next ? (const char*)g.A + (size_t)nxt.pm * tstepA : cA; const char* nB = has_next ? (const char*)g.Bt + (size_t)nxt.pn * tstepB : cB;
        for (int t = 0; t < nt; t += 2) {
            const bool last = (t == nt - 2);
            const char* a1 = cA + (size_t)(t + 1) * kstep;
            const char* a2 = last ? nA : cA + (size_t)(t + 2) * kstep; const char* b2 = last ? nB : cB + (size_t)(t + 2) * kstep;
            const char* a3 = a2 + kstep; const char* b3 = b2 + kstep;
            PG8_LDB(B0, 0, 0); PG8_LDB(B1, 0, 1); PG8_SCHED; PG8_LDA(At, 0, 0); PG8_STAGE(PG8_SA(1, 1), a1 + hstepA, voffA);
            PG8_WAIT_V(8); PG8_WAIT_L(0); PG8_BAR; PG8_MMA(0, 0, At, B0); PG8_MMA(0, 1, At, B1); PG8_BAR; PG8_SCHED;
            PG8_LDA(At, 0, 1); PG8_STAGE(PG8_SB(0, 0), b2, voffB); PG8_STAGE(PG8_SB(0, 1), b2 + hstepB, voffB); PG8_STAGE(PG8_SA(0, 0), a2, voffA);
            PG8_WAIT_V(8); PG8_WAIT_L(0); PG8_BAR; PG8_MMA(1, 0, At, B0); PG8_MMA(1, 1, At, B1); PG8_BAR; PG8_SCHED;
            PG8_LDB(B0, 1, 0); PG8_LDB(B1, 1, 1); PG8_SCHED; PG8_LDA(At, 1, 0); PG8_STAGE(PG8_SA(0, 1), a2 + hstepA, voffA);
            PG8_WAIT_V(8); PG8_WAIT_L(0); PG8_BAR; PG8_MMA(0, 0, At, B0); PG8_MMA(0, 1, At, B1); PG8_BAR; PG8_SCHED;
            PG8_LDA(At, 1, 1); PG8_STAGE(PG8_SB(1, 0), b3, voffB); PG8_STAGE(PG8_SB(1, 1), b3 + hstepB, voffB); PG8_STAGE(PG8_SA(1, 0), a3, voffA);
            PG8_WAIT_V(8); PG8_WAIT_L(0); PG8_BAR; PG8_MMA(1, 0, At, B0); PG8_MMA(1, 1, At, B1); PG8_BAR; PG8_SCHED;
        }
        if (wr == 0) PG8_BAR;
        E(acc, cur, wr, wc, fr, fq);
        if (!has_next) break;
#pragma unroll
        for (int a = 0; a < 2; ++a)
#pragma unroll
            for (int b = 0; b < 2; ++b)
#pragma unroll
                for (int m = 0; m < 4; ++m)
#pragma unroll
                    for (int n = 0; n < 2; ++n) acc[a][b][m][n] = (f32x4){0.f, 0.f, 0.f, 0.f};
        cur = nxt; cA = nA; cB = nB; ++ui;
        if (wr == 1) PG8_BAR;
    }
    PG8_WAIT_V(0);
    PG8_BAR;
#undef PG8_SA
#undef PG8_SB
#undef PG8_STAGE
#undef PG8_LDA
#undef PG8_LDB
#undef PG8_MMA
#undef PG8_WAIT_V
#undef PG8_WAIT_L
#undef PG8_BAR
#undef PG8_SCHED
}
}

struct Frame {
    LAS unsigned char* lds;
    int tid, lane, wave, G, bid;
};

__device__ __forceinline__ void conv_item(const float* W, int Nsrc, int K, int src_col0, bf16_t* WT, int dst_row0, int k0, LAS float* scr, int lane) {
#pragma unroll 8
    for (int i = 0; i < 32; ++i) { const int kk = 2 * i + (lane >> 5); scr[kk * 33 + (lane & 31)] = W[(size_t)(k0 + kk) * Nsrc + src_col0 + (lane & 31)]; }
    asm volatile("s_waitcnt lgkmcnt(0)" ::: "memory");
    const int c = lane & 7;
#pragma unroll
    for (int j = 0; j < 4; ++j) { const int n = (lane >> 3) + 8 * j; const LAS float* s = scr + (8 * c) * 33 + n;
        u32x4 o; o.x = cvt_pk_bf16(s[0 * 33], s[1 * 33]); o.y = cvt_pk_bf16(s[2 * 33], s[3 * 33]); o.z = cvt_pk_bf16(s[4 * 33], s[5 * 33]); o.w = cvt_pk_bf16(s[6 * 33], s[7 * 33]);
        *(u32x4*)(WT + (size_t)(dst_row0 + n) * K + k0 + 8 * c) = o; }
    asm volatile("s_waitcnt lgkmcnt(0)" ::: "memory");
}
__device__ __forceinline__ void convert_ffn(const Frame& F, const float* wg, const float* wu, const float* wd, bf16_t* WFU, bf16_t* WFD) {
    LAS float* scr = (LAS float*)(F.lds + F.wave * 16384);
    const int gw = F.bid * NWAVE + F.wave, NGW = F.G * NWAVE;
    constexpr int I_U = 16 * 176, I_D = 44 * 32;
    for (int it = gw; it < I_U + I_D; it += NGW) {
        if (it < I_U) { const int kb = it / 176, nb = it % 176, r0 = nb * 32, pn = r0 >> 8, i0 = r0 & 255;
            conv_item(i0 < 128 ? wg : wu, DFF, DM, pn * 128 + (i0 & 127), WFU, r0, kb * 64, scr, F.lane); }
        else { const int r = it - I_U, kb = r / 32, nb = r % 32; conv_item(wd, DM, DFF, nb * 32, WFD, nb * 32, kb * 64, scr, F.lane); }
    }
}
__device__ __forceinline__ void convert_mix(const Frame& F, const float* w_in, const float* w_out, bf16_t* WIN, bf16_t* WOUT) {
    LAS float* scr = (LAS float*)(F.lds + F.wave * 16384);
    const int gw = F.bid * NWAVE + F.wave, NGW = F.G * NWAVE;
    constexpr int I_I = 16 * 160, I_O = 24 * 32;
    for (int it = gw; it < I_I + I_O; it += NGW) {
        if (it < I_I) { const int kb = it / 160, nb = it % 160, r0 = nb * 32, blk = r0 >> 9;
            const int sb = blk == 0 ? 0 : blk == 1 ? 4 : blk == 2 ? 7 : blk == 3 ? 1 : blk == 4 ? 2 : blk == 5 ? 3 : blk == 6 ? 5 : blk == 7 ? 6 : blk;
            conv_item(w_in, INW, DM, sb * 512 + (r0 & 511), WIN, r0, kb * 64, scr, F.lane); }
        else { const int r = it - I_I, kb = r / 32, nb = r % 32; conv_item(w_out, DM, 1536, nb * 32, WOUT, nb * 32, kb * 64, scr, F.lane); }
    }
}

__device__ __forceinline__ void sincos_d(double x, double& s, double& c) {
    const double k = rint(x * 0.63661977236758134308);
    double r = fma(-k, 1.57079632679489655800e+00, x); r = fma(-k, 6.12323399573676603587e-17, r);
    const double r2 = r * r;
    double sp = -7.6471637318198164759e-13; sp = sp * r2 + 1.6059043836821614599e-10; sp = sp * r2 - 2.5052108385441718775e-08; sp = sp * r2 + 2.7557319223985890653e-06;
    sp = sp * r2 - 1.9841269841269841270e-04; sp = sp * r2 + 8.3333333333333333333e-03; sp = sp * r2 - 1.6666666666666666667e-01; const double sn = r + r * r2 * sp;
    double cp = 4.7794773323873852974e-14; cp = cp * r2 - 1.1470745597729724714e-11; cp = cp * r2 + 2.0876756987868098979e-09; cp = cp * r2 - 2.7557319223985890653e-07;
    cp = cp * r2 + 2.4801587301587301587e-05; cp = cp * r2 - 1.3888888888888888889e-03; cp = cp * r2 + 4.1666666666666666667e-02; cp = cp * r2 - 0.5; const double cs = 1.0 + r2 * cp;
    const int q = ((int)k) & 3;
    s = (q == 0) ? sn : (q == 1) ? cs : (q == 2) ? -sn : -cs;
    c = (q == 0) ? cs : (q == 1) ? -sn : (q == 2) ? -cs : sn;
}
__device__ __forceinline__ void prologue(const Frame& F, const Params& p, unsigned char* ws, int zi) {
    LAS float* cs = (LAS float*)F.lds;
    LAS float* red = (LAS float*)(F.lds + 16384);
    const float* c = p.in[1 + zi];
    for (int i = F.tid; i < 4096; i += NTHR) cs[i] = silu_f(c[i]);
    __syncthreads();
    float* MOD = (float*)(ws + WS_MOD);
    for (int task = F.bid; task < 320; task += F.G) {
        const float* W; const float* bias; int N, n0; float* dst; int dstride;
        if (task < 288) { const int l = task / 144, t = task % 144; W = p.in[2 + zi] + (size_t)l * DM * 9216; bias = p.in[3 + zi] + l * 9216; N = 9216; n0 = t * 64; dst = MOD + (size_t)l * 4 * 9216; dstride = 9216; }
        else { const int t = task - 288; W = p.in[22 + zi]; bias = p.in[23 + zi]; N = 2048; n0 = t * 64; dst = MOD + FMOD_OFF; dstride = 2048; }
        float a0 = 0.f, a1 = 0.f, a2 = 0.f, a3 = 0.f;
        const int kb = F.wave * 128;
#pragma unroll 8
        for (int k = 0; k < 128; ++k) { const float w = W[(size_t)(kb + k) * N + n0 + F.lane];
            a0 += cs[kb + k] * w; a1 += cs[1024 + kb + k] * w; a2 += cs[2048 + kb + k] * w; a3 += cs[3072 + kb + k] * w; }
        red[(F.wave * 4 + 0) * 64 + F.lane] = a0; red[(F.wave * 4 + 1) * 64 + F.lane] = a1; red[(F.wave * 4 + 2) * 64 + F.lane] = a2; red[(F.wave * 4 + 3) * 64 + F.lane] = a3;
        __syncthreads();
        if (F.tid < 256) { const int b = F.tid >> 6, col = F.tid & 63; float s = bias[n0 + col];
#pragma unroll
            for (int w = 0; w < 8; ++w) s += red[(w * 4 + b) * 64 + col];
            dst[(size_t)b * dstride + n0 + col] = s; }
        __syncthreads();
    }
    f32x2* ROPE = (f32x2*)(ws + WS_ROPE);
    for (int idx = F.bid * NTHR + F.tid; idx < SEQ * 64; idx += F.G * NTHR) {
        const int pos = idx >> 6, i = idx & 63;
        const float invf = (float)exp(-(double)i * (9.210340371976184 / 64.0));
        const float ang = (float)pos * invf;
        double s, cc; sincos_d((double)ang, s, cc);
        ROPE[idx] = (f32x2){(float)cc, (float)s};
    }
}

__device__ __forceinline__ void norm_phase(const Frame& F, const float* h, const float* gain, const float* shift0, const float* scale0, int bstride, bf16_t* U) {
    const int gw = F.bid * NWAVE + F.wave, NGW = F.G * NWAVE;
    for (int m = gw; m < T_TOK; m += NGW) {
        const int b = m >> 13;
        const f32x4* xr = (const f32x4*)(h + (size_t)m * DM) + F.lane;
        f32x4 v[4]; float s = 0.f;
#pragma unroll
        for (int j = 0; j < 4; ++j) { v[j] = xr[64 * j]; s += (v[j].x * v[j].x + v[j].y * v[j].y) + (v[j].z * v[j].z + v[j].w * v[j].w); }
        const float rstd = rsqrtf(wave_sum(s) * (1.f / DM) + EPS);
        u32x2* o8 = (u32x2*)(U + (size_t)m * DM) + F.lane;
#pragma unroll
        for (int j = 0; j < 4; ++j) {
            const f32x4 g = ((const f32x4*)gain)[F.lane + 64 * j], sh = ((const f32x4*)(shift0 + (size_t)b * bstride))[F.lane + 64 * j], sc = ((const f32x4*)(scale0 + (size_t)b * bstride))[F.lane + 64 * j];
            const f32x4 y = v[j] * rstd * g * (sc + 1.0f) + sh;
            o8[64 * j] = pack4(y);
        }
    }
}
__device__ __forceinline__ void final_phase(const Frame& F, float* h, const float* gain, const float* fmod) {
    const int gw = F.bid * NWAVE + F.wave, NGW = F.G * NWAVE;
    for (int m = gw; m < T_TOK; m += NGW) {
        const int b = m >> 13;
        f32x4* xr = (f32x4*)(h + (size_t)m * DM) + F.lane;
        f32x4 v[4]; float s = 0.f;
#pragma unroll
        for (int j = 0; j < 4; ++j) { v[j] = xr[64 * j]; s += (v[j].x * v[j].x + v[j].y * v[j].y) + (v[j].z * v[j].z + v[j].w * v[j].w); }
        const float rstd = rsqrtf(wave_sum(s) * (1.f / DM) + EPS);
#pragma unroll
        for (int j = 0; j < 4; ++j) {
            const f32x4 g = ((const f32x4*)gain)[F.lane + 64 * j], sh = ((const f32x4*)(fmod + (size_t)b * 2048))[F.lane + 64 * j], sc = ((const f32x4*)(fmod + (size_t)b * 2048 + 1024))[F.lane + 64 * j];
            xr[64 * j] = v[j] * rstd * g * (sc + 1.0f) + sh;
        }
    }
}

__device__ __forceinline__ void dt_gemv(const Frame& F, const bf16_t* U, const float* w_in, float* DT) {
    LAS float* Wd = (LAS float*)F.lds;
    __syncthreads();
    for (int idx = F.tid; idx < 8192; idx += NTHR) { const int k = idx >> 3, j = idx & 7; Wd[8 * k + 4 * (k >> 3) + j] = w_in[(size_t)k * INW + 5120 + j]; }
    __syncthreads();
    const int gw = F.bid * NWAVE + F.wave, NGW = F.G * NWAVE;
    for (int m = gw; m < T_TOK; m += NGW) {
        float acc[8];
#pragma unroll
        for (int j = 0; j < 8; ++j) acc[j] = 0.f;
#pragma unroll
        for (int hf = 0; hf < 2; ++hf) {
            const u32x4 uv = *(const u32x4*)(U + (size_t)m * DM + 512 * hf + 8 * F.lane);
            float uf[8]; unpack8(uv, uf);
#pragma unroll
            for (int kk = 0; kk < 8; ++kk) { const int k = 512 * hf + 8 * F.lane + kk; const LAS float* wp = Wd + 8 * k + 4 * (k >> 3);
                const f32x4 w0 = *(const LAS f32x4*)wp, w1 = *(const LAS f32x4*)(wp + 4);
                acc[0] += uf[kk] * w0.x; acc[1] += uf[kk] * w0.y; acc[2] += uf[kk] * w0.z; acc[3] += uf[kk] * w0.w;
                acc[4] += uf[kk] * w1.x; acc[5] += uf[kk] * w1.y; acc[6] += uf[kk] * w1.z; acc[7] += uf[kk] * w1.w; }
        }
#pragma unroll
        for (int j = 0; j < 8; ++j) acc[j] = wave_sum(acc[j]);
        if (F.lane < 8) { float v = acc[0];
#pragma unroll
            for (int j = 1; j < 8; ++j) v = (F.lane == j) ? acc[j] : v;
            DT[(size_t)m * 8 + F.lane] = v; }
    }
    __syncthreads();
}

__device__ __forceinline__ void sb_task(const Frame& F, bf16_t* P, int b, int h, int qb) {
    LAS unsigned char* Ks = F.lds;
    LAS unsigned char* Vt = F.lds + 17408;
    LAS unsigned char* Pw = F.lds + 35840 + F.wave * 2304;
    LAS float* red = (LAS float*)(F.lds + 54272);
    int lane = F.lane; asm volatile("" : "+v"(lane)); const int wid = F.wave, fr = lane & 15, fq = lane >> 4;
    const size_t rowbase = (size_t)b * SEQ;
    const int q0 = qb * 128, trow = q0 + 16 * wid + fr;
    bf16x8 qf[4];
    { const bf16_t* qp = P + (rowbase + trow) * PW + C_SQ + h * 128 + 8 * fq;
#pragma unroll
      for (int s = 0; s < 4; ++s) qf[s] = *(const bf16x8*)(qp + 32 * s); }
    f32x4 o[8];
#pragma unroll
    for (int i = 0; i < 8; ++i) o[i] = (f32x4){0.f, 0.f, 0.f, 0.f};
    float R = 0.f;
    for (int kt = 2 * qb + 1; kt >= 0; --kt) {
        __syncthreads();
#pragma unroll
        for (int i = 0; i < 2; ++i) { const int idx = F.tid + NTHR * i, key = idx >> 4, c8 = idx & 15;
            const bf16_t* src = P + (rowbase + 64 * kt + key) * PW + h * 128 + 8 * c8;
            const u32x4 kv = *(const u32x4*)(src + C_SK), vv = *(const u32x4*)(src + C_SV);
            *(LAS u32x4*)(Ks + key * 272 + c8 * 16) = kv;
            LAS bf16_t* vd = (LAS bf16_t*)(Vt + (8 * c8) * 144 + key * 2);
            vd[0 * 72] = (bf16_t)(vv.x & 0xffff); vd[1 * 72] = (bf16_t)(vv.x >> 16); vd[2 * 72] = (bf16_t)(vv.y & 0xffff); vd[3 * 72] = (bf16_t)(vv.y >> 16);
            vd[4 * 72] = (bf16_t)(vv.z & 0xffff); vd[5 * 72] = (bf16_t)(vv.z >> 16); vd[6 * 72] = (bf16_t)(vv.w & 0xffff); vd[7 * 72] = (bf16_t)(vv.w >> 16); }
        __syncthreads();
        if (64 * kt < q0 + 16 * wid + 15) {
            f32x4 sc[4];
#pragma unroll
            for (int j = 0; j < 4; ++j) { sc[j] = (f32x4){0.f, 0.f, 0.f, 0.f};
#pragma unroll
                for (int s = 0; s < 4; ++s) sc[j] = mfma16(ldsfrag(Ks + (16 * j + fr) * 272 + (32 * s + 8 * fq) * 2), qf[s], sc[j]); }
            float lk[4][4], lb[4][4], Tj[4], Wj[4], Gj[4];
#pragma unroll
            for (int j = 0; j < 4; ++j) { float t = 0.f;
#pragma unroll
                for (int i = 0; i < 4; ++i) { const float z = sc[j][i] * 0.08838834764831845f; const int key = 64 * kt + 16 * j + 4 * fq + i; const bool vis = key < trow;
                    const float e = __expf(-fabsf(z)); const float sp = fmaxf(z, 0.f) + __logf(1.0f + e);
                    lk[j][i] = vis ? -sp : 0.f; lb[j][i] = vis ? (z - sp) : -1e30f; t += lk[j][i]; }
                Tj[j] = t; }
#pragma unroll
            for (int j = 0; j < 4; ++j) { const float a1 = __shfl_xor(Tj[j], 16), a2 = __shfl_xor(Tj[j], 32), a3 = __shfl_xor(Tj[j], 48);
                Wj[j] = Tj[j] + a1 + a2 + a3;
                Gj[j] = (((fq ^ 1) > fq) ? a1 : 0.f) + (((fq ^ 2) > fq) ? a2 : 0.f) + (((fq ^ 3) > fq) ? a3 : 0.f); }
            float suf = 0.f;
#pragma unroll
            for (int j = 3; j >= 0; --j) { float tl = R + suf + Gj[j]; f32x4 w;
                w[3] = __expf(lb[j][3] + tl); tl += lk[j][3];
                w[2] = __expf(lb[j][2] + tl); tl += lk[j][2];
                w[1] = __expf(lb[j][1] + tl); tl += lk[j][1];
                w[0] = __expf(lb[j][0] + tl);
                *(LAS u32x2*)(Pw + fr * 144 + (16 * j + 4 * fq) * 2) = pack4(w);
                suf += Wj[j]; }
            R += suf;
#pragma unroll
            for (int ks = 0; ks < 2; ++ks) { const bf16x8 pf = ldsfrag(Pw + fr * 144 + (32 * ks + 8 * fq) * 2);
#pragma unroll
                for (int dt = 0; dt < 8; ++dt) o[dt] = mfma16(ldsfrag(Vt + (16 * dt + fr) * 144 + (32 * ks + 8 * fq) * 2), pf, o[dt]); }
        }
        const float rm = wave_max(R);
        if (lane == 0) red[wid] = rm;
        __syncthreads();
        float mx = red[0];
#pragma unroll
        for (int w = 1; w < 8; ++w) mx = fmaxf(mx, red[w]);
        if (mx < -120.f) break;
    }
    bf16_t* op = P + (rowbase + trow) * PW + C_SQ + h * 128 + 4 * fq;
#pragma unroll
    for (int dt = 0; dt < 8; ++dt) *(u32x2*)(op + 16 * dt) = pack4(o[dt]);
}

__device__ __forceinline__ void ret_kv_task(const Frame& F, const bf16_t* P, const f32x2* ROPE, bf16_t* RST, int b, int c, int h) {
    LAS unsigned char* KT = F.lds;
    LAS unsigned char* VT = F.lds + 18432;
    int lane = F.lane; asm volatile("" : "+v"(lane)); const int fr = lane & 15, fq = lane >> 4;
    const float l2g = log2gamma(h);
    __syncthreads();
    { const int s = F.tid >> 3, g8 = F.tid & 7; const size_t row = (size_t)b * SEQ + c * 64 + s; const int pos = c * 64 + s;
      const bf16_t* kp = P + row * PW + C_RK + h * 128 + 8 * g8;
      const u32x4 k1 = *(const u32x4*)kp, k2 = *(const u32x4*)(kp + 64);
      float x1[8], x2[8]; unpack8(k1, x1); unpack8(k2, x2);
      const f32x4* cp = (const f32x4*)(ROPE + pos * 64 + 8 * g8);
      const float dec = __builtin_amdgcn_exp2f(l2g * (float)(63 - s)) * 0.08838834764831845f;
      LAS bf16_t* kd = (LAS bf16_t*)(KT + (8 * g8) * 144 + s * 2);
#pragma unroll
      for (int jj = 0; jj < 4; ++jj) { const f32x4 cs = cp[jj];
          { const int j = 2 * jj; const float y1 = (x1[j] * cs.x - x2[j] * cs.y) * dec, y2 = (x1[j] * cs.y + x2[j] * cs.x) * dec; kd[j * 72] = f2bf(y1); kd[(64 + j) * 72] = f2bf(y2); }
          { const int j = 2 * jj + 1; const float y1 = (x1[j] * cs.z - x2[j] * cs.w) * dec, y2 = (x1[j] * cs.w + x2[j] * cs.z) * dec; kd[j * 72] = f2bf(y1); kd[(64 + j) * 72] = f2bf(y2); } }
      const bf16_t* vp = P + row * PW + C_RV + h * 128 + 16 * g8;
#pragma unroll
      for (int hh = 0; hh < 2; ++hh) { const u32x4 vv = *(const u32x4*)(vp + 8 * hh);
          LAS bf16_t* vd = (LAS bf16_t*)(VT + (16 * g8 + 8 * hh) * 144 + s * 2);
          vd[0 * 72] = (bf16_t)(vv.x & 0xffff); vd[1 * 72] = (bf16_t)(vv.x >> 16); vd[2 * 72] = (bf16_t)(vv.y & 0xffff); vd[3 * 72] = (bf16_t)(vv.y >> 16);
          vd[4 * 72] = (bf16_t)(vv.z & 0xffff); vd[5 * 72] = (bf16_t)(vv.z >> 16); vd[6 * 72] = (bf16_t)(vv.w & 0xffff); vd[7 * 72] = (bf16_t)(vv.w >> 16); } }
    __syncthreads();
    const int w = F.wave;
    bf16x8 xf[2];
#pragma unroll
    for (int ks = 0; ks < 2; ++ks) xf[ks] = ldsfrag(KT + (16 * w + fr) * 144 + (32 * ks + 8 * fq) * 2);
    bf16_t* dst = RST + (size_t)((b * 128 + c) * 4 + h) * 16384;
#pragma unroll
    for (int et = 0; et < 8; ++et) { f32x4 acc = (f32x4){0.f, 0.f, 0.f, 0.f};
#pragma unroll
        for (int ks = 0; ks < 2; ++ks) acc = mfma16(xf[ks], ldsfrag(VT + (16 * et + fr) * 144 + (32 * ks + 8 * fq) * 2), acc);
        *(u32x2*)(dst + (16 * et + fr) * 128 + 16 * w + 4 * fq) = pack4(acc); }
}

__device__ __forceinline__ void ret_out_task(const Frame& F, bf16_t* P, const f32x2* ROPE, const bf16_t* RST, const float* gn, int b, int c, int h) {
    LAS unsigned char* Kr = F.lds;
    LAS unsigned char* VT = F.lds + 17408;
    LAS unsigned char* Sx = F.lds + 35840;
    LAS unsigned char* Pw = F.lds + 70656 + F.wave * 2304;
    LAS float* ssq = (LAS float*)(F.lds + 89088);
    int lane = F.lane; asm volatile("" : "+v"(lane)); const int fr = lane & 15, fq = lane >> 4, w = F.wave, lt = w & 3, eh = w >> 2;
    const float l2g = log2gamma(h);
    const int unit = (b * 128 + c) * 4 + h;
    __syncthreads();
    { const int s = F.tid >> 3, g8 = F.tid & 7; const size_t row = (size_t)b * SEQ + c * 64 + s; const int pos = c * 64 + s;
      const bf16_t* kp = P + row * PW + C_RK + h * 128 + 8 * g8;
      const u32x4 k1 = *(const u32x4*)kp, k2 = *(const u32x4*)(kp + 64);
      float x1[8], x2[8], y1[8], y2[8]; unpack8(k1, x1); unpack8(k2, x2);
      const f32x4* cp = (const f32x4*)(ROPE + pos * 64 + 8 * g8);
#pragma unroll
      for (int jj = 0; jj < 4; ++jj) { const f32x4 cs = cp[jj];
          { const int j = 2 * jj; y1[j] = (x1[j] * cs.x - x2[j] * cs.y) * 0.08838834764831845f; y2[j] = (x1[j] * cs.y + x2[j] * cs.x) * 0.08838834764831845f; }
          { const int j = 2 * jj + 1; y1[j] = (x1[j] * cs.z - x2[j] * cs.w) * 0.08838834764831845f; y2[j] = (x1[j] * cs.w + x2[j] * cs.z) * 0.08838834764831845f; } }
      u32x4 o1, o2; o1.x = cvt_pk_bf16(y1[0], y1[1]); o1.y = cvt_pk_bf16(y1[2], y1[3]); o1.z = cvt_pk_bf16(y1[4], y1[5]); o1.w = cvt_pk_bf16(y1[6], y1[7]);
      o2.x = cvt_pk_bf16(y2[0], y2[1]); o2.y = cvt_pk_bf16(y2[2], y2[3]); o2.z = cvt_pk_bf16(y2[4], y2[5]); o2.w = cvt_pk_bf16(y2[6], y2[7]);
      *(LAS u32x4*)(Kr + s * 272 + (8 * g8) * 2) = o1; *(LAS u32x4*)(Kr + s * 272 + (64 + 8 * g8) * 2) = o2;
      const bf16_t* vp = P + row * PW + C_RV + h * 128 + 16 * g8;
#pragma unroll
      for (int hh = 0; hh < 2; ++hh) { const u32x4 vv = *(const u32x4*)(vp + 8 * hh);
          LAS bf16_t* vd = (LAS bf16_t*)(VT + (16 * g8 + 8 * hh) * 144 + s * 2);
          vd[0 * 72] = (bf16_t)(vv.x & 0xffff); vd[1 * 72] = (bf16_t)(vv.x >> 16); vd[2 * 72] = (bf16_t)(vv.y & 0xffff); vd[3 * 72] = (bf16_t)(vv.y >> 16);
          vd[4 * 72] = (bf16_t)(vv.z & 0xffff); vd[5 * 72] = (bf16_t)(vv.z >> 16); vd[6 * 72] = (bf16_t)(vv.w & 0xffff); vd[7 * 72] = (bf16_t)(vv.w >> 16); }
      const bf16_t* sp = RST + (size_t)unit * 16384;
#pragma unroll
      for (int i = 0; i < 4; ++i) { const int idx = F.tid + NTHR * i, e = idx >> 4, c16 = idx & 15;
          *(LAS u32x4*)(Sx + e * 272 + c16 * 16) = *(const u32x4*)(sp + e * 128 + 8 * c16); } }
    const int l = 16 * lt + fr; const size_t qrow = (size_t)b * SEQ + c * 64 + l; const int qpos = c * 64 + l;
    bf16x8 qf[4];
    { const bf16_t* qp = P + qrow * PW + C_RQ + h * 128 + 8 * fq;
      u32x4 qv[4];
#pragma unroll
      for (int s = 0; s < 4; ++s) qv[s] = *(const u32x4*)(qp + 32 * s);
#pragma unroll
      for (int s = 0; s < 2; ++s) { float x1[8], x2[8], y1[8], y2[8]; unpack8(qv[s], x1); unpack8(qv[s + 2], x2);
          const f32x4* cp = (const f32x4*)(ROPE + qpos * 64 + 32 * s + 8 * fq);
#pragma unroll
          for (int jj = 0; jj < 4; ++jj) { const f32x4 cs = cp[jj];
              { const int j = 2 * jj; y1[j] = x1[j] * cs.x - x2[j] * cs.y; y2[j] = x1[j] * cs.y + x2[j] * cs.x; }
              { const int j = 2 * jj + 1; y1[j] = x1[j] * cs.z - x2[j] * cs.w; y2[j] = x1[j] * cs.w + x2[j] * cs.z; } }
          u32x4 o1, o2; o1.x = cvt_pk_bf16(y1[0], y1[1]); o1.y = cvt_pk_bf16(y1[2], y1[3]); o1.z = cvt_pk_bf16(y1[4], y1[5]); o1.w = cvt_pk_bf16(y1[6], y1[7]);
          o2.x = cvt_pk_bf16(y2[0], y2[1]); o2.y = cvt_pk_bf16(y2[2], y2[3]); o2.z = cvt_pk_bf16(y2[4], y2[5]); o2.w = cvt_pk_bf16(y2[6], y2[7]);
          qf[s] = __builtin_bit_cast(bf16x8, o1); qf[s + 2] = __builtin_bit_cast(bf16x8, o2); } }
    __syncthreads();
#pragma unroll
    for (int j = 0; j < 4; ++j) { f32x4 acc = (f32x4){0.f, 0.f, 0.f, 0.f};
#pragma unroll
        for (int ks = 0; ks < 4; ++ks) acc = mfma16(ldsfrag(Kr + (16 * j + fr) * 272 + (32 * ks + 8 * fq) * 2), qf[ks], acc);
#pragma unroll
        for (int i = 0; i < 4; ++i) { const int s = 16 * j + 4 * fq + i; acc[i] *= __builtin_amdgcn_exp2f(l2g * fabsf((float)(l - s))); }
        *(LAS u32x2*)(Pw + fr * 144 + (16 * j + 4 * fq) * 2) = pack4(acc); }
    f32x4 y[4];
    const float qdec = __builtin_amdgcn_exp2f(l2g * (float)(l + 1));
#pragma unroll
    for (int et = 0; et < 4; ++et) { y[et] = (f32x4){0.f, 0.f, 0.f, 0.f};
#pragma unroll
        for (int ks = 0; ks < 4; ++ks) y[et] = mfma16(ldsfrag(Sx + (64 * eh + 16 * et + fr) * 272 + (32 * ks + 8 * fq) * 2), qf[ks], y[et]);
        y[et] = y[et] * qdec; }
#pragma unroll
    for (int ks = 0; ks < 2; ++ks) { const bf16x8 pf = ldsfrag(Pw + fr * 144 + (32 * ks + 8 * fq) * 2);
#pragma unroll
        for (int et = 0; et < 4; ++et) y[et] = mfma16(ldsfrag(VT + (64 * eh + 16 * et + fr) * 144 + (32 * ks + 8 * fq) * 2), pf, y[et]); }
    float ss = 0.f;
#pragma unroll
    for (int et = 0; et < 4; ++et) ss += (y[et][0] * y[et][0] + y[et][1] * y[et][1]) + (y[et][2] * y[et][2] + y[et][3] * y[et][3]);
    ss += __shfl_xor(ss, 16); ss += __shfl_xor(ss, 32);
    if (fq == 0) ssq[w * 16 + fr] = ss;
    __syncthreads();
    const float rstd = rsqrtf((ssq[w * 16 + fr] + ssq[(w ^ 4) * 16 + fr]) * (1.f / 128.f) + EPS);
#pragma unroll
    for (int et = 0; et < 4; ++et) { const int e0 = 64 * eh + 16 * et + 4 * fq;
        const u32x2 gv = *(const u32x2*)(P + qrow * PW + C_RG + h * 128 + e0);
        const f32x4 gg = *(const f32x4*)(gn + h * 128 + e0);
        f32x4 r;
        r[0] = y[et][0] * rstd * gg[0] * silu_f(bf_lo(gv.x)); r[1] = y[et][1] * rstd * gg[1] * silu_f(bf_hi(gv.x));
        r[2] = y[et][2] * rstd * gg[2] * silu_f(bf_lo(gv.y)); r[3] = y[et][3] * rstd * gg[3] * silu_f(bf_hi(gv.y));
        *(u32x2*)(P + qrow * PW + C_RQ + h * 128 + e0) = pack4(r); }
}

__device__ __forceinline__ float softplus_f(float x) { return fmaxf(x, 0.f) + log1pf(__expf(-fabsf(x))); }
__device__ __forceinline__ void conv8(const bf16_t* P, const float* cw, const float* cb, int b, int tpos, int col, float* v) {
    const int chan = col - C_XBC;
    { const f32x4 b0 = *(const f32x4*)(cb + chan), b1 = *(const f32x4*)(cb + chan + 4);
      v[0] = b0.x; v[1] = b0.y; v[2] = b0.z; v[3] = b0.w; v[4] = b1.x; v[5] = b1.y; v[6] = b1.z; v[7] = b1.w; }
#pragma unroll
    for (int j = 0; j < 4; ++j) { const int ts = tpos - 3 + j;
        if (ts >= 0) { const u32x4 xv = *(const u32x4*)(P + ((size_t)b * SEQ + ts) * PW + col); float xf[8]; unpack8(xv, xf);
            const f32x4 w0 = *(const f32x4*)(cw + j * 1024 + chan), w1 = *(const f32x4*)(cw + j * 1024 + chan + 4);
            v[0] += xf[0] * w0.x; v[1] += xf[1] * w0.y; v[2] += xf[2] * w0.z; v[3] += xf[3] * w0.w; v[4] += xf[4] * w1.x; v[5] += xf[5] * w1.y; v[6] += xf[6] * w1.z; v[7] += xf[7] * w1.w; } }
#pragma unroll
    for (int i = 0; i < 8; ++i) v[i] = silu_f(v[i]);
}
__device__ __forceinline__ float dt_scan(const float* DT, const float* dt_bias, const float* a_log, int b, int c, int hd, int lane, float& dtv) {
    const size_t t = (size_t)b * SEQ + c * 64 + lane;
    dtv = softplus_f(DT[t * 8 + hd] + dt_bias[hd]);
    float x = dtv * (-__expf(a_log[hd]));
#pragma unroll
    for (int o = 1; o < 64; o <<= 1) { const float y = __shfl_up(x, o); if (lane >= o) x += y; }
    return x;
}

__device__ __forceinline__ void ssd_state_task(const Frame& F, const bf16_t* P, const float* DT, const float* cw, const float* cb, const float* dt_bias, const float* a_log,
                                               bf16_t* SST, float* CD, int b, int c, int g) {
    LAS unsigned char* XT = F.lds;
    LAS unsigned char* BT = F.lds + 36864;
    LAS float* dtl = (LAS float*)(F.lds + 55296);
    LAS float* acl = (LAS float*)(F.lds + 56320);
    int lane = F.lane; asm volatile("" : "+v"(lane)); const int fr = lane & 15, fq = lane >> 4, w = F.wave;
    __syncthreads();
    if (w < 4) { float dtv; const float cum = dt_scan(DT, dt_bias, a_log, b, c, 4 * g + w, lane, dtv);
        dtl[lane * 4 + w] = dtv; acl[lane * 4 + w] = cum;
        if (lane == 63) CD[(b * 128 + c) * 8 + 4 * g + w] = __expf(cum); }
    __syncthreads();
#pragma unroll 1
    for (int i = 0; i < 6; ++i) { int idx = F.tid + NTHR * i; asm volatile("" : "+v"(idx)); const int cgi = idx % 48, s = idx / 48;
        const int col = (cgi < 32) ? (C_XBC + g * 256 + 8 * cgi) : (C_XBC + 512 + g * 128 + 8 * (cgi - 32));
        float v[8]; conv8(P, cw, cb, b, c * 64 + s, col, v);
        if (cgi < 32) { const int hl = cgi >> 3; const float f = dtl[s * 4 + hl] * __expf(acl[63 * 4 + hl] - acl[s * 4 + hl]);
            LAS bf16_t* d = (LAS bf16_t*)(XT + (8 * cgi) * 144 + s * 2);
#pragma unroll
            for (int j = 0; j < 8; ++j) d[j * 72] = f2bf(v[j] * f); }
        else { LAS bf16_t* d = (LAS bf16_t*)(BT + (8 * (cgi - 32)) * 144 + s * 2);
#pragma unroll
            for (int j = 0; j < 8; ++j) d[j * 72] = f2bf(v[j]); } }
    __syncthreads();
    const int hl = w >> 1, ph = w & 1;
    bf16x8 yf[2][2];
#pragma unroll
    for (int pt = 0; pt < 2; ++pt)
#pragma unroll
        for (int ks = 0; ks < 2; ++ks) yf[pt][ks] = ldsfrag(XT + (hl * 64 + ph * 32 + 16 * pt + fr) * 144 + (32 * ks + 8 * fq) * 2);
    bf16_t* dst = SST + (size_t)((b * 128 + c) * 8 + 4 * g + hl) * 8192;
#pragma unroll
    for (int nt = 0; nt < 8; ++nt) { f32x4 a0 = (f32x4){0.f, 0.f, 0.f, 0.f}, a1 = a0;
#pragma unroll
        for (int ks = 0; ks < 2; ++ks) { const bf16x8 xf = ldsfrag(BT + (16 * nt + fr) * 144 + (32 * ks + 8 * fq) * 2); a0 = mfma16(xf, yf[0][ks], a0); a1 = mfma16(xf, yf[1][ks], a1); }
#ifdef PROBE_CONST
        a0 = (f32x4){0.01f, 0.02f, 0.03f, 0.04f}; a1 = a0;
#endif
        *(u32x2*)(dst + (ph * 32 + fr) * 128 + 16 * nt + 4 * fq) = pack4(a0);
        *(u32x2*)(dst + (ph * 32 + 16 + fr) * 128 + 16 * nt + 4 * fq) = pack4(a1); }
}

__device__ __forceinline__ void ssd_out_task(const Frame& F, bf16_t* P, const float* DT, const float* cw, const float* cb, const float* dt_bias, const float* a_log,
                                             const float* d_skip, const float* nrm, const bf16_t* SST, int b, int c) {
    LAS unsigned char* Bs = F.lds;
    LAS unsigned char* Cs = F.lds + 17408;
    LAS unsigned char* XT = F.lds + 34816;
    LAS unsigned char* Pw = F.lds + 71680 + F.wave * 2304;
    LAS float* dtl = (LAS float*)(F.lds + 90112);
    LAS float* acl = (LAS float*)(F.lds + 92160);
    LAS float* ssq = (LAS float*)(F.lds + 94208);
    int lane = F.lane; asm volatile("" : "+v"(lane)); const int fr = lane & 15, fq = lane >> 4, w = F.wave, hl = w >> 1, half = w & 1;
    __syncthreads();
    { float dtv; const float cum = dt_scan(DT, dt_bias, a_log, b, c, w, lane, dtv); dtl[lane * 8 + w] = dtv; acl[lane * 8 + w] = cum; }
    u32x2 yk[2][2][4]; float ssl[2] = {0.f, 0.f};
#pragma unroll
    for (int g = 0; g < 2; ++g) {
        __syncthreads();
#pragma unroll 1
        for (int i = 0; i < 8; ++i) { int idx = F.tid + NTHR * i; asm volatile("" : "+v"(idx)); const int cgi = idx & 63, s = idx >> 6;
            const int col = (cgi < 32) ? (C_XBC + g * 256 + 8 * cgi) : (cgi < 48) ? (C_XBC + 512 + g * 128 + 8 * (cgi - 32)) : (C_XBC + 768 + g * 128 + 8 * (cgi - 48));
            float v[8]; conv8(P, cw, cb, b, c * 64 + s, col, v);
            if (cgi < 32) { LAS bf16_t* d = (LAS bf16_t*)(XT + (8 * cgi) * 144 + s * 2);
#pragma unroll
                for (int j = 0; j < 8; ++j) d[j * 72] = f2bf(v[j]); }
            else { u32x4 o; o.x = cvt_pk_bf16(v[0], v[1]); o.y = cvt_pk_bf16(v[2], v[3]); o.z = cvt_pk_bf16(v[4], v[5]); o.w = cvt_pk_bf16(v[6], v[7]);
                if (cgi < 48) *(LAS u32x4*)(Bs + s * 272 + (8 * (cgi - 32)) * 2) = o; else *(LAS u32x4*)(Cs + s * 272 + (8 * (cgi - 48)) * 2) = o; } }
        __syncthreads();
        const int head = 4 * g + hl;
        const bf16_t* hsrc = SST + (size_t)((b * 128 + c) * 8 + head) * 8192;
        const float dsk = d_skip[head];
#pragma unroll
        for (int li = 0; li < 2; ++li) {
            asm volatile("" ::: "memory"); __builtin_amdgcn_sched_barrier(0);
            const int lt = 2 * half + li, l = 16 * lt + fr;
            const float al = acl[l * 8 + head];
            bf16x8 cf[4];
#pragma unroll
            for (int ks = 0; ks < 4; ++ks) cf[ks] = ldsfrag(Cs + (16 * lt + fr) * 272 + (32 * ks + 8 * fq) * 2);
            f32x4 y[4];
#pragma unroll
            for (int pt = 0; pt < 4; ++pt) y[pt] = (f32x4){0.f, 0.f, 0.f, 0.f};
#pragma unroll 1
            for (int ks = 0; ks < (EN_SINTER ? 4 : 0); ++ks) { const bf16x8 cfk = ldsfrag(Cs + (16 * lt + fr) * 272 + (32 * ks + 8 * fq) * 2);
#pragma unroll
                for (int pt = 0; pt < 4; ++pt) { const bf16x8 hf = *(const bf16x8*)(hsrc + (16 * pt + fr) * 128 + 32 * ks + 8 * fq); y[pt] = mfma16(hf, cfk, y[pt]); } }
            { const float eal = __expf(al);
#pragma unroll
              for (int pt = 0; pt < 4; ++pt) y[pt] = y[pt] * eal; }
#pragma unroll
            for (int st = 0; st < 4; ++st) { f32x4 acc = (f32x4){0.f, 0.f, 0.f, 0.f};
                if (st <= lt) {
#pragma unroll
                    for (int ks = 0; ks < 4; ++ks) acc = mfma16(ldsfrag(Bs + (16 * st + fr) * 272 + (32 * ks + 8 * fq) * 2), cf[ks], acc);
#pragma unroll
                    for (int i = 0; i < 4; ++i) { const int s = 16 * st + 4 * fq + i;
                        acc[i] = (s <= l) ? acc[i] * __expf(al - acl[s * 8 + head]) * dtl[s * 8 + head] : 0.f; } }
                *(LAS u32x2*)(Pw + fr * 144 + (16 * st + 4 * fq) * 2) = pack4(acc); }
#pragma unroll
            for (int ks = 0; ks < 2; ++ks) { if (2 * ks <= lt) { const bf16x8 pf = ldsfrag(Pw + fr * 144 + (32 * ks + 8 * fq) * 2);
#pragma unroll
                for (int pt = 0; pt < 4; ++pt) y[pt] = mfma16(ldsfrag(XT + (hl * 64 + 16 * pt + fr) * 144 + (32 * ks + 8 * fq) * 2), pf, y[pt]); } }
            const size_t row = (size_t)b * SEQ + c * 64 + l;
#pragma unroll
            for (int pt = 0; pt < 4; ++pt) { const int p0 = 16 * pt + 4 * fq;
                const u32x2 zv = *(const u32x2*)(P + row * PW + C_MZ + head * 64 + p0);
                const LAS bf16_t* xp = (const LAS bf16_t*)(XT + (hl * 64 + p0) * 144 + l * 2);
                f32x4 r;
                r[0] = (y[pt][0] + bf2f(xp[0 * 72]) * dsk) * silu_f(bf_lo(zv.x)); r[1] = (y[pt][1] + bf2f(xp[1 * 72]) * dsk) * silu_f(bf_hi(zv.x));
                r[2] = (y[pt][2] + bf2f(xp[2 * 72]) * dsk) * silu_f(bf_lo(zv.y)); r[3] = (y[pt][3] + bf2f(xp[3 * 72]) * dsk) * silu_f(bf_hi(zv.y));
                ssl[li] += (r[0] * r[0] + r[1] * r[1]) + (r[2] * r[2] + r[3] * r[3]); yk[g][li][pt] = pack4(r); }
        }
    }
#pragma unroll
    for (int li = 0; li < 2; ++li) { float ss = ssl[li];
        ss += __shfl_xor(ss, 16); ss += __shfl_xor(ss, 32);
        if (fq == 0) ssq[hl * 64 + 16 * (2 * half + li) + fr] = ss; }
    __syncthreads();
#pragma unroll
    for (int li = 0; li < 2; ++li) { const int l = 16 * (2 * half + li) + fr;
        const float rstd = rsqrtf((ssq[l] + ssq[64 + l] + ssq[128 + l] + ssq[192 + l]) * (1.f / 512.f) + EPS);
        const size_t row = (size_t)b * SEQ + c * 64 + l;
#pragma unroll
        for (int g = 0; g < 2; ++g)
#pragma unroll
            for (int pt = 0; pt < 4; ++pt) { const int ch = (4 * g + hl) * 64 + 16 * pt + 4 * fq;
                const f32x4 ng = *(const f32x4*)(nrm + ch);
                const u32x2 pk = yk[g][li][pt]; const f32x4 r = (f32x4){bf_lo(pk.x), bf_hi(pk.x), bf_lo(pk.y), bf_hi(pk.y)};
                *(u32x2*)(P + row * PW + C_MZ + ch) = pack4(r * rstd * ng); } }
}

__device__ __forceinline__ void scan_phase(const Frame& F, bf16_t* RST, bf16_t* SST, const float* CD) {
    for (int task = F.bid * NTHR + F.tid; task < 131072; task += F.G * NTHR) {
        {
          const int pr = task & 8191, bh = task >> 13, b = bh >> 2, h = bh & 3;
          unsigned* p = (unsigned*)(RST + (size_t)((b * 128) * 4 + h) * 16384) + pr;
          const float dec = __builtin_amdgcn_exp2f(64.f * log2gamma(h));
          float s0 = 0.f, s1 = 0.f;
          for (int c0 = 0; c0 < 128; c0 += 8) { unsigned v[8];
#pragma unroll
              for (int i = 0; i < 8; ++i) v[i] = p[(size_t)(c0 + i) * 32768];
#pragma unroll
              for (int i = 0; i < 8; ++i) { p[(size_t)(c0 + i) * 32768] = cvt_pk_bf16(s0, s1); s0 = s0 * dec + bf_lo(v[i]); s1 = s1 * dec + bf_hi(v[i]); } } }
        {
          const int pr = task & 4095, bh = task >> 12, b = bh >> 3, hd = bh & 7;
          unsigned* p = (unsigned*)(SST + (size_t)((b * 128) * 8 + hd) * 8192) + pr;
          const float* cd = CD + (b * 128) * 8 + hd;
          float s0 = 0.f, s1 = 0.f;
          for (int c0 = 0; c0 < 128; c0 += 8) { unsigned v[8]; float d[8];
#pragma unroll
              for (int i = 0; i < 8; ++i) { v[i] = p[(size_t)(c0 + i) * 32768]; d[i] = cd[(c0 + i) * 8]; }
#pragma unroll
              for (int i = 0; i < 8; ++i) { p[(size_t)(c0 + i) * 32768] = cvt_pk_bf16(s0, s1); s0 = s0 * d[i] + bf_lo(v[i]); s1 = s1 * d[i] + bf_hi(v[i]); } } }
    }
}

constexpr int NPH = 26;
__global__ void __launch_bounds__(NTHR, 2) fwd_kernel(Params p) {
    extern __shared__ __attribute__((aligned(16))) unsigned char lds_raw[];
    if (p.ph_lo == 0) {
        Frame F0; F0.lds = (LAS unsigned char*)lds_raw; F0.tid = threadIdx.x; F0.lane = F0.tid & 63; F0.wave = __builtin_amdgcn_readfirstlane(F0.tid >> 6); F0.G = gridDim.x; F0.bid = blockIdx.x;
        if (EN_PRO) prologue(F0, p, p.ws, 0);
        if (p.ph_hi > 1) cg::this_grid().sync();
    }
    for (int ph_ = (p.ph_lo < 1 ? 1 : p.ph_lo); ph_ < p.ph_hi; ++ph_) {
    int ph = __builtin_amdgcn_readfirstlane(ph_);
#ifdef PH_LIMIT
    if (ph > PH_LIMIT && ph < NPH - 1) continue;
#endif
    int tid_ = threadIdx.x; asm volatile("" : "+v"(tid_));
    unsigned char* ws = p.ws; asm volatile("" : "+s"(ws));
    int zi = 0; asm volatile("" : "+s"(zi));
    Frame F;
    F.lds = (LAS unsigned char*)lds_raw;
    F.tid = tid_; F.lane = F.tid & 63; F.wave = __builtin_amdgcn_readfirstlane(F.tid >> 6); { int g_ = gridDim.x, b_ = blockIdx.x; asm volatile("" : "+s"(g_), "+s"(b_)); F.G = g_; F.bid = b_; }
    float* MOD = (float*)(ws + WS_MOD);
    const f32x2* ROPE = (const f32x2*)(ws + WS_ROPE);
    float* DT = (float*)(ws + WS_DT);
    float* CD = (float*)(ws + WS_CD);
    bf16_t* WFU = (bf16_t*)(ws + WS_WFU); bf16_t* WFD = (bf16_t*)(ws + WS_WFD); bf16_t* WIN = (bf16_t*)(ws + WS_WIN); bf16_t* WOUT = (bf16_t*)(ws + WS_WOUT);
    bf16_t* U = (bf16_t*)(ws + WS_U); bf16_t* RST = (bf16_t*)(ws + WS_RST); bf16_t* SST = (bf16_t*)(ws + WS_SST);
    bf16_t* PROJ = (bf16_t*)(ws + WS_PROJ); bf16_t* HID = PROJ;
    float* hbuf = p.out; asm volatile("" : "+s"(hbuf));
        if (ph == NPH - 1) {
            if (EN_FIN) final_phase(F, hbuf, p.in[24 + zi], MOD + FMOD_OFF);
        } else {
            const int l = (ph - 1) / 12, j = (ph - 1) % 12;
            const float* modl = MOD + (size_t)l * 4 * 9216;
            if (j == 0 || j == 3 || j == 9) {
                const float* hin = (l == 0 && j == 0) ? p.in[0 + zi] : hbuf;
                const int gi = (j == 0) ? 4 : (j == 3) ? 8 : 18;
                const int mi = (j == 0) ? 0 : (j == 3) ? 3 : 6;
                if (EN_NORM) norm_phase(F, hin, p.in[gi + zi] + l * DM, modl + mi * 1024, modl + (mi + 1) * 1024, 9216, U);
                __syncthreads();
                if (!EN_CONV) {} else if (j == 0) convert_ffn(F, p.in[5 + zi] + (size_t)l * DM * DFF, p.in[6 + zi] + (size_t)l * DM * DFF, p.in[7 + zi] + (size_t)l * DM * DFF, WFU, WFD);
                else if (j == 9) convert_ffn(F, p.in[19 + zi] + (size_t)l * DM * DFF, p.in[20 + zi] + (size_t)l * DM * DFF, p.in[21 + zi] + (size_t)l * DM * DFF, WFU, WFD);
                else convert_mix(F, p.in[9 + zi] + (size_t)l * DM * INW, p.in[17 + zi] + (size_t)l * 1536 * DM, WIN, WOUT);
            } else if (j == 1 || j == 10) {
                pg8::Gemm g{U, WFU, T_TOK, 2 * DFF, DM, DM}; pg8::StaticOrder S; S.init(T_TOK, 2 * DFF, F.G, F.bid);
                pg8::EpiSwiGLU E{HID, DFF};
                if (EN_G1) pg8::gemm_phase<pg8::EpiSwiGLU>(F.lds, F.tid, g, S, E);
            } else if (j == 2 || j == 11 || j == 8) {
                pg8::Gemm g; pg8::EpiResid E;
                if (j == 8) { g = pg8::Gemm{PROJ, WOUT, T_TOK, DM, 1536, PW}; E = pg8::EpiResid{hbuf, hbuf, modl + 5 * 1024, 1.0f}; }
                else { g = pg8::Gemm{HID, WFD, T_TOK, DM, DFF, DFF}; E = pg8::EpiResid{(l == 0 && j == 2) ? p.in[0 + zi] : hbuf, hbuf, modl + (j == 2 ? 2 : 8) * 1024, 0.5f}; }
                pg8::StaticOrder S; S.init(T_TOK, DM, F.G, F.bid);
                if (EN_G2) pg8::gemm_phase<pg8::EpiResid>(F.lds, F.tid, g, S, E);
            } else if (j == 4) {
                pg8::Gemm g{U, WIN, T_TOK, PW, DM, DM}; pg8::StaticOrder S; S.init(T_TOK, PW, F.G, F.bid);
                pg8::EpiBf16 E{PROJ, PW};
                if (EN_G3) pg8::gemm_phase<pg8::EpiBf16>(F.lds, F.tid, g, S, E);
                if (EN_DT) dt_gemv(F, U, p.in[9 + zi] + (size_t)l * DM * INW, DT);
            } else if (j == 5) {
                if (EN_SB) for (int t = F.bid; t < 1024; t += F.G) { const int qb = 63 - (t >> 4), bh = t & 15; sb_task(F, PROJ, bh >> 2, bh & 3, qb); }
                if (EN_RKV) for (int t = F.bid; t < 2048; t += F.G) { const int h = t & 3, bc = t >> 2; ret_kv_task(F, PROJ, ROPE, RST, bc >> 7, bc & 127, h); }
                if (EN_SST) for (int t = F.bid; t < 1024; t += F.G) { const int g = t & 1, bc = t >> 1;
                    ssd_state_task(F, PROJ, DT, p.in[10 + zi] + l * 4096, p.in[11 + zi] + l * 1024, p.in[12 + zi] + l * 8, p.in[13 + zi] + l * 8, SST, CD, bc >> 7, bc & 127, g); }
            } else if (j == 6) {
                if (EN_SCAN) scan_phase(F, RST, SST, CD);
            } else if (j == 7) {
                if (EN_ROUT) for (int t = F.bid; t < 2048; t += F.G) { const int h = t & 3, bc = t >> 2; ret_out_task(F, PROJ, ROPE, RST, p.in[15 + zi] + l * 512, bc >> 7, bc & 127, h); }
                if (EN_SOUT) for (int t = F.bid; t < 512; t += F.G) {
                    ssd_out_task(F, PROJ, DT, p.in[10 + zi] + l * 4096, p.in[11 + zi] + l * 1024, p.in[12 + zi] + l * 8, p.in[13 + zi] + l * 8, p.in[14 + zi] + l * 8, p.in[16 + zi] + l * 512, SST, t >> 7, t & 127); }
            }
        }
        if (ph + 1 < p.ph_hi) { cg::this_grid().sync(); }
    }
}

extern "C" void kernel_launch(void* const* d_in, const int* in_sizes, int n_in, void* d_out, int out_size, void* d_ws, size_t ws_size, hipStream_t stream) {
    static int grid = 0;
    if (grid == 0) {
        if (n_in != 25 || out_size != T_TOK * DM || ws_size < WS_END) { fprintf(stderr, "kernel_launch: unexpected shapes (n_in %d out %d ws %zu)\n", n_in, out_size, ws_size); grid = -1; return; }
        int dev = 0, cus = 0, per_cu = 0;
        hipGetDevice(&dev);
        hipDeviceGetAttribute(&cus, hipDeviceAttributeMultiprocessorCount, dev);
        hipFuncSetAttribute((const void*)fwd_kernel, hipFuncAttributeMaxDynamicSharedMemorySize, LDS_BYTES);
        hipOccupancyMaxActiveBlocksPerMultiprocessor(&per_cu, (const void*)fwd_kernel, NTHR, LDS_BYTES);
        if (per_cu < 1) per_cu = 1;
        (void)hipGetLastError();
        grid = cus * per_cu;
    }
    if (grid < 0) return;
    Params p{};
    for (int i = 0; i < 25; ++i) p.in[i] = (const float*)d_in[i];
    p.out = (float*)d_out; p.ws = (unsigned char*)d_ws;
#if ONE_LAUNCH
    p.ph_lo = 0; p.ph_hi = NPH;
    void* args[] = {&p};
    hipError_t e = hipLaunchCooperativeKernel((const void*)fwd_kernel, dim3(grid), dim3(NTHR), args, LDS_BYTES, stream);
    if (e != hipSuccess) fprintf(stderr, "cooperative launch failed: %s (grid %d)\n", hipGetErrorString(e), grid);
#else
    for (int ph = 0; ph < NPH; ++ph) { p.ph_lo = ph; p.ph_hi = ph + 1; hipLaunchKernelGGL(fwd_kernel, dim3(grid), dim3(NTHR), LDS_BYTES, stream, p); }
#endif
}
```

```cpp
#include <hip/hip_runtime.h>
#include <hip/hip_cooperative_groups.h>
#include <cstdint>
#include <cstdio>
namespace cg = cooperative_groups;

#ifndef ONE_LAUNCH
#define ONE_LAUNCH 1
#endif

#ifndef EN_ALL
#define EN_ALL 1
#endif
#ifndef EN_PRO
#define EN_PRO EN_ALL
#endif
#ifndef EN_FIN
#define EN_FIN EN_ALL
#endif
#ifndef EN_NORM
#define EN_NORM EN_ALL
#endif
#ifndef EN_CONV
#define EN_CONV EN_ALL
#endif
#ifndef EN_G1
#define EN_G1 EN_ALL
#endif
#ifndef EN_G2
#define EN_G2 EN_ALL
#endif
#ifndef EN_G3
#define EN_G3 EN_ALL
#endif
#ifndef EN_DT
#define EN_DT EN_ALL
#endif
#ifndef EN_SB
#define EN_SB EN_ALL
#endif
#ifndef EN_RKV
#define EN_RKV EN_ALL
#endif
#ifndef EN_SST
#define EN_SST EN_ALL
#endif
#ifndef EN_SCAN
#define EN_SCAN EN_ALL
#endif
#ifndef EN_ROUT
#define EN_ROUT EN_ALL
#endif
#ifndef EN_SOUT
#define EN_SOUT EN_ALL
#endif
#ifndef EN_SINTER
#define EN_SINTER 1
#endif
#ifndef XSEL
#define XSEL 31
#endif
#define XS(m) (ph < NPH || (XSEL & (m)))
#ifndef XMODE
#define XMODE 0
#endif
#define LAS __attribute__((address_space(3)))
#define GAS __attribute__((address_space(1)))
template <class T> __device__ __forceinline__ T* as_global(T* p) {
#if defined(__HIP_DEVICE_COMPILE__)
    __builtin_assume(!__builtin_amdgcn_is_shared((const void*)p)); __builtin_assume(!__builtin_amdgcn_is_private((const void*)p));
#endif
    return p; }
typedef unsigned short bf16_t;
typedef short bf16x8 __attribute__((ext_vector_type(8)));
typedef float f32x4 __attribute__((ext_vector_type(4)));
typedef float f32x2 __attribute__((ext_vector_type(2)));
typedef unsigned u32x4 __attribute__((ext_vector_type(4)));
typedef unsigned u32x2 __attribute__((ext_vector_type(2)));

constexpr int T_TOK = 32768, SEQ = 8192, DM = 1024, DFF = 2816, INW = 5128, PW = 5120;
constexpr int NTHR = 512, NWAVE = 8;
constexpr float EPS = 1e-6f;
constexpr int C_RQ = 0, C_SQ = 512, C_MZ = 1024, C_RK = 1536, C_RV = 2048, C_RG = 2560, C_SK = 3072, C_SV = 3584, C_XBC = 4096;

constexpr size_t MiB = 1u << 20;
constexpr size_t WS_MOD = 1 * MiB, WS_ROPE = 2 * MiB, WS_DT = 6 * MiB, WS_CD = 7 * MiB;
constexpr size_t WS_WFU = 8 * MiB, WS_WFD = 19 * MiB, WS_WIN = 25 * MiB, WS_WOUT = 35 * MiB;
constexpr size_t WS_U = 38 * MiB, WS_RST = 38 * MiB, WS_SST = 102 * MiB, WS_PROJ = 166 * MiB, WS_END = 486 * MiB;
constexpr int FMOD_OFF = 2 * 4 * 9 * 1024;

constexpr size_t PLANE = (size_t)T_TOK * 128;
__device__ __forceinline__ size_t pidx(size_t row, int col) { return (size_t)(col >> 7) * PLANE + row * 128 + (col & 127); }
constexpr int LDS_BYTES = 147456;

struct Params {
    const float* in[25];
    float* out;
    unsigned char* ws;
    int ph_lo, ph_hi;
};

typedef __bf16 bf16x2_t __attribute__((ext_vector_type(2)));
__device__ __forceinline__ unsigned cvt_pk_bf16(float lo, float hi) { const f32x2 v = {lo, hi}; const bf16x2_t b = __builtin_convertvector(v, bf16x2_t); return __builtin_bit_cast(unsigned, b); }
__device__ __forceinline__ float bf_lo(unsigned u) { return __uint_as_float(u << 16); }
__device__ __forceinline__ float bf_hi(unsigned u) { return __uint_as_float(u & 0xffff0000u); }
__device__ __forceinline__ float bf2f(bf16_t x) { return __uint_as_float(((unsigned)x) << 16); }
__device__ __forceinline__ bf16_t f2bf(float f) { return (bf16_t)(cvt_pk_bf16(f, 0.f) & 0xffffu); }
__device__ __forceinline__ float wave_sum(float v) {
#pragma unroll
    for (int o = 1; o < 64; o <<= 1) v += __shfl_xor(v, o);
    return v;
}
__device__ __forceinline__ float wave_max(float v) {
#pragma unroll
    for (int o = 1; o < 64; o <<= 1) v = fmaxf(v, __shfl_xor(v, o));
    return v;
}
__device__ __forceinline__ void lds_barrier() { asm volatile("s_waitcnt lgkmcnt(0)" ::: "memory"); __builtin_amdgcn_s_barrier(); asm volatile("" ::: "memory"); }
__device__ __forceinline__ float silu_f(float g) { return g * __builtin_amdgcn_rcpf(1.0f + __builtin_amdgcn_exp2f(-1.44269504f * g)); }
__device__ __forceinline__ f32x4 mfma16(bf16x8 a, bf16x8 b, f32x4 c) { return __builtin_amdgcn_mfma_f32_16x16x32_bf16(a, b, c, 0, 0, 0); }
__device__ __forceinline__ bf16x8 ldsfrag(const LAS unsigned char* p) { return *(const LAS bf16x8*)p; }
__device__ __forceinline__ u32x2 pack4(f32x4 v) { u32x2 w; w.x = cvt_pk_bf16(v[0], v[1]); w.y = cvt_pk_bf16(v[2], v[3]); return w; }
__device__ __forceinline__ void unpack8(u32x4 v, float* f) {
    f[0] = bf_lo(v.x); f[1] = bf_hi(v.x); f[2] = bf_lo(v.y); f[3] = bf_hi(v.y); f[4] = bf_lo(v.z); f[5] = bf_hi(v.z); f[6] = bf_lo(v.w); f[7] = bf_hi(v.w);
}
__device__ __forceinline__ float log2gamma(int h) { return h == 0 ? -0.04580368961312479f : (h == 1 ? -0.02272007650008353f : (h == 2 ? -0.011315313227834146f : -0.005646563141142063f)); }

namespace pg8 {
constexpr int BM = 256, BK = 64, HALF = 128, HTB = HALF * BK * 2, STAGE_BYTES = 8 * HTB, NXCD = 8, WGM = 8;
__host__ __device__ __forceinline__ int lds_byte(int r, int c) { const int st = (r >> 4) * 2 + (c >> 5), rr = r & 15, cc = c & 31, ob = rr * 64 + cc * 2; return st * 1024 + (ob ^ (((ob >> 9) & 1) << 5)); }
__host__ __device__ __forceinline__ void stage_rc(int b, int& R, int& C) { const int st = b / 1024, sb = b % 1024, swz = sb ^ (((sb >> 9) & 1) << 5); R = (st >> 1) * 16 + swz / 64; C = (st & 1) * 32 + (swz % 64) / 2; }
__host__ __device__ __forceinline__ int perm32(int rho) { const int n = rho >> 4, i = rho & 15; return 8 * (i >> 2) + 4 * n + (i & 3); }
struct Unit { int pm, pn; };
struct Gemm { const bf16_t* A; const bf16_t* Bt; int M, N, K, lda; };
struct StaticOrder {
    int nM, nN, nwg, G, c;
    __device__ void init(int M, int N, int G_, int c_) { nM = M / BM; nN = N / BM; nwg = nM * nN; G = G_; c = c_; }
    __device__ bool next(int i, Unit& u) const {
        const long L = (long)i * G + c; if (L >= nwg) return false;
        int wgid = (int)L; { const int q = nwg / NXCD, r = nwg % NXCD, xcd = wgid % NXCD, off = wgid / NXCD; wgid = (xcd < r ? xcd * (q + 1) : r * (q + 1) + (xcd - r) * q) + off; }
        const int nig = WGM * nN, gid = wgid / nig, fm = gid * WGM, gsz = (nM - fm) < WGM ? (nM - fm) : WGM;
        u.pm = fm + ((wgid % nig) % gsz); u.pn = (wgid % nig) / gsz; return true;
    }
};
struct EpiBf16 {
    bf16_t* O; int ldc;
    __device__ __forceinline__ void operator()(const f32x4 (&acc)[2][2][4][2], const Unit& u, int wr, int wc, int fr, int fq) const {
        const int row0 = u.pm * BM + wr * 64 + fr, col0 = u.pn * BM + wc * 32 + 8 * fq;
#pragma unroll
        for (int ai = 0; ai < 2; ++ai)
#pragma unroll
            for (int m = 0; m < 4; ++m) { bf16_t* rowp = O + (size_t)(2 * u.pn) * PLANE + (size_t)(row0 + ai * HALF + m * 16) * 128 + wc * 32 + 8 * fq;
#pragma unroll
                for (int bj = 0; bj < 2; ++bj) { const f32x4 v0 = acc[ai][bj][m][0], v1 = acc[ai][bj][m][1];
                    u32x4 w; w.x = cvt_pk_bf16(v0[0], v0[1]); w.y = cvt_pk_bf16(v0[2], v0[3]); w.z = cvt_pk_bf16(v1[0], v1[1]); w.w = cvt_pk_bf16(v1[2], v1[3]);
                    *(GAS u32x4*)(rowp + bj * PLANE) = w; } }
    }
};
struct EpiSwiGLU {
    bf16_t* O; int ldo;
    __device__ __forceinline__ void operator()(const f32x4 (&acc)[2][2][4][2], const Unit& u, int wr, int wc, int fr, int fq) const {
        const int row0 = u.pm * BM + wr * 64 + fr, col0 = u.pn * HALF + wc * 32 + 8 * fq;
#pragma unroll
        for (int ai = 0; ai < 2; ++ai)
#pragma unroll
            for (int m = 0; m < 4; ++m) { bf16_t* rowp = O + (size_t)(row0 + ai * HALF + m * 16) * ldo + col0;
                float hv[8];
#pragma unroll
                for (int n = 0; n < 2; ++n)
#pragma unroll
                    for (int i = 0; i < 4; ++i) hv[4 * n + i] = silu_f(acc[ai][0][m][n][i]) * acc[ai][1][m][n][i];
                u32x4 w; w.x = cvt_pk_bf16(hv[0], hv[1]); w.y = cvt_pk_bf16(hv[2], hv[3]); w.z = cvt_pk_bf16(hv[4], hv[5]); w.w = cvt_pk_bf16(hv[6], hv[7]);
                *(GAS u32x4*)rowp = w; }
    }
};
struct EpiResid {
    const float* hin; float* hout; const float* gate; float cmul;
    __device__ __forceinline__ void operator()(const f32x4 (&acc)[2][2][4][2], const Unit& u, int wr, int wc, int fr, int fq) const {
        const int row0 = u.pm * BM + wr * 64 + fr, col0 = u.pn * BM + wc * 32 + 8 * fq;
        const int b = (u.pm * BM) >> 13;
        f32x4 gm[2][2];
#pragma unroll
        for (int bj = 0; bj < 2; ++bj)
#pragma unroll
            for (int n = 0; n < 2; ++n) { const f32x4 g = *(const GAS f32x4*)(gate + (size_t)b * 9216 + col0 + bj * HALF + 4 * n); gm[bj][n] = (g + 1.0f) * cmul; }
#pragma unroll
        for (int ai = 0; ai < 2; ++ai)
#pragma unroll
            for (int m = 0; m < 4; ++m) { const size_t off = (size_t)(row0 + ai * HALF + m * 16) * DM + col0;
#pragma unroll
                for (int bj = 0; bj < 2; ++bj)
#pragma unroll
                    for (int n = 0; n < 2; ++n) { const f32x4 hv = *(const GAS f32x4*)(hin + off + bj * HALF + 4 * n);
                        *(GAS f32x4*)(hout + off + bj * HALF + 4 * n) = hv + gm[bj][n] * acc[ai][bj][m][n]; } }
    }
};

template <class Epi, bool APL = false>
__device__ __forceinline__ void gemm_phase(LAS unsigned char* lds, const int tid, const Gemm g, const StaticOrder& S, const Epi& E) {
    const int wid = __builtin_amdgcn_readfirstlane(tid >> 6), lane = tid & 63, wr = wid >> 2, wc = wid & 3, fr = lane & 15, fq = lane >> 4;
    const int K = g.K, nt = K / BK, lda = g.lda;
    unsigned voffA[2], voffB[2];
#pragma unroll
    for (int i = 0; i < 2; ++i) { int R, C; stage_rc(tid * 16 + i * 8192, R, C); const int Rb = (R & ~31) + perm32(R & 31);
        voffA[i] = (unsigned)(R * (APL ? 128 : lda) + C) * 2u; voffB[i] = (unsigned)(Rb * K + C) * 2u; }
    const size_t kstep = (size_t)(BK * 2);
    const size_t hstepA = (size_t)HALF * (APL ? 128 : lda) * 2, hstepB = (size_t)HALF * K * 2;
#define PG8_KA(t) (APL ? ((size_t)((t) >> 1) * (PLANE * 2) + (size_t)((t) & 1) * 128) : (size_t)(t) * kstep)
    const size_t tstepA = 2 * hstepA, tstepB = 2 * hstepB;
    const unsigned ldsw = (unsigned)wid * 1024u;
    const int aoff = lds_byte(wr * 64 + fr, fq * 8), boff = lds_byte(wc * 32 + fr, fq * 8);
#define PG8_SA(b, h) (((b) * 2 + (h)) * HTB)
#define PG8_SB(b, h) ((4 + (b) * 2 + (h)) * HTB)
#define PG8_STAGE(bufoff, gbase, voff) do { _Pragma("unroll") for (int _i = 0; _i < 2; ++_i) \
        __builtin_amdgcn_global_load_lds((const unsigned*)((const char*)(gbase) + (voff)[_i]), (LAS unsigned*)(lds + (bufoff) + ldsw + _i * 8192), 16, 0, 0); } while (0)
#define PG8_LDA(dst, b, h) do { _Pragma("unroll") for (int m = 0; m < 4; ++m) _Pragma("unroll") for (int k = 0; k < 2; ++k) dst[m][k] = *(const LAS bf16x8*)(lds + PG8_SA(b, h) + aoff + m * 2048 + k * 1024); } while (0)
#define PG8_LDB(dst, b, h) do { _Pragma("unroll") for (int n = 0; n < 2; ++n) _Pragma("unroll") for (int k = 0; k < 2; ++k) dst[n][k] = *(const LAS bf16x8*)(lds + PG8_SB(b, h) + boff + n * 2048 + k * 1024); } while (0)
#define PG8_MMA(ai, bj, At, Bt) do { __builtin_amdgcn_s_setprio(1); _Pragma("unroll") for (int m = 0; m < 4; ++m) _Pragma("unroll") for (int n = 0; n < 2; ++n) _Pragma("unroll") for (int k = 0; k < 2; ++k) \
        acc[ai][bj][m][n] = __builtin_amdgcn_mfma_f32_16x16x32_bf16(Bt[n][k], At[m][k], acc[ai][bj][m][n], 0, 0, 0); __builtin_amdgcn_s_setprio(0); } while (0)
#define PG8_WAIT_V(n) asm volatile("s_waitcnt vmcnt(" #n ")" ::: "memory")
#define PG8_WAIT_L(n) asm volatile("s_waitcnt lgkmcnt(" #n ")" ::: "memory")
#define PG8_BAR __builtin_amdgcn_s_barrier()
#define PG8_SCHED __builtin_amdgcn_sched_barrier(0)
    Unit cur, nxt; int ui = 0;
    if (!S.next(0, cur)) return;
    f32x4 acc[2][2][4][2];
#pragma unroll
    for (int a = 0; a < 2; ++a)
#pragma unroll
        for (int b = 0; b < 2; ++b)
#pragma unroll
            for (int m = 0; m < 4; ++m)
#pragma unroll
                for (int n = 0; n < 2; ++n) acc[a][b][m][n] = (f32x4){0.f, 0.f, 0.f, 0.f};
    bf16x8 At[4][2], B0[2][2], B1[2][2];
    const char* cA = (const char*)g.A + (size_t)cur.pm * tstepA; const char* cB = (const char*)g.Bt + (size_t)cur.pn * tstepB;
    PG8_STAGE(PG8_SB(0, 0), cB, voffB); PG8_STAGE(PG8_SB(0, 1), cB + hstepB, voffB); PG8_STAGE(PG8_SA(0, 0), cA, voffA); PG8_STAGE(PG8_SA(0, 1), cA + hstepA, voffA);
    if (wr == 1) PG8_BAR;
    PG8_WAIT_V(2); PG8_BAR;
    PG8_STAGE(PG8_SB(1, 0), cB + kstep, voffB); PG8_STAGE(PG8_SA(1, 0), cA + PG8_KA(1), voffA); PG8_STAGE(PG8_SB(1, 1), cB + hstepB + kstep, voffB);
    PG8_WAIT_V(6); PG8_BAR;
    for (;;) {
        const bool has_next = S.next(ui + 1, nxt);
        const char* nA = has_next ? (const char*)g.A + (size_t)nxt.pm * tstepA : cA; const char* nB = has_next ? (const char*)g.Bt + (size_t)nxt.pn * tstepB : cB;
        for (int t = 0; t < nt; t += 2) {
            const bool last = (t == nt - 2);
            const char* a1 = cA + PG8_KA(t + 1);
            const char* a2 = last ? nA : cA + PG8_KA(t + 2); const char* b2 = last ? nB : cB + (size_t)(t + 2) * kstep;
            const char* a3 = last ? nA + PG8_KA(1) : cA + PG8_KA(t + 3); const char* b3 = b2 + kstep;
            PG8_LDB(B0, 0, 0); PG8_LDB(B1, 0, 1); PG8_SCHED; PG8_LDA(At, 0, 0); PG8_STAGE(PG8_SA(1, 1), a1 + hstepA, voffA);
            PG8_WAIT_V(8); PG8_WAIT_L(0); PG8_BAR; PG8_MMA(0, 0, At, B0); PG8_MMA(0, 1, At, B1); PG8_BAR; PG8_SCHED;
            PG8_LDA(At, 0, 1); PG8_STAGE(PG8_SB(0, 0), b2, voffB); PG8_STAGE(PG8_SB(0, 1), b2 + hstepB, voffB); PG8_STAGE(PG8_SA(0, 0), a2, voffA);
            PG8_WAIT_V(8); PG8_WAIT_L(0); PG8_BAR; PG8_MMA(1, 0, At, B0); PG8_MMA(1, 1, At, B1); PG8_BAR; PG8_SCHED;
            PG8_LDB(B0, 1, 0); PG8_LDB(B1, 1, 1); PG8_SCHED; PG8_LDA(At, 1, 0); PG8_STAGE(PG8_SA(0, 1), a2 + hstepA, voffA);
            PG8_WAIT_V(8); PG8_WAIT_L(0); PG8_BAR; PG8_MMA(0, 0, At, B0); PG8_MMA(0, 1, At, B1); PG8_BAR; PG8_SCHED;
            PG8_LDA(At, 1, 1); PG8_STAGE(PG8_SB(1, 0), b3, voffB); PG8_STAGE(PG8_SB(1, 1), b3 + hstepB, voffB); PG8_STAGE(PG8_SA(1, 0), a3, voffA);
            PG8_WAIT_V(8); PG8_WAIT_L(0); PG8_BAR; PG8_MMA(1, 0, At, B0); PG8_MMA(1, 1, At, B1); PG8_BAR; PG8_SCHED;
        }
        if (wr == 0) PG8_BAR;
        E(acc, cur, wr, wc, fr, fq);
        if (!has_next) break;
#pragma unroll
        for (int a = 0; a < 2; ++a)
#pragma unroll
            for (int b = 0; b < 2; ++b)
#pragma unroll
                for (int m = 0; m < 4; ++m)
#pragma unroll
                    for (int n = 0; n < 2; ++n) acc[a][b][m][n] = (f32x4){0.f, 0.f, 0.f, 0.f};
        cur = nxt; cA = nA; cB = nB; ++ui;
        if (wr == 1) PG8_BAR;
    }
    PG8_WAIT_V(0);
    PG8_BAR;
#undef PG8_KA
#undef PG8_SA
#undef PG8_SB
#undef PG8_STAGE
#undef PG8_LDA
#undef PG8_LDB
#undef PG8_MMA
#undef PG8_WAIT_V
#undef PG8_WAIT_L
#undef PG8_BAR
#undef PG8_SCHED
}
}

struct Frame {
    LAS unsigned char* lds;
    int tid, lane, wave, G, bid;
};

__device__ __forceinline__ void conv_item(const float* W, int Nsrc, int K, int src_col0, bf16_t* WT, int dst_row0, int k0, LAS float* scr, int lane) {
#pragma unroll 8
    for (int i = 0; i < 32; ++i) { const int kk = 2 * i + (lane >> 5); scr[kk * 33 + (lane & 31)] = ((const GAS float*)W)[(size_t)(k0 + kk) * Nsrc + src_col0 + (lane & 31)]; }
    asm volatile("s_waitcnt lgkmcnt(0)" ::: "memory");
    const int c = lane & 7;
#pragma unroll
    for (int j = 0; j < 4; ++j) { const int n = (lane >> 3) + 8 * j; const LAS float* s = scr + (8 * c) * 33 + n;
        u32x4 o; o.x = cvt_pk_bf16(s[0 * 33], s[1 * 33]); o.y = cvt_pk_bf16(s[2 * 33], s[3 * 33]); o.z = cvt_pk_bf16(s[4 * 33], s[5 * 33]); o.w = cvt_pk_bf16(s[6 * 33], s[7 * 33]);
        *(GAS u32x4*)(WT + (size_t)(dst_row0 + n) * K + k0 + 8 * c) = o; }
    asm volatile("s_waitcnt lgkmcnt(0)" ::: "memory");
}
__device__ __forceinline__ void convert_ffn(const Frame& F, const float* wg, const float* wu, const float* wd, bf16_t* WFU, bf16_t* WFD) {
    LAS float* scr = (LAS float*)(F.lds + F.wave * 16384);
    const int gw = F.bid * NWAVE + F.wave, NGW = F.G * NWAVE;
    constexpr int I_U = 16 * 176, I_D = 44 * 32;
    for (int it = gw; it < I_U + I_D; it += NGW) {
        if (it < I_U) { const int kb = it / 176, nb = it % 176, r0 = nb * 32, pn = r0 >> 8, i0 = r0 & 255;
            conv_item(i0 < 128 ? wg : wu, DFF, DM, pn * 128 + (i0 & 127), WFU, r0, kb * 64, scr, F.lane); }
        else { const int r = it - I_U, kb = r / 32, nb = r % 32; conv_item(wd, DM, DFF, nb * 32, WFD, nb * 32, kb * 64, scr, F.lane); }
    }
}
__device__ __forceinline__ void convert_mix(const Frame& F, const float* w_in, const float* w_out, bf16_t* WIN, bf16_t* WOUT) {
    LAS float* scr = (LAS float*)(F.lds + F.wave * 16384);
    const int gw = F.bid * NWAVE + F.wave, NGW = F.G * NWAVE;
    constexpr int I_I = 16 * 160, I_O = 24 * 32;
    for (int it = gw; it < I_I + I_O; it += NGW) {
        if (it < I_I) { const int kb = it / 160, nb = it % 160, r0 = nb * 32, blk = r0 >> 9;
            const int sb = blk == 0 ? 0 : blk == 1 ? 4 : blk == 2 ? 7 : blk == 3 ? 1 : blk == 4 ? 2 : blk == 5 ? 3 : blk == 6 ? 5 : blk == 7 ? 6 : blk;
            conv_item(w_in, INW, DM, sb * 512 + (r0 & 511), WIN, r0, kb * 64, scr, F.lane); }
        else { const int r = it - I_I, kb = r / 32, nb = r % 32; conv_item(w_out, DM, 1536, nb * 32, WOUT, nb * 32, kb * 64, scr, F.lane); }
    }
}

__device__ __forceinline__ void sincos_d(double x, double& s, double& c) {
    const double k = rint(x * 0.63661977236758134308);
    double r = fma(-k, 1.57079632679489655800e+00, x); r = fma(-k, 6.12323399573676603587e-17, r);
    const double r2 = r * r;
    double sp = -7.6471637318198164759e-13; sp = sp * r2 + 1.6059043836821614599e-10; sp = sp * r2 - 2.5052108385441718775e-08; sp = sp * r2 + 2.7557319223985890653e-06;
    sp = sp * r2 - 1.9841269841269841270e-04; sp = sp * r2 + 8.3333333333333333333e-03; sp = sp * r2 - 1.6666666666666666667e-01; const double sn = r + r * r2 * sp;
    double cp = 4.7794773323873852974e-14; cp = cp * r2 - 1.1470745597729724714e-11; cp = cp * r2 + 2.0876756987868098979e-09; cp = cp * r2 - 2.7557319223985890653e-07;
    cp = cp * r2 + 2.4801587301587301587e-05; cp = cp * r2 - 1.3888888888888888889e-03; cp = cp * r2 + 4.1666666666666666667e-02; cp = cp * r2 - 0.5; const double cs = 1.0 + r2 * cp;
    const int q = ((int)k) & 3;
    s = (q == 0) ? sn : (q == 1) ? cs : (q == 2) ? -sn : -cs;
    c = (q == 0) ? cs : (q == 1) ? -sn : (q == 2) ? -cs : sn;
}
__device__ __forceinline__ void prologue(const Frame& F, const Params& p, unsigned char* ws, int zi) {
    LAS float* cs = (LAS float*)F.lds;
    LAS float* red = (LAS float*)(F.lds + 16384);
    const float* c = as_global(p.in[1 + zi]);
    for (int i = F.tid; i < 4096; i += NTHR) cs[i] = silu_f(c[i]);
    __syncthreads();
    float* MOD = (float*)(ws + WS_MOD);
    for (int task = F.bid; task < 320; task += F.G) {
        const float* W; const float* bias; int N, n0; float* dst; int dstride;
        if (task < 288) { const int l = task / 144, t = task % 144; W = as_global(p.in[2 + zi]) + (size_t)l * DM * 9216; bias = as_global(p.in[3 + zi]) + l * 9216; N = 9216; n0 = t * 64; dst = MOD + (size_t)l * 4 * 9216; dstride = 9216; }
        else { const int t = task - 288; W = as_global(p.in[22 + zi]); bias = as_global(p.in[23 + zi]); N = 2048; n0 = t * 64; dst = MOD + FMOD_OFF; dstride = 2048; }
        float a0 = 0.f, a1 = 0.f, a2 = 0.f, a3 = 0.f;
        const int kb = F.wave * 128;
#pragma unroll 8
        for (int k = 0; k < 128; ++k) { const float w = ((const GAS float*)W)[(size_t)(kb + k) * N + n0 + F.lane];
            a0 += cs[kb + k] * w; a1 += cs[1024 + kb + k] * w; a2 += cs[2048 + kb + k] * w; a3 += cs[3072 + kb + k] * w; }
        red[(F.wave * 4 + 0) * 64 + F.lane] = a0; red[(F.wave * 4 + 1) * 64 + F.lane] = a1; red[(F.wave * 4 + 2) * 64 + F.lane] = a2; red[(F.wave * 4 + 3) * 64 + F.lane] = a3;
        __syncthreads();
        if (F.tid < 256) { const int b = F.tid >> 6, col = F.tid & 63; float s = bias[n0 + col];
#pragma unroll
            for (int w = 0; w < 8; ++w) s += red[(w * 4 + b) * 64 + col];
            dst[(size_t)b * dstride + n0 + col] = s; }
        __syncthreads();
    }
    f32x2* ROPE = (f32x2*)(ws + WS_ROPE);
    for (int idx = F.bid * NTHR + F.tid; idx < SEQ * 64; idx += F.G * NTHR) {
        const int pos = idx >> 6, i = idx & 63;
        const float invf = (float)exp(-(double)i * (9.210340371976184 / 64.0));
        const float ang = (float)pos * invf;
        double s, cc; sincos_d((double)ang, s, cc);
        ROPE[idx] = (f32x2){(float)cc, (float)s};
    }
}

__device__ __forceinline__ void norm_phase(const Frame& F, const float* h, const float* gain, const float* shift0, const float* scale0, int bstride, bf16_t* U) {
    const int gw = F.bid * NWAVE + F.wave, NGW = F.G * NWAVE;
    for (int m = gw; m < T_TOK; m += NGW) {
        const int b = m >> 13;
        const GAS f32x4* xr = (const GAS f32x4*)(h + (size_t)m * DM) + F.lane;
        f32x4 v[4]; float s = 0.f;
#pragma unroll
        for (int j = 0; j < 4; ++j) { v[j] = xr[64 * j]; s += (v[j].x * v[j].x + v[j].y * v[j].y) + (v[j].z * v[j].z + v[j].w * v[j].w); }
        const float rstd = rsqrtf(wave_sum(s) * (1.f / DM) + EPS);
        GAS u32x2* o8 = (GAS u32x2*)(U + (size_t)m * DM) + F.lane;
#pragma unroll
        for (int j = 0; j < 4; ++j) {
            const f32x4 g = ((const GAS f32x4*)gain)[F.lane + 64 * j], sh = ((const GAS f32x4*)(shift0 + (size_t)b * bstride))[F.lane + 64 * j], sc = ((const GAS f32x4*)(scale0 + (size_t)b * bstride))[F.lane + 64 * j];
            const f32x4 y = v[j] * rstd * g * (sc + 1.0f) + sh;
            o8[64 * j] = pack4(y);
        }
    }
}
__device__ __forceinline__ void final_phase(const Frame& F, float* h, const float* gain, const float* fmod) {
    const int gw = F.bid * NWAVE + F.wave, NGW = F.G * NWAVE;
    for (int m = gw; m < T_TOK; m += NGW) {
        const int b = m >> 13;
        GAS f32x4* xr = (GAS f32x4*)(h + (size_t)m * DM) + F.lane;
        f32x4 v[4]; float s = 0.f;
#pragma unroll
        for (int j = 0; j < 4; ++j) { v[j] = xr[64 * j]; s += (v[j].x * v[j].x + v[j].y * v[j].y) + (v[j].z * v[j].z + v[j].w * v[j].w); }
        const float rstd = rsqrtf(wave_sum(s) * (1.f / DM) + EPS);
#pragma unroll
        for (int j = 0; j < 4; ++j) {
            const f32x4 g = ((const GAS f32x4*)gain)[F.lane + 64 * j], sh = ((const GAS f32x4*)(fmod + (size_t)b * 2048))[F.lane + 64 * j], sc = ((const GAS f32x4*)(fmod + (size_t)b * 2048 + 1024))[F.lane + 64 * j];
            xr[64 * j] = v[j] * rstd * g * (sc + 1.0f) + sh;
        }
    }
}

__device__ __forceinline__ void dt_gemv(const Frame& F, const bf16_t* U, const float* w_in, float* DT) {
    LAS float* Wd = (LAS float*)F.lds;
    __syncthreads();
    for (int idx = F.tid; idx < 8192; idx += NTHR) { const int k = idx >> 3, j = idx & 7; Wd[8 * k + 4 * (k >> 3) + j] = ((const GAS float*)w_in)[(size_t)k * INW + 5120 + j]; }
    __syncthreads();
    const int gw = F.bid * NWAVE + F.wave, NGW = F.G * NWAVE;
    for (int m = gw; m < T_TOK; m += NGW) {
        float acc[8];
#pragma unroll
        for (int j = 0; j < 8; ++j) acc[j] = 0.f;
#pragma unroll
        for (int hf = 0; hf < 2; ++hf) {
            const u32x4 uv = *(const GAS u32x4*)(U + (size_t)m * DM + 512 * hf + 8 * F.lane);
            float uf[8]; unpack8(uv, uf);
#pragma unroll
            for (int kk = 0; kk < 8; ++kk) { const int k = 512 * hf + 8 * F.lane + kk; const LAS float* wp = Wd + 8 * k + 4 * (k >> 3);
                const f32x4 w0 = *(const LAS f32x4*)wp, w1 = *(const LAS f32x4*)(wp + 4);
                acc[0] += uf[kk] * w0.x; acc[1] += uf[kk] * w0.y; acc[2] += uf[kk] * w0.z; acc[3] += uf[kk] * w0.w;
                acc[4] += uf[kk] * w1.x; acc[5] += uf[kk] * w1.y; acc[6] += uf[kk] * w1.z; acc[7] += uf[kk] * w1.w; }
        }
#pragma unroll
        for (int j = 0; j < 8; ++j) acc[j] = wave_sum(acc[j]);
        if (F.lane < 8) { float v = acc[0];
#pragma unroll
            for (int j = 1; j < 8; ++j) v = (F.lane == j) ? acc[j] : v;
            ((GAS float*)DT)[(size_t)m * 8 + F.lane] = v; }
    }
    __syncthreads();
}

__device__ __forceinline__ void sb_task(const Frame& F, bf16_t* P, int b, int h, int qb) {
    LAS unsigned char* Ks = F.lds;
    LAS unsigned char* Vt = F.lds + 17408;
    LAS unsigned char* Pw = F.lds + 35840 + F.wave * 2304;
    LAS float* red = (LAS float*)(F.lds + 54272);
    int lane = F.lane; asm volatile("" : "+v"(lane)); const int wid = F.wave, fr = lane & 15, fq = lane >> 4;
    const size_t rowbase = (size_t)b * SEQ;
    const int q0 = qb * 128, trow = q0 + 16 * wid + fr;
    bf16x8 qf[4];
    { const bf16_t* qp = P + pidx(rowbase + trow, C_SQ + h * 128) + 8 * fq;
#pragma unroll
      for (int s = 0; s < 4; ++s) qf[s] = *(const GAS bf16x8*)(qp + 32 * s); }
    f32x4 o[8];
#pragma unroll
    for (int i = 0; i < 8; ++i) o[i] = (f32x4){0.f, 0.f, 0.f, 0.f};
    float R = 0.f;
    u32x4 kvr[2], vvr[2];
#pragma unroll
    for (int i = 0; i < 2; ++i) { const int idx = F.tid + NTHR * i, key = idx >> 4, c8 = idx & 15; const size_t krow = rowbase + 64 * (2 * qb + 1) + key;
        kvr[i] = *(const GAS u32x4*)(P + pidx(krow, C_SK + h * 128) + 8 * c8); vvr[i] = *(const GAS u32x4*)(P + pidx(krow, C_SV + h * 128) + 8 * c8); }
    for (int kt = 2 * qb + 1; kt >= 0; --kt) {
        lds_barrier();
#pragma unroll
        for (int i = 0; i < 2; ++i) { const int idx = F.tid + NTHR * i, key = idx >> 4, c8 = idx & 15;
            const u32x4 kv = kvr[i], vv = vvr[i];
            *(LAS u32x4*)(Ks + key * 272 + c8 * 16) = kv;
            LAS bf16_t* vd = (LAS bf16_t*)(Vt + (8 * c8) * 144 + key * 2);
            vd[0 * 72] = (bf16_t)(vv.x & 0xffff); vd[1 * 72] = (bf16_t)(vv.x >> 16); vd[2 * 72] = (bf16_t)(vv.y & 0xffff); vd[3 * 72] = (bf16_t)(vv.y >> 16);
            vd[4 * 72] = (bf16_t)(vv.z & 0xffff); vd[5 * 72] = (bf16_t)(vv.z >> 16); vd[6 * 72] = (bf16_t)(vv.w & 0xffff); vd[7 * 72] = (bf16_t)(vv.w >> 16); }
        if (kt > 0) {
#pragma unroll
            for (int i = 0; i < 2; ++i) { const int idx = F.tid + NTHR * i, key = idx >> 4, c8 = idx & 15; const size_t krow = rowbase + 64 * (kt - 1) + key;
                kvr[i] = *(const GAS u32x4*)(P + pidx(krow, C_SK + h * 128) + 8 * c8); vvr[i] = *(const GAS u32x4*)(P + pidx(krow, C_SV + h * 128) + 8 * c8); } }
        lds_barrier();
        if (64 * kt < q0 + 16 * wid + 15) {
            f32x4 sc[4];
#pragma unroll
            for (int j = 0; j < 4; ++j) { sc[j] = (f32x4){0.f, 0.f, 0.f, 0.f};
#pragma unroll
                for (int s = 0; s < 4; ++s) sc[j] = mfma16(ldsfrag(Ks + (16 * j + fr) * 272 + (32 * s + 8 * fq) * 2), qf[s], sc[j]); }
            float lk[4][4], lb[4][4], Tj[4], Wj[4], Gj[4];
#pragma unroll
            for (int j = 0; j < 4; ++j) { float t = 0.f;
#pragma unroll
                for (int i = 0; i < 4; ++i) { const float z = sc[j][i] * 0.08838834764831845f; const int key = 64 * kt + 16 * j + 4 * fq + i; const bool vis = key < trow;
                    const float e = __expf(-fabsf(z)); const float sp = fmaxf(z, 0.f) + __logf(1.0f + e);
                    lk[j][i] = vis ? -sp : 0.f; lb[j][i] = vis ? (z - sp) : -1e30f; t += lk[j][i]; }
                Tj[j] = t; }
#pragma unroll
            for (int j = 0; j < 4; ++j) { const float a1 = __shfl_xor(Tj[j], 16), a2 = __shfl_xor(Tj[j], 32), a3 = __shfl_xor(Tj[j], 48);
                Wj[j] = Tj[j] + a1 + a2 + a3;
                Gj[j] = (((fq ^ 1) > fq) ? a1 : 0.f) + (((fq ^ 2) > fq) ? a2 : 0.f) + (((fq ^ 3) > fq) ? a3 : 0.f); }
            float suf = 0.f;
#pragma unroll
            for (int j = 3; j >= 0; --j) { float tl = R + suf + Gj[j]; f32x4 w;
                w[3] = __expf(lb[j][3] + tl); tl += lk[j][3];
                w[2] = __expf(lb[j][2] + tl); tl += lk[j][2];
                w[1] = __expf(lb[j][1] + tl); tl += lk[j][1];
                w[0] = __expf(lb[j][0] + tl);
                *(LAS u32x2*)(Pw + fr * 144 + (16 * j + 4 * fq) * 2) = pack4(w);
                suf += Wj[j]; }
            R += suf;
#pragma unroll
            for (int ks = 0; ks < 2; ++ks) { const bf16x8 pf = ldsfrag(Pw + fr * 144 + (32 * ks + 8 * fq) * 2);
#pragma unroll
                for (int dt = 0; dt < 8; ++dt) o[dt] = mfma16(ldsfrag(Vt + (16 * dt + fr) * 144 + (32 * ks + 8 * fq) * 2), pf, o[dt]); }
        }
        const float rm = wave_max(R);
        if (lane == 0) red[wid] = rm;
        lds_barrier();
        float mx = red[0];
#pragma unroll
        for (int w = 1; w < 8; ++w) mx = fmaxf(mx, red[w]);
        if (mx < -120.f) break;
    }
    bf16_t* op = P + pidx(rowbase + trow, C_SQ + h * 128) + 4 * fq;
#pragma unroll
    for (int dt = 0; dt < 8; ++dt) *(GAS u32x2*)(op + 16 * dt) = pack4(o[dt]);
}

__device__ __forceinline__ void ret_kv_task(const Frame& F, const bf16_t* P, const f32x2* ROPE, bf16_t* RST, int b, int c, int h) {
    LAS unsigned char* KT = F.lds;
    LAS unsigned char* VT = F.lds + 18432;
    int lane = F.lane; asm volatile("" : "+v"(lane)); const int fr = lane & 15, fq = lane >> 4;
    const float l2g = log2gamma(h);
    lds_barrier();
    { const int s = F.tid >> 3, g8 = F.tid & 7; const size_t row = (size_t)b * SEQ + c * 64 + s; const int pos = c * 64 + s;
      const bf16_t* kp = P + pidx(row, C_RK + h * 128) + 8 * g8;
      const u32x4 k1 = *(const GAS u32x4*)kp, k2 = *(const GAS u32x4*)(kp + 64);
      float x1[8], x2[8]; unpack8(k1, x1); unpack8(k2, x2);
      const GAS f32x4* cp = (const GAS f32x4*)(ROPE + pos * 64 + 8 * g8);
      const float dec = __builtin_amdgcn_exp2f(l2g * (float)(63 - s)) * 0.08838834764831845f;
      LAS bf16_t* kd = (LAS bf16_t*)(KT + (8 * g8) * 144 + s * 2);
#pragma unroll
      for (int jj = 0; jj < 4; ++jj) { const f32x4 cs = cp[jj];
          { const int j = 2 * jj; const float y1 = (x1[j] * cs.x - x2[j] * cs.y) * dec, y2 = (x1[j] * cs.y + x2[j] * cs.x) * dec; kd[j * 72] = f2bf(y1); kd[(64 + j) * 72] = f2bf(y2); }
          { const int j = 2 * jj + 1; const float y1 = (x1[j] * cs.z - x2[j] * cs.w) * dec, y2 = (x1[j] * cs.w + x2[j] * cs.z) * dec; kd[j * 72] = f2bf(y1); kd[(64 + j) * 72] = f2bf(y2); } }
      const bf16_t* vp = P + pidx(row, C_RV + h * 128) + 16 * g8;
#pragma unroll
      for (int hh = 0; hh < 2; ++hh) { const u32x4 vv = *(const GAS u32x4*)(vp + 8 * hh);
          LAS bf16_t* vd = (LAS bf16_t*)(VT + (16 * g8 + 8 * hh) * 144 + s * 2);
          vd[0 * 72] = (bf16_t)(vv.x & 0xffff); vd[1 * 72] = (bf16_t)(vv.x >> 16); vd[2 * 72] = (bf16_t)(vv.y & 0xffff); vd[3 * 72] = (bf16_t)(vv.y >> 16);
          vd[4 * 72] = (bf16_t)(vv.z & 0xffff); vd[5 * 72] = (bf16_t)(vv.z >> 16); vd[6 * 72] = (bf16_t)(vv.w & 0xffff); vd[7 * 72] = (bf16_t)(vv.w >> 16); } }
    lds_barrier();
    const int w = F.wave;
    bf16x8 xf[2];
#pragma unroll
    for (int ks = 0; ks < 2; ++ks) xf[ks] = ldsfrag(KT + (16 * w + fr) * 144 + (32 * ks + 8 * fq) * 2);
    bf16_t* dst = RST + (size_t)((b * 128 + c) * 4 + h) * 16384;
#pragma unroll
    for (int et = 0; et < 8; ++et) { f32x4 acc = (f32x4){0.f, 0.f, 0.f, 0.f};
#pragma unroll
        for (int ks = 0; ks < 2; ++ks) acc = mfma16(xf[ks], ldsfrag(VT + (16 * et + fr) * 144 + (32 * ks + 8 * fq) * 2), acc);
        *(GAS u32x2*)(dst + (16 * et + fr) * 128 + 16 * w + 4 * fq) = pack4(acc); }
}

__device__ __forceinline__ void ret_out_task(const Frame& F, bf16_t* P, const f32x2* ROPE, const bf16_t* RST, const float* gn, int b, int c, int h, int xm = 0) {
    LAS unsigned char* Kr = F.lds;
    LAS unsigned char* VT = F.lds + 17408;
    LAS unsigned char* Sx = F.lds + 35840;
    LAS unsigned char* Pw = F.lds + 70656 + F.wave * 2304;
    LAS float* ssq = (LAS float*)(F.lds + 89088);
    int lane = F.lane; asm volatile("" : "+v"(lane)); const int fr = lane & 15, fq = lane >> 4, w = F.wave, lt = w & 3, eh = w >> 2;
    const float l2g = log2gamma(h);
    const int unit = (b * 128 + c) * 4 + h;
    lds_barrier();
    { const int s = F.tid >> 3, g8 = F.tid & 7; const size_t row = (size_t)b * SEQ + c * 64 + s; const int pos = c * 64 + s;
      const bf16_t* kp = P + pidx(row, C_RK + h * 128) + 8 * g8;
      const u32x4 k1 = *(const GAS u32x4*)kp, k2 = *(const GAS u32x4*)(kp + 64);
      float x1[8], x2[8], y1[8], y2[8]; unpack8(k1, x1); unpack8(k2, x2);
      const GAS f32x4* cp = (const GAS f32x4*)(ROPE + pos * 64 + 8 * g8);
#pragma unroll
      for (int jj = 0; jj < 4; ++jj) { const f32x4 cs = cp[jj];
          { const int j = 2 * jj; y1[j] = (x1[j] * cs.x - x2[j] * cs.y) * 0.08838834764831845f; y2[j] = (x1[j] * cs.y + x2[j] * cs.x) * 0.08838834764831845f; }
          { const int j = 2 * jj + 1; y1[j] = (x1[j] * cs.z - x2[j] * cs.w) * 0.08838834764831845f; y2[j] = (x1[j] * cs.w + x2[j] * cs.z) * 0.08838834764831845f; } }
      u32x4 o1, o2; o1.x = cvt_pk_bf16(y1[0], y1[1]); o1.y = cvt_pk_bf16(y1[2], y1[3]); o1.z = cvt_pk_bf16(y1[4], y1[5]); o1.w = cvt_pk_bf16(y1[6], y1[7]);
      o2.x = cvt_pk_bf16(y2[0], y2[1]); o2.y = cvt_pk_bf16(y2[2], y2[3]); o2.z = cvt_pk_bf16(y2[4], y2[5]); o2.w = cvt_pk_bf16(y2[6], y2[7]);
      *(LAS u32x4*)(Kr + s * 272 + (8 * g8) * 2) = o1; *(LAS u32x4*)(Kr + s * 272 + (64 + 8 * g8) * 2) = o2;
      const bf16_t* vp = P + pidx(row, C_RV + h * 128) + 16 * g8;
#pragma unroll
      for (int hh = 0; hh < 2; ++hh) { const u32x4 vv = *(const GAS u32x4*)(vp + 8 * hh);
          LAS bf16_t* vd = (LAS bf16_t*)(VT + (16 * g8 + 8 * hh) * 144 + s * 2);
          vd[0 * 72] = (bf16_t)(vv.x & 0xffff); vd[1 * 72] = (bf16_t)(vv.x >> 16); vd[2 * 72] = (bf16_t)(vv.y & 0xffff); vd[3 * 72] = (bf16_t)(vv.y >> 16);
          vd[4 * 72] = (bf16_t)(vv.z & 0xffff); vd[5 * 72] = (bf16_t)(vv.z >> 16); vd[6 * 72] = (bf16_t)(vv.w & 0xffff); vd[7 * 72] = (bf16_t)(vv.w >> 16); }
      const bf16_t* sp = RST + (size_t)unit * 16384;
#pragma unroll
      for (int i = 0; i < 4; ++i) { const int idx = F.tid + NTHR * i, e = idx >> 4, c16 = idx & 15;
          *(LAS u32x4*)(Sx + e * 272 + c16 * 16) = *(const GAS u32x4*)(sp + e * 128 + 8 * c16); } }
    const int l = 16 * lt + fr; const size_t qrow = (size_t)b * SEQ + c * 64 + l; const int qpos = c * 64 + l;
    bf16x8 qf[4];
    { const bf16_t* qp = P + pidx(qrow, C_RQ + h * 128) + 8 * fq;
      u32x4 qv[4];
#pragma unroll
      for (int s = 0; s < 4; ++s) qv[s] = *(const GAS u32x4*)(qp + 32 * s);
#pragma unroll
      for (int s = 0; s < 2; ++s) { float x1[8], x2[8], y1[8], y2[8]; unpack8(qv[s], x1); unpack8(qv[s + 2], x2);
          const GAS f32x4* cp = (const GAS f32x4*)(ROPE + qpos * 64 + 32 * s + 8 * fq);
#pragma unroll
          for (int jj = 0; jj < 4; ++jj) { const f32x4 cs = cp[jj];
              { const int j = 2 * jj; y1[j] = x1[j] * cs.x - x2[j] * cs.y; y2[j] = x1[j] * cs.y + x2[j] * cs.x; }
              { const int j = 2 * jj + 1; y1[j] = x1[j] * cs.z - x2[j] * cs.w; y2[j] = x1[j] * cs.w + x2[j] * cs.z; } }
          u32x4 o1, o2; o1.x = cvt_pk_bf16(y1[0], y1[1]); o1.y = cvt_pk_bf16(y1[2], y1[3]); o1.z = cvt_pk_bf16(y1[4], y1[5]); o1.w = cvt_pk_bf16(y1[6], y1[7]);
          o2.x = cvt_pk_bf16(y2[0], y2[1]); o2.y = cvt_pk_bf16(y2[2], y2[3]); o2.z = cvt_pk_bf16(y2[4], y2[5]); o2.w = cvt_pk_bf16(y2[6], y2[7]);
          qf[s] = __builtin_bit_cast(bf16x8, o1); qf[s + 2] = __builtin_bit_cast(bf16x8, o2); } }
    u32x2 gvr[4]; f32x4 ggr[4];
#pragma unroll
    for (int et = 0; et < 4; ++et) { const int e0 = 64 * eh + 16 * et + 4 * fq;
        gvr[et] = *(const GAS u32x2*)(P + pidx(qrow, C_RG + h * 128) + e0); ggr[et] = *(const GAS f32x4*)(gn + h * 128 + e0); }
    lds_barrier();
    if (xm == 1) return;
#pragma unroll
    for (int j = 0; j < 4; ++j) { f32x4 acc = (f32x4){0.f, 0.f, 0.f, 0.f};
#pragma unroll
        for (int ks = 0; ks < 4; ++ks) acc = mfma16(ldsfrag(Kr + (16 * j + fr) * 272 + (32 * ks + 8 * fq) * 2), qf[ks], acc);
#pragma unroll
        for (int i = 0; i < 4; ++i) { const int s = 16 * j + 4 * fq + i; acc[i] *= __builtin_amdgcn_exp2f(l2g * fabsf((float)(l - s))); }
        *(LAS u32x2*)(Pw + fr * 144 + (16 * j + 4 * fq) * 2) = pack4(acc); }
    f32x4 y[4];
    const float qdec = __builtin_amdgcn_exp2f(l2g * (float)(l + 1));
#pragma unroll
    for (int et = 0; et < 4; ++et) { y[et] = (f32x4){0.f, 0.f, 0.f, 0.f};
#pragma unroll
        for (int ks = 0; ks < 4; ++ks) y[et] = mfma16(ldsfrag(Sx + (64 * eh + 16 * et + fr) * 272 + (32 * ks + 8 * fq) * 2), qf[ks], y[et]);
        y[et] = y[et] * qdec; }
#pragma unroll
    for (int ks = 0; ks < 2; ++ks) { const bf16x8 pf = ldsfrag(Pw + fr * 144 + (32 * ks + 8 * fq) * 2);
#pragma unroll
        for (int et = 0; et < 4; ++et) y[et] = mfma16(ldsfrag(VT + (64 * eh + 16 * et + fr) * 144 + (32 * ks + 8 * fq) * 2), pf, y[et]); }
    float ss = 0.f;
#pragma unroll
    for (int et = 0; et < 4; ++et) ss += (y[et][0] * y[et][0] + y[et][1] * y[et][1]) + (y[et][2] * y[et][2] + y[et][3] * y[et][3]);
    ss += __shfl_xor(ss, 16); ss += __shfl_xor(ss, 32);
    if (fq == 0) ssq[w * 16 + fr] = ss;
    lds_barrier();
    const float rstd = rsqrtf((ssq[w * 16 + fr] + ssq[(w ^ 4) * 16 + fr]) * (1.f / 128.f) + EPS);
#pragma unroll
    for (int et = 0; et < 4; ++et) { const int e0 = 64 * eh + 16 * et + 4 * fq;
        const u32x2 gv = gvr[et]; const f32x4 gg = ggr[et];
        f32x4 r;
        r[0] = y[et][0] * rstd * gg[0] * silu_f(bf_lo(gv.x)); r[1] = y[et][1] * rstd * gg[1] * silu_f(bf_hi(gv.x));
        r[2] = y[et][2] * rstd * gg[2] * silu_f(bf_lo(gv.y)); r[3] = y[et][3] * rstd * gg[3] * silu_f(bf_hi(gv.y));
        *(GAS u32x2*)(P + pidx(qrow, C_RQ + h * 128) + e0) = pack4(r); }
}

__device__ __forceinline__ float softplus_f(float x) { return fmaxf(x, 0.f) + log1pf(__expf(-fabsf(x))); }
__device__ __forceinline__ void conv8(const bf16_t* P, const float* cw, const float* cb, int b, int tpos, int col, float* v) {
    const int chan = col - C_XBC;
    { const f32x4 b0 = *(const GAS f32x4*)(cb + chan), b1 = *(const GAS f32x4*)(cb + chan + 4);
      v[0] = b0.x; v[1] = b0.y; v[2] = b0.z; v[3] = b0.w; v[4] = b1.x; v[5] = b1.y; v[6] = b1.z; v[7] = b1.w; }
#pragma unroll
    for (int j = 0; j < 4; ++j) { const int ts = tpos - 3 + j;
        if (ts >= 0) { const u32x4 xv = *(const GAS u32x4*)(P + pidx((size_t)b * SEQ + ts, col)); float xf[8]; unpack8(xv, xf);
            const f32x4 w0 = *(const GAS f32x4*)(cw + j * 1024 + chan), w1 = *(const GAS f32x4*)(cw + j * 1024 + chan + 4);
            v[0] += xf[0] * w0.x; v[1] += xf[1] * w0.y; v[2] += xf[2] * w0.z; v[3] += xf[3] * w0.w; v[4] += xf[4] * w1.x; v[5] += xf[5] * w1.y; v[6] += xf[6] * w1.z; v[7] += xf[7] * w1.w; } }
#pragma unroll
    for (int i = 0; i < 8; ++i) v[i] = silu_f(v[i]);
}

template <bool TR, bool HASF>
__device__ __forceinline__ void conv_tile(const bf16_t* P, const float* cw, const float* cb, int b, int tpos0, int col, const float (&f)[8], u32x4 (&pk)[8]) {
    const int chan = col - C_XBC;
    float w[4][8], bias[8];
#pragma unroll
    for (int j = 0; j < 4; ++j) { const f32x4 w0 = *(const GAS f32x4*)(cw + j * 1024 + chan), w1 = *(const GAS f32x4*)(cw + j * 1024 + chan + 4);
        w[j][0] = w0.x; w[j][1] = w0.y; w[j][2] = w0.z; w[j][3] = w0.w; w[j][4] = w1.x; w[j][5] = w1.y; w[j][6] = w1.z; w[j][7] = w1.w; }
    { const f32x4 b0 = *(const GAS f32x4*)(cb + chan), b1 = *(const GAS f32x4*)(cb + chan + 4);
      bias[0] = b0.x; bias[1] = b0.y; bias[2] = b0.z; bias[3] = b0.w; bias[4] = b1.x; bias[5] = b1.y; bias[6] = b1.z; bias[7] = b1.w; }
    u32x4 rows[11];
    const bf16_t* base = P + pidx((size_t)b * SEQ + tpos0, col);
#pragma unroll
    for (int r = 0; r < 11; ++r) { rows[r] = (u32x4){0u, 0u, 0u, 0u}; if (tpos0 - 3 + r >= 0) rows[r] = *(const GAS u32x4*)(base + (long)(r - 3) * 128); }
    float prev[8];
#pragma unroll
    for (int t = 0; t < 8; ++t) {
        float a[8];
#pragma unroll
        for (int i = 0; i < 8; ++i) a[i] = bias[i];
#pragma unroll
        for (int j = 0; j < 4; ++j) { float xf[8]; unpack8(rows[t + j], xf);
#pragma unroll
            for (int i = 0; i < 8; ++i) a[i] += xf[i] * w[j][i]; }
#pragma unroll
        for (int i = 0; i < 8; ++i) { a[i] = silu_f(a[i]); if (HASF) a[i] *= f[t]; }
        if (TR) {
            if (t & 1) {
#pragma unroll
                for (int i = 0; i < 8; ++i) { const unsigned u = cvt_pk_bf16(prev[i], a[i]);
                    if ((t >> 1) == 0) pk[i].x = u; else if ((t >> 1) == 1) pk[i].y = u; else if ((t >> 1) == 2) pk[i].z = u; else pk[i].w = u; }
            } else {
#pragma unroll
                for (int i = 0; i < 8; ++i) prev[i] = a[i];
            }
        } else {
            pk[t].x = cvt_pk_bf16(a[0], a[1]); pk[t].y = cvt_pk_bf16(a[2], a[3]); pk[t].z = cvt_pk_bf16(a[4], a[5]); pk[t].w = cvt_pk_bf16(a[6], a[7]);
        }
    }
}
__device__ __forceinline__ float dt_scan(const float* DT, const float* dt_bias, const float* a_log, int b, int c, int hd, int lane, float& dtv) {
    const size_t t = (size_t)b * SEQ + c * 64 + lane;
    dtv = softplus_f(((const GAS float*)DT)[t * 8 + hd] + ((const GAS float*)dt_bias)[hd]);
    float x = dtv * (-__expf(((const GAS float*)a_log)[hd]));
#pragma unroll
    for (int o = 1; o < 64; o <<= 1) { const float y = __shfl_up(x, o); if (lane >= o) x += y; }
    return x;
}

__device__ __forceinline__ void ssd_state_task(const Frame& F, const bf16_t* P, const float* DT, const float* cw, const float* cb, const float* dt_bias, const float* a_log,
                                               bf16_t* SST, float* CD, int b, int c, int g) {
    LAS unsigned char* XT = F.lds;
    LAS unsigned char* BT = F.lds + 36864;
    LAS float* dtl = (LAS float*)(F.lds + 55296);
    LAS float* acl = (LAS float*)(F.lds + 56320);
    int lane = F.lane; asm volatile("" : "+v"(lane)); const int fr = lane & 15, fq = lane >> 4, w = F.wave;
    lds_barrier();
    if (w < 4) { float dtv; const float cum = dt_scan(DT, dt_bias, a_log, b, c, 4 * g + w, lane, dtv);
        dtl[lane * 4 + w] = dtv; acl[lane * 4 + w] = cum;
        if (lane == 63) ((GAS float*)CD)[(b * 128 + c) * 8 + 4 * g + w] = __expf(cum); }
    lds_barrier();
    if (F.tid < 384) { int tt = F.tid; asm volatile("" : "+v"(tt)); const int cgi = tt % 48, seg = tt / 48, s0 = 8 * seg;
        const int col = (cgi < 32) ? (C_XBC + g * 256 + 8 * cgi) : (C_XBC + 512 + g * 128 + 8 * (cgi - 32));
        float f[8]; u32x4 pk[8];
        if (cgi < 32) { const int hl = cgi >> 3; const float ae = acl[63 * 4 + hl];
#pragma unroll
            for (int t = 0; t < 8; ++t) f[t] = dtl[(s0 + t) * 4 + hl] * __expf(ae - acl[(s0 + t) * 4 + hl]); }
        else {
#pragma unroll
            for (int t = 0; t < 8; ++t) f[t] = 1.0f; }
        conv_tile<true, true>(P, cw, cb, b, c * 64 + s0, col, f, pk);
        LAS unsigned char* d = (cgi < 32) ? (XT + (8 * cgi) * 144 + s0 * 2) : (BT + (8 * (cgi - 32)) * 144 + s0 * 2);
#pragma unroll
        for (int i = 0; i < 8; ++i) *(LAS u32x4*)(d + i * 144) = pk[i]; }
    lds_barrier();
    const int hl = w >> 1, ph = w & 1;
    bf16x8 yf[2][2];
#pragma unroll
    for (int pt = 0; pt < 2; ++pt)
#pragma unroll
        for (int ks = 0; ks < 2; ++ks) yf[pt][ks] = ldsfrag(XT + (hl * 64 + ph * 32 + 16 * pt + fr) * 144 + (32 * ks + 8 * fq) * 2);
    bf16_t* dst = SST + (size_t)((b * 128 + c) * 8 + 4 * g + hl) * 8192;
#pragma unroll
    for (int nt = 0; nt < 8; ++nt) { f32x4 a0 = (f32x4){0.f, 0.f, 0.f, 0.f}, a1 = a0;
#pragma unroll
        for (int ks = 0; ks < 2; ++ks) { const bf16x8 xf = ldsfrag(BT + (16 * nt + fr) * 144 + (32 * ks + 8 * fq) * 2); a0 = mfma16(xf, yf[0][ks], a0); a1 = mfma16(xf, yf[1][ks], a1); }
#ifdef PROBE_CONST
        a0 = (f32x4){0.01f, 0.02f, 0.03f, 0.04f}; a1 = a0;
#endif
        *(GAS u32x2*)(dst + (ph * 32 + fr) * 128 + 16 * nt + 4 * fq) = pack4(a0);
        *(GAS u32x2*)(dst + (ph * 32 + 16 + fr) * 128 + 16 * nt + 4 * fq) = pack4(a1); }
}

__device__ __forceinline__ void ssd_out_task(const Frame& F, bf16_t* P, const float* DT, const float* cw, const float* cb, const float* dt_bias, const float* a_log,
                                             const float* d_skip, const float* nrm, const bf16_t* SST, int b, int c) {
    LAS unsigned char* Bs = F.lds;
    LAS unsigned char* Cs = F.lds + 17408;
    LAS unsigned char* XT = F.lds + 34816;
    LAS unsigned char* Pw = F.lds + 71680 + F.wave * 2304;
    LAS float* dtl = (LAS float*)(F.lds + 90112);
    LAS float* acl = (LAS float*)(F.lds + 92160);
    LAS float* ssq = (LAS float*)(F.lds + 94208);
    int lane = F.lane; asm volatile("" : "+v"(lane)); const int fr = lane & 15, fq = lane >> 4, w = F.wave, hl = w >> 1, half = w & 1;
    lds_barrier();
    { float dtv; const float cum = dt_scan(DT, dt_bias, a_log, b, c, w, lane, dtv); dtl[lane * 8 + w] = dtv; acl[lane * 8 + w] = cum; }
    float ssl[2] = {0.f, 0.f};
#pragma unroll 1
    for (int g = 0; g < 2; ++g) {
        const int head = 4 * g + hl;
        const bf16_t* hsrc = SST + (size_t)((b * 128 + c) * 8 + head) * 8192;
        bf16x8 hfr[4][4];
#pragma unroll
        for (int ks = 0; ks < 4; ++ks)
#pragma unroll
            for (int pt = 0; pt < 4; ++pt) hfr[ks][pt] = *(const GAS bf16x8*)(hsrc + (16 * pt + fr) * 128 + 32 * ks + 8 * fq);
        lds_barrier();
        { int tt = F.tid; asm volatile("" : "+v"(tt)); const int cgi = tt & 63, seg = tt >> 6, s0 = 8 * seg;
            const int col = (cgi < 32) ? (C_XBC + g * 256 + 8 * cgi) : (cgi < 48) ? (C_XBC + 512 + g * 128 + 8 * (cgi - 32)) : (C_XBC + 768 + g * 128 + 8 * (cgi - 48));
            const float f[8] = {1.f, 1.f, 1.f, 1.f, 1.f, 1.f, 1.f, 1.f}; u32x4 pk[8];
            if (cgi < 32) { conv_tile<true, false>(P, cw, cb, b, c * 64 + s0, col, f, pk);
                LAS unsigned char* d = XT + (8 * cgi) * 144 + s0 * 2;
#pragma unroll
                for (int i = 0; i < 8; ++i) *(LAS u32x4*)(d + i * 144) = pk[i]; }
            else { conv_tile<false, false>(P, cw, cb, b, c * 64 + s0, col, f, pk);
                LAS unsigned char* d = ((cgi < 48) ? (Bs + (8 * (cgi - 32)) * 2) : (Cs + (8 * (cgi - 48)) * 2)) + s0 * 272;
#pragma unroll
                for (int i = 0; i < 8; ++i) *(LAS u32x4*)(d + i * 272) = pk[i]; } }
        u32x2 zvr[2][4];
#pragma unroll
        for (int li = 0; li < 2; ++li)
#pragma unroll
            for (int pt = 0; pt < 4; ++pt) zvr[li][pt] = *(const GAS u32x2*)(P + pidx((size_t)b * SEQ + c * 64 + 16 * (2 * half + li) + fr, C_MZ + head * 64 + 16 * pt + 4 * fq));
        lds_barrier();
        const float dsk = ((const GAS float*)d_skip)[head];
#pragma unroll
        for (int li = 0; li < 2; ++li) {
            asm volatile("" ::: "memory"); __builtin_amdgcn_sched_barrier(0);
            const int lt = 2 * half + li, l = 16 * lt + fr;
            const float al = acl[l * 8 + head];
            bf16x8 cf[4];
#pragma unroll
            for (int ks = 0; ks < 4; ++ks) cf[ks] = ldsfrag(Cs + (16 * lt + fr) * 272 + (32 * ks + 8 * fq) * 2);
            f32x4 y[4];
#pragma unroll
            for (int pt = 0; pt < 4; ++pt) y[pt] = (f32x4){0.f, 0.f, 0.f, 0.f};
#pragma unroll
            for (int ks = 0; ks < 4; ++ks) {
#pragma unroll
                for (int pt = 0; pt < 4; ++pt) y[pt] = mfma16(hfr[ks][pt], cf[ks], y[pt]); }
            { const float eal = __expf(al);
#pragma unroll
              for (int pt = 0; pt < 4; ++pt) y[pt] = y[pt] * eal; }
#pragma unroll
            for (int st = 0; st < 4; ++st) { f32x4 acc = (f32x4){0.f, 0.f, 0.f, 0.f};
#pragma unroll
                for (int ks = 0; ks < 4; ++ks) acc = mfma16(ldsfrag(Bs + (16 * st + fr) * 272 + (32 * ks + 8 * fq) * 2), cf[ks], acc);
#pragma unroll
                for (int i = 0; i < 4; ++i) { const int s = 16 * st + 4 * fq + i;
                    acc[i] = (s <= l) ? acc[i] * __expf(al - acl[s * 8 + head]) * dtl[s * 8 + head] : 0.f; }
                *(LAS u32x2*)(Pw + fr * 144 + (16 * st + 4 * fq) * 2) = pack4(acc); }
#pragma unroll
            for (int ks = 0; ks < 2; ++ks) { if (2 * ks <= lt) { const bf16x8 pf = ldsfrag(Pw + fr * 144 + (32 * ks + 8 * fq) * 2);
#pragma unroll
                for (int pt = 0; pt < 4; ++pt) y[pt] = mfma16(ldsfrag(XT + (hl * 64 + 16 * pt + fr) * 144 + (32 * ks + 8 * fq) * 2), pf, y[pt]); } }
            const size_t row = (size_t)b * SEQ + c * 64 + l;
#pragma unroll
            for (int pt = 0; pt < 4; ++pt) { const int p0 = 16 * pt + 4 * fq;
                const u32x2 zv = zvr[li][pt];
                const LAS bf16_t* xp = (const LAS bf16_t*)(XT + (hl * 64 + p0) * 144 + l * 2);
                f32x4 r;
                r[0] = (y[pt][0] + bf2f(xp[0 * 72]) * dsk) * silu_f(bf_lo(zv.x)); r[1] = (y[pt][1] + bf2f(xp[1 * 72]) * dsk) * silu_f(bf_hi(zv.x));
                r[2] = (y[pt][2] + bf2f(xp[2 * 72]) * dsk) * silu_f(bf_lo(zv.y)); r[3] = (y[pt][3] + bf2f(xp[3 * 72]) * dsk) * silu_f(bf_hi(zv.y));
                ssl[li] += (r[0] * r[0] + r[1] * r[1]) + (r[2] * r[2] + r[3] * r[3]);
                *(GAS u32x2*)(P + pidx(row, C_MZ + head * 64 + p0)) = pack4(r); }
        }
    }
#pragma unroll
    for (int li = 0; li < 2; ++li) { float ss = ssl[li];
        ss += __shfl_xor(ss, 16); ss += __shfl_xor(ss, 32);
        if (fq == 0) ssq[hl * 64 + 16 * (2 * half + li) + fr] = ss; }
    asm volatile("s_waitcnt vmcnt(0)" ::: "memory");
    lds_barrier();
#pragma unroll
    for (int li = 0; li < 2; ++li) { const int l = 16 * (2 * half + li) + fr;
        const float rstd = rsqrtf((ssq[l] + ssq[64 + l] + ssq[128 + l] + ssq[192 + l]) * (1.f / 512.f) + EPS);
        const size_t row = (size_t)b * SEQ + c * 64 + l;
#pragma unroll 1
        for (int g = 0; g < 2; ++g)
#pragma unroll
            for (int pt = 0; pt < 4; ++pt) { const int ch = (4 * g + hl) * 64 + 16 * pt + 4 * fq;
                const f32x4 ng = *(const GAS f32x4*)(nrm + ch);
                GAS u32x2* yp = (GAS u32x2*)(P + pidx(row, C_MZ + ch));
                const u32x2 pk = *yp; const f32x4 r = (f32x4){bf_lo(pk.x), bf_hi(pk.x), bf_lo(pk.y), bf_hi(pk.y)};
                *yp = pack4(r * rstd * ng); } }
}

__device__ __forceinline__ void scan_phase(const Frame& F, bf16_t* RST, bf16_t* SST, const float* CD) {
    for (int task = F.bid * NTHR + F.tid; task < 131072; task += F.G * NTHR) {
        {
          const int pr = task & 8191, bh = task >> 13, b = bh >> 2, h = bh & 3;
          GAS unsigned* p = (GAS unsigned*)(RST + (size_t)((b * 128) * 4 + h) * 16384) + pr;
          const float dec = __builtin_amdgcn_exp2f(64.f * log2gamma(h));
          float s0 = 0.f, s1 = 0.f;
#pragma unroll 1
          for (int c0 = 0; c0 < 128; c0 += 32) { unsigned v[32];
#pragma unroll
              for (int i = 0; i < 32; ++i) v[i] = p[(size_t)(c0 + i) * 32768];
#pragma unroll
              for (int i = 0; i < 32; ++i) { p[(size_t)(c0 + i) * 32768] = cvt_pk_bf16(s0, s1); s0 = s0 * dec + bf_lo(v[i]); s1 = s1 * dec + bf_hi(v[i]); } } }
        {
          const int pr = task & 4095, bh = task >> 12, b = bh >> 3, hd = bh & 7;
          GAS unsigned* p = (GAS unsigned*)(SST + (size_t)((b * 128) * 8 + hd) * 8192) + pr;
          const GAS float* cd = (const GAS float*)(CD + (b * 128) * 8 + hd);
          float s0 = 0.f, s1 = 0.f;
#pragma unroll 1
          for (int c0 = 0; c0 < 128; c0 += 32) { unsigned v[32]; float d[32];
#pragma unroll
              for (int i = 0; i < 32; ++i) { v[i] = p[(size_t)(c0 + i) * 32768]; d[i] = cd[(c0 + i) * 8]; }
#pragma unroll
              for (int i = 0; i < 32; ++i) { p[(size_t)(c0 + i) * 32768] = cvt_pk_bf16(s0, s1); s0 = s0 * d[i] + bf_lo(v[i]); s1 = s1 * d[i] + bf_hi(v[i]); } } }
    }
}

constexpr int NPH = 26;
__global__ void __launch_bounds__(NTHR, 2) fwd_kernel(Params p) {
    extern __shared__ __attribute__((aligned(16))) unsigned char lds_raw[];
    if (p.ph_lo == 0) {
        Frame F0; F0.lds = (LAS unsigned char*)lds_raw; F0.tid = threadIdx.x; F0.lane = F0.tid & 63; F0.wave = __builtin_amdgcn_readfirstlane(F0.tid >> 6); F0.G = gridDim.x; F0.bid = blockIdx.x;
        if (EN_PRO) prologue(F0, p, as_global(p.ws), 0);
        if (p.ph_hi > 1) cg::this_grid().sync();
    }
#ifdef TPROBE
    unsigned long long tA = 0, tB = 0;
#endif
    for (int ph_ = (p.ph_lo < 1 ? 1 : p.ph_lo); ph_ < p.ph_hi; ++ph_) {
#ifdef TPROBE
    const unsigned long long tp0 = __builtin_amdgcn_s_memrealtime();
#endif
    int ph = __builtin_amdgcn_readfirstlane(ph_);
#ifdef PH_LIMIT
    if (ph > PH_LIMIT && ph < NPH - 1) continue;
#endif
    int tid_ = threadIdx.x; asm volatile("" : "+v"(tid_));
    unsigned char* ws_ = p.ws; asm volatile("" : "+s"(ws_)); unsigned char* ws = as_global(ws_);
    int zi = 0; asm volatile("" : "+s"(zi));
    Frame F;
    F.lds = (LAS unsigned char*)lds_raw;
    F.tid = tid_; F.lane = F.tid & 63; F.wave = __builtin_amdgcn_readfirstlane(F.tid >> 6); { int g_ = gridDim.x, b_ = blockIdx.x; asm volatile("" : "+s"(g_), "+s"(b_)); F.G = g_; F.bid = b_; }
    float* MOD = (float*)(ws + WS_MOD);
    const f32x2* ROPE = (const f32x2*)(ws + WS_ROPE);
    float* DT = (float*)(ws + WS_DT);
    float* CD = (float*)(ws + WS_CD);
    bf16_t* WFU = (bf16_t*)(ws + WS_WFU); bf16_t* WFD = (bf16_t*)(ws + WS_WFD); bf16_t* WIN = (bf16_t*)(ws + WS_WIN); bf16_t* WOUT = (bf16_t*)(ws + WS_WOUT);
    bf16_t* U = (bf16_t*)(ws + WS_U); bf16_t* RST = (bf16_t*)(ws + WS_RST); bf16_t* SST = (bf16_t*)(ws + WS_SST);
    bf16_t* PROJ = (bf16_t*)(ws + WS_PROJ); bf16_t* HID = PROJ;
    float* hbuf_ = p.out; asm volatile("" : "+s"(hbuf_)); float* hbuf = as_global(hbuf_);
        if (ph == NPH - 1) {
            if (EN_FIN) final_phase(F, hbuf, as_global(p.in[24 + zi]), MOD + FMOD_OFF);
        } else {
#ifdef XTRA_LIST
            static constexpr int xtra[] = XTRA_LIST;
            const int l = (ph >= NPH) ? 1 : (ph - 1) / 12, j = (ph >= NPH) ? xtra[ph - NPH] : (ph - 1) % 12;
#else
            const int l = (ph - 1) / 12, j = (ph - 1) % 12;
#endif
            const float* modl = MOD + (size_t)l * 4 * 9216;
            if (j == 0 || j == 3 || j == 9) {
                const float* hin = (l == 0 && j == 0) ? as_global(p.in[0 + zi]) : hbuf;
                const int gi = (j == 0) ? 4 : (j == 3) ? 8 : 18;
                const int mi = (j == 0) ? 0 : (j == 3) ? 3 : 6;
                if (EN_NORM) norm_phase(F, hin, as_global(p.in[gi + zi]) + l * DM, modl + mi * 1024, modl + (mi + 1) * 1024, 9216, U);
                __syncthreads();
                if (!EN_CONV) {} else if (j == 0) convert_ffn(F, as_global(p.in[5 + zi]) + (size_t)l * DM * DFF, as_global(p.in[6 + zi]) + (size_t)l * DM * DFF, as_global(p.in[7 + zi]) + (size_t)l * DM * DFF, WFU, WFD);
                else if (j == 9) convert_ffn(F, as_global(p.in[19 + zi]) + (size_t)l * DM * DFF, as_global(p.in[20 + zi]) + (size_t)l * DM * DFF, as_global(p.in[21 + zi]) + (size_t)l * DM * DFF, WFU, WFD);
                else convert_mix(F, as_global(p.in[9 + zi]) + (size_t)l * DM * INW, as_global(p.in[17 + zi]) + (size_t)l * 1536 * DM, WIN, WOUT);
            } else if (j == 1 || j == 10) {
                pg8::Gemm g{U, WFU, T_TOK, 2 * DFF, DM, DM}; pg8::StaticOrder S; S.init(T_TOK, 2 * DFF, F.G, F.bid);
                pg8::EpiSwiGLU E{HID, DFF};
                if (EN_G1) pg8::gemm_phase<pg8::EpiSwiGLU>(F.lds, F.tid, g, S, E);
            } else if (j == 2 || j == 11 || j == 8) {
                pg8::Gemm g; pg8::EpiResid E;
                if (j == 8) { g = pg8::Gemm{PROJ, WOUT, T_TOK, DM, 1536, PW}; E = pg8::EpiResid{hbuf, hbuf, modl + 5 * 1024, 1.0f}; }
                else { g = pg8::Gemm{HID, WFD, T_TOK, DM, DFF, DFF}; E = pg8::EpiResid{(l == 0 && j == 2) ? as_global(p.in[0 + zi]) : hbuf, hbuf, modl + (j == 2 ? 2 : 8) * 1024, 0.5f}; }
                pg8::StaticOrder S; S.init(T_TOK, DM, F.G, F.bid);
                if (EN_G2) { if (j == 8) pg8::gemm_phase<pg8::EpiResid, true>(F.lds, F.tid, g, S, E); else pg8::gemm_phase<pg8::EpiResid, false>(F.lds, F.tid, g, S, E); }
            } else if (j == 4) {
                pg8::Gemm g{U, WIN, T_TOK, PW, DM, DM}; pg8::StaticOrder S; S.init(T_TOK, PW, F.G, F.bid);
                pg8::EpiBf16 E{PROJ, PW};
                if (EN_G3) pg8::gemm_phase<pg8::EpiBf16>(F.lds, F.tid, g, S, E);
                if (EN_DT) dt_gemv(F, U, as_global(p.in[9 + zi]) + (size_t)l * DM * INW, DT);
            } else if (j == 5) {
                if (EN_SB && XS(1)) for (int t = F.bid; t < 1024; t += F.G) { const int qb = 63 - (t >> 4), bh = t & 15; sb_task(F, PROJ, bh >> 2, bh & 3, qb); }
                if (EN_RKV && XS(2)) for (int t = F.bid; t < 2048; t += F.G) { const int h = t & 3, bc = t >> 2; ret_kv_task(F, PROJ, ROPE, RST, bc >> 7, bc & 127, h); }
                if (EN_SST && XS(4)) for (int t = F.bid; t < 1024; t += F.G) { const int g = t & 1, bc = t >> 1;
                    ssd_state_task(F, PROJ, DT, as_global(p.in[10 + zi]) + l * 4096, as_global(p.in[11 + zi]) + l * 1024, as_global(p.in[12 + zi]) + l * 8, as_global(p.in[13 + zi]) + l * 8, SST, CD, bc >> 7, bc & 127, g); }
            } else if (j == 6) {
                if (EN_SCAN) scan_phase(F, RST, SST, CD);
            } else if (j == 7) {
                if (EN_ROUT && XS(8)) for (int t = F.bid; t < 2048; t += F.G) { const int h = t & 3, bc = t >> 2; ret_out_task(F, PROJ, ROPE, RST, as_global(p.in[15 + zi]) + l * 512, bc >> 7, bc & 127, h, ph >= NPH ? XMODE : 0); }
                if (EN_SOUT && XS(16)) for (int t = F.bid; t < 512; t += F.G) {
                    ssd_out_task(F, PROJ, DT, as_global(p.in[10 + zi]) + l * 4096, as_global(p.in[11 + zi]) + l * 1024, as_global(p.in[12 + zi]) + l * 8, as_global(p.in[13 + zi]) + l * 8, as_global(p.in[14 + zi]) + l * 8, as_global(p.in[16 + zi]) + l * 512, SST, t >> 7, t & 127); }
            }
        }
        if (ph + 1 < p.ph_hi) { cg::this_grid().sync(); }
#ifdef TPROBE
        { const unsigned long long tp1 = __builtin_amdgcn_s_memrealtime(); const int jj = (ph - 1) % 12;
          if (ph < NPH - 1) { if (TPROBE_A(jj)) tA += tp1 - tp0; if (TPROBE_B(jj)) tB += tp1 - tp0; } }
#endif
    }
#ifdef TPROBE
    cg::this_grid().sync();
    if (blockIdx.x == 0) { const float a = (float)tA * 0.01f, b = (float)tB * 0.01f * TPROBE_BS;
        if (threadIdx.x == 0) p.out[0] += a;
        for (int i = threadIdx.x; i < (1 << 20); i += NTHR) p.out[1024 + i] += b; }
#endif
}

extern "C" void kernel_launch(void* const* d_in, const int* in_sizes, int n_in, void* d_out, int out_size, void* d_ws, size_t ws_size, hipStream_t stream) {
    static int grid = 0;
    if (grid == 0) {
        if (n_in != 25 || out_size != T_TOK * DM || ws_size < WS_END) { fprintf(stderr, "kernel_launch: unexpected shapes (n_in %d out %d ws %zu)\n", n_in, out_size, ws_size); grid = -1; return; }
        int dev = 0, cus = 0, per_cu = 0;
        hipGetDevice(&dev);
        hipDeviceGetAttribute(&cus, hipDeviceAttributeMultiprocessorCount, dev);
        hipFuncSetAttribute((const void*)fwd_kernel, hipFuncAttributeMaxDynamicSharedMemorySize, LDS_BYTES);
        hipOccupancyMaxActiveBlocksPerMultiprocessor(&per_cu, (const void*)fwd_kernel, NTHR, LDS_BYTES);
        if (per_cu < 1) per_cu = 1;
        (void)hipGetLastError();
        grid = cus * per_cu;
    }
    if (grid < 0) return;
    Params p{};
    for (int i = 0; i < 25; ++i) p.in[i] = (const float*)d_in[i];
    p.out = (float*)d_out; p.ws = (unsigned char*)d_ws;
#if ONE_LAUNCH
#ifdef XTRA_LIST
    p.ph_lo = 0; p.ph_hi = NPH + XTRA_N;
#else
    p.ph_lo = 0; p.ph_hi = NPH;
#endif
    void* args[] = {&p};
    hipError_t e = hipLaunchCooperativeKernel((const void*)fwd_kernel, dim3(grid), dim3(NTHR), args, LDS_BYTES, stream);
    if (e != hipSuccess) fprintf(stderr, "cooperative launch failed: %s (grid %d)\n", hipGetErrorString(e), grid);
#else
    for (int ph = 0; ph < NPH; ++ph) { p.ph_lo = ph; p.ph_hi = ph + 1; hipLaunchKernelGGL(fwd_kernel, dim3(grid), dim3(NTHR), LDS_BYTES, stream, p); }
#endif
}
```

```cpp
#include <hip/hip_runtime.h>
#include <hip/hip_cooperative_groups.h>
#include <cstdint>
#include <cstdio>
namespace cg = cooperative_groups;

#ifndef ONE_LAUNCH
#define ONE_LAUNCH 1
#endif

#ifndef EN_ALL
#define EN_ALL 1
#endif
#ifndef EN_PRO
#define EN_PRO EN_ALL
#endif
#ifndef EN_FIN
#define EN_FIN EN_ALL
#endif
#ifndef EN_NORM
#define EN_NORM EN_ALL
#endif
#ifndef EN_CONV
#define EN_CONV EN_ALL
#endif
#ifndef EN_G1
#define EN_G1 EN_ALL
#endif
#ifndef EN_G2
#define EN_G2 EN_ALL
#endif
#ifndef EN_G3
#define EN_G3 EN_ALL
#endif
#ifndef EN_DT
#define EN_DT EN_ALL
#endif
#ifndef EN_SB
#define EN_SB EN_ALL
#endif
#ifndef EN_RKV
#define EN_RKV EN_ALL
#endif
#ifndef EN_SST
#define EN_SST EN_ALL
#endif
#ifndef EN_SCAN
#define EN_SCAN EN_ALL
#endif
#ifndef EN_ROUT
#define EN_ROUT EN_ALL
#endif
#ifndef EN_SOUT
#define EN_SOUT EN_ALL
#endif
#ifndef EN_SINTER
#define EN_SINTER 1
#endif
#ifndef XSEL
#define XSEL 31
#endif
#define XS(m) (ph < NPH || (XSEL & (m)))
#ifndef XMODE
#define XMODE 0
#endif
#define LAS __attribute__((address_space(3)))
#define GAS __attribute__((address_space(1)))
template <class T> __device__ __forceinline__ T* as_global(T* p) {
#if defined(__HIP_DEVICE_COMPILE__)
    __builtin_assume(!__builtin_amdgcn_is_shared((const void*)p)); __builtin_assume(!__builtin_amdgcn_is_private((const void*)p));
#endif
    return p; }
typedef unsigned short bf16_t;
typedef short bf16x8 __attribute__((ext_vector_type(8)));
typedef float f32x4 __attribute__((ext_vector_type(4)));
typedef float f32x2 __attribute__((ext_vector_type(2)));
typedef unsigned u32x4 __attribute__((ext_vector_type(4)));
typedef unsigned u32x2 __attribute__((ext_vector_type(2)));

constexpr int T_TOK = 32768, SEQ = 8192, DM = 1024, DFF = 2816, INW = 5128, PW = 5120;
constexpr int NTHR = 512, NWAVE = 8;
constexpr float EPS = 1e-6f;
constexpr int C_RQ = 0, C_SQ = 512, C_MZ = 1024, C_RK = 1536, C_RV = 2048, C_RG = 2560, C_SK = 3072, C_SV = 3584, C_XBC = 4096;

constexpr size_t MiB = 1u << 20;
constexpr size_t WS_MOD = 1 * MiB, WS_ROPE = 2 * MiB, WS_DT = 6 * MiB, WS_CD = 7 * MiB;
constexpr size_t WS_WFU = 8 * MiB, WS_WFD = 19 * MiB, WS_WIN = 25 * MiB, WS_WOUT = 35 * MiB;
constexpr size_t WS_U = 38 * MiB, WS_RST = 38 * MiB, WS_SST = 102 * MiB, WS_PROJ = 166 * MiB, WS_END = 486 * MiB;
constexpr int FMOD_OFF = 2 * 4 * 9 * 1024;

constexpr size_t PLANE = (size_t)T_TOK * 128;
__device__ __forceinline__ size_t pidx(size_t row, int col) { return (size_t)(col >> 7) * PLANE + row * 128 + (col & 127); }
constexpr int LDS_BYTES = 147456;

struct Params {
    const float* in[25];
    float* out;
    unsigned char* ws;
    int ph_lo, ph_hi;
};

typedef __bf16 bf16x2_t __attribute__((ext_vector_type(2)));
__device__ __forceinline__ unsigned cvt_pk_bf16(float lo, float hi) { const f32x2 v = {lo, hi}; const bf16x2_t b = __builtin_convertvector(v, bf16x2_t); return __builtin_bit_cast(unsigned, b); }
__device__ __forceinline__ float bf_lo(unsigned u) { return __uint_as_float(u << 16); }
__device__ __forceinline__ float bf_hi(unsigned u) { return __uint_as_float(u & 0xffff0000u); }
__device__ __forceinline__ float bf2f(bf16_t x) { return __uint_as_float(((unsigned)x) << 16); }
__device__ __forceinline__ bf16_t f2bf(float f) { return (bf16_t)(cvt_pk_bf16(f, 0.f) & 0xffffu); }
__device__ __forceinline__ float wave_sum(float v) {
#pragma unroll
    for (int o = 1; o < 64; o <<= 1) v += __shfl_xor(v, o);
    return v;
}
__device__ __forceinline__ float wave_max(float v) {
#pragma unroll
    for (int o = 1; o < 64; o <<= 1) v = fmaxf(v, __shfl_xor(v, o));
    return v;
}
__device__ __forceinline__ void lds_barrier() { asm volatile("s_waitcnt lgkmcnt(0)" ::: "memory"); __builtin_amdgcn_s_barrier(); asm volatile("" ::: "memory"); }
__device__ __forceinline__ float silu_f(float g) { return g * __builtin_amdgcn_rcpf(1.0f + __builtin_amdgcn_exp2f(-1.44269504f * g)); }
__device__ __forceinline__ f32x4 mfma16(bf16x8 a, bf16x8 b, f32x4 c) { return __builtin_amdgcn_mfma_f32_16x16x32_bf16(a, b, c, 0, 0, 0); }
__device__ __forceinline__ bf16x8 ldsfrag(const LAS unsigned char* p) { return *(const LAS bf16x8*)p; }
__device__ __forceinline__ u32x2 pack4(f32x4 v) { u32x2 w; w.x = cvt_pk_bf16(v[0], v[1]); w.y = cvt_pk_bf16(v[2], v[3]); return w; }
__device__ __forceinline__ void unpack8(u32x4 v, float* f) {
    f[0] = bf_lo(v.x); f[1] = bf_hi(v.x); f[2] = bf_lo(v.y); f[3] = bf_hi(v.y); f[4] = bf_lo(v.z); f[5] = bf_hi(v.z); f[6] = bf_lo(v.w); f[7] = bf_hi(v.w);
}
__device__ __forceinline__ float log2gamma(int h) { return h == 0 ? -0.04580368961312479f : (h == 1 ? -0.02272007650008353f : (h == 2 ? -0.011315313227834146f : -0.005646563141142063f)); }

namespace pg8 {
constexpr int BM = 256, BK = 64, HALF = 128, HTB = HALF * BK * 2, STAGE_BYTES = 8 * HTB, NXCD = 8, WGM = 8;
__host__ __device__ __forceinline__ int lds_byte(int r, int c) { const int st = (r >> 4) * 2 + (c >> 5), rr = r & 15, cc = c & 31, ob = rr * 64 + cc * 2; return st * 1024 + (ob ^ (((ob >> 9) & 1) << 5)); }
__host__ __device__ __forceinline__ void stage_rc(int b, int& R, int& C) { const int st = b / 1024, sb = b % 1024, swz = sb ^ (((sb >> 9) & 1) << 5); R = (st >> 1) * 16 + swz / 64; C = (st & 1) * 32 + (swz % 64) / 2; }
__host__ __device__ __forceinline__ int perm32(int rho) { const int n = rho >> 4, i = rho & 15; return 8 * (i >> 2) + 4 * n + (i & 3); }
struct Unit { int pm, pn; };
struct Gemm { const bf16_t* A; const bf16_t* Bt; int M, N, K, lda; };
struct StaticOrder {
    int nM, nN, nwg, G, c;
    __device__ void init(int M, int N, int G_, int c_) { nM = M / BM; nN = N / BM; nwg = nM * nN; G = G_; c = c_; }
    __device__ bool next(int i, Unit& u) const {
        const long L = (long)i * G + c; if (L >= nwg) return false;
        int wgid = (int)L; { const int q = nwg / NXCD, r = nwg % NXCD, xcd = wgid % NXCD, off = wgid / NXCD; wgid = (xcd < r ? xcd * (q + 1) : r * (q + 1) + (xcd - r) * q) + off; }
        const int nig = WGM * nN, gid = wgid / nig, fm = gid * WGM, gsz = (nM - fm) < WGM ? (nM - fm) : WGM;
        u.pm = fm + ((wgid % nig) % gsz); u.pn = (wgid % nig) / gsz; return true;
    }
};
struct EpiBf16 {
    bf16_t* O; int ldc;
    __device__ __forceinline__ void operator()(const f32x4 (&acc)[2][2][4][2], const Unit& u, int wr, int wc, int fr, int fq) const {
        const int row0 = u.pm * BM + wr * 64 + fr, col0 = u.pn * BM + wc * 32 + 8 * fq;
#pragma unroll
        for (int ai = 0; ai < 2; ++ai)
#pragma unroll
            for (int m = 0; m < 4; ++m) { bf16_t* rowp = O + (size_t)(2 * u.pn) * PLANE + (size_t)(row0 + ai * HALF + m * 16) * 128 + wc * 32 + 8 * fq;
#pragma unroll
                for (int bj = 0; bj < 2; ++bj) { const f32x4 v0 = acc[ai][bj][m][0], v1 = acc[ai][bj][m][1];
                    u32x4 w; w.x = cvt_pk_bf16(v0[0], v0[1]); w.y = cvt_pk_bf16(v0[2], v0[3]); w.z = cvt_pk_bf16(v1[0], v1[1]); w.w = cvt_pk_bf16(v1[2], v1[3]);
                    *(GAS u32x4*)(rowp + bj * PLANE) = w; } }
    }
};
struct EpiSwiGLU {
    bf16_t* O; int ldo;
    __device__ __forceinline__ void operator()(const f32x4 (&acc)[2][2][4][2], const Unit& u, int wr, int wc, int fr, int fq) const {
        const int row0 = u.pm * BM + wr * 64 + fr, col0 = u.pn * HALF + wc * 32 + 8 * fq;
#pragma unroll
        for (int ai = 0; ai < 2; ++ai)
#pragma unroll
            for (int m = 0; m < 4; ++m) { bf16_t* rowp = O + (size_t)(row0 + ai * HALF + m * 16) * ldo + col0;
                float hv[8];
#pragma unroll
                for (int n = 0; n < 2; ++n)
#pragma unroll
                    for (int i = 0; i < 4; ++i) hv[4 * n + i] = silu_f(acc[ai][0][m][n][i]) * acc[ai][1][m][n][i];
                u32x4 w; w.x = cvt_pk_bf16(hv[0], hv[1]); w.y = cvt_pk_bf16(hv[2], hv[3]); w.z = cvt_pk_bf16(hv[4], hv[5]); w.w = cvt_pk_bf16(hv[6], hv[7]);
                *(GAS u32x4*)rowp = w; }
    }
};
struct EpiResid {
    const float* hin; float* hout; const float* gate; float cmul;
    __device__ __forceinline__ void operator()(const f32x4 (&acc)[2][2][4][2], const Unit& u, int wr, int wc, int fr, int fq) const {
        const int row0 = u.pm * BM + wr * 64 + fr, col0 = u.pn * BM + wc * 32 + 8 * fq;
        const int b = (u.pm * BM) >> 13;
        f32x4 gm[2][2];
#pragma unroll
        for (int bj = 0; bj < 2; ++bj)
#pragma unroll
            for (int n = 0; n < 2; ++n) { const f32x4 g = *(const GAS f32x4*)(gate + (size_t)b * 9216 + col0 + bj * HALF + 4 * n); gm[bj][n] = (g + 1.0f) * cmul; }
#pragma unroll
        for (int ai = 0; ai < 2; ++ai)
#pragma unroll
            for (int m = 0; m < 4; ++m) { const size_t off = (size_t)(row0 + ai * HALF + m * 16) * DM + col0;
#pragma unroll
                for (int bj = 0; bj < 2; ++bj)
#pragma unroll
                    for (int n = 0; n < 2; ++n) { const f32x4 hv = *(const GAS f32x4*)(hin + off + bj * HALF + 4 * n);
                        *(GAS f32x4*)(hout + off + bj * HALF + 4 * n) = hv + gm[bj][n] * acc[ai][bj][m][n]; } }
    }
};

template <class Epi, bool APL = false>
__device__ __forceinline__ void gemm_phase(LAS unsigned char* lds, const int tid, const Gemm g, const StaticOrder& S, const Epi& E) {
    const int wid = __builtin_amdgcn_readfirstlane(tid >> 6), lane = tid & 63, wr = wid >> 2, wc = wid & 3, fr = lane & 15, fq = lane >> 4;
    const int K = g.K, nt = K / BK, lda = g.lda;
    unsigned voffA[2], voffB[2];
#pragma unroll
    for (int i = 0; i < 2; ++i) { int R, C; stage_rc(tid * 16 + i * 8192, R, C); const int Rb = (R & ~31) + perm32(R & 31);
        voffA[i] = (unsigned)(R * (APL ? 128 : lda) + C) * 2u; voffB[i] = (unsigned)(Rb * K + C) * 2u; }
    const size_t kstep = (size_t)(BK * 2);
    const size_t hstepA = (size_t)HALF * (APL ? 128 : lda) * 2, hstepB = (size_t)HALF * K * 2;
#define PG8_KA(t) (APL ? ((size_t)((t) >> 1) * (PLANE * 2) + (size_t)((t) & 1) * 128) : (size_t)(t) * kstep)
    const size_t tstepA = 2 * hstepA, tstepB = 2 * hstepB;
    const unsigned ldsw = (unsigned)wid * 1024u;
    const int aoff = lds_byte(wr * 64 + fr, fq * 8), boff = lds_byte(wc * 32 + fr, fq * 8);
#define PG8_SA(b, h) (((b) * 2 + (h)) * HTB)
#define PG8_SB(b, h) ((4 + (b) * 2 + (h)) * HTB)
#define PG8_STAGE(bufoff, gbase, voff) do { _Pragma("unroll") for (int _i = 0; _i < 2; ++_i) \
        __builtin_amdgcn_global_load_lds((const unsigned*)((const char*)(gbase) + (voff)[_i]), (LAS unsigned*)(lds + (bufoff) + ldsw + _i * 8192), 16, 0, 0); } while (0)
#define PG8_LDA(dst, b, h) do { _Pragma("unroll") for (int m = 0; m < 4; ++m) _Pragma("unroll") for (int k = 0; k < 2; ++k) dst[m][k] = *(const LAS bf16x8*)(lds + PG8_SA(b, h) + aoff + m * 2048 + k * 1024); } while (0)
#define PG8_LDB(dst, b, h) do { _Pragma("unroll") for (int n = 0; n < 2; ++n) _Pragma("unroll") for (int k = 0; k < 2; ++k) dst[n][k] = *(const LAS bf16x8*)(lds + PG8_SB(b, h) + boff + n * 2048 + k * 1024); } while (0)
#define PG8_MMA(ai, bj, At, Bt) do { __builtin_amdgcn_s_setprio(1); _Pragma("unroll") for (int m = 0; m < 4; ++m) _Pragma("unroll") for (int n = 0; n < 2; ++n) _Pragma("unroll") for (int k = 0; k < 2; ++k) \
        acc[ai][bj][m][n] = __builtin_amdgcn_mfma_f32_16x16x32_bf16(Bt[n][k], At[m][k], acc[ai][bj][m][n], 0, 0, 0); __builtin_amdgcn_s_setprio(0); } while (0)
#define PG8_WAIT_V(n) asm volatile("s_waitcnt vmcnt(" #n ")" ::: "memory")
#define PG8_WAIT_L(n) asm volatile("s_waitcnt lgkmcnt(" #n ")" ::: "memory")
#define PG8_BAR __builtin_amdgcn_s_barrier()
#define PG8_SCHED __builtin_amdgcn_sched_barrier(0)
    Unit cur, nxt; int ui = 0;
    if (!S.next(0, cur)) return;
    f32x4 acc[2][2][4][2];
#pragma unroll
    for (int a = 0; a < 2; ++a)
#pragma unroll
        for (int b = 0; b < 2; ++b)
#pragma unroll
            for (int m = 0; m < 4; ++m)
#pragma unroll
                for (int n = 0; n < 2; ++n) acc[a][b][m][n] = (f32x4){0.f, 0.f, 0.f, 0.f};
    bf16x8 At[4][2], B0[2][2], B1[2][2];
    const char* cA = (const char*)g.A + (size_t)cur.pm * tstepA; const char* cB = (const char*)g.Bt + (size_t)cur.pn * tstepB;
    PG8_STAGE(PG8_SB(0, 0), cB, voffB); PG8_STAGE(PG8_SB(0, 1), cB + hstepB, voffB); PG8_STAGE(PG8_SA(0, 0), cA, voffA); PG8_STAGE(PG8_SA(0, 1), cA + hstepA, voffA);
    if (wr == 1) PG8_BAR;
    PG8_WAIT_V(2); PG8_BAR;
    PG8_STAGE(PG8_SB(1, 0), cB + kstep, voffB); PG8_STAGE(PG8_SA(1, 0), cA + PG8_KA(1), voffA); PG8_STAGE(PG8_SB(1, 1), cB + hstepB + kstep, voffB);
    PG8_WAIT_V(6); PG8_BAR;
    for (;;) {
        const bool has_next = S.next(ui + 1, nxt);
        const char* nA = has_next ? (const char*)g.A + (size_t)nxt.pm * tstepA : cA; const char* nB = has_next ? (const char*)g.Bt + (size_t)nxt.pn * tstepB : cB;
        for (int t = 0; t < nt; t += 2) {
            const bool last = (t == nt - 2);
            const char* a1 = cA + PG8_KA(t + 1);
            const char* a2 = last ? nA : cA + PG8_KA(t + 2); const char* b2 = last ? nB : cB + (size_t)(t + 2) * kstep;
            const char* a3 = last ? nA + PG8_KA(1) : cA + PG8_KA(t + 3); const char* b3 = b2 + kstep;
            PG8_LDB(B0, 0, 0); PG8_LDB(B1, 0, 1); PG8_SCHED; PG8_LDA(At, 0, 0); PG8_STAGE(PG8_SA(1, 1), a1 + hstepA, voffA);
            PG8_WAIT_V(8); PG8_WAIT_L(0); PG8_BAR; PG8_MMA(0, 0, At, B0); PG8_MMA(0, 1, At, B1); PG8_BAR; PG8_SCHED;
            PG8_LDA(At, 0, 1); PG8_STAGE(PG8_SB(0, 0), b2, voffB); PG8_STAGE(PG8_SB(0, 1), b2 + hstepB, voffB); PG8_STAGE(PG8_SA(0, 0), a2, voffA);
            PG8_WAIT_V(8); PG8_WAIT_L(0); PG8_BAR; PG8_MMA(1, 0, At, B0); PG8_MMA(1, 1, At, B1); PG8_BAR; PG8_SCHED;
            PG8_LDB(B0, 1, 0); PG8_LDB(B1, 1, 1); PG8_SCHED; PG8_LDA(At, 1, 0); PG8_STAGE(PG8_SA(0, 1), a2 + hstepA, voffA);
            PG8_WAIT_V(8); PG8_WAIT_L(0); PG8_BAR; PG8_MMA(0, 0, At, B0); PG8_MMA(0, 1, At, B1); PG8_BAR; PG8_SCHED;
            PG8_LDA(At, 1, 1); PG8_STAGE(PG8_SB(1, 0), b3, voffB); PG8_STAGE(PG8_SB(1, 1), b3 + hstepB, voffB); PG8_STAGE(PG8_SA(1, 0), a3, voffA);
            PG8_WAIT_V(8); PG8_WAIT_L(0); PG8_BAR; PG8_MMA(1, 0, At, B0); PG8_MMA(1, 1, At, B1); PG8_BAR; PG8_SCHED;
        }
        if (wr == 0) PG8_BAR;
        E(acc, cur, wr, wc, fr, fq);
        if (!has_next) break;
#pragma unroll
        for (int a = 0; a < 2; ++a)
#pragma unroll
            for (int b = 0; b < 2; ++b)
#pragma unroll
                for (int m = 0; m < 4; ++m)
#pragma unroll
                    for (int n = 0; n < 2; ++n) acc[a][b][m][n] = (f32x4){0.f, 0.f, 0.f, 0.f};
        cur = nxt; cA = nA; cB = nB; ++ui;
        if (wr == 1) PG8_BAR;
    }
    PG8_WAIT_V(0);
    PG8_BAR;
#undef PG8_KA
#undef PG8_SA
#undef PG8_SB
#undef PG8_STAGE
#undef PG8_LDA
#undef PG8_LDB
#undef PG8_MMA
#undef PG8_WAIT_V
#undef PG8_WAIT_L
#undef PG8_BAR
#undef PG8_SCHED
}
}

struct Frame {
    LAS unsigned char* lds;
    int tid, lane, wave, G, bid;
};

__device__ __forceinline__ void conv_item(const float* W, int Nsrc, int K, int src_col0, bf16_t* WT, int dst_row0, int k0, LAS float* scr, int lane) {
#pragma unroll 8
    for (int i = 0; i < 32; ++i) { const int kk = 2 * i + (lane >> 5); scr[kk * 33 + (lane & 31)] = ((const GAS float*)W)[(size_t)(k0 + kk) * Nsrc + src_col0 + (lane & 31)]; }
    asm volatile("s_waitcnt lgkmcnt(0)" ::: "memory");
    const int c = lane & 7;
#pragma unroll
    for (int j = 0; j < 4; ++j) { const int n = (lane >> 3) + 8 * j; const LAS float* s = scr + (8 * c) * 33 + n;
        u32x4 o; o.x = cvt_pk_bf16(s[0 * 33], s[1 * 33]); o.y = cvt_pk_bf16(s[2 * 33], s[3 * 33]); o.z = cvt_pk_bf16(s[4 * 33], s[5 * 33]); o.w = cvt_pk_bf16(s[6 * 33], s[7 * 33]);
        *(GAS u32x4*)(WT + (size_t)(dst_row0 + n) * K + k0 + 8 * c) = o; }
    asm volatile("s_waitcnt lgkmcnt(0)" ::: "memory");
}
__device__ __forceinline__ void convert_ffn(const Frame& F, const float* wg, const float* wu, const float* wd, bf16_t* WFU, bf16_t* WFD) {
    LAS float* scr = (LAS float*)(F.lds + F.wave * 16384);
    const int gw = F.bid * NWAVE + F.wave, NGW = F.G * NWAVE;
    constexpr int I_U = 16 * 176, I_D = 44 * 32;
    for (int it = gw; it < I_U + I_D; it += NGW) {
        if (it < I_U) { const int kb = it / 176, nb = it % 176, r0 = nb * 32, pn = r0 >> 8, i0 = r0 & 255;
            conv_item(i0 < 128 ? wg : wu, DFF, DM, pn * 128 + (i0 & 127), WFU, r0, kb * 64, scr, F.lane); }
        else { const int r = it - I_U, kb = r / 32, nb = r % 32; conv_item(wd, DM, DFF, nb * 32, WFD, nb * 32, kb * 64, scr, F.lane); }
    }
}
__device__ __forceinline__ void convert_mix(const Frame& F, const float* w_in, const float* w_out, bf16_t* WIN, bf16_t* WOUT) {
    LAS float* scr = (LAS float*)(F.lds + F.wave * 16384);
    const int gw = F.bid * NWAVE + F.wave, NGW = F.G * NWAVE;
    constexpr int I_I = 16 * 160, I_O = 24 * 32;
    for (int it = gw; it < I_I + I_O; it += NGW) {
        if (it < I_I) { const int kb = it / 160, nb = it % 160, r0 = nb * 32, blk = r0 >> 9;
            const int sb = blk == 0 ? 0 : blk == 1 ? 4 : blk == 2 ? 7 : blk == 3 ? 1 : blk == 4 ? 2 : blk == 5 ? 3 : blk == 6 ? 5 : blk == 7 ? 6 : blk;
            conv_item(w_in, INW, DM, sb * 512 + (r0 & 511), WIN, r0, kb * 64, scr, F.lane); }
        else { const int r = it - I_I, kb = r / 32, nb = r % 32; conv_item(w_out, DM, 1536, nb * 32, WOUT, nb * 32, kb * 64, scr, F.lane); }
    }
}

__device__ __forceinline__ void sincos_d(double x, double& s, double& c) {
    const double k = rint(x * 0.63661977236758134308);
    double r = fma(-k, 1.57079632679489655800e+00, x); r = fma(-k, 6.12323399573676603587e-17, r);
    const double r2 = r * r;
    double sp = -7.6471637318198164759e-13; sp = sp * r2 + 1.6059043836821614599e-10; sp = sp * r2 - 2.5052108385441718775e-08; sp = sp * r2 + 2.7557319223985890653e-06;
    sp = sp * r2 - 1.9841269841269841270e-04; sp = sp * r2 + 8.3333333333333333333e-03; sp = sp * r2 - 1.6666666666666666667e-01; const double sn = r + r * r2 * sp;
    double cp = 4.7794773323873852974e-14; cp = cp * r2 - 1.1470745597729724714e-11; cp = cp * r2 + 2.0876756987868098979e-09; cp = cp * r2 - 2.7557319223985890653e-07;
    cp = cp * r2 + 2.4801587301587301587e-05; cp = cp * r2 - 1.3888888888888888889e-03; cp = cp * r2 + 4.1666666666666666667e-02; cp = cp * r2 - 0.5; const double cs = 1.0 + r2 * cp;
    const int q = ((int)k) & 3;
    s = (q == 0) ? sn : (q == 1) ? cs : (q == 2) ? -sn : -cs;
    c = (q == 0) ? cs : (q == 1) ? -sn : (q == 2) ? -cs : sn;
}
__device__ __forceinline__ void prologue(const Frame& F, const Params& p, unsigned char* ws, int zi) {
    LAS float* cs = (LAS float*)F.lds;
    LAS float* red = (LAS float*)(F.lds + 16384);
    const float* c = as_global(p.in[1 + zi]);
    for (int i = F.tid; i < 4096; i += NTHR) cs[i] = silu_f(c[i]);
    __syncthreads();
    float* MOD = (float*)(ws + WS_MOD);
    for (int task = F.bid; task < 320; task += F.G) {
        const float* W; const float* bias; int N, n0; float* dst; int dstride;
        if (task < 288) { const int l = task / 144, t = task % 144; W = as_global(p.in[2 + zi]) + (size_t)l * DM * 9216; bias = as_global(p.in[3 + zi]) + l * 9216; N = 9216; n0 = t * 64; dst = MOD + (size_t)l * 4 * 9216; dstride = 9216; }
        else { const int t = task - 288; W = as_global(p.in[22 + zi]); bias = as_global(p.in[23 + zi]); N = 2048; n0 = t * 64; dst = MOD + FMOD_OFF; dstride = 2048; }
        float a0 = 0.f, a1 = 0.f, a2 = 0.f, a3 = 0.f;
        const int kb = F.wave * 128;
#pragma unroll 32
        for (int k = 0; k < 128; ++k) { const float w = ((const GAS float*)W)[(size_t)(kb + k) * N + n0 + F.lane];
            a0 += cs[kb + k] * w; a1 += cs[1024 + kb + k] * w; a2 += cs[2048 + kb + k] * w; a3 += cs[3072 + kb + k] * w; }
        red[(F.wave * 4 + 0) * 64 + F.lane] = a0; red[(F.wave * 4 + 1) * 64 + F.lane] = a1; red[(F.wave * 4 + 2) * 64 + F.lane] = a2; red[(F.wave * 4 + 3) * 64 + F.lane] = a3;
        __syncthreads();
        if (F.tid < 256) { const int b = F.tid >> 6, col = F.tid & 63; float s = bias[n0 + col];
#pragma unroll
            for (int w = 0; w < 8; ++w) s += red[(w * 4 + b) * 64 + col];
            dst[(size_t)b * dstride + n0 + col] = s; }
        __syncthreads();
    }
    f32x2* ROPE = (f32x2*)(ws + WS_ROPE);
    for (int idx = F.bid * NTHR + F.tid; idx < SEQ * 64; idx += F.G * NTHR) {
        const int pos = idx >> 6, i = idx & 63;
        const float invf = (float)exp(-(double)i * (9.210340371976184 / 64.0));
        const float ang = (float)pos * invf;
        double s, cc; sincos_d((double)ang, s, cc);
        ROPE[idx] = (f32x2){(float)cc, (float)s};
    }
}

__device__ __forceinline__ void norm_phase(const Frame& F, const float* h, const float* gain, const float* shift0, const float* scale0, int bstride, bf16_t* U) {
    const int gw = F.bid * NWAVE + F.wave, NGW = F.G * NWAVE;
    for (int m = gw; m < T_TOK; m += NGW) {
        const int b = m >> 13;
        const GAS f32x4* xr = (const GAS f32x4*)(h + (size_t)m * DM) + F.lane;
        f32x4 v[4]; float s = 0.f;
#pragma unroll
        for (int j = 0; j < 4; ++j) { v[j] = xr[64 * j]; s += (v[j].x * v[j].x + v[j].y * v[j].y) + (v[j].z * v[j].z + v[j].w * v[j].w); }
        const float rstd = rsqrtf(wave_sum(s) * (1.f / DM) + EPS);
        GAS u32x2* o8 = (GAS u32x2*)(U + (size_t)m * DM) + F.lane;
#pragma unroll
        for (int j = 0; j < 4; ++j) {
            const f32x4 g = ((const GAS f32x4*)gain)[F.lane + 64 * j], sh = ((const GAS f32x4*)(shift0 + (size_t)b * bstride))[F.lane + 64 * j], sc = ((const GAS f32x4*)(scale0 + (size_t)b * bstride))[F.lane + 64 * j];
            const f32x4 y = v[j] * rstd * g * (sc + 1.0f) + sh;
            o8[64 * j] = pack4(y);
        }
    }
}
__device__ __forceinline__ void final_phase(const Frame& F, float* h, const float* gain, const float* fmod) {
    const int gw = F.bid * NWAVE + F.wave, NGW = F.G * NWAVE;
    for (int m = gw; m < T_TOK; m += NGW) {
        const int b = m >> 13;
        GAS f32x4* xr = (GAS f32x4*)(h + (size_t)m * DM) + F.lane;
        f32x4 v[4]; float s = 0.f;
#pragma unroll
        for (int j = 0; j < 4; ++j) { v[j] = xr[64 * j]; s += (v[j].x * v[j].x + v[j].y * v[j].y) + (v[j].z * v[j].z + v[j].w * v[j].w); }
        const float rstd = rsqrtf(wave_sum(s) * (1.f / DM) + EPS);
#pragma unroll
        for (int j = 0; j < 4; ++j) {
            const f32x4 g = ((const GAS f32x4*)gain)[F.lane + 64 * j], sh = ((const GAS f32x4*)(fmod + (size_t)b * 2048))[F.lane + 64 * j], sc = ((const GAS f32x4*)(fmod + (size_t)b * 2048 + 1024))[F.lane + 64 * j];
            xr[64 * j] = v[j] * rstd * g * (sc + 1.0f) + sh;
        }
    }
}

__device__ __forceinline__ void dt_gemv(const Frame& F, const bf16_t* U, const float* w_in, float* DT) {
    LAS float* Wd = (LAS float*)F.lds;
    __syncthreads();
    for (int idx = F.tid; idx < 8192; idx += NTHR) { const int k = idx >> 3, j = idx & 7; Wd[8 * k + 4 * (k >> 3) + j] = ((const GAS float*)w_in)[(size_t)k * INW + 5120 + j]; }
    __syncthreads();
    const int gw = F.bid * NWAVE + F.wave, NGW = F.G * NWAVE;
    for (int m = gw; m < T_TOK; m += NGW) {
        float acc[8];
#pragma unroll
        for (int j = 0; j < 8; ++j) acc[j] = 0.f;
#pragma unroll
        for (int hf = 0; hf < 2; ++hf) {
            const u32x4 uv = *(const GAS u32x4*)(U + (size_t)m * DM + 512 * hf + 8 * F.lane);
            float uf[8]; unpack8(uv, uf);
#pragma unroll
            for (int kk = 0; kk < 8; ++kk) { const int k = 512 * hf + 8 * F.lane + kk; const LAS float* wp = Wd + 8 * k + 4 * (k >> 3);
                const f32x4 w0 = *(const LAS f32x4*)wp, w1 = *(const LAS f32x4*)(wp + 4);
                acc[0] += uf[kk] * w0.x; acc[1] += uf[kk] * w0.y; acc[2] += uf[kk] * w0.z; acc[3] += uf[kk] * w0.w;
                acc[4] += uf[kk] * w1.x; acc[5] += uf[kk] * w1.y; acc[6] += uf[kk] * w1.z; acc[7] += uf[kk] * w1.w; }
        }
#pragma unroll
        for (int j = 0; j < 8; ++j) acc[j] = wave_sum(acc[j]);
        if (F.lane < 8) { float v = acc[0];
#pragma unroll
            for (int j = 1; j < 8; ++j) v = (F.lane == j) ? acc[j] : v;
            ((GAS float*)DT)[(size_t)m * 8 + F.lane] = v; }
    }
    __syncthreads();
}

__device__ __forceinline__ void sb_task(const Frame& F, bf16_t* P, int b, int h, int qb) {
    LAS unsigned char* Ks = F.lds;
    LAS unsigned char* Vt = F.lds + 17408;
    LAS unsigned char* Pw = F.lds + 35840 + F.wave * 2304;
    LAS float* red = (LAS float*)(F.lds + 54272);
    int lane = F.lane; asm volatile("" : "+v"(lane)); const int wid = F.wave, fr = lane & 15, fq = lane >> 4;
    const size_t rowbase = (size_t)b * SEQ;
    const int q0 = qb * 128, trow = q0 + 16 * wid + fr;
    bf16x8 qf[4];
    { const bf16_t* qp = P + pidx(rowbase + trow, C_SQ + h * 128) + 8 * fq;
#pragma unroll
      for (int s = 0; s < 4; ++s) qf[s] = *(const GAS bf16x8*)(qp + 32 * s); }
    f32x4 o[8];
#pragma unroll
    for (int i = 0; i < 8; ++i) o[i] = (f32x4){0.f, 0.f, 0.f, 0.f};
    float R = 0.f;
    u32x4 kvr[2], vvr[2];
#pragma unroll
    for (int i = 0; i < 2; ++i) { const int idx = F.tid + NTHR * i, key = idx >> 4, c8 = idx & 15; const size_t krow = rowbase + 64 * (2 * qb + 1) + key;
        kvr[i] = *(const GAS u32x4*)(P + pidx(krow, C_SK + h * 128) + 8 * c8); vvr[i] = *(const GAS u32x4*)(P + pidx(krow, C_SV + h * 128) + 8 * c8); }
    for (int kt = 2 * qb + 1; kt >= 0; --kt) {
        lds_barrier();
#pragma unroll
        for (int i = 0; i < 2; ++i) { const int idx = F.tid + NTHR * i, key = idx >> 4, c8 = idx & 15;
            const u32x4 kv = kvr[i], vv = vvr[i];
            *(LAS u32x4*)(Ks + key * 272 + c8 * 16) = kv;
            LAS bf16_t* vd = (LAS bf16_t*)(Vt + (8 * c8) * 144 + key * 2);
            vd[0 * 72] = (bf16_t)(vv.x & 0xffff); vd[1 * 72] = (bf16_t)(vv.x >> 16); vd[2 * 72] = (bf16_t)(vv.y & 0xffff); vd[3 * 72] = (bf16_t)(vv.y >> 16);
            vd[4 * 72] = (bf16_t)(vv.z & 0xffff); vd[5 * 72] = (bf16_t)(vv.z >> 16); vd[6 * 72] = (bf16_t)(vv.w & 0xffff); vd[7 * 72] = (bf16_t)(vv.w >> 16); }
        if (kt > 0) {
#pragma unroll
            for (int i = 0; i < 2; ++i) { const int idx = F.tid + NTHR * i, key = idx >> 4, c8 = idx & 15; const size_t krow = rowbase + 64 * (kt - 1) + key;
                kvr[i] = *(const GAS u32x4*)(P + pidx(krow, C_SK + h * 128) + 8 * c8); vvr[i] = *(const GAS u32x4*)(P + pidx(krow, C_SV + h * 128) + 8 * c8); } }
        lds_barrier();
        if (64 * kt < q0 + 16 * wid + 15) {
            f32x4 sc[4];
#pragma unroll
            for (int j = 0; j < 4; ++j) { sc[j] = (f32x4){0.f, 0.f, 0.f, 0.f};
#pragma unroll
                for (int s = 0; s < 4; ++s) sc[j] = mfma16(ldsfrag(Ks + (16 * j + fr) * 272 + (32 * s + 8 * fq) * 2), qf[s], sc[j]); }
            float lk[4][4], lb[4][4], Tj[4], Wj[4], Gj[4];
#pragma unroll
            for (int j = 0; j < 4; ++j) { float t = 0.f;
#pragma unroll
                for (int i = 0; i < 4; ++i) { const float z = sc[j][i] * 0.08838834764831845f; const int key = 64 * kt + 16 * j + 4 * fq + i; const bool vis = key < trow;
                    const float e = __expf(-fabsf(z)); const float sp = fmaxf(z, 0.f) + __logf(1.0f + e);
                    lk[j][i] = vis ? -sp : 0.f; lb[j][i] = vis ? (z - sp) : -1e30f; t += lk[j][i]; }
                Tj[j] = t; }
#pragma unroll
            for (int j = 0; j < 4; ++j) { const float a1 = __shfl_xor(Tj[j], 16), a2 = __shfl_xor(Tj[j], 32), a3 = __shfl_xor(Tj[j], 48);
                Wj[j] = Tj[j] + a1 + a2 + a3;
                Gj[j] = (((fq ^ 1) > fq) ? a1 : 0.f) + (((fq ^ 2) > fq) ? a2 : 0.f) + (((fq ^ 3) > fq) ? a3 : 0.f); }
            float suf = 0.f;
#pragma unroll
            for (int j = 3; j >= 0; --j) { float tl = R + suf + Gj[j]; f32x4 w;
                w[3] = __expf(lb[j][3] + tl); tl += lk[j][3];
                w[2] = __expf(lb[j][2] + tl); tl += lk[j][2];
                w[1] = __expf(lb[j][1] + tl); tl += lk[j][1];
                w[0] = __expf(lb[j][0] + tl);
                *(LAS u32x2*)(Pw + fr * 144 + (16 * j + 4 * fq) * 2) = pack4(w);
                suf += Wj[j]; }
            R += suf;
#pragma unroll
            for (int ks = 0; ks < 2; ++ks) { const bf16x8 pf = ldsfrag(Pw + fr * 144 + (32 * ks + 8 * fq) * 2);
#pragma unroll
                for (int dt = 0; dt < 8; ++dt) o[dt] = mfma16(ldsfrag(Vt + (16 * dt + fr) * 144 + (32 * ks + 8 * fq) * 2), pf, o[dt]); }
        }
        const float rm = wave_max(R);
        if (lane == 0) red[wid] = rm;
        lds_barrier();
        float mx = red[0];
#pragma unroll
        for (int w = 1; w < 8; ++w) mx = fmaxf(mx, red[w]);
        if (mx < -120.f) break;
    }
    bf16_t* op = P + pidx(rowbase + trow, C_SQ + h * 128) + 4 * fq;
#pragma unroll
    for (int dt = 0; dt < 8; ++dt) *(GAS u32x2*)(op + 16 * dt) = pack4(o[dt]);
}

__device__ __forceinline__ void ret_kv_task(const Frame& F, const bf16_t* P, const f32x2* ROPE, bf16_t* RST, int b, int c, int h) {
    LAS unsigned char* KT = F.lds;
    LAS unsigned char* VT = F.lds + 18432;
    int lane = F.lane; asm volatile("" : "+v"(lane)); const int fr = lane & 15, fq = lane >> 4;
    const float l2g = log2gamma(h);
    lds_barrier();
    { const int s = F.tid >> 3, g8 = F.tid & 7; const size_t row = (size_t)b * SEQ + c * 64 + s; const int pos = c * 64 + s;
      const bf16_t* kp = P + pidx(row, C_RK + h * 128) + 8 * g8;
      const u32x4 k1 = *(const GAS u32x4*)kp, k2 = *(const GAS u32x4*)(kp + 64);
      float x1[8], x2[8]; unpack8(k1, x1); unpack8(k2, x2);
      const GAS f32x4* cp = (const GAS f32x4*)(ROPE + pos * 64 + 8 * g8);
      const float dec = __builtin_amdgcn_exp2f(l2g * (float)(63 - s)) * 0.08838834764831845f;
      LAS bf16_t* kd = (LAS bf16_t*)(KT + (8 * g8) * 144 + s * 2);
#pragma unroll
      for (int jj = 0; jj < 4; ++jj) { const f32x4 cs = cp[jj];
          { const int j = 2 * jj; const float y1 = (x1[j] * cs.x - x2[j] * cs.y) * dec, y2 = (x1[j] * cs.y + x2[j] * cs.x) * dec; kd[j * 72] = f2bf(y1); kd[(64 + j) * 72] = f2bf(y2); }
          { const int j = 2 * jj + 1; const float y1 = (x1[j] * cs.z - x2[j] * cs.w) * dec, y2 = (x1[j] * cs.w + x2[j] * cs.z) * dec; kd[j * 72] = f2bf(y1); kd[(64 + j) * 72] = f2bf(y2); } }
      const bf16_t* vp = P + pidx(row, C_RV + h * 128) + 16 * g8;
#pragma unroll
      for (int hh = 0; hh < 2; ++hh) { const u32x4 vv = *(const GAS u32x4*)(vp + 8 * hh);
          LAS bf16_t* vd = (LAS bf16_t*)(VT + (16 * g8 + 8 * hh) * 144 + s * 2);
          vd[0 * 72] = (bf16_t)(vv.x & 0xffff); vd[1 * 72] = (bf16_t)(vv.x >> 16); vd[2 * 72] = (bf16_t)(vv.y & 0xffff); vd[3 * 72] = (bf16_t)(vv.y >> 16);
          vd[4 * 72] = (bf16_t)(vv.z & 0xffff); vd[5 * 72] = (bf16_t)(vv.z >> 16); vd[6 * 72] = (bf16_t)(vv.w & 0xffff); vd[7 * 72] = (bf16_t)(vv.w >> 16); } }
    lds_barrier();
    const int w = F.wave;
    bf16x8 xf[2];
#pragma unroll
    for (int ks = 0; ks < 2; ++ks) xf[ks] = ldsfrag(KT + (16 * w + fr) * 144 + (32 * ks + 8 * fq) * 2);
    bf16_t* dst = RST + (size_t)((b * 128 + c) * 4 + h) * 16384;
#pragma unroll
    for (int et = 0; et < 8; ++et) { f32x4 acc = (f32x4){0.f, 0.f, 0.f, 0.f};
#pragma unroll
        for (int ks = 0; ks < 2; ++ks) acc = mfma16(xf[ks], ldsfrag(VT + (16 * et + fr) * 144 + (32 * ks + 8 * fq) * 2), acc);
        *(GAS u32x2*)(dst + (16 * et + fr) * 128 + 16 * w + 4 * fq) = pack4(acc); }
}

__device__ __forceinline__ void ret_out_task(const Frame& F, bf16_t* P, const f32x2* ROPE, const bf16_t* RST, const float* gn, int b, int c, int h, int xm = 0) {
    LAS unsigned char* Kr = F.lds;
    LAS unsigned char* VT = F.lds + 17408;
    LAS unsigned char* Sx = F.lds + 35840;
    LAS unsigned char* Pw = F.lds + 70656 + F.wave * 2304;
    LAS float* ssq = (LAS float*)(F.lds + 89088);
    int lane = F.lane; asm volatile("" : "+v"(lane)); const int fr = lane & 15, fq = lane >> 4, w = F.wave, lt = w & 3, eh = w >> 2;
    const float l2g = log2gamma(h);
    const int unit = (b * 128 + c) * 4 + h;
    lds_barrier();
    { const int s = F.tid >> 3, g8 = F.tid & 7; const size_t row = (size_t)b * SEQ + c * 64 + s; const int pos = c * 64 + s;
      const bf16_t* kp = P + pidx(row, C_RK + h * 128) + 8 * g8;
      const u32x4 k1 = *(const GAS u32x4*)kp, k2 = *(const GAS u32x4*)(kp + 64);
      float x1[8], x2[8], y1[8], y2[8]; unpack8(k1, x1); unpack8(k2, x2);
      const GAS f32x4* cp = (const GAS f32x4*)(ROPE + pos * 64 + 8 * g8);
#pragma unroll
      for (int jj = 0; jj < 4; ++jj) { const f32x4 cs = cp[jj];
          { const int j = 2 * jj; y1[j] = (x1[j] * cs.x - x2[j] * cs.y) * 0.08838834764831845f; y2[j] = (x1[j] * cs.y + x2[j] * cs.x) * 0.08838834764831845f; }
          { const int j = 2 * jj + 1; y1[j] = (x1[j] * cs.z - x2[j] * cs.w) * 0.08838834764831845f; y2[j] = (x1[j] * cs.w + x2[j] * cs.z) * 0.08838834764831845f; } }
      u32x4 o1, o2; o1.x = cvt_pk_bf16(y1[0], y1[1]); o1.y = cvt_pk_bf16(y1[2], y1[3]); o1.z = cvt_pk_bf16(y1[4], y1[5]); o1.w = cvt_pk_bf16(y1[6], y1[7]);
      o2.x = cvt_pk_bf16(y2[0], y2[1]); o2.y = cvt_pk_bf16(y2[2], y2[3]); o2.z = cvt_pk_bf16(y2[4], y2[5]); o2.w = cvt_pk_bf16(y2[6], y2[7]);
      *(LAS u32x4*)(Kr + s * 272 + (8 * g8) * 2) = o1; *(LAS u32x4*)(Kr + s * 272 + (64 + 8 * g8) * 2) = o2;
      const bf16_t* vp = P + pidx(row, C_RV + h * 128) + 16 * g8;
#pragma unroll
      for (int hh = 0; hh < 2; ++hh) { const u32x4 vv = *(const GAS u32x4*)(vp + 8 * hh);
          LAS bf16_t* vd = (LAS bf16_t*)(VT + (16 * g8 + 8 * hh) * 144 + s * 2);
          vd[0 * 72] = (bf16_t)(vv.x & 0xffff); vd[1 * 72] = (bf16_t)(vv.x >> 16); vd[2 * 72] = (bf16_t)(vv.y & 0xffff); vd[3 * 72] = (bf16_t)(vv.y >> 16);
          vd[4 * 72] = (bf16_t)(vv.z & 0xffff); vd[5 * 72] = (bf16_t)(vv.z >> 16); vd[6 * 72] = (bf16_t)(vv.w & 0xffff); vd[7 * 72] = (bf16_t)(vv.w >> 16); }
      const bf16_t* sp = RST + (size_t)unit * 16384;
#pragma unroll
      for (int i = 0; i < 4; ++i) { const int idx = F.tid + NTHR * i, e = idx >> 4, c16 = idx & 15;
          *(LAS u32x4*)(Sx + e * 272 + c16 * 16) = *(const GAS u32x4*)(sp + e * 128 + 8 * c16); } }
    const int l = 16 * lt + fr; const size_t qrow = (size_t)b * SEQ + c * 64 + l; const int qpos = c * 64 + l;
    bf16x8 qf[4];
    { const bf16_t* qp = P + pidx(qrow, C_RQ + h * 128) + 8 * fq;
      u32x4 qv[4];
#pragma unroll
      for (int s = 0; s < 4; ++s) qv[s] = *(const GAS u32x4*)(qp + 32 * s);
#pragma unroll
      for (int s = 0; s < 2; ++s) { float x1[8], x2[8], y1[8], y2[8]; unpack8(qv[s], x1); unpack8(qv[s + 2], x2);
          const GAS f32x4* cp = (const GAS f32x4*)(ROPE + qpos * 64 + 32 * s + 8 * fq);
#pragma unroll
          for (int jj = 0; jj < 4; ++jj) { const f32x4 cs = cp[jj];
              { const int j = 2 * jj; y1[j] = x1[j] * cs.x - x2[j] * cs.y; y2[j] = x1[j] * cs.y + x2[j] * cs.x; }
              { const int j = 2 * jj + 1; y1[j] = x1[j] * cs.z - x2[j] * cs.w; y2[j] = x1[j] * cs.w + x2[j] * cs.z; } }
          u32x4 o1, o2; o1.x = cvt_pk_bf16(y1[0], y1[1]); o1.y = cvt_pk_bf16(y1[2], y1[3]); o1.z = cvt_pk_bf16(y1[4], y1[5]); o1.w = cvt_pk_bf16(y1[6], y1[7]);
          o2.x = cvt_pk_bf16(y2[0], y2[1]); o2.y = cvt_pk_bf16(y2[2], y2[3]); o2.z = cvt_pk_bf16(y2[4], y2[5]); o2.w = cvt_pk_bf16(y2[6], y2[7]);
          qf[s] = __builtin_bit_cast(bf16x8, o1); qf[s + 2] = __builtin_bit_cast(bf16x8, o2); } }
    u32x2 gvr[4]; f32x4 ggr[4];
#pragma unroll
    for (int et = 0; et < 4; ++et) { const int e0 = 64 * eh + 16 * et + 4 * fq;
        gvr[et] = *(const GAS u32x2*)(P + pidx(qrow, C_RG + h * 128) + e0); ggr[et] = *(const GAS f32x4*)(gn + h * 128 + e0); }
    lds_barrier();
    if (xm == 1) return;
#pragma unroll
    for (int j = 0; j < 4; ++j) { f32x4 acc = (f32x4){0.f, 0.f, 0.f, 0.f};
#pragma unroll
        for (int ks = 0; ks < 4; ++ks) acc = mfma16(ldsfrag(Kr + (16 * j + fr) * 272 + (32 * ks + 8 * fq) * 2), qf[ks], acc);
#pragma unroll
        for (int i = 0; i < 4; ++i) { const int s = 16 * j + 4 * fq + i; acc[i] *= __builtin_amdgcn_exp2f(l2g * fabsf((float)(l - s))); }
        *(LAS u32x2*)(Pw + fr * 144 + (16 * j + 4 * fq) * 2) = pack4(acc); }
    f32x4 y[4];
    const float qdec = __builtin_amdgcn_exp2f(l2g * (float)(l + 1));
#pragma unroll
    for (int et = 0; et < 4; ++et) { y[et] = (f32x4){0.f, 0.f, 0.f, 0.f};
#pragma unroll
        for (int ks = 0; ks < 4; ++ks) y[et] = mfma16(ldsfrag(Sx + (64 * eh + 16 * et + fr) * 272 + (32 * ks + 8 * fq) * 2), qf[ks], y[et]);
        y[et] = y[et] * qdec; }
#pragma unroll
    for (int ks = 0; ks < 2; ++ks) { const bf16x8 pf = ldsfrag(Pw + fr * 144 + (32 * ks + 8 * fq) * 2);
#pragma unroll
        for (int et = 0; et < 4; ++et) y[et] = mfma16(ldsfrag(VT + (64 * eh + 16 * et + fr) * 144 + (32 * ks + 8 * fq) * 2), pf, y[et]); }
    float ss = 0.f;
#pragma unroll
    for (int et = 0; et < 4; ++et) ss += (y[et][0] * y[et][0] + y[et][1] * y[et][1]) + (y[et][2] * y[et][2] + y[et][3] * y[et][3]);
    ss += __shfl_xor(ss, 16); ss += __shfl_xor(ss, 32);
    if (fq == 0) ssq[w * 16 + fr] = ss;
    lds_barrier();
    const float rstd = rsqrtf((ssq[w * 16 + fr] + ssq[(w ^ 4) * 16 + fr]) * (1.f / 128.f) + EPS);
#pragma unroll
    for (int et = 0; et < 4; ++et) { const int e0 = 64 * eh + 16 * et + 4 * fq;
        const u32x2 gv = gvr[et]; const f32x4 gg = ggr[et];
        f32x4 r;
        r[0] = y[et][0] * rstd * gg[0] * silu_f(bf_lo(gv.x)); r[1] = y[et][1] * rstd * gg[1] * silu_f(bf_hi(gv.x));
        r[2] = y[et][2] * rstd * gg[2] * silu_f(bf_lo(gv.y)); r[3] = y[et][3] * rstd * gg[3] * silu_f(bf_hi(gv.y));
        *(GAS u32x2*)(P + pidx(qrow, C_RQ + h * 128) + e0) = pack4(r); }
}

__device__ __forceinline__ float softplus_f(float x) { return fmaxf(x, 0.f) + log1pf(__expf(-fabsf(x))); }
__device__ __forceinline__ void conv8(const bf16_t* P, const float* cw, const float* cb, int b, int tpos, int col, float* v) {
    const int chan = col - C_XBC;
    { const f32x4 b0 = *(const GAS f32x4*)(cb + chan), b1 = *(const GAS f32x4*)(cb + chan + 4);
      v[0] = b0.x; v[1] = b0.y; v[2] = b0.z; v[3] = b0.w; v[4] = b1.x; v[5] = b1.y; v[6] = b1.z; v[7] = b1.w; }
#pragma unroll
    for (int j = 0; j < 4; ++j) { const int ts = tpos - 3 + j;
        if (ts >= 0) { const u32x4 xv = *(const GAS u32x4*)(P + pidx((size_t)b * SEQ + ts, col)); float xf[8]; unpack8(xv, xf);
            const f32x4 w0 = *(const GAS f32x4*)(cw + j * 1024 + chan), w1 = *(const GAS f32x4*)(cw + j * 1024 + chan + 4);
            v[0] += xf[0] * w0.x; v[1] += xf[1] * w0.y; v[2] += xf[2] * w0.z; v[3] += xf[3] * w0.w; v[4] += xf[4] * w1.x; v[5] += xf[5] * w1.y; v[6] += xf[6] * w1.z; v[7] += xf[7] * w1.w; } }
#pragma unroll
    for (int i = 0; i < 8; ++i) v[i] = silu_f(v[i]);
}

template <bool TR, bool HASF>
__device__ __forceinline__ void conv_tile(const bf16_t* P, const float* cw, const float* cb, int b, int tpos0, int col, const float (&f)[8], u32x4 (&pk)[8]) {
    const int chan = col - C_XBC;
    float w[4][8], bias[8];
#pragma unroll
    for (int j = 0; j < 4; ++j) { const f32x4 w0 = *(const GAS f32x4*)(cw + j * 1024 + chan), w1 = *(const GAS f32x4*)(cw + j * 1024 + chan + 4);
        w[j][0] = w0.x; w[j][1] = w0.y; w[j][2] = w0.z; w[j][3] = w0.w; w[j][4] = w1.x; w[j][5] = w1.y; w[j][6] = w1.z; w[j][7] = w1.w; }
    { const f32x4 b0 = *(const GAS f32x4*)(cb + chan), b1 = *(const GAS f32x4*)(cb + chan + 4);
      bias[0] = b0.x; bias[1] = b0.y; bias[2] = b0.z; bias[3] = b0.w; bias[4] = b1.x; bias[5] = b1.y; bias[6] = b1.z; bias[7] = b1.w; }
    u32x4 rows[11];
    const bf16_t* base = P + pidx((size_t)b * SEQ + tpos0, col);
#pragma unroll
    for (int r = 0; r < 11; ++r) { rows[r] = (u32x4){0u, 0u, 0u, 0u}; if (tpos0 - 3 + r >= 0) rows[r] = *(const GAS u32x4*)(base + (long)(r - 3) * 128); }
    float prev[8];
#pragma unroll
    for (int t = 0; t < 8; ++t) {
        float a[8];
#pragma unroll
        for (int i = 0; i < 8; ++i) a[i] = bias[i];
#pragma unroll
        for (int j = 0; j < 4; ++j) { float xf[8]; unpack8(rows[t + j], xf);
#pragma unroll
            for (int i = 0; i < 8; ++i) a[i] += xf[i] * w[j][i]; }
#pragma unroll
        for (int i = 0; i < 8; ++i) { a[i] = silu_f(a[i]); if (HASF) a[i] *= f[t]; }
        if (TR) {
            if (t & 1) {
#pragma unroll
                for (int i = 0; i < 8; ++i) { const unsigned u = cvt_pk_bf16(prev[i], a[i]);
                    if ((t >> 1) == 0) pk[i].x = u; else if ((t >> 1) == 1) pk[i].y = u; else if ((t >> 1) == 2) pk[i].z = u; else pk[i].w = u; }
            } else {
#pragma unroll
                for (int i = 0; i < 8; ++i) prev[i] = a[i];
            }
        } else {
            pk[t].x = cvt_pk_bf16(a[0], a[1]); pk[t].y = cvt_pk_bf16(a[2], a[3]); pk[t].z = cvt_pk_bf16(a[4], a[5]); pk[t].w = cvt_pk_bf16(a[6], a[7]);
        }
    }
}
__device__ __forceinline__ float dt_scan(const float* DT, const float* dt_bias, const float* a_log, int b, int c, int hd, int lane, float& dtv) {
    const size_t t = (size_t)b * SEQ + c * 64 + lane;
    dtv = softplus_f(((const GAS float*)DT)[t * 8 + hd] + ((const GAS float*)dt_bias)[hd]);
    float x = dtv * (-__expf(((const GAS float*)a_log)[hd]));
#pragma unroll
    for (int o = 1; o < 64; o <<= 1) { const float y = __shfl_up(x, o); if (lane >= o) x += y; }
    return x;
}

__device__ __forceinline__ void ssd_state_task(const Frame& F, const bf16_t* P, const float* DT, const float* cw, const float* cb, const float* dt_bias, const float* a_log,
                                               bf16_t* SST, float* CD, int b, int c, int g) {
    LAS unsigned char* XT = F.lds;
    LAS unsigned char* BT = F.lds + 36864;
    LAS float* dtl = (LAS float*)(F.lds + 55296);
    LAS float* acl = (LAS float*)(F.lds + 56320);
    int lane = F.lane; asm volatile("" : "+v"(lane)); const int fr = lane & 15, fq = lane >> 4, w = F.wave;
    lds_barrier();
    if (w < 4) { float dtv; const float cum = dt_scan(DT, dt_bias, a_log, b, c, 4 * g + w, lane, dtv);
        dtl[lane * 4 + w] = dtv; acl[lane * 4 + w] = cum;
        if (lane == 63) ((GAS float*)CD)[(b * 128 + c) * 8 + 4 * g + w] = __expf(cum); }
    lds_barrier();
    if (F.tid < 384) { int tt = F.tid; asm volatile("" : "+v"(tt)); const int cgi = tt % 48, seg = tt / 48, s0 = 8 * seg;
        const int col = (cgi < 32) ? (C_XBC + g * 256 + 8 * cgi) : (C_XBC + 512 + g * 128 + 8 * (cgi - 32));
        float f[8]; u32x4 pk[8];
        if (cgi < 32) { const int hl = cgi >> 3; const float ae = acl[63 * 4 + hl];
#pragma unroll
            for (int t = 0; t < 8; ++t) f[t] = dtl[(s0 + t) * 4 + hl] * __expf(ae - acl[(s0 + t) * 4 + hl]); }
        else {
#pragma unroll
            for (int t = 0; t < 8; ++t) f[t] = 1.0f; }
        conv_tile<true, true>(P, cw, cb, b, c * 64 + s0, col, f, pk);
        LAS unsigned char* d = (cgi < 32) ? (XT + (8 * cgi) * 144 + s0 * 2) : (BT + (8 * (cgi - 32)) * 144 + s0 * 2);
#pragma unroll
        for (int i = 0; i < 8; ++i) *(LAS u32x4*)(d + i * 144) = pk[i]; }
    lds_barrier();
    const int hl = w >> 1, ph = w & 1;
    bf16x8 yf[2][2];
#pragma unroll
    for (int pt = 0; pt < 2; ++pt)
#pragma unroll
        for (int ks = 0; ks < 2; ++ks) yf[pt][ks] = ldsfrag(XT + (hl * 64 + ph * 32 + 16 * pt + fr) * 144 + (32 * ks + 8 * fq) * 2);
    bf16_t* dst = SST + (size_t)((b * 128 + c) * 8 + 4 * g + hl) * 8192;
#pragma unroll
    for (int nt = 0; nt < 8; ++nt) { f32x4 a0 = (f32x4){0.f, 0.f, 0.f, 0.f}, a1 = a0;
#pragma unroll
        for (int ks = 0; ks < 2; ++ks) { const bf16x8 xf = ldsfrag(BT + (16 * nt + fr) * 144 + (32 * ks + 8 * fq) * 2); a0 = mfma16(xf, yf[0][ks], a0); a1 = mfma16(xf, yf[1][ks], a1); }
#ifdef PROBE_CONST
        a0 = (f32x4){0.01f, 0.02f, 0.03f, 0.04f}; a1 = a0;
#endif
        *(GAS u32x2*)(dst + (ph * 32 + fr) * 128 + 16 * nt + 4 * fq) = pack4(a0);
        *(GAS u32x2*)(dst + (ph * 32 + 16 + fr) * 128 + 16 * nt + 4 * fq) = pack4(a1); }
}

__device__ __forceinline__ void ssd_out_task(const Frame& F, bf16_t* P, const float* DT, const float* cw, const float* cb, const float* dt_bias, const float* a_log,
                                             const float* d_skip, const float* nrm, const bf16_t* SST, int b, int c) {
    LAS unsigned char* Bs = F.lds;
    LAS unsigned char* Cs = F.lds + 17408;
    LAS unsigned char* XT = F.lds + 34816;
    LAS unsigned char* Pw = F.lds + 71680 + F.wave * 2304;
    LAS float* dtl = (LAS float*)(F.lds + 90112);
    LAS float* acl = (LAS float*)(F.lds + 92160);
    LAS float* ssq = (LAS float*)(F.lds + 94208);
    int lane = F.lane; asm volatile("" : "+v"(lane)); const int fr = lane & 15, fq = lane >> 4, w = F.wave, hl = w >> 1, half = w & 1;
    lds_barrier();
    { float dtv; const float cum = dt_scan(DT, dt_bias, a_log, b, c, w, lane, dtv); dtl[lane * 8 + w] = dtv; acl[lane * 8 + w] = cum; }
    float ssl[2] = {0.f, 0.f};
#pragma unroll 1
    for (int g = 0; g < 2; ++g) {
        const int head = 4 * g + hl;
        const bf16_t* hsrc = SST + (size_t)((b * 128 + c) * 8 + head) * 8192;
        bf16x8 hfr[4][4];
#pragma unroll
        for (int ks = 0; ks < 4; ++ks)
#pragma unroll
            for (int pt = 0; pt < 4; ++pt) hfr[ks][pt] = *(const GAS bf16x8*)(hsrc + (16 * pt + fr) * 128 + 32 * ks + 8 * fq);
        lds_barrier();
        { int tt = F.tid; asm volatile("" : "+v"(tt)); const int cgi = tt & 63, seg = tt >> 6, s0 = 8 * seg;
            const int col = (cgi < 32) ? (C_XBC + g * 256 + 8 * cgi) : (cgi < 48) ? (C_XBC + 512 + g * 128 + 8 * (cgi - 32)) : (C_XBC + 768 + g * 128 + 8 * (cgi - 48));
            const float f[8] = {1.f, 1.f, 1.f, 1.f, 1.f, 1.f, 1.f, 1.f}; u32x4 pk[8];
            if (cgi < 32) { conv_tile<true, false>(P, cw, cb, b, c * 64 + s0, col, f, pk);
                LAS unsigned char* d = XT + (8 * cgi) * 144 + s0 * 2;
#pragma unroll
                for (int i = 0; i < 8; ++i) *(LAS u32x4*)(d + i * 144) = pk[i]; }
            else { conv_tile<false, false>(P, cw, cb, b, c * 64 + s0, col, f, pk);
                LAS unsigned char* d = ((cgi < 48) ? (Bs + (8 * (cgi - 32)) * 2) : (Cs + (8 * (cgi - 48)) * 2)) + s0 * 272;
#pragma unroll
                for (int i = 0; i < 8; ++i) *(LAS u32x4*)(d + i * 272) = pk[i]; } }
        u32x2 zvr[2][4];
#pragma unroll
        for (int li = 0; li < 2; ++li)
#pragma unroll
            for (int pt = 0; pt < 4; ++pt) zvr[li][pt] = *(const GAS u32x2*)(P + pidx((size_t)b * SEQ + c * 64 + 16 * (2 * half + li) + fr, C_MZ + head * 64 + 16 * pt + 4 * fq));
        lds_barrier();
        const float dsk = ((const GAS float*)d_skip)[head];
#pragma unroll
        for (int li = 0; li < 2; ++li) {
            asm volatile("" ::: "memory"); __builtin_amdgcn_sched_barrier(0);
            const int lt = 2 * half + li, l = 16 * lt + fr;
            const float al = acl[l * 8 + head];
            bf16x8 cf[4];
#pragma unroll
            for (int ks = 0; ks < 4; ++ks) cf[ks] = ldsfrag(Cs + (16 * lt + fr) * 272 + (32 * ks + 8 * fq) * 2);
            f32x4 y[4];
#pragma unroll
            for (int pt = 0; pt < 4; ++pt) y[pt] = (f32x4){0.f, 0.f, 0.f, 0.f};
#pragma unroll
            for (int ks = 0; ks < 4; ++ks) {
#pragma unroll
                for (int pt = 0; pt < 4; ++pt) y[pt] = mfma16(hfr[ks][pt], cf[ks], y[pt]); }
            { const float eal = __expf(al);
#pragma unroll
              for (int pt = 0; pt < 4; ++pt) y[pt] = y[pt] * eal; }
#pragma unroll
            for (int st = 0; st < 4; ++st) { f32x4 acc = (f32x4){0.f, 0.f, 0.f, 0.f};
#pragma unroll
                for (int ks = 0; ks < 4; ++ks) acc = mfma16(ldsfrag(Bs + (16 * st + fr) * 272 + (32 * ks + 8 * fq) * 2), cf[ks], acc);
#pragma unroll
                for (int i = 0; i < 4; ++i) { const int s = 16 * st + 4 * fq + i;
                    acc[i] = (s <= l) ? acc[i] * __expf(al - acl[s * 8 + head]) * dtl[s * 8 + head] : 0.f; }
                *(LAS u32x2*)(Pw + fr * 144 + (16 * st + 4 * fq) * 2) = pack4(acc); }
#pragma unroll
            for (int ks = 0; ks < 2; ++ks) { if (2 * ks <= lt) { const bf16x8 pf = ldsfrag(Pw + fr * 144 + (32 * ks + 8 * fq) * 2);
#pragma unroll
                for (int pt = 0; pt < 4; ++pt) y[pt] = mfma16(ldsfrag(XT + (hl * 64 + 16 * pt + fr) * 144 + (32 * ks + 8 * fq) * 2), pf, y[pt]); } }
            const size_t row = (size_t)b * SEQ + c * 64 + l;
#pragma unroll
            for (int pt = 0; pt < 4; ++pt) { const int p0 = 16 * pt + 4 * fq;
                const u32x2 zv = zvr[li][pt];
                const LAS bf16_t* xp = (const LAS bf16_t*)(XT + (hl * 64 + p0) * 144 + l * 2);
                f32x4 r;
                r[0] = (y[pt][0] + bf2f(xp[0 * 72]) * dsk) * silu_f(bf_lo(zv.x)); r[1] = (y[pt][1] + bf2f(xp[1 * 72]) * dsk) * silu_f(bf_hi(zv.x));
                r[2] = (y[pt][2] + bf2f(xp[2 * 72]) * dsk) * silu_f(bf_lo(zv.y)); r[3] = (y[pt][3] + bf2f(xp[3 * 72]) * dsk) * silu_f(bf_hi(zv.y));
                ssl[li] += (r[0] * r[0] + r[1] * r[1]) + (r[2] * r[2] + r[3] * r[3]);
                *(GAS u32x2*)(P + pidx(row, C_MZ + head * 64 + p0)) = pack4(r); }
        }
    }
#pragma unroll
    for (int li = 0; li < 2; ++li) { float ss = ssl[li];
        ss += __shfl_xor(ss, 16); ss += __shfl_xor(ss, 32);
        if (fq == 0) ssq[hl * 64 + 16 * (2 * half + li) + fr] = ss; }
    asm volatile("s_waitcnt vmcnt(0)" ::: "memory");
    lds_barrier();
#pragma unroll
    for (int li = 0; li < 2; ++li) { const int l = 16 * (2 * half + li) + fr;
        const float rstd = rsqrtf((ssq[l] + ssq[64 + l] + ssq[128 + l] + ssq[192 + l]) * (1.f / 512.f) + EPS);
        const size_t row = (size_t)b * SEQ + c * 64 + l;
#pragma unroll 1
        for (int g = 0; g < 2; ++g)
#pragma unroll
            for (int pt = 0; pt < 4; ++pt) { const int ch = (4 * g + hl) * 64 + 16 * pt + 4 * fq;
                const f32x4 ng = *(const GAS f32x4*)(nrm + ch);
                GAS u32x2* yp = (GAS u32x2*)(P + pidx(row, C_MZ + ch));
                const u32x2 pk = *yp; const f32x4 r = (f32x4){bf_lo(pk.x), bf_hi(pk.x), bf_lo(pk.y), bf_hi(pk.y)};
                *yp = pack4(r * rstd * ng); } }
}

__device__ __forceinline__ void scan_phase(const Frame& F, bf16_t* RST, bf16_t* SST, const float* CD) {
    for (int task = F.bid * NTHR + F.tid; task < 131072; task += F.G * NTHR) {
        {
          const int pr = task & 8191, bh = task >> 13, b = bh >> 2, h = bh & 3;
          GAS unsigned* p = (GAS unsigned*)(RST + (size_t)((b * 128) * 4 + h) * 16384) + pr;
          const float dec = __builtin_amdgcn_exp2f(64.f * log2gamma(h));
          float s0 = 0.f, s1 = 0.f;
#pragma unroll 1
          for (int c0 = 0; c0 < 128; c0 += 32) { unsigned v[32];
#pragma unroll
              for (int i = 0; i < 32; ++i) v[i] = p[(size_t)(c0 + i) * 32768];
#pragma unroll
              for (int i = 0; i < 32; ++i) { p[(size_t)(c0 + i) * 32768] = cvt_pk_bf16(s0, s1); s0 = s0 * dec + bf_lo(v[i]); s1 = s1 * dec + bf_hi(v[i]); } } }
        {
          const int pr = task & 4095, bh = task >> 12, b = bh >> 3, hd = bh & 7;
          GAS unsigned* p = (GAS unsigned*)(SST + (size_t)((b * 128) * 8 + hd) * 8192) + pr;
          const GAS float* cd = (const GAS float*)(CD + (b * 128) * 8 + hd);
          float s0 = 0.f, s1 = 0.f;
#pragma unroll 1
          for (int c0 = 0; c0 < 128; c0 += 32) { unsigned v[32]; float d[32];
#pragma unroll
              for (int i = 0; i < 32; ++i) { v[i] = p[(size_t)(c0 + i) * 32768]; d[i] = cd[(c0 + i) * 8]; }
#pragma unroll
              for (int i = 0; i < 32; ++i) { p[(size_t)(c0 + i) * 32768] = cvt_pk_bf16(s0, s1); s0 = s0 * d[i] + bf_lo(v[i]); s1 = s1 * d[i] + bf_hi(v[i]); } } }
    }
}


#define XB_TMO      128
#define XB_XCNT(j)  (256  + 64 * (j))
#define XB_XSUB(j)  (1280 + 64 * (j))
#define XB_XGEN(j)  (2304 + 64 * (j))
#define XB_TOP      3328
#define XB_TOPGEN   3392
#define XB_SPIN_CAP (1u << 22)
__device__ __forceinline__ unsigned xb_ld(unsigned* p)              { return __hip_atomic_load(p, __ATOMIC_RELAXED, __HIP_MEMORY_SCOPE_AGENT); }
__device__ __forceinline__ unsigned xb_add(unsigned* p, unsigned v) { return __hip_atomic_fetch_add(p, v, __ATOMIC_RELAXED, __HIP_MEMORY_SCOPE_AGENT); }
__device__ __forceinline__ unsigned xb_xcc_id() { return (unsigned)__builtin_amdgcn_s_getreg((3 << 11) | 20) & 0xFu; }
#define XB_SPIN(cond, bar) do { unsigned _sp = 0; while (cond) { __builtin_amdgcn_s_sleep(1); \
    if ((++_sp & 255u) == 0u) { if (xb_ld(&(bar)[XB_TMO])) break; if (_sp > XB_SPIN_CAP) { atomicAdd(&(bar)[XB_TMO], 1u); break; } } } } while (0)
struct XcdBarrier { unsigned* bar; unsigned x; volatile LAS unsigned* st; };
__device__ __forceinline__ XcdBarrier xcd_barrier_post(unsigned* bar, volatile LAS unsigned* st) {
    XcdBarrier b; b.bar = bar; b.x = xb_xcc_id(); b.st = st;
    if (threadIdx.x == 0) (void)xb_add(&bar[XB_XCNT(b.x)], 1u);
    return b;
}
__device__ __forceinline__ void xcd_barrier_complete(unsigned* bar, unsigned x, unsigned& nloc, unsigned& nx) {
    const unsigned G = gridDim.x * gridDim.y * gridDim.z;
    unsigned sum, cnt, mine, sp = 0u;
    for (;;) {
        sum = 0u; cnt = 0u; mine = 0u;
#pragma unroll
        for (unsigned j = 0; j < 16; ++j) { const unsigned c = xb_ld(&bar[XB_XCNT(j)]); sum += c; cnt += (c > 0u) ? 1u : 0u; mine = (j == x) ? c : mine; }
        if (sum == G) break;
        __builtin_amdgcn_s_sleep(1);
        if ((++sp & 255u) == 0u) { if (xb_ld(&bar[XB_TMO])) break; if (sp > XB_SPIN_CAP) { atomicAdd(&bar[XB_TMO], 1u); break; } }
    }
    nloc = mine > 0u ? mine : 1u; nx = cnt > 0u ? cnt : 1u;
}
__device__ __forceinline__ void xcd_barrier(const XcdBarrier& b) {
    asm volatile("s_waitcnt vmcnt(0)" ::: "memory");
    __syncthreads();
    if (threadIdx.x == 0) {
        unsigned* bar = b.bar;
        __builtin_amdgcn_s_waitcnt(0);
        unsigned nloc = b.st[0], nx = b.st[1];
        if (nloc == 0u) { xcd_barrier_complete(bar, b.x, nloc, nx); b.st[0] = nloc; b.st[1] = nx; }
        const unsigned old = xb_add(&bar[XB_XSUB(b.x)], 1u);
        const unsigned gen = old / nloc;
        if (old + 1u == (gen + 1u) * nloc) {
            __builtin_amdgcn_fence(__ATOMIC_RELEASE, "agent");
            asm volatile("s_waitcnt vmcnt(0)" ::: "memory");
            const unsigned og = xb_add(&bar[XB_TOP], 1u);
            const unsigned tg = og / nx;
            if (og + 1u == (tg + 1u) * nx) xb_add(&bar[XB_TOPGEN], 1u);
            else XB_SPIN(xb_ld(&bar[XB_TOPGEN]) == tg, bar);
            __builtin_amdgcn_fence(__ATOMIC_ACQUIRE, "agent");
            xb_add(&bar[XB_XGEN(b.x)], 1u);
            asm volatile("s_waitcnt vmcnt(0)" ::: "memory");
        } else {
            XB_SPIN(xb_ld(&bar[XB_XGEN(b.x)]) == gen, bar);
            __builtin_amdgcn_fence(__ATOMIC_ACQUIRE, "agent");
            asm volatile("s_waitcnt vmcnt(0)" ::: "memory");
        }
    }
    __syncthreads();
}

constexpr int NPH = 26;
__global__ void __launch_bounds__(NTHR, 2) fwd_kernel(Params p) {
    extern __shared__ __attribute__((aligned(16))) unsigned char lds_raw[];
    volatile LAS unsigned* xb_st = (volatile LAS unsigned*)((LAS unsigned char*)lds_raw + LDS_BYTES - 64);
    if (threadIdx.x == 0) { xb_st[0] = 0u; xb_st[1] = 0u; }
    __syncthreads();
    const XcdBarrier xbar = xcd_barrier_post((unsigned*)p.ws, xb_st);
    if (p.ph_lo == 0) {
        Frame F0; F0.lds = (LAS unsigned char*)lds_raw; F0.tid = threadIdx.x; F0.lane = F0.tid & 63; F0.wave = __builtin_amdgcn_readfirstlane(F0.tid >> 6); F0.G = gridDim.x; F0.bid = blockIdx.x;
        if (EN_PRO) prologue(F0, p, as_global(p.ws), 0);
        if (p.ph_hi > 1) cg::this_grid().sync();
    }
#ifdef TPROBE
    unsigned long long tA = 0, tB = 0;
#endif
    for (int ph_ = (p.ph_lo < 1 ? 1 : p.ph_lo); ph_ < p.ph_hi; ++ph_) {
#ifdef TPROBE
    const unsigned long long tp0 = __builtin_amdgcn_s_memrealtime();
#endif
    int ph = __builtin_amdgcn_readfirstlane(ph_);
#ifdef PH_LIMIT
    if (ph > PH_LIMIT && ph < NPH - 1) continue;
#endif
    int tid_ = threadIdx.x; asm volatile("" : "+v"(tid_));
    unsigned char* ws_ = p.ws; asm volatile("" : "+s"(ws_)); unsigned char* ws = as_global(ws_);
    int zi = 0; asm volatile("" : "+s"(zi));
    Frame F;
    F.lds = (LAS unsigned char*)lds_raw;
    F.tid = tid_; F.lane = F.tid & 63; F.wave = __builtin_amdgcn_readfirstlane(F.tid >> 6); { int g_ = gridDim.x, b_ = blockIdx.x; asm volatile("" : "+s"(g_), "+s"(b_)); F.G = g_; F.bid = b_; }
    float* MOD = (float*)(ws + WS_MOD);
    const f32x2* ROPE = (const f32x2*)(ws + WS_ROPE);
    float* DT = (float*)(ws + WS_DT);
    float* CD = (float*)(ws + WS_CD);
    bf16_t* WFU = (bf16_t*)(ws + WS_WFU); bf16_t* WFD = (bf16_t*)(ws + WS_WFD); bf16_t* WIN = (bf16_t*)(ws + WS_WIN); bf16_t* WOUT = (bf16_t*)(ws + WS_WOUT);
    bf16_t* U = (bf16_t*)(ws + WS_U); bf16_t* RST = (bf16_t*)(ws + WS_RST); bf16_t* SST = (bf16_t*)(ws + WS_SST);
    bf16_t* PROJ = (bf16_t*)(ws + WS_PROJ); bf16_t* HID = PROJ;
    float* hbuf_ = p.out; asm volatile("" : "+s"(hbuf_)); float* hbuf = as_global(hbuf_);
        if (ph == NPH - 1) {
            if (EN_FIN) final_phase(F, hbuf, as_global(p.in[24 + zi]), MOD + FMOD_OFF);
        } else {
#ifdef XTRA_LIST
            static constexpr int xtra[] = XTRA_LIST;
            const int l = (ph >= NPH) ? 1 : (ph - 1) / 12, j = (ph >= NPH) ? xtra[ph - NPH] : (ph - 1) % 12;
#else
            const int l = (ph - 1) / 12, j = (ph - 1) % 12;
#endif
            const float* modl = MOD + (size_t)l * 4 * 9216;
            if (j == 0 || j == 3 || j == 9) {
                const float* hin = (l == 0 && j == 0) ? as_global(p.in[0 + zi]) : hbuf;
                const int gi = (j == 0) ? 4 : (j == 3) ? 8 : 18;
                const int mi = (j == 0) ? 0 : (j == 3) ? 3 : 6;
                if (EN_NORM) norm_phase(F, hin, as_global(p.in[gi + zi]) + l * DM, modl + mi * 1024, modl + (mi + 1) * 1024, 9216, U);
                __syncthreads();
                if (!EN_CONV) {} else if (j == 0) convert_ffn(F, as_global(p.in[5 + zi]) + (size_t)l * DM * DFF, as_global(p.in[6 + zi]) + (size_t)l * DM * DFF, as_global(p.in[7 + zi]) + (size_t)l * DM * DFF, WFU, WFD);
                else if (j == 9) convert_ffn(F, as_global(p.in[19 + zi]) + (size_t)l * DM * DFF, as_global(p.in[20 + zi]) + (size_t)l * DM * DFF, as_global(p.in[21 + zi]) + (size_t)l * DM * DFF, WFU, WFD);
                else convert_mix(F, as_global(p.in[9 + zi]) + (size_t)l * DM * INW, as_global(p.in[17 + zi]) + (size_t)l * 1536 * DM, WIN, WOUT);
            } else if (j == 1 || j == 10) {
                pg8::Gemm g{U, WFU, T_TOK, 2 * DFF, DM, DM}; pg8::StaticOrder S; S.init(T_TOK, 2 * DFF, F.G, F.bid);
                pg8::EpiSwiGLU E{HID, DFF};
                if (EN_G1) pg8::gemm_phase<pg8::EpiSwiGLU>(F.lds, F.tid, g, S, E);
            } else if (j == 2 || j == 11 || j == 8) {
                pg8::Gemm g; pg8::EpiResid E;
                if (j == 8) { g = pg8::Gemm{PROJ, WOUT, T_TOK, DM, 1536, PW}; E = pg8::EpiResid{hbuf, hbuf, modl + 5 * 1024, 1.0f}; }
                else { g = pg8::Gemm{HID, WFD, T_TOK, DM, DFF, DFF}; E = pg8::EpiResid{(l == 0 && j == 2) ? as_global(p.in[0 + zi]) : hbuf, hbuf, modl + (j == 2 ? 2 : 8) * 1024, 0.5f}; }
                pg8::StaticOrder S; S.init(T_TOK, DM, F.G, F.bid);
                if (EN_G2) { if (j == 8) pg8::gemm_phase<pg8::EpiResid, true>(F.lds, F.tid, g, S, E); else pg8::gemm_phase<pg8::EpiResid, false>(F.lds, F.tid, g, S, E); }
            } else if (j == 4) {
                pg8::Gemm g{U, WIN, T_TOK, PW, DM, DM}; pg8::StaticOrder S; S.init(T_TOK, PW, F.G, F.bid);
                pg8::EpiBf16 E{PROJ, PW};
                if (EN_G3) pg8::gemm_phase<pg8::EpiBf16>(F.lds, F.tid, g, S, E);
                if (EN_DT) dt_gemv(F, U, as_global(p.in[9 + zi]) + (size_t)l * DM * INW, DT);
            } else if (j == 5) {
                if (EN_SB && XS(1)) for (int t = F.bid; t < 1024; t += F.G) { const int qb = 63 - (t >> 4), bh = t & 15; sb_task(F, PROJ, bh >> 2, bh & 3, qb); }
                if (EN_RKV && XS(2)) for (int t = F.bid; t < 2048; t += F.G) { const int h = t & 3, bc = t >> 2; ret_kv_task(F, PROJ, ROPE, RST, bc >> 7, bc & 127, h); }
                if (EN_SST && XS(4)) for (int t = F.bid; t < 1024; t += F.G) { const int g = t & 1, bc = t >> 1;
                    ssd_state_task(F, PROJ, DT, as_global(p.in[10 + zi]) + l * 4096, as_global(p.in[11 + zi]) + l * 1024, as_global(p.in[12 + zi]) + l * 8, as_global(p.in[13 + zi]) + l * 8, SST, CD, bc >> 7, bc & 127, g); }
            } else if (j == 6) {
                if (EN_SCAN) scan_phase(F, RST, SST, CD);
            } else if (j == 7) {
                if (EN_ROUT && XS(8)) for (int t = F.bid; t < 2048; t += F.G) { const int h = t & 3, bc = t >> 2; ret_out_task(F, PROJ, ROPE, RST, as_global(p.in[15 + zi]) + l * 512, bc >> 7, bc & 127, h, ph >= NPH ? XMODE : 0); }
                if (EN_SOUT && XS(16)) for (int t = F.bid; t < 512; t += F.G) {
                    ssd_out_task(F, PROJ, DT, as_global(p.in[10 + zi]) + l * 4096, as_global(p.in[11 + zi]) + l * 1024, as_global(p.in[12 + zi]) + l * 8, as_global(p.in[13 + zi]) + l * 8, as_global(p.in[14 + zi]) + l * 8, as_global(p.in[16 + zi]) + l * 512, SST, t >> 7, t & 127); }
            }
        }
        if (ph + 1 < p.ph_hi) { xcd_barrier(xbar); }
#ifdef TPROBE
        { const unsigned long long tp1 = __builtin_amdgcn_s_memrealtime(); const int jj = (ph - 1) % 12;
          if (ph < NPH - 1) { if (TPROBE_A(jj)) tA += tp1 - tp0; if (TPROBE_B(jj)) tB += tp1 - tp0; } }
#endif
    }
#ifdef TPROBE
    cg::this_grid().sync();
    if (blockIdx.x == 0) { const float a = (float)tA * 0.01f, b = (float)tB * 0.01f * TPROBE_BS;
        if (threadIdx.x == 0) p.out[0] += a;
        for (int i = threadIdx.x; i < (1 << 20); i += NTHR) p.out[1024 + i] += b; }
#endif
}

extern "C" void kernel_launch(void* const* d_in, const int* in_sizes, int n_in, void* d_out, int out_size, void* d_ws, size_t ws_size, hipStream_t stream) {
    static int grid = 0;
    if (grid == 0) {
        if (n_in != 25 || out_size != T_TOK * DM || ws_size < WS_END) { fprintf(stderr, "kernel_launch: unexpected shapes (n_in %d out %d ws %zu)\n", n_in, out_size, ws_size); grid = -1; return; }
        int dev = 0, cus = 0, per_cu = 0;
        hipGetDevice(&dev);
        hipDeviceGetAttribute(&cus, hipDeviceAttributeMultiprocessorCount, dev);
        hipFuncSetAttribute((const void*)fwd_kernel, hipFuncAttributeMaxDynamicSharedMemorySize, LDS_BYTES);
        hipOccupancyMaxActiveBlocksPerMultiprocessor(&per_cu, (const void*)fwd_kernel, NTHR, LDS_BYTES);
        if (per_cu < 1) per_cu = 1;
        (void)hipGetLastError();
        grid = cus * per_cu;
    }
    if (grid < 0) return;
    (void)hipMemsetAsync(d_ws, 0, 65536, stream);
    Params p{};
    for (int i = 0; i < 25; ++i) p.in[i] = (const float*)d_in[i];
    p.out = (float*)d_out; p.ws = (unsigned char*)d_ws;
#if ONE_LAUNCH
#ifdef XTRA_LIST
    p.ph_lo = 0; p.ph_hi = NPH + XTRA_N;
#else
    p.ph_lo = 0; p.ph_hi = NPH;
#endif
    void* args[] = {&p};
    hipError_t e = hipLaunchCooperativeKernel((const void*)fwd_kernel, dim3(grid), dim3(NTHR), args, LDS_BYTES, stream);
    if (e != hipSuccess) fprintf(stderr, "cooperative launch failed: %s (grid %d)\n", hipGetErrorString(e), grid);
#else
    for (int ph = 0; ph < NPH; ++ph) { p.ph_lo = ph; p.ph_hi = ph + 1; hipLaunchKernelGGL(fwd_kernel, dim3(grid), dim3(NTHR), LDS_BYTES, stream, p); }
#endif
}
```

```cpp
#include <hip/hip_runtime.h>
#include <hip/hip_cooperative_groups.h>
#include <cstdint>
#include <cstdio>
namespace cg = cooperative_groups;

#ifndef ONE_LAUNCH
#define ONE_LAUNCH 1
#endif

#ifndef EN_ALL
#define EN_ALL 1
#endif
#ifndef EN_PRO
#define EN_PRO EN_ALL
#endif
#ifndef EN_FIN
#define EN_FIN EN_ALL
#endif
#ifndef EN_NORM
#define EN_NORM EN_ALL
#endif
#ifndef EN_CONV
#define EN_CONV EN_ALL
#endif
#ifndef EN_G1
#define EN_G1 EN_ALL
#endif
#ifndef EN_G2
#define EN_G2 EN_ALL
#endif
#ifndef EN_G3
#define EN_G3 EN_ALL
#endif
#ifndef EN_DT
#define EN_DT EN_ALL
#endif
#ifndef EN_SB
#define EN_SB EN_ALL
#endif
#ifndef EN_RKV
#define EN_RKV EN_ALL
#endif
#ifndef EN_SST
#define EN_SST EN_ALL
#endif
#ifndef EN_SCAN
#define EN_SCAN EN_ALL
#endif
#ifndef EN_ROUT
#define EN_ROUT EN_ALL
#endif
#ifndef EN_SOUT
#define EN_SOUT EN_ALL
#endif
#ifndef EN_SINTER
#define EN_SINTER 1
#endif
#ifndef XSEL
#define XSEL 31
#endif
#define XS(m) (ph < NPH || (XSEL & (m)))
#ifndef XMODE
#define XMODE 0
#endif
#define LAS __attribute__((address_space(3)))
#define GAS __attribute__((address_space(1)))
template <class T> __device__ __forceinline__ T* as_global(T* p) {
#if defined(__HIP_DEVICE_COMPILE__)
    __builtin_assume(!__builtin_amdgcn_is_shared((const void*)p)); __builtin_assume(!__builtin_amdgcn_is_private((const void*)p));
#endif
    return p; }
typedef unsigned short bf16_t;
typedef short bf16x8 __attribute__((ext_vector_type(8)));
typedef float f32x4 __attribute__((ext_vector_type(4)));
typedef float f32x2 __attribute__((ext_vector_type(2)));
typedef unsigned u32x4 __attribute__((ext_vector_type(4)));
typedef unsigned u32x2 __attribute__((ext_vector_type(2)));

constexpr int T_TOK = 32768, SEQ = 8192, DM = 1024, DFF = 2816, INW = 5128, PW = 5120;
constexpr int NTHR = 512, NWAVE = 8;
constexpr float EPS = 1e-6f;
constexpr int C_RQ = 0, C_SQ = 512, C_MZ = 1024, C_RK = 1536, C_RV = 2048, C_RG = 2560, C_SK = 3072, C_SV = 3584, C_XBC = 4096;

constexpr size_t MiB = 1u << 20;
constexpr size_t WS_MOD = 1 * MiB, WS_ROPE = 2 * MiB, WS_DT = 6 * MiB, WS_CD = 7 * MiB;
constexpr size_t WS_WFU = 8 * MiB, WS_WFD = 19 * MiB, WS_WIN = 25 * MiB, WS_WOUT = 35 * MiB;
constexpr size_t WS_U = 38 * MiB, WS_RST = 38 * MiB, WS_SST = 102 * MiB, WS_PROJ = 166 * MiB, WS_END = 486 * MiB;
constexpr int FMOD_OFF = 2 * 4 * 9 * 1024;

constexpr size_t PLANE = (size_t)T_TOK * 128;
__device__ __forceinline__ size_t pidx(size_t row, int col) { return (size_t)(col >> 7) * PLANE + row * 128 + (col & 127); }
constexpr int LDS_BYTES = 147456;

struct Params {
    const float* in[25];
    float* out;
    unsigned char* ws;
    int ph_lo, ph_hi;
};

typedef __bf16 bf16x2_t __attribute__((ext_vector_type(2)));
__device__ __forceinline__ unsigned cvt_pk_bf16(float lo, float hi) { const f32x2 v = {lo, hi}; const bf16x2_t b = __builtin_convertvector(v, bf16x2_t); return __builtin_bit_cast(unsigned, b); }
__device__ __forceinline__ float bf_lo(unsigned u) { return __uint_as_float(u << 16); }
__device__ __forceinline__ float bf_hi(unsigned u) { return __uint_as_float(u & 0xffff0000u); }
__device__ __forceinline__ float bf2f(bf16_t x) { return __uint_as_float(((unsigned)x) << 16); }
__device__ __forceinline__ bf16_t f2bf(float f) { return (bf16_t)(cvt_pk_bf16(f, 0.f) & 0xffffu); }
__device__ __forceinline__ float wave_sum(float v) {
#pragma unroll
    for (int o = 1; o < 64; o <<= 1) v += __shfl_xor(v, o);
    return v;
}
__device__ __forceinline__ float wave_max(float v) {
#pragma unroll
    for (int o = 1; o < 64; o <<= 1) v = fmaxf(v, __shfl_xor(v, o));
    return v;
}
__device__ __forceinline__ void lds_barrier() { asm volatile("s_waitcnt lgkmcnt(0)" ::: "memory"); __builtin_amdgcn_s_barrier(); asm volatile("" ::: "memory"); }
__device__ __forceinline__ float silu_f(float g) { return g * __builtin_amdgcn_rcpf(1.0f + __builtin_amdgcn_exp2f(-1.44269504f * g)); }
__device__ __forceinline__ f32x4 mfma16(bf16x8 a, bf16x8 b, f32x4 c) { return __builtin_amdgcn_mfma_f32_16x16x32_bf16(a, b, c, 0, 0, 0); }
__device__ __forceinline__ bf16x8 ldsfrag(const LAS unsigned char* p) { return *(const LAS bf16x8*)p; }
__device__ __forceinline__ u32x2 pack4(f32x4 v) { u32x2 w; w.x = cvt_pk_bf16(v[0], v[1]); w.y = cvt_pk_bf16(v[2], v[3]); return w; }
__device__ __forceinline__ void unpack8(u32x4 v, float* f) {
    f[0] = bf_lo(v.x); f[1] = bf_hi(v.x); f[2] = bf_lo(v.y); f[3] = bf_hi(v.y); f[4] = bf_lo(v.z); f[5] = bf_hi(v.z); f[6] = bf_lo(v.w); f[7] = bf_hi(v.w);
}
__device__ __forceinline__ float log2gamma(int h) { return h == 0 ? -0.04580368961312479f : (h == 1 ? -0.02272007650008353f : (h == 2 ? -0.011315313227834146f : -0.005646563141142063f)); }

namespace pg8 {
constexpr int BM = 256, BK = 64, HALF = 128, HTB = HALF * BK * 2, STAGE_BYTES = 8 * HTB, NXCD = 8, WGM = 8;
__host__ __device__ __forceinline__ int lds_byte(int r, int c) { const int st = (r >> 4) * 2 + (c >> 5), rr = r & 15, cc = c & 31, ob = rr * 64 + cc * 2; return st * 1024 + (ob ^ (((ob >> 9) & 1) << 5)); }
__host__ __device__ __forceinline__ void stage_rc(int b, int& R, int& C) { const int st = b / 1024, sb = b % 1024, swz = sb ^ (((sb >> 9) & 1) << 5); R = (st >> 1) * 16 + swz / 64; C = (st & 1) * 32 + (swz % 64) / 2; }
__host__ __device__ __forceinline__ int perm32(int rho) { const int n = rho >> 4, i = rho & 15; return 8 * (i >> 2) + 4 * n + (i & 3); }
struct Unit { int pm, pn; };
struct Gemm { const bf16_t* A; const bf16_t* Bt; int M, N, K, lda; };
struct StaticOrder {
    int nM, nN, nwg, G, c;
    __device__ void init(int M, int N, int G_, int c_) { nM = M / BM; nN = N / BM; nwg = nM * nN; G = G_; c = c_; }
    __device__ bool next(int i, Unit& u) const {
        const long L = (long)i * G + c; if (L >= nwg) return false;
        int wgid = (int)L; { const int q = nwg / NXCD, r = nwg % NXCD, xcd = wgid % NXCD, off = wgid / NXCD; wgid = (xcd < r ? xcd * (q + 1) : r * (q + 1) + (xcd - r) * q) + off; }
        const int nig = WGM * nN, gid = wgid / nig, fm = gid * WGM, gsz = (nM - fm) < WGM ? (nM - fm) : WGM;
        u.pm = fm + ((wgid % nig) % gsz); u.pn = (wgid % nig) / gsz; return true;
    }
};
struct EpiBf16 {
    bf16_t* O; int ldc;
    __device__ __forceinline__ void operator()(const f32x4 (&acc)[2][2][4][2], const Unit& u, int wr, int wc, int fr, int fq) const {
        const int row0 = u.pm * BM + wr * 64 + fr, col0 = u.pn * BM + wc * 32 + 8 * fq;
#pragma unroll
        for (int ai = 0; ai < 2; ++ai)
#pragma unroll
            for (int m = 0; m < 4; ++m) { bf16_t* rowp = O + (size_t)(2 * u.pn) * PLANE + (size_t)(row0 + ai * HALF + m * 16) * 128 + wc * 32 + 8 * fq;
#pragma unroll
                for (int bj = 0; bj < 2; ++bj) { const f32x4 v0 = acc[ai][bj][m][0], v1 = acc[ai][bj][m][1];
                    u32x4 w; w.x = cvt_pk_bf16(v0[0], v0[1]); w.y = cvt_pk_bf16(v0[2], v0[3]); w.z = cvt_pk_bf16(v1[0], v1[1]); w.w = cvt_pk_bf16(v1[2], v1[3]);
                    *(GAS u32x4*)(rowp + bj * PLANE) = w; } }
    }
};
struct EpiSwiGLU {
    bf16_t* O; int ldo;
    __device__ __forceinline__ void operator()(const f32x4 (&acc)[2][2][4][2], const Unit& u, int wr, int wc, int fr, int fq) const {
        const int row0 = u.pm * BM + wr * 64 + fr, col0 = u.pn * HALF + wc * 32 + 8 * fq;
#pragma unroll
        for (int ai = 0; ai < 2; ++ai)
#pragma unroll
            for (int m = 0; m < 4; ++m) { bf16_t* rowp = O + (size_t)(row0 + ai * HALF + m * 16) * ldo + col0;
                float hv[8];
#pragma unroll
                for (int n = 0; n < 2; ++n)
#pragma unroll
                    for (int i = 0; i < 4; ++i) hv[4 * n + i] = silu_f(acc[ai][0][m][n][i]) * acc[ai][1][m][n][i];
                u32x4 w; w.x = cvt_pk_bf16(hv[0], hv[1]); w.y = cvt_pk_bf16(hv[2], hv[3]); w.z = cvt_pk_bf16(hv[4], hv[5]); w.w = cvt_pk_bf16(hv[6], hv[7]);
                *(GAS u32x4*)rowp = w; }
    }
};
struct EpiResid {
    const float* hin; float* hout; const float* gate; float cmul;
    __device__ __forceinline__ void operator()(const f32x4 (&acc)[2][2][4][2], const Unit& u, int wr, int wc, int fr, int fq) const {
        const int row0 = u.pm * BM + wr * 64 + fr, col0 = u.pn * BM + wc * 32 + 8 * fq;
        const int b = (u.pm * BM) >> 13;
        f32x4 gm[2][2];
#pragma unroll
        for (int bj = 0; bj < 2; ++bj)
#pragma unroll
            for (int n = 0; n < 2; ++n) { const f32x4 g = *(const GAS f32x4*)(gate + (size_t)b * 9216 + col0 + bj * HALF + 4 * n); gm[bj][n] = (g + 1.0f) * cmul; }
#pragma unroll
        for (int ai = 0; ai < 2; ++ai)
#pragma unroll
            for (int m = 0; m < 4; ++m) { const size_t off = (size_t)(row0 + ai * HALF + m * 16) * DM + col0;
#pragma unroll
                for (int bj = 0; bj < 2; ++bj)
#pragma unroll
                    for (int n = 0; n < 2; ++n) { const f32x4 hv = *(const GAS f32x4*)(hin + off + bj * HALF + 4 * n);
                        *(GAS f32x4*)(hout + off + bj * HALF + 4 * n) = hv + gm[bj][n] * acc[ai][bj][m][n]; } }
    }
};

template <class Epi, bool APL = false>
__device__ __forceinline__ void gemm_phase(LAS unsigned char* lds, const int tid, const Gemm g, const StaticOrder& S, const Epi& E) {
    const int wid = __builtin_amdgcn_readfirstlane(tid >> 6), lane = tid & 63, wr = wid >> 2, wc = wid & 3, fr = lane & 15, fq = lane >> 4;
    const int K = g.K, nt = K / BK, lda = g.lda;
    unsigned voffA[2], voffB[2];
#pragma unroll
    for (int i = 0; i < 2; ++i) { int R, C; stage_rc(tid * 16 + i * 8192, R, C); const int Rb = (R & ~31) + perm32(R & 31);
        voffA[i] = (unsigned)(R * (APL ? 128 : lda) + C) * 2u; voffB[i] = (unsigned)(Rb * K + C) * 2u; }
    const size_t kstep = (size_t)(BK * 2);
    const size_t hstepA = (size_t)HALF * (APL ? 128 : lda) * 2, hstepB = (size_t)HALF * K * 2;
#define PG8_KA(t) (APL ? ((size_t)((t) >> 1) * (PLANE * 2) + (size_t)((t) & 1) * 128) : (size_t)(t) * kstep)
    const size_t tstepA = 2 * hstepA, tstepB = 2 * hstepB;
    const unsigned ldsw = (unsigned)wid * 1024u;
    const int aoff = lds_byte(wr * 64 + fr, fq * 8), boff = lds_byte(wc * 32 + fr, fq * 8);
#define PG8_SA(b, h) (((b) * 2 + (h)) * HTB)
#define PG8_SB(b, h) ((4 + (b) * 2 + (h)) * HTB)
#define PG8_STAGE(bufoff, gbase, voff) do { _Pragma("unroll") for (int _i = 0; _i < 2; ++_i) \
        __builtin_amdgcn_global_load_lds((const unsigned*)((const char*)(gbase) + (voff)[_i]), (LAS unsigned*)(lds + (bufoff) + ldsw + _i * 8192), 16, 0, 0); } while (0)
#define PG8_LDA(dst, b, h) do { _Pragma("unroll") for (int m = 0; m < 4; ++m) _Pragma("unroll") for (int k = 0; k < 2; ++k) dst[m][k] = *(const LAS bf16x8*)(lds + PG8_SA(b, h) + aoff + m * 2048 + k * 1024); } while (0)
#define PG8_LDB(dst, b, h) do { _Pragma("unroll") for (int n = 0; n < 2; ++n) _Pragma("unroll") for (int k = 0; k < 2; ++k) dst[n][k] = *(const LAS bf16x8*)(lds + PG8_SB(b, h) + boff + n * 2048 + k * 1024); } while (0)
#define PG8_MMA(ai, bj, At, Bt) do { __builtin_amdgcn_s_setprio(1); _Pragma("unroll") for (int m = 0; m < 4; ++m) _Pragma("unroll") for (int n = 0; n < 2; ++n) _Pragma("unroll") for (int k = 0; k < 2; ++k) \
        acc[ai][bj][m][n] = __builtin_amdgcn_mfma_f32_16x16x32_bf16(Bt[n][k], At[m][k], acc[ai][bj][m][n], 0, 0, 0); __builtin_amdgcn_s_setprio(0); } while (0)
#define PG8_WAIT_V(n) asm volatile("s_waitcnt vmcnt(" #n ")" ::: "memory")
#define PG8_WAIT_L(n) asm volatile("s_waitcnt lgkmcnt(" #n ")" ::: "memory")
#define PG8_BAR __builtin_amdgcn_s_barrier()
#define PG8_SCHED __builtin_amdgcn_sched_barrier(0)
    Unit cur, nxt; int ui = 0;
    if (!S.next(0, cur)) return;
    f32x4 acc[2][2][4][2];
#pragma unroll
    for (int a = 0; a < 2; ++a)
#pragma unroll
        for (int b = 0; b < 2; ++b)
#pragma unroll
            for (int m = 0; m < 4; ++m)
#pragma unroll
                for (int n = 0; n < 2; ++n) acc[a][b][m][n] = (f32x4){0.f, 0.f, 0.f, 0.f};
    bf16x8 At[4][2], B0[2][2], B1[2][2];
    const char* cA = (const char*)g.A + (size_t)cur.pm * tstepA; const char* cB = (const char*)g.Bt + (size_t)cur.pn * tstepB;
    PG8_STAGE(PG8_SB(0, 0), cB, voffB); PG8_STAGE(PG8_SB(0, 1), cB + hstepB, voffB); PG8_STAGE(PG8_SA(0, 0), cA, voffA); PG8_STAGE(PG8_SA(0, 1), cA + hstepA, voffA);
    if (wr == 1) PG8_BAR;
    PG8_WAIT_V(2); PG8_BAR;
    PG8_STAGE(PG8_SB(1, 0), cB + kstep, voffB); PG8_STAGE(PG8_SA(1, 0), cA + PG8_KA(1), voffA); PG8_STAGE(PG8_SB(1, 1), cB + hstepB + kstep, voffB);
    PG8_WAIT_V(6); PG8_BAR;
    for (;;) {
        const bool has_next = S.next(ui + 1, nxt);
        const char* nA = has_next ? (const char*)g.A + (size_t)nxt.pm * tstepA : cA; const char* nB = has_next ? (const char*)g.Bt + (size_t)nxt.pn * tstepB : cB;
        for (int t = 0; t < nt; t += 2) {
            const bool last = (t == nt - 2);
            const char* a1 = cA + PG8_KA(t + 1);
            const char* a2 = last ? nA : cA + PG8_KA(t + 2); const char* b2 = last ? nB : cB + (size_t)(t + 2) * kstep;
            const char* a3 = last ? nA + PG8_KA(1) : cA + PG8_KA(t + 3); const char* b3 = b2 + kstep;
            PG8_LDB(B0, 0, 0); PG8_LDB(B1, 0, 1); PG8_SCHED; PG8_LDA(At, 0, 0); PG8_STAGE(PG8_SA(1, 1), a1 + hstepA, voffA);
            PG8_WAIT_V(8); PG8_WAIT_L(0); PG8_BAR; PG8_MMA(0, 0, At, B0); PG8_MMA(0, 1, At, B1); PG8_BAR; PG8_SCHED;
            PG8_LDA(At, 0, 1); PG8_STAGE(PG8_SB(0, 0), b2, voffB); PG8_STAGE(PG8_SB(0, 1), b2 + hstepB, voffB); PG8_STAGE(PG8_SA(0, 0), a2, voffA);
            PG8_WAIT_V(8); PG8_WAIT_L(0); PG8_BAR; PG8_MMA(1, 0, At, B0); PG8_MMA(1, 1, At, B1); PG8_BAR; PG8_SCHED;
            PG8_LDB(B0, 1, 0); PG8_LDB(B1, 1, 1); PG8_SCHED; PG8_LDA(At, 1, 0); PG8_STAGE(PG8_SA(0, 1), a2 + hstepA, voffA);
            PG8_WAIT_V(8); PG8_WAIT_L(0); PG8_BAR; PG8_MMA(0, 0, At, B0); PG8_MMA(0, 1, At, B1); PG8_BAR; PG8_SCHED;
            PG8_LDA(At, 1, 1); PG8_STAGE(PG8_SB(1, 0), b3, voffB); PG8_STAGE(PG8_SB(1, 1), b3 + hstepB, voffB); PG8_STAGE(PG8_SA(1, 0), a3, voffA);
            PG8_WAIT_V(8); PG8_WAIT_L(0); PG8_BAR; PG8_MMA(1, 0, At, B0); PG8_MMA(1, 1, At, B1); PG8_BAR; PG8_SCHED;
        }
        if (wr == 0) PG8_BAR;
        E(acc, cur, wr, wc, fr, fq);
        if (!has_next) break;
#pragma unroll
        for (int a = 0; a < 2; ++a)
#pragma unroll
            for (int b = 0; b < 2; ++b)
#pragma unroll
                for (int m = 0; m < 4; ++m)
#pragma unroll
                    for (int n = 0; n < 2; ++n) acc[a][b][m][n] = (f32x4){0.f, 0.f, 0.f, 0.f};
        cur = nxt; cA = nA; cB = nB; ++ui;
        if (wr == 1) PG8_BAR;
    }
    PG8_WAIT_V(0);
    PG8_BAR;
#undef PG8_KA
#undef PG8_SA
#undef PG8_SB
#undef PG8_STAGE
#undef PG8_LDA
#undef PG8_LDB
#undef PG8_MMA
#undef PG8_WAIT_V
#undef PG8_WAIT_L
#undef PG8_BAR
#undef PG8_SCHED
}
}

struct Frame {
    LAS unsigned char* lds;
    int tid, lane, wave, G, bid;
};

__device__ __forceinline__ void conv_item(const float* W, int Nsrc, int K, int src_col0, bf16_t* WT, int dst_row0, int k0, LAS float* scr, int lane) {
#pragma unroll 8
    for (int i = 0; i < 32; ++i) { const int kk = 2 * i + (lane >> 5); scr[kk * 33 + (lane & 31)] = ((const GAS float*)W)[(size_t)(k0 + kk) * Nsrc + src_col0 + (lane & 31)]; }
    asm volatile("s_waitcnt lgkmcnt(0)" ::: "memory");
    const int c = lane & 7;
#pragma unroll
    for (int j = 0; j < 4; ++j) { const int n = (lane >> 3) + 8 * j; const LAS float* s = scr + (8 * c) * 33 + n;
        u32x4 o; o.x = cvt_pk_bf16(s[0 * 33], s[1 * 33]); o.y = cvt_pk_bf16(s[2 * 33], s[3 * 33]); o.z = cvt_pk_bf16(s[4 * 33], s[5 * 33]); o.w = cvt_pk_bf16(s[6 * 33], s[7 * 33]);
        *(GAS u32x4*)(WT + (size_t)(dst_row0 + n) * K + k0 + 8 * c) = o; }
    asm volatile("s_waitcnt lgkmcnt(0)" ::: "memory");
}
__device__ __forceinline__ void convert_ffn(const Frame& F, const float* wg, const float* wu, const float* wd, bf16_t* WFU, bf16_t* WFD) {
    LAS float* scr = (LAS float*)(F.lds + F.wave * 16384);
    const int gw = F.bid * NWAVE + F.wave, NGW = F.G * NWAVE;
    constexpr int I_U = 16 * 176, I_D = 44 * 32;
    for (int it = gw; it < I_U + I_D; it += NGW) {
        if (it < I_U) { const int kb = it / 176, nb = it % 176, r0 = nb * 32, pn = r0 >> 8, i0 = r0 & 255;
            conv_item(i0 < 128 ? wg : wu, DFF, DM, pn * 128 + (i0 & 127), WFU, r0, kb * 64, scr, F.lane); }
        else { const int r = it - I_U, kb = r / 32, nb = r % 32; conv_item(wd, DM, DFF, nb * 32, WFD, nb * 32, kb * 64, scr, F.lane); }
    }
}
__device__ __forceinline__ void convert_mix(const Frame& F, const float* w_in, const float* w_out, bf16_t* WIN, bf16_t* WOUT) {
    LAS float* scr = (LAS float*)(F.lds + F.wave * 16384);
    const int gw = F.bid * NWAVE + F.wave, NGW = F.G * NWAVE;
    constexpr int I_I = 16 * 160, I_O = 24 * 32;
    for (int it = gw; it < I_I + I_O; it += NGW) {
        if (it < I_I) { const int kb = it / 160, nb = it % 160, r0 = nb * 32, blk = r0 >> 9;
            const int sb = blk == 0 ? 0 : blk == 1 ? 4 : blk == 2 ? 7 : blk == 3 ? 1 : blk == 4 ? 2 : blk == 5 ? 3 : blk == 6 ? 5 : blk == 7 ? 6 : blk;
            conv_item(w_in, INW, DM, sb * 512 + (r0 & 511), WIN, r0, kb * 64, scr, F.lane); }
        else { const int r = it - I_I, kb = r / 32, nb = r % 32; conv_item(w_out, DM, 1536, nb * 32, WOUT, nb * 32, kb * 64, scr, F.lane); }
    }
}

__device__ __forceinline__ void sincos_d(double x, double& s, double& c) {
    const double k = rint(x * 0.63661977236758134308);
    double r = fma(-k, 1.57079632679489655800e+00, x); r = fma(-k, 6.12323399573676603587e-17, r);
    const double r2 = r * r;
    double sp = -7.6471637318198164759e-13; sp = sp * r2 + 1.6059043836821614599e-10; sp = sp * r2 - 2.5052108385441718775e-08; sp = sp * r2 + 2.7557319223985890653e-06;
    sp = sp * r2 - 1.9841269841269841270e-04; sp = sp * r2 + 8.3333333333333333333e-03; sp = sp * r2 - 1.6666666666666666667e-01; const double sn = r + r * r2 * sp;
    double cp = 4.7794773323873852974e-14; cp = cp * r2 - 1.1470745597729724714e-11; cp = cp * r2 + 2.0876756987868098979e-09; cp = cp * r2 - 2.7557319223985890653e-07;
    cp = cp * r2 + 2.4801587301587301587e-05; cp = cp * r2 - 1.3888888888888888889e-03; cp = cp * r2 + 4.1666666666666666667e-02; cp = cp * r2 - 0.5; const double cs = 1.0 + r2 * cp;
    const int q = ((int)k) & 3;
    s = (q == 0) ? sn : (q == 1) ? cs : (q == 2) ? -sn : -cs;
    c = (q == 0) ? cs : (q == 1) ? -sn : (q == 2) ? -cs : sn;
}
__device__ __forceinline__ void prologue(const Frame& F, const Params& p, unsigned char* ws, int zi) {
    LAS float* cs = (LAS float*)F.lds;
    LAS float* red = (LAS float*)(F.lds + 16384);
    const float* c = as_global(p.in[1 + zi]);
    for (int i = F.tid; i < 4096; i += NTHR) cs[i] = silu_f(c[i]);
    __syncthreads();
    float* MOD = (float*)(ws + WS_MOD);
    for (int task = F.bid; task < 320; task += F.G) {
        const float* W; const float* bias; int N, n0; float* dst; int dstride;
        if (task < 288) { const int l = task / 144, t = task % 144; W = as_global(p.in[2 + zi]) + (size_t)l * DM * 9216; bias = as_global(p.in[3 + zi]) + l * 9216; N = 9216; n0 = t * 64; dst = MOD + (size_t)l * 4 * 9216; dstride = 9216; }
        else { const int t = task - 288; W = as_global(p.in[22 + zi]); bias = as_global(p.in[23 + zi]); N = 2048; n0 = t * 64; dst = MOD + FMOD_OFF; dstride = 2048; }
        float a0 = 0.f, a1 = 0.f, a2 = 0.f, a3 = 0.f;
        const int kb = F.wave * 128;
#pragma unroll 32
        for (int k = 0; k < 128; ++k) { const float w = ((const GAS float*)W)[(size_t)(kb + k) * N + n0 + F.lane];
            a0 += cs[kb + k] * w; a1 += cs[1024 + kb + k] * w; a2 += cs[2048 + kb + k] * w; a3 += cs[3072 + kb + k] * w; }
        red[(F.wave * 4 + 0) * 64 + F.lane] = a0; red[(F.wave * 4 + 1) * 64 + F.lane] = a1; red[(F.wave * 4 + 2) * 64 + F.lane] = a2; red[(F.wave * 4 + 3) * 64 + F.lane] = a3;
        __syncthreads();
        if (F.tid < 256) { const int b = F.tid >> 6, col = F.tid & 63; float s = bias[n0 + col];
#pragma unroll
            for (int w = 0; w < 8; ++w) s += red[(w * 4 + b) * 64 + col];
            dst[(size_t)b * dstride + n0 + col] = s; }
        __syncthreads();
    }
    f32x2* ROPE = (f32x2*)(ws + WS_ROPE);
    for (int idx = F.bid * NTHR + F.tid; idx < SEQ * 64; idx += F.G * NTHR) {
        const int pos = idx >> 6, i = idx & 63;
        const float invf = (float)exp(-(double)i * (9.210340371976184 / 64.0));
        const float ang = (float)pos * invf;
        double s, cc; sincos_d((double)ang, s, cc);
        ROPE[idx] = (f32x2){(float)cc, (float)s};
    }
}

__device__ __forceinline__ void norm_phase(const Frame& F, const float* h, const float* gain, const float* shift0, const float* scale0, int bstride, bf16_t* U) {
    const int gw = F.bid * NWAVE + F.wave, NGW = F.G * NWAVE;
    for (int m0 = gw; m0 < T_TOK; m0 += 4 * NGW) {
        f32x4 v[4][4];
#pragma unroll
        for (int r = 0; r < 4; ++r) { const int m = m0 + r * NGW; if (m < T_TOK) { const GAS f32x4* xr = (const GAS f32x4*)(h + (size_t)m * DM) + F.lane;
#pragma unroll
            for (int j = 0; j < 4; ++j) v[r][j] = xr[64 * j]; } }
#pragma unroll
        for (int r = 0; r < 4; ++r) { const int m = m0 + r * NGW; if (m < T_TOK) {
            const int b = m >> 13; float s = 0.f;
#pragma unroll
            for (int j = 0; j < 4; ++j) s += (v[r][j].x * v[r][j].x + v[r][j].y * v[r][j].y) + (v[r][j].z * v[r][j].z + v[r][j].w * v[r][j].w);
            const float rstd = rsqrtf(wave_sum(s) * (1.f / DM) + EPS);
            GAS u32x2* o8 = (GAS u32x2*)(U + (size_t)m * DM) + F.lane;
#pragma unroll
            for (int j = 0; j < 4; ++j) {
                const f32x4 g = ((const GAS f32x4*)gain)[F.lane + 64 * j], sh = ((const GAS f32x4*)(shift0 + (size_t)b * bstride))[F.lane + 64 * j], sc = ((const GAS f32x4*)(scale0 + (size_t)b * bstride))[F.lane + 64 * j];
                o8[64 * j] = pack4(v[r][j] * rstd * g * (sc + 1.0f) + sh); } } }
    }
}
__device__ __forceinline__ void final_phase(const Frame& F, float* h, const float* gain, const float* fmod) {
    const int gw = F.bid * NWAVE + F.wave, NGW = F.G * NWAVE;
    for (int m0 = gw; m0 < T_TOK; m0 += 4 * NGW) {
        f32x4 v[4][4];
#pragma unroll
        for (int r = 0; r < 4; ++r) { const int m = m0 + r * NGW; if (m < T_TOK) { const GAS f32x4* xr = (const GAS f32x4*)(h + (size_t)m * DM) + F.lane;
#pragma unroll
            for (int j = 0; j < 4; ++j) v[r][j] = xr[64 * j]; } }
#pragma unroll
        for (int r = 0; r < 4; ++r) { const int m = m0 + r * NGW; if (m < T_TOK) {
            const int b = m >> 13; float s = 0.f;
#pragma unroll
            for (int j = 0; j < 4; ++j) s += (v[r][j].x * v[r][j].x + v[r][j].y * v[r][j].y) + (v[r][j].z * v[r][j].z + v[r][j].w * v[r][j].w);
            const float rstd = rsqrtf(wave_sum(s) * (1.f / DM) + EPS);
            GAS f32x4* xr = (GAS f32x4*)(h + (size_t)m * DM) + F.lane;
#pragma unroll
            for (int j = 0; j < 4; ++j) {
                const f32x4 g = ((const GAS f32x4*)gain)[F.lane + 64 * j], sh = ((const GAS f32x4*)(fmod + (size_t)b * 2048))[F.lane + 64 * j], sc = ((const GAS f32x4*)(fmod + (size_t)b * 2048 + 1024))[F.lane + 64 * j];
                xr[64 * j] = v[r][j] * rstd * g * (sc + 1.0f) + sh; } } }
    }
}

__device__ __forceinline__ void dt_gemv(const Frame& F, const bf16_t* U, const float* w_in, float* DT) {
    LAS float* Wd = (LAS float*)F.lds;
    __syncthreads();
    for (int idx = F.tid; idx < 8192; idx += NTHR) { const int k = idx >> 3, j = idx & 7; Wd[8 * k + 4 * (k >> 3) + j] = ((const GAS float*)w_in)[(size_t)k * INW + 5120 + j]; }
    __syncthreads();
    const int gw = F.bid * NWAVE + F.wave, NGW = F.G * NWAVE;
    for (int m0 = gw; m0 < T_TOK; m0 += 4 * NGW) {
      u32x4 uvr[4][2];
#pragma unroll
      for (int r = 0; r < 4; ++r) { const int mm = (m0 + r * NGW < T_TOK) ? m0 + r * NGW : m0;
#pragma unroll
          for (int hf = 0; hf < 2; ++hf) uvr[r][hf] = *(const GAS u32x4*)(U + (size_t)mm * DM + 512 * hf + 8 * F.lane); }
#pragma unroll
      for (int r = 0; r < 4; ++r) { const int m = m0 + r * NGW; if (m < T_TOK) {
        float acc[8];
#pragma unroll
        for (int j = 0; j < 8; ++j) acc[j] = 0.f;
#pragma unroll
        for (int hf = 0; hf < 2; ++hf) {
            const u32x4 uv = uvr[r][hf];
            float uf[8]; unpack8(uv, uf);
#pragma unroll
            for (int kk = 0; kk < 8; ++kk) { const int k = 512 * hf + 8 * F.lane + kk; const LAS float* wp = Wd + 8 * k + 4 * (k >> 3);
                const f32x4 w0 = *(const LAS f32x4*)wp, w1 = *(const LAS f32x4*)(wp + 4);
                acc[0] += uf[kk] * w0.x; acc[1] += uf[kk] * w0.y; acc[2] += uf[kk] * w0.z; acc[3] += uf[kk] * w0.w;
                acc[4] += uf[kk] * w1.x; acc[5] += uf[kk] * w1.y; acc[6] += uf[kk] * w1.z; acc[7] += uf[kk] * w1.w; }
        }
#pragma unroll
        for (int j = 0; j < 8; ++j) acc[j] = wave_sum(acc[j]);
        if (F.lane < 8) { float v = acc[0];
#pragma unroll
            for (int j = 1; j < 8; ++j) v = (F.lane == j) ? acc[j] : v;
            ((GAS float*)DT)[(size_t)m * 8 + F.lane] = v; }
      } }
    }
    __syncthreads();
}

__device__ __forceinline__ void sb_task(const Frame& F, bf16_t* P, int b, int h, int qb) {
    LAS unsigned char* Ks = F.lds;
    LAS unsigned char* Vt = F.lds + 17408;
    LAS unsigned char* Pw = F.lds + 35840 + F.wave * 2304;
    LAS float* red = (LAS float*)(F.lds + 54272);
    int lane = F.lane; asm volatile("" : "+v"(lane)); const int wid = F.wave, fr = lane & 15, fq = lane >> 4;
    const size_t rowbase = (size_t)b * SEQ;
    const int q0 = qb * 128, trow = q0 + 16 * wid + fr;
    bf16x8 qf[4];
    { const bf16_t* qp = P + pidx(rowbase + trow, C_SQ + h * 128) + 8 * fq;
#pragma unroll
      for (int s = 0; s < 4; ++s) qf[s] = *(const GAS bf16x8*)(qp + 32 * s); }
    f32x4 o[8];
#pragma unroll
    for (int i = 0; i < 8; ++i) o[i] = (f32x4){0.f, 0.f, 0.f, 0.f};
    float R = 0.f;
    u32x4 kvr[2], vvr[2];
#pragma unroll
    for (int i = 0; i < 2; ++i) { const int idx = F.tid + NTHR * i, key = idx >> 4, c8 = idx & 15; const size_t krow = rowbase + 64 * (2 * qb + 1) + key;
        kvr[i] = *(const GAS u32x4*)(P + pidx(krow, C_SK + h * 128) + 8 * c8); vvr[i] = *(const GAS u32x4*)(P + pidx(krow, C_SV + h * 128) + 8 * c8); }
    for (int kt = 2 * qb + 1; kt >= 0; --kt) {
        lds_barrier();
#pragma unroll
        for (int i = 0; i < 2; ++i) { const int idx = F.tid + NTHR * i, key = idx >> 4, c8 = idx & 15;
            const u32x4 kv = kvr[i], vv = vvr[i];
            *(LAS u32x4*)(Ks + key * 272 + c8 * 16) = kv;
            LAS bf16_t* vd = (LAS bf16_t*)(Vt + (8 * c8) * 144 + key * 2);
            vd[0 * 72] = (bf16_t)(vv.x & 0xffff); vd[1 * 72] = (bf16_t)(vv.x >> 16); vd[2 * 72] = (bf16_t)(vv.y & 0xffff); vd[3 * 72] = (bf16_t)(vv.y >> 16);
            vd[4 * 72] = (bf16_t)(vv.z & 0xffff); vd[5 * 72] = (bf16_t)(vv.z >> 16); vd[6 * 72] = (bf16_t)(vv.w & 0xffff); vd[7 * 72] = (bf16_t)(vv.w >> 16); }
        if (kt > 0) {
#pragma unroll
            for (int i = 0; i < 2; ++i) { const int idx = F.tid + NTHR * i, key = idx >> 4, c8 = idx & 15; const size_t krow = rowbase + 64 * (kt - 1) + key;
                kvr[i] = *(const GAS u32x4*)(P + pidx(krow, C_SK + h * 128) + 8 * c8); vvr[i] = *(const GAS u32x4*)(P + pidx(krow, C_SV + h * 128) + 8 * c8); } }
        lds_barrier();
        if (64 * kt < q0 + 16 * wid + 15) {
            f32x4 sc[4];
#pragma unroll
            for (int j = 0; j < 4; ++j) { sc[j] = (f32x4){0.f, 0.f, 0.f, 0.f};
#pragma unroll
                for (int s = 0; s < 4; ++s) sc[j] = mfma16(ldsfrag(Ks + (16 * j + fr) * 272 + (32 * s + 8 * fq) * 2), qf[s], sc[j]); }
            float lk[4][4], lb[4][4], Tj[4], Wj[4], Gj[4];
#pragma unroll
            for (int j = 0; j < 4; ++j) { float t = 0.f;
#pragma unroll
                for (int i = 0; i < 4; ++i) { const float z = sc[j][i] * 0.08838834764831845f; const int key = 64 * kt + 16 * j + 4 * fq + i; const bool vis = key < trow;
                    const float e = __expf(-fabsf(z)); const float sp = fmaxf(z, 0.f) + __logf(1.0f + e);
                    lk[j][i] = vis ? -sp : 0.f; lb[j][i] = vis ? (z - sp) : -1e30f; t += lk[j][i]; }
                Tj[j] = t; }
#pragma unroll
            for (int j = 0; j < 4; ++j) { const float a1 = __shfl_xor(Tj[j], 16), a2 = __shfl_xor(Tj[j], 32), a3 = __shfl_xor(Tj[j], 48);
                Wj[j] = Tj[j] + a1 + a2 + a3;
                Gj[j] = (((fq ^ 1) > fq) ? a1 : 0.f) + (((fq ^ 2) > fq) ? a2 : 0.f) + (((fq ^ 3) > fq) ? a3 : 0.f); }
            float suf = 0.f;
#pragma unroll
            for (int j = 3; j >= 0; --j) { float tl = R + suf + Gj[j]; f32x4 w;
                w[3] = __expf(lb[j][3] + tl); tl += lk[j][3];
                w[2] = __expf(lb[j][2] + tl); tl += lk[j][2];
                w[1] = __expf(lb[j][1] + tl); tl += lk[j][1];
                w[0] = __expf(lb[j][0] + tl);
                *(LAS u32x2*)(Pw + fr * 144 + (16 * j + 4 * fq) * 2) = pack4(w);
                suf += Wj[j]; }
            R += suf;
#pragma unroll
            for (int ks = 0; ks < 2; ++ks) { const bf16x8 pf = ldsfrag(Pw + fr * 144 + (32 * ks + 8 * fq) * 2);
#pragma unroll
                for (int dt = 0; dt < 8; ++dt) o[dt] = mfma16(ldsfrag(Vt + (16 * dt + fr) * 144 + (32 * ks + 8 * fq) * 2), pf, o[dt]); }
        }
        const float rm = wave_max(R);
        if (lane == 0) red[wid] = rm;
        lds_barrier();
        float mx = red[0];
#pragma unroll
        for (int w = 1; w < 8; ++w) mx = fmaxf(mx, red[w]);
        if (mx < -120.f) break;
    }
    bf16_t* op = P + pidx(rowbase + trow, C_SQ + h * 128) + 4 * fq;
#pragma unroll
    for (int dt = 0; dt < 8; ++dt) *(GAS u32x2*)(op + 16 * dt) = pack4(o[dt]);
}

__device__ __forceinline__ void ret_kv_task(const Frame& F, const bf16_t* P, const f32x2* ROPE, bf16_t* RST, int b, int c, int h) {
    LAS unsigned char* KT = F.lds;
    LAS unsigned char* VT = F.lds + 18432;
    int lane = F.lane; asm volatile("" : "+v"(lane)); const int fr = lane & 15, fq = lane >> 4;
    const float l2g = log2gamma(h);
    lds_barrier();
    { const int s = F.tid >> 3, g8 = F.tid & 7; const size_t row = (size_t)b * SEQ + c * 64 + s; const int pos = c * 64 + s;
      const bf16_t* kp = P + pidx(row, C_RK + h * 128) + 8 * g8;
      const u32x4 k1 = *(const GAS u32x4*)kp, k2 = *(const GAS u32x4*)(kp + 64);
      float x1[8], x2[8]; unpack8(k1, x1); unpack8(k2, x2);
      const GAS f32x4* cp = (const GAS f32x4*)(ROPE + pos * 64 + 8 * g8);
      const float dec = __builtin_amdgcn_exp2f(l2g * (float)(63 - s)) * 0.08838834764831845f;
      LAS bf16_t* kd = (LAS bf16_t*)(KT + (8 * g8) * 144 + s * 2);
#pragma unroll
      for (int jj = 0; jj < 4; ++jj) { const f32x4 cs = cp[jj];
          { const int j = 2 * jj; const float y1 = (x1[j] * cs.x - x2[j] * cs.y) * dec, y2 = (x1[j] * cs.y + x2[j] * cs.x) * dec; kd[j * 72] = f2bf(y1); kd[(64 + j) * 72] = f2bf(y2); }
          { const int j = 2 * jj + 1; const float y1 = (x1[j] * cs.z - x2[j] * cs.w) * dec, y2 = (x1[j] * cs.w + x2[j] * cs.z) * dec; kd[j * 72] = f2bf(y1); kd[(64 + j) * 72] = f2bf(y2); } }
      const bf16_t* vp = P + pidx(row, C_RV + h * 128) + 16 * g8;
#pragma unroll
      for (int hh = 0; hh < 2; ++hh) { const u32x4 vv = *(const GAS u32x4*)(vp + 8 * hh);
          LAS bf16_t* vd = (LAS bf16_t*)(VT + (16 * g8 + 8 * hh) * 144 + s * 2);
          vd[0 * 72] = (bf16_t)(vv.x & 0xffff); vd[1 * 72] = (bf16_t)(vv.x >> 16); vd[2 * 72] = (bf16_t)(vv.y & 0xffff); vd[3 * 72] = (bf16_t)(vv.y >> 16);
          vd[4 * 72] = (bf16_t)(vv.z & 0xffff); vd[5 * 72] = (bf16_t)(vv.z >> 16); vd[6 * 72] = (bf16_t)(vv.w & 0xffff); vd[7 * 72] = (bf16_t)(vv.w >> 16); } }
    lds_barrier();
    const int w = F.wave;
    bf16x8 xf[2];
#pragma unroll
    for (int ks = 0; ks < 2; ++ks) xf[ks] = ldsfrag(KT + (16 * w + fr) * 144 + (32 * ks + 8 * fq) * 2);
    bf16_t* dst = RST + (size_t)((b * 128 + c) * 4 + h) * 16384;
#pragma unroll
    for (int et = 0; et < 8; ++et) { f32x4 acc = (f32x4){0.f, 0.f, 0.f, 0.f};
#pragma unroll
        for (int ks = 0; ks < 2; ++ks) acc = mfma16(xf[ks], ldsfrag(VT + (16 * et + fr) * 144 + (32 * ks + 8 * fq) * 2), acc);
        *(GAS u32x2*)(dst + (16 * et + fr) * 128 + 16 * w + 4 * fq) = pack4(acc); }
}

__device__ __forceinline__ void ret_out_task(const Frame& F, bf16_t* P, const f32x2* ROPE, const bf16_t* RST, const float* gn, int b, int c, int h, int xm = 0) {
    LAS unsigned char* Kr = F.lds;
    LAS unsigned char* VT = F.lds + 17408;
    LAS unsigned char* Sx = F.lds + 35840;
    LAS unsigned char* Pw = F.lds + 70656 + F.wave * 2304;
    LAS float* ssq = (LAS float*)(F.lds + 89088);
    int lane = F.lane; asm volatile("" : "+v"(lane)); const int fr = lane & 15, fq = lane >> 4, w = F.wave, lt = w & 3, eh = w >> 2;
    const float l2g = log2gamma(h);
    const int unit = (b * 128 + c) * 4 + h;
    lds_barrier();
    { const int s = F.tid >> 3, g8 = F.tid & 7; const size_t row = (size_t)b * SEQ + c * 64 + s; const int pos = c * 64 + s;
      const bf16_t* kp = P + pidx(row, C_RK + h * 128) + 8 * g8;
      const u32x4 k1 = *(const GAS u32x4*)kp, k2 = *(const GAS u32x4*)(kp + 64);
      float x1[8], x2[8], y1[8], y2[8]; unpack8(k1, x1); unpack8(k2, x2);
      const GAS f32x4* cp = (const GAS f32x4*)(ROPE + pos * 64 + 8 * g8);
#pragma unroll
      for (int jj = 0; jj < 4; ++jj) { const f32x4 cs = cp[jj];
          { const int j = 2 * jj; y1[j] = (x1[j] * cs.x - x2[j] * cs.y) * 0.08838834764831845f; y2[j] = (x1[j] * cs.y + x2[j] * cs.x) * 0.08838834764831845f; }
          { const int j = 2 * jj + 1; y1[j] = (x1[j] * cs.z - x2[j] * cs.w) * 0.08838834764831845f; y2[j] = (x1[j] * cs.w + x2[j] * cs.z) * 0.08838834764831845f; } }
      u32x4 o1, o2; o1.x = cvt_pk_bf16(y1[0], y1[1]); o1.y = cvt_pk_bf16(y1[2], y1[3]); o1.z = cvt_pk_bf16(y1[4], y1[5]); o1.w = cvt_pk_bf16(y1[6], y1[7]);
      o2.x = cvt_pk_bf16(y2[0], y2[1]); o2.y = cvt_pk_bf16(y2[2], y2[3]); o2.z = cvt_pk_bf16(y2[4], y2[5]); o2.w = cvt_pk_bf16(y2[6], y2[7]);
      *(LAS u32x4*)(Kr + s * 272 + (8 * g8) * 2) = o1; *(LAS u32x4*)(Kr + s * 272 + (64 + 8 * g8) * 2) = o2;
      const bf16_t* vp = P + pidx(row, C_RV + h * 128) + 16 * g8;
#pragma unroll
      for (int hh = 0; hh < 2; ++hh) { const u32x4 vv = *(const GAS u32x4*)(vp + 8 * hh);
          LAS bf16_t* vd = (LAS bf16_t*)(VT + (16 * g8 + 8 * hh) * 144 + s * 2);
          vd[0 * 72] = (bf16_t)(vv.x & 0xffff); vd[1 * 72] = (bf16_t)(vv.x >> 16); vd[2 * 72] = (bf16_t)(vv.y & 0xffff); vd[3 * 72] = (bf16_t)(vv.y >> 16);
          vd[4 * 72] = (bf16_t)(vv.z & 0xffff); vd[5 * 72] = (bf16_t)(vv.z >> 16); vd[6 * 72] = (bf16_t)(vv.w & 0xffff); vd[7 * 72] = (bf16_t)(vv.w >> 16); }
      const bf16_t* sp = RST + (size_t)unit * 16384;
#pragma unroll
      for (int i = 0; i < 4; ++i) { const int idx = F.tid + NTHR * i, e = idx >> 4, c16 = idx & 15;
          *(LAS u32x4*)(Sx + e * 272 + c16 * 16) = *(const GAS u32x4*)(sp + e * 128 + 8 * c16); } }
    const int l = 16 * lt + fr; const size_t qrow = (size_t)b * SEQ + c * 64 + l; const int qpos = c * 64 + l;
    bf16x8 qf[4];
    { const bf16_t* qp = P + pidx(qrow, C_RQ + h * 128) + 8 * fq;
      u32x4 qv[4];
#pragma unroll
      for (int s = 0; s < 4; ++s) qv[s] = *(const GAS u32x4*)(qp + 32 * s);
#pragma unroll
      for (int s = 0; s < 2; ++s) { float x1[8], x2[8], y1[8], y2[8]; unpack8(qv[s], x1); unpack8(qv[s + 2], x2);
          const GAS f32x4* cp = (const GAS f32x4*)(ROPE + qpos * 64 + 32 * s + 8 * fq);
#pragma unroll
          for (int jj = 0; jj < 4; ++jj) { const f32x4 cs = cp[jj];
              { const int j = 2 * jj; y1[j] = x1[j] * cs.x - x2[j] * cs.y; y2[j] = x1[j] * cs.y + x2[j] * cs.x; }
              { const int j = 2 * jj + 1; y1[j] = x1[j] * cs.z - x2[j] * cs.w; y2[j] = x1[j] * cs.w + x2[j] * cs.z; } }
          u32x4 o1, o2; o1.x = cvt_pk_bf16(y1[0], y1[1]); o1.y = cvt_pk_bf16(y1[2], y1[3]); o1.z = cvt_pk_bf16(y1[4], y1[5]); o1.w = cvt_pk_bf16(y1[6], y1[7]);
          o2.x = cvt_pk_bf16(y2[0], y2[1]); o2.y = cvt_pk_bf16(y2[2], y2[3]); o2.z = cvt_pk_bf16(y2[4], y2[5]); o2.w = cvt_pk_bf16(y2[6], y2[7]);
          qf[s] = __builtin_bit_cast(bf16x8, o1); qf[s + 2] = __builtin_bit_cast(bf16x8, o2); } }
    u32x2 gvr[4]; f32x4 ggr[4];
#pragma unroll
    for (int et = 0; et < 4; ++et) { const int e0 = 64 * eh + 16 * et + 4 * fq;
        gvr[et] = *(const GAS u32x2*)(P + pidx(qrow, C_RG + h * 128) + e0); ggr[et] = *(const GAS f32x4*)(gn + h * 128 + e0); }
    lds_barrier();
    if (xm == 1) return;
#pragma unroll
    for (int j = 0; j < 4; ++j) { f32x4 acc = (f32x4){0.f, 0.f, 0.f, 0.f};
#pragma unroll
        for (int ks = 0; ks < 4; ++ks) acc = mfma16(ldsfrag(Kr + (16 * j + fr) * 272 + (32 * ks + 8 * fq) * 2), qf[ks], acc);
#pragma unroll
        for (int i = 0; i < 4; ++i) { const int s = 16 * j + 4 * fq + i; acc[i] *= __builtin_amdgcn_exp2f(l2g * fabsf((float)(l - s))); }
        *(LAS u32x2*)(Pw + fr * 144 + (16 * j + 4 * fq) * 2) = pack4(acc); }
    f32x4 y[4];
    const float qdec = __builtin_amdgcn_exp2f(l2g * (float)(l + 1));
#pragma unroll
    for (int et = 0; et < 4; ++et) { y[et] = (f32x4){0.f, 0.f, 0.f, 0.f};
#pragma unroll
        for (int ks = 0; ks < 4; ++ks) y[et] = mfma16(ldsfrag(Sx + (64 * eh + 16 * et + fr) * 272 + (32 * ks + 8 * fq) * 2), qf[ks], y[et]);
        y[et] = y[et] * qdec; }
#pragma unroll
    for (int ks = 0; ks < 2; ++ks) { const bf16x8 pf = ldsfrag(Pw + fr * 144 + (32 * ks + 8 * fq) * 2);
#pragma unroll
        for (int et = 0; et < 4; ++et) y[et] = mfma16(ldsfrag(VT + (64 * eh + 16 * et + fr) * 144 + (32 * ks + 8 * fq) * 2), pf, y[et]); }
    float ss = 0.f;
#pragma unroll
    for (int et = 0; et < 4; ++et) ss += (y[et][0] * y[et][0] + y[et][1] * y[et][1]) + (y[et][2] * y[et][2] + y[et][3] * y[et][3]);
    ss += __shfl_xor(ss, 16); ss += __shfl_xor(ss, 32);
    if (fq == 0) ssq[w * 16 + fr] = ss;
    lds_barrier();
    const float rstd = rsqrtf((ssq[w * 16 + fr] + ssq[(w ^ 4) * 16 + fr]) * (1.f / 128.f) + EPS);
#pragma unroll
    for (int et = 0; et < 4; ++et) { const int e0 = 64 * eh + 16 * et + 4 * fq;
        const u32x2 gv = gvr[et]; const f32x4 gg = ggr[et];
        f32x4 r;
        r[0] = y[et][0] * rstd * gg[0] * silu_f(bf_lo(gv.x)); r[1] = y[et][1] * rstd * gg[1] * silu_f(bf_hi(gv.x));
        r[2] = y[et][2] * rstd * gg[2] * silu_f(bf_lo(gv.y)); r[3] = y[et][3] * rstd * gg[3] * silu_f(bf_hi(gv.y));
        *(GAS u32x2*)(P + pidx(qrow, C_RQ + h * 128) + e0) = pack4(r); }
}

__device__ __forceinline__ float softplus_f(float x) { return fmaxf(x, 0.f) + log1pf(__expf(-fabsf(x))); }
__device__ __forceinline__ void conv8(const bf16_t* P, const float* cw, const float* cb, int b, int tpos, int col, float* v) {
    const int chan = col - C_XBC;
    { const f32x4 b0 = *(const GAS f32x4*)(cb + chan), b1 = *(const GAS f32x4*)(cb + chan + 4);
      v[0] = b0.x; v[1] = b0.y; v[2] = b0.z; v[3] = b0.w; v[4] = b1.x; v[5] = b1.y; v[6] = b1.z; v[7] = b1.w; }
#pragma unroll
    for (int j = 0; j < 4; ++j) { const int ts = tpos - 3 + j;
        if (ts >= 0) { const u32x4 xv = *(const GAS u32x4*)(P + pidx((size_t)b * SEQ + ts, col)); float xf[8]; unpack8(xv, xf);
            const f32x4 w0 = *(const GAS f32x4*)(cw + j * 1024 + chan), w1 = *(const GAS f32x4*)(cw + j * 1024 + chan + 4);
            v[0] += xf[0] * w0.x; v[1] += xf[1] * w0.y; v[2] += xf[2] * w0.z; v[3] += xf[3] * w0.w; v[4] += xf[4] * w1.x; v[5] += xf[5] * w1.y; v[6] += xf[6] * w1.z; v[7] += xf[7] * w1.w; } }
#pragma unroll
    for (int i = 0; i < 8; ++i) v[i] = silu_f(v[i]);
}

template <bool TR, bool HASF>
__device__ __forceinline__ void conv_tile(const bf16_t* P, const float* cw, const float* cb, int b, int tpos0, int col, const float (&f)[8], u32x4 (&pk)[8]) {
    const int chan = col - C_XBC;
    float w[4][8], bias[8];
#pragma unroll
    for (int j = 0; j < 4; ++j) { const f32x4 w0 = *(const GAS f32x4*)(cw + j * 1024 + chan), w1 = *(const GAS f32x4*)(cw + j * 1024 + chan + 4);
        w[j][0] = w0.x; w[j][1] = w0.y; w[j][2] = w0.z; w[j][3] = w0.w; w[j][4] = w1.x; w[j][5] = w1.y; w[j][6] = w1.z; w[j][7] = w1.w; }
    { const f32x4 b0 = *(const GAS f32x4*)(cb + chan), b1 = *(const GAS f32x4*)(cb + chan + 4);
      bias[0] = b0.x; bias[1] = b0.y; bias[2] = b0.z; bias[3] = b0.w; bias[4] = b1.x; bias[5] = b1.y; bias[6] = b1.z; bias[7] = b1.w; }
    u32x4 rows[11];
    const bf16_t* base = P + pidx((size_t)b * SEQ + tpos0, col);
#pragma unroll
    for (int r = 0; r < 11; ++r) { rows[r] = (u32x4){0u, 0u, 0u, 0u}; if (tpos0 - 3 + r >= 0) rows[r] = *(const GAS u32x4*)(base + (long)(r - 3) * 128); }
    float prev[8];
#pragma unroll
    for (int t = 0; t < 8; ++t) {
        float a[8];
#pragma unroll
        for (int i = 0; i < 8; ++i) a[i] = bias[i];
#pragma unroll
        for (int j = 0; j < 4; ++j) { float xf[8]; unpack8(rows[t + j], xf);
#pragma unroll
            for (int i = 0; i < 8; ++i) a[i] += xf[i] * w[j][i]; }
#pragma unroll
        for (int i = 0; i < 8; ++i) { a[i] = silu_f(a[i]); if (HASF) a[i] *= f[t]; }
        if (TR) {
            if (t & 1) {
#pragma unroll
                for (int i = 0; i < 8; ++i) { const unsigned u = cvt_pk_bf16(prev[i], a[i]);
                    if ((t >> 1) == 0) pk[i].x = u; else if ((t >> 1) == 1) pk[i].y = u; else if ((t >> 1) == 2) pk[i].z = u; else pk[i].w = u; }
            } else {
#pragma unroll
                for (int i = 0; i < 8; ++i) prev[i] = a[i];
            }
        } else {
            pk[t].x = cvt_pk_bf16(a[0], a[1]); pk[t].y = cvt_pk_bf16(a[2], a[3]); pk[t].z = cvt_pk_bf16(a[4], a[5]); pk[t].w = cvt_pk_bf16(a[6], a[7]);
        }
    }
}
__device__ __forceinline__ float dt_scan(const float* DT, const float* dt_bias, const float* a_log, int b, int c, int hd, int lane, float& dtv) {
    const size_t t = (size_t)b * SEQ + c * 64 + lane;
    dtv = softplus_f(((const GAS float*)DT)[t * 8 + hd] + ((const GAS float*)dt_bias)[hd]);
    float x = dtv * (-__expf(((const GAS float*)a_log)[hd]));
#pragma unroll
    for (int o = 1; o < 64; o <<= 1) { const float y = __shfl_up(x, o); if (lane >= o) x += y; }
    return x;
}

__device__ __forceinline__ void ssd_state_task(const Frame& F, const bf16_t* P, const float* DT, const float* cw, const float* cb, const float* dt_bias, const float* a_log,
                                               bf16_t* SST, float* CD, int b, int c, int g) {
    LAS unsigned char* XT = F.lds;
    LAS unsigned char* BT = F.lds + 36864;
    LAS float* dtl = (LAS float*)(F.lds + 55296);
    LAS float* acl = (LAS float*)(F.lds + 56320);
    int lane = F.lane; asm volatile("" : "+v"(lane)); const int fr = lane & 15, fq = lane >> 4, w = F.wave;
    lds_barrier();
    if (w < 4) { float dtv; const float cum = dt_scan(DT, dt_bias, a_log, b, c, 4 * g + w, lane, dtv);
        dtl[lane * 4 + w] = dtv; acl[lane * 4 + w] = cum;
        if (lane == 63) ((GAS float*)CD)[(b * 128 + c) * 8 + 4 * g + w] = __expf(cum); }
    lds_barrier();
    if (F.tid < 384) { int tt = F.tid; asm volatile("" : "+v"(tt)); const int cgi = tt % 48, seg = tt / 48, s0 = 8 * seg;
        const int col = (cgi < 32) ? (C_XBC + g * 256 + 8 * cgi) : (C_XBC + 512 + g * 128 + 8 * (cgi - 32));
        float f[8]; u32x4 pk[8];
        if (cgi < 32) { const int hl = cgi >> 3; const float ae = acl[63 * 4 + hl];
#pragma unroll
            for (int t = 0; t < 8; ++t) f[t] = dtl[(s0 + t) * 4 + hl] * __expf(ae - acl[(s0 + t) * 4 + hl]); }
        else {
#pragma unroll
            for (int t = 0; t < 8; ++t) f[t] = 1.0f; }
        conv_tile<true, true>(P, cw, cb, b, c * 64 + s0, col, f, pk);
        LAS unsigned char* d = (cgi < 32) ? (XT + (8 * cgi) * 144 + s0 * 2) : (BT + (8 * (cgi - 32)) * 144 + s0 * 2);
#pragma unroll
        for (int i = 0; i < 8; ++i) *(LAS u32x4*)(d + i * 144) = pk[i]; }
    lds_barrier();
    const int hl = w >> 1, ph = w & 1;
    bf16x8 yf[2][2];
#pragma unroll
    for (int pt = 0; pt < 2; ++pt)
#pragma unroll
        for (int ks = 0; ks < 2; ++ks) yf[pt][ks] = ldsfrag(XT + (hl * 64 + ph * 32 + 16 * pt + fr) * 144 + (32 * ks + 8 * fq) * 2);
    bf16_t* dst = SST + (size_t)((b * 128 + c) * 8 + 4 * g + hl) * 8192;
#pragma unroll
    for (int nt = 0; nt < 8; ++nt) { f32x4 a0 = (f32x4){0.f, 0.f, 0.f, 0.f}, a1 = a0;
#pragma unroll
        for (int ks = 0; ks < 2; ++ks) { const bf16x8 xf = ldsfrag(BT + (16 * nt + fr) * 144 + (32 * ks + 8 * fq) * 2); a0 = mfma16(xf, yf[0][ks], a0); a1 = mfma16(xf, yf[1][ks], a1); }
#ifdef PROBE_CONST
        a0 = (f32x4){0.01f, 0.02f, 0.03f, 0.04f}; a1 = a0;
#endif
        *(GAS u32x2*)(dst + (ph * 32 + fr) * 128 + 16 * nt + 4 * fq) = pack4(a0);
        *(GAS u32x2*)(dst + (ph * 32 + 16 + fr) * 128 + 16 * nt + 4 * fq) = pack4(a1); }
}

__device__ __forceinline__ void ssd_out_task(const Frame& F, bf16_t* P, const float* DT, const float* cw, const float* cb, const float* dt_bias, const float* a_log,
                                             const float* d_skip, const float* nrm, const bf16_t* SST, int b, int c) {
    LAS unsigned char* Bs = F.lds;
    LAS unsigned char* Cs = F.lds + 17408;
    LAS unsigned char* XT = F.lds + 34816;
    LAS unsigned char* Pw = F.lds + 71680 + F.wave * 2304;
    LAS float* dtl = (LAS float*)(F.lds + 90112);
    LAS float* acl = (LAS float*)(F.lds + 92160);
    LAS float* ssq = (LAS float*)(F.lds + 94208);
    int lane = F.lane; asm volatile("" : "+v"(lane)); const int fr = lane & 15, fq = lane >> 4, w = F.wave, hl = w >> 1, half = w & 1;
    lds_barrier();
    { float dtv; const float cum = dt_scan(DT, dt_bias, a_log, b, c, w, lane, dtv); dtl[lane * 8 + w] = dtv; acl[lane * 8 + w] = cum; }
    float ssl[2] = {0.f, 0.f};
#pragma unroll 1
    for (int g = 0; g < 2; ++g) {
        const int head = 4 * g + hl;
        const bf16_t* hsrc = SST + (size_t)((b * 128 + c) * 8 + head) * 8192;
        bf16x8 hfr[4][4];
#pragma unroll
        for (int ks = 0; ks < 4; ++ks)
#pragma unroll
            for (int pt = 0; pt < 4; ++pt) hfr[ks][pt] = *(const GAS bf16x8*)(hsrc + (16 * pt + fr) * 128 + 32 * ks + 8 * fq);
        lds_barrier();
        { int tt = F.tid; asm volatile("" : "+v"(tt)); const int cgi = tt & 63, seg = tt >> 6, s0 = 8 * seg;
            const int col = (cgi < 32) ? (C_XBC + g * 256 + 8 * cgi) : (cgi < 48) ? (C_XBC + 512 + g * 128 + 8 * (cgi - 32)) : (C_XBC + 768 + g * 128 + 8 * (cgi - 48));
            const float f[8] = {1.f, 1.f, 1.f, 1.f, 1.f, 1.f, 1.f, 1.f}; u32x4 pk[8];
            if (cgi < 32) { conv_tile<true, false>(P, cw, cb, b, c * 64 + s0, col, f, pk);
                LAS unsigned char* d = XT + (8 * cgi) * 144 + s0 * 2;
#pragma unroll
                for (int i = 0; i < 8; ++i) *(LAS u32x4*)(d + i * 144) = pk[i]; }
            else { conv_tile<false, false>(P, cw, cb, b, c * 64 + s0, col, f, pk);
                LAS unsigned char* d = ((cgi < 48) ? (Bs + (8 * (cgi - 32)) * 2) : (Cs + (8 * (cgi - 48)) * 2)) + s0 * 272;
#pragma unroll
                for (int i = 0; i < 8; ++i) *(LAS u32x4*)(d + i * 272) = pk[i]; } }
        u32x2 zvr[2][4];
#pragma unroll
        for (int li = 0; li < 2; ++li)
#pragma unroll
            for (int pt = 0; pt < 4; ++pt) zvr[li][pt] = *(const GAS u32x2*)(P + pidx((size_t)b * SEQ + c * 64 + 16 * (2 * half + li) + fr, C_MZ + head * 64 + 16 * pt + 4 * fq));
        lds_barrier();
        const float dsk = ((const GAS float*)d_skip)[head];
#pragma unroll
        for (int li = 0; li < 2; ++li) {
            asm volatile("" ::: "memory"); __builtin_amdgcn_sched_barrier(0);
            const int lt = 2 * half + li, l = 16 * lt + fr;
            const float al = acl[l * 8 + head];
            bf16x8 cf[4];
#pragma unroll
            for (int ks = 0; ks < 4; ++ks) cf[ks] = ldsfrag(Cs + (16 * lt + fr) * 272 + (32 * ks + 8 * fq) * 2);
            f32x4 y[4];
#pragma unroll
            for (int pt = 0; pt < 4; ++pt) y[pt] = (f32x4){0.f, 0.f, 0.f, 0.f};
#pragma unroll
            for (int ks = 0; ks < 4; ++ks) {
#pragma unroll
                for (int pt = 0; pt < 4; ++pt) y[pt] = mfma16(hfr[ks][pt], cf[ks], y[pt]); }
            { const float eal = __expf(al);
#pragma unroll
              for (int pt = 0; pt < 4; ++pt) y[pt] = y[pt] * eal; }
#pragma unroll
            for (int st = 0; st < 4; ++st) { f32x4 acc = (f32x4){0.f, 0.f, 0.f, 0.f};
#pragma unroll
                for (int ks = 0; ks < 4; ++ks) acc = mfma16(ldsfrag(Bs + (16 * st + fr) * 272 + (32 * ks + 8 * fq) * 2), cf[ks], acc);
#pragma unroll
                for (int i = 0; i < 4; ++i) { const int s = 16 * st + 4 * fq + i;
                    acc[i] = (s <= l) ? acc[i] * __expf(al - acl[s * 8 + head]) * dtl[s * 8 + head] : 0.f; }
                *(LAS u32x2*)(Pw + fr * 144 + (16 * st + 4 * fq) * 2) = pack4(acc); }
#pragma unroll
            for (int ks = 0; ks < 2; ++ks) { if (2 * ks <= lt) { const bf16x8 pf = ldsfrag(Pw + fr * 144 + (32 * ks + 8 * fq) * 2);
#pragma unroll
                for (int pt = 0; pt < 4; ++pt) y[pt] = mfma16(ldsfrag(XT + (hl * 64 + 16 * pt + fr) * 144 + (32 * ks + 8 * fq) * 2), pf, y[pt]); } }
            const size_t row = (size_t)b * SEQ + c * 64 + l;
#pragma unroll
            for (int pt = 0; pt < 4; ++pt) { const int p0 = 16 * pt + 4 * fq;
                const u32x2 zv = zvr[li][pt];
                const LAS bf16_t* xp = (const LAS bf16_t*)(XT + (hl * 64 + p0) * 144 + l * 2);
                f32x4 r;
                r[0] = (y[pt][0] + bf2f(xp[0 * 72]) * dsk) * silu_f(bf_lo(zv.x)); r[1] = (y[pt][1] + bf2f(xp[1 * 72]) * dsk) * silu_f(bf_hi(zv.x));
                r[2] = (y[pt][2] + bf2f(xp[2 * 72]) * dsk) * silu_f(bf_lo(zv.y)); r[3] = (y[pt][3] + bf2f(xp[3 * 72]) * dsk) * silu_f(bf_hi(zv.y));
                ssl[li] += (r[0] * r[0] + r[1] * r[1]) + (r[2] * r[2] + r[3] * r[3]);
                *(GAS u32x2*)(P + pidx(row, C_MZ + head * 64 + p0)) = pack4(r); }
        }
    }
#pragma unroll
    for (int li = 0; li < 2; ++li) { float ss = ssl[li];
        ss += __shfl_xor(ss, 16); ss += __shfl_xor(ss, 32);
        if (fq == 0) ssq[hl * 64 + 16 * (2 * half + li) + fr] = ss; }
    asm volatile("s_waitcnt vmcnt(0)" ::: "memory");
    lds_barrier();
#pragma unroll
    for (int li = 0; li < 2; ++li) { const int l = 16 * (2 * half + li) + fr;
        const float rstd = rsqrtf((ssq[l] + ssq[64 + l] + ssq[128 + l] + ssq[192 + l]) * (1.f / 512.f) + EPS);
        const size_t row = (size_t)b * SEQ + c * 64 + l;
#pragma unroll 1
        for (int g = 0; g < 2; ++g)
#pragma unroll
            for (int pt = 0; pt < 4; ++pt) { const int ch = (4 * g + hl) * 64 + 16 * pt + 4 * fq;
                const f32x4 ng = *(const GAS f32x4*)(nrm + ch);
                GAS u32x2* yp = (GAS u32x2*)(P + pidx(row, C_MZ + ch));
                const u32x2 pk = *yp; const f32x4 r = (f32x4){bf_lo(pk.x), bf_hi(pk.x), bf_lo(pk.y), bf_hi(pk.y)};
                *yp = pack4(r * rstd * ng); } }
}

__device__ __forceinline__ void scan_phase(const Frame& F, bf16_t* RST, bf16_t* SST, const float* CD) {
    for (int task = F.bid * NTHR + F.tid; task < 131072; task += F.G * NTHR) {
        {
          const int pr = task & 8191, bh = task >> 13, b = bh >> 2, h = bh & 3;
          GAS unsigned* p = (GAS unsigned*)(RST + (size_t)((b * 128) * 4 + h) * 16384) + pr;
          const float dec = __builtin_amdgcn_exp2f(64.f * log2gamma(h));
          float s0 = 0.f, s1 = 0.f;
#pragma unroll 1
          for (int c0 = 0; c0 < 128; c0 += 32) { unsigned v[32];
#pragma unroll
              for (int i = 0; i < 32; ++i) v[i] = p[(size_t)(c0 + i) * 32768];
#pragma unroll
              for (int i = 0; i < 32; ++i) { p[(size_t)(c0 + i) * 32768] = cvt_pk_bf16(s0, s1); s0 = s0 * dec + bf_lo(v[i]); s1 = s1 * dec + bf_hi(v[i]); } } }
        {
          const int pr = task & 4095, bh = task >> 12, b = bh >> 3, hd = bh & 7;
          GAS unsigned* p = (GAS unsigned*)(SST + (size_t)((b * 128) * 8 + hd) * 8192) + pr;
          const GAS float* cd = (const GAS float*)(CD + (b * 128) * 8 + hd);
          float s0 = 0.f, s1 = 0.f;
#pragma unroll 1
          for (int c0 = 0; c0 < 128; c0 += 32) { unsigned v[32]; float d[32];
#pragma unroll
              for (int i = 0; i < 32; ++i) { v[i] = p[(size_t)(c0 + i) * 32768]; d[i] = cd[(c0 + i) * 8]; }
#pragma unroll
              for (int i = 0; i < 32; ++i) { p[(size_t)(c0 + i) * 32768] = cvt_pk_bf16(s0, s1); s0 = s0 * d[i] + bf_lo(v[i]); s1 = s1 * d[i] + bf_hi(v[i]); } } }
    }
}


#define XB_TMO      128
#define XB_XCNT(j)  (256  + 64 * (j))
#define XB_XSUB(j)  (1280 + 64 * (j))
#define XB_XGEN(j)  (2304 + 64 * (j))
#define XB_TOP      3328
#define XB_TOPGEN   3392
#define XB_SPIN_CAP (1u << 22)
__device__ __forceinline__ unsigned xb_ld(unsigned* p)              { return __hip_atomic_load(p, __ATOMIC_RELAXED, __HIP_MEMORY_SCOPE_AGENT); }
__device__ __forceinline__ unsigned xb_add(unsigned* p, unsigned v) { return __hip_atomic_fetch_add(p, v, __ATOMIC_RELAXED, __HIP_MEMORY_SCOPE_AGENT); }
__device__ __forceinline__ unsigned xb_xcc_id() { return (unsigned)__builtin_amdgcn_s_getreg((3 << 11) | 20) & 0xFu; }
#define XB_SPIN(cond, bar) do { unsigned _sp = 0; while (cond) { __builtin_amdgcn_s_sleep(1); \
    if ((++_sp & 255u) == 0u) { if (xb_ld(&(bar)[XB_TMO])) break; if (_sp > XB_SPIN_CAP) { atomicAdd(&(bar)[XB_TMO], 1u); break; } } } } while (0)
struct XcdBarrier { unsigned* bar; unsigned x; volatile LAS unsigned* st; };
__device__ __forceinline__ XcdBarrier xcd_barrier_post(unsigned* bar, volatile LAS unsigned* st) {
    XcdBarrier b; b.bar = bar; b.x = xb_xcc_id(); b.st = st;
    if (threadIdx.x == 0) (void)xb_add(&bar[XB_XCNT(b.x)], 1u);
    return b;
}
__device__ __forceinline__ void xcd_barrier_complete(unsigned* bar, unsigned x, unsigned& nloc, unsigned& nx) {
    const unsigned G = gridDim.x * gridDim.y * gridDim.z;
    unsigned sum, cnt, mine, sp = 0u;
    for (;;) {
        sum = 0u; cnt = 0u; mine = 0u;
#pragma unroll
        for (unsigned j = 0; j < 16; ++j) { const unsigned c = xb_ld(&bar[XB_XCNT(j)]); sum += c; cnt += (c > 0u) ? 1u : 0u; mine = (j == x) ? c : mine; }
        if (sum == G) break;
        __builtin_amdgcn_s_sleep(1);
        if ((++sp & 255u) == 0u) { if (xb_ld(&bar[XB_TMO])) break; if (sp > XB_SPIN_CAP) { atomicAdd(&bar[XB_TMO], 1u); break; } }
    }
    nloc = mine > 0u ? mine : 1u; nx = cnt > 0u ? cnt : 1u;
}
__device__ __forceinline__ void xcd_barrier(const XcdBarrier& b) {
    asm volatile("s_waitcnt vmcnt(0)" ::: "memory");
    __syncthreads();
    if (threadIdx.x == 0) {
        unsigned* bar = b.bar;
        __builtin_amdgcn_s_waitcnt(0);
        unsigned nloc = b.st[0], nx = b.st[1];
        if (nloc == 0u) { xcd_barrier_complete(bar, b.x, nloc, nx); b.st[0] = nloc; b.st[1] = nx; }
        const unsigned old = xb_add(&bar[XB_XSUB(b.x)], 1u);
        const unsigned gen = old / nloc;
        if (old + 1u == (gen + 1u) * nloc) {
            __builtin_amdgcn_fence(__ATOMIC_RELEASE, "agent");
            asm volatile("s_waitcnt vmcnt(0)" ::: "memory");
            const unsigned og = xb_add(&bar[XB_TOP], 1u);
            const unsigned tg = og / nx;
            if (og + 1u == (tg + 1u) * nx) xb_add(&bar[XB_TOPGEN], 1u);
            else XB_SPIN(xb_ld(&bar[XB_TOPGEN]) == tg, bar);
            __builtin_amdgcn_fence(__ATOMIC_ACQUIRE, "agent");
            xb_add(&bar[XB_XGEN(b.x)], 1u);
            asm volatile("s_waitcnt vmcnt(0)" ::: "memory");
        } else {
            XB_SPIN(xb_ld(&bar[XB_XGEN(b.x)]) == gen, bar);
            __builtin_amdgcn_fence(__ATOMIC_ACQUIRE, "agent");
            asm volatile("s_waitcnt vmcnt(0)" ::: "memory");
        }
    }
    __syncthreads();
}

constexpr int NPH = 26;
__global__ void __launch_bounds__(NTHR, 2) fwd_kernel(Params p) {
    extern __shared__ __attribute__((aligned(16))) unsigned char lds_raw[];
    volatile LAS unsigned* xb_st = (volatile LAS unsigned*)((LAS unsigned char*)lds_raw + LDS_BYTES - 64);
    if (threadIdx.x == 0) { xb_st[0] = 0u; xb_st[1] = 0u; }
    __syncthreads();
    const XcdBarrier xbar = xcd_barrier_post((unsigned*)p.ws, xb_st);
    if (p.ph_lo == 0) {
        Frame F0; F0.lds = (LAS unsigned char*)lds_raw; F0.tid = threadIdx.x; F0.lane = F0.tid & 63; F0.wave = __builtin_amdgcn_readfirstlane(F0.tid >> 6); F0.G = gridDim.x; F0.bid = blockIdx.x;
        if (EN_PRO) prologue(F0, p, as_global(p.ws), 0);
        if (p.ph_hi > 1) cg::this_grid().sync();
    }
#ifdef TPROBE
    unsigned long long tA = 0, tB = 0;
#endif
    for (int ph_ = (p.ph_lo < 1 ? 1 : p.ph_lo); ph_ < p.ph_hi; ++ph_) {
#ifdef TPROBE
    const unsigned long long tp0 = __builtin_amdgcn_s_memrealtime();
#endif
    int ph = __builtin_amdgcn_readfirstlane(ph_);
#ifdef PH_LIMIT
    if (ph > PH_LIMIT && ph < NPH - 1) continue;
#endif
    int tid_ = threadIdx.x; asm volatile("" : "+v"(tid_));
    unsigned char* ws_ = p.ws; asm volatile("" : "+s"(ws_)); unsigned char* ws = as_global(ws_);
    int zi = 0; asm volatile("" : "+s"(zi));
    Frame F;
    F.lds = (LAS unsigned char*)lds_raw;
    F.tid = tid_; F.lane = F.tid & 63; F.wave = __builtin_amdgcn_readfirstlane(F.tid >> 6); { int g_ = gridDim.x, b_ = blockIdx.x; asm volatile("" : "+s"(g_), "+s"(b_)); F.G = g_; F.bid = b_; }
    float* MOD = (float*)(ws + WS_MOD);
    const f32x2* ROPE = (const f32x2*)(ws + WS_ROPE);
    float* DT = (float*)(ws + WS_DT);
    float* CD = (float*)(ws + WS_CD);
    bf16_t* WFU = (bf16_t*)(ws + WS_WFU); bf16_t* WFD = (bf16_t*)(ws + WS_WFD); bf16_t* WIN = (bf16_t*)(ws + WS_WIN); bf16_t* WOUT = (bf16_t*)(ws + WS_WOUT);
    bf16_t* U = (bf16_t*)(ws + WS_U); bf16_t* RST = (bf16_t*)(ws + WS_RST); bf16_t* SST = (bf16_t*)(ws + WS_SST);
    bf16_t* PROJ = (bf16_t*)(ws + WS_PROJ); bf16_t* HID = PROJ;
    float* hbuf_ = p.out; asm volatile("" : "+s"(hbuf_)); float* hbuf = as_global(hbuf_);
        if (ph == NPH - 1) {
            if (EN_FIN) final_phase(F, hbuf, as_global(p.in[24 + zi]), MOD + FMOD_OFF);
        } else {
#ifdef XTRA_LIST
            static constexpr int xtra[] = XTRA_LIST;
            const int l = (ph >= NPH) ? 1 : (ph - 1) / 12, j = (ph >= NPH) ? xtra[ph - NPH] : (ph - 1) % 12;
#else
            const int l = (ph - 1) / 12, j = (ph - 1) % 12;
#endif
            const float* modl = MOD + (size_t)l * 4 * 9216;
            if (j == 0 || j == 3 || j == 9) {
                const float* hin = (l == 0 && j == 0) ? as_global(p.in[0 + zi]) : hbuf;
                const int gi = (j == 0) ? 4 : (j == 3) ? 8 : 18;
                const int mi = (j == 0) ? 0 : (j == 3) ? 3 : 6;
                if (EN_NORM) norm_phase(F, hin, as_global(p.in[gi + zi]) + l * DM, modl + mi * 1024, modl + (mi + 1) * 1024, 9216, U);
                __syncthreads();
                if (!EN_CONV) {} else if (j == 0) convert_ffn(F, as_global(p.in[5 + zi]) + (size_t)l * DM * DFF, as_global(p.in[6 + zi]) + (size_t)l * DM * DFF, as_global(p.in[7 + zi]) + (size_t)l * DM * DFF, WFU, WFD);
                else if (j == 9) convert_ffn(F, as_global(p.in[19 + zi]) + (size_t)l * DM * DFF, as_global(p.in[20 + zi]) + (size_t)l * DM * DFF, as_global(p.in[21 + zi]) + (size_t)l * DM * DFF, WFU, WFD);
                else convert_mix(F, as_global(p.in[9 + zi]) + (size_t)l * DM * INW, as_global(p.in[17 + zi]) + (size_t)l * 1536 * DM, WIN, WOUT);
            } else if (j == 1 || j == 10) {
                pg8::Gemm g{U, WFU, T_TOK, 2 * DFF, DM, DM}; pg8::StaticOrder S; S.init(T_TOK, 2 * DFF, F.G, F.bid);
                pg8::EpiSwiGLU E{HID, DFF};
                if (EN_G1) pg8::gemm_phase<pg8::EpiSwiGLU>(F.lds, F.tid, g, S, E);
            } else if (j == 2 || j == 11 || j == 8) {
                pg8::Gemm g; pg8::EpiResid E;
                if (j == 8) { g = pg8::Gemm{PROJ, WOUT, T_TOK, DM, 1536, PW}; E = pg8::EpiResid{hbuf, hbuf, modl + 5 * 1024, 1.0f}; }
                else { g = pg8::Gemm{HID, WFD, T_TOK, DM, DFF, DFF}; E = pg8::EpiResid{(l == 0 && j == 2) ? as_global(p.in[0 + zi]) : hbuf, hbuf, modl + (j == 2 ? 2 : 8) * 1024, 0.5f}; }
                pg8::StaticOrder S; S.init(T_TOK, DM, F.G, F.bid);
                if (EN_G2) { if (j == 8) pg8::gemm_phase<pg8::EpiResid, true>(F.lds, F.tid, g, S, E); else pg8::gemm_phase<pg8::EpiResid, false>(F.lds, F.tid, g, S, E); }
            } else if (j == 4) {
                pg8::Gemm g{U, WIN, T_TOK, PW, DM, DM}; pg8::StaticOrder S; S.init(T_TOK, PW, F.G, F.bid);
                pg8::EpiBf16 E{PROJ, PW};
                if (EN_G3) pg8::gemm_phase<pg8::EpiBf16>(F.lds, F.tid, g, S, E);
                if (EN_DT) dt_gemv(F, U, as_global(p.in[9 + zi]) + (size_t)l * DM * INW, DT);
            } else if (j == 5) {
                if (EN_SB && XS(1)) for (int t = F.bid; t < 1024; t += F.G) { const int qb = 63 - (t >> 4), bh = t & 15; sb_task(F, PROJ, bh >> 2, bh & 3, qb); }
                if (EN_RKV && XS(2)) for (int t = F.bid; t < 2048; t += F.G) { const int h = t & 3, bc = t >> 2; ret_kv_task(F, PROJ, ROPE, RST, bc >> 7, bc & 127, h); }
                if (EN_SST && XS(4)) for (int t = F.bid; t < 1024; t += F.G) { const int g = t & 1, bc = t >> 1;
                    ssd_state_task(F, PROJ, DT, as_global(p.in[10 + zi]) + l * 4096, as_global(p.in[11 + zi]) + l * 1024, as_global(p.in[12 + zi]) + l * 8, as_global(p.in[13 + zi]) + l * 8, SST, CD, bc >> 7, bc & 127, g); }
            } else if (j == 6) {
                if (EN_SCAN) scan_phase(F, RST, SST, CD);
            } else if (j == 7) {
                if (EN_ROUT && XS(8)) for (int t = F.bid; t < 2048; t += F.G) { const int h = t & 3, bc = t >> 2; ret_out_task(F, PROJ, ROPE, RST, as_global(p.in[15 + zi]) + l * 512, bc >> 7, bc & 127, h, ph >= NPH ? XMODE : 0); }
                if (EN_SOUT && XS(16)) for (int t = F.bid; t < 512; t += F.G) {
                    ssd_out_task(F, PROJ, DT, as_global(p.in[10 + zi]) + l * 4096, as_global(p.in[11 + zi]) + l * 1024, as_global(p.in[12 + zi]) + l * 8, as_global(p.in[13 + zi]) + l * 8, as_global(p.in[14 + zi]) + l * 8, as_global(p.in[16 + zi]) + l * 512, SST, t >> 7, t & 127); }
            }
        }
        if (ph + 1 < p.ph_hi) { xcd_barrier(xbar); }
#ifdef TPROBE
        { const unsigned long long tp1 = __builtin_amdgcn_s_memrealtime(); const int jj = (ph - 1) % 12;
          if (ph < NPH - 1) { if (TPROBE_A(jj)) tA += tp1 - tp0; if (TPROBE_B(jj)) tB += tp1 - tp0; } }
#endif
    }
#ifdef TPROBE
    cg::this_grid().sync();
    if (blockIdx.x == 0) { const float a = (float)tA * 0.01f, b = (float)tB * 0.01f * TPROBE_BS;
        if (threadIdx.x == 0) p.out[0] += a;
        for (int i = threadIdx.x; i < (1 << 20); i += NTHR) p.out[1024 + i] += b; }
#endif
}

extern "C" void kernel_launch(void* const* d_in, const int* in_sizes, int n_in, void* d_out, int out_size, void* d_ws, size_t ws_size, hipStream_t stream) {
    static int grid = 0;
    if (grid == 0) {
        if (n_in != 25 || out_size != T_TOK * DM || ws_size < WS_END) { fprintf(stderr, "kernel_launch: unexpected shapes (n_in %d out %d ws %zu)\n", n_in, out_size, ws_size); grid = -1; return; }
        int dev = 0, cus = 0, per_cu = 0;
        hipGetDevice(&dev);
        hipDeviceGetAttribute(&cus, hipDeviceAttributeMultiprocessorCount, dev);
        hipFuncSetAttribute((const void*)fwd_kernel, hipFuncAttributeMaxDynamicSharedMemorySize, LDS_BYTES);
        hipOccupancyMaxActiveBlocksPerMultiprocessor(&per_cu, (const void*)fwd_kernel, NTHR, LDS_BYTES);
        if (per_cu < 1) per_cu = 1;
        (void)hipGetLastError();
        grid = cus * per_cu;
    }
    if (grid < 0) return;
    (void)hipMemsetAsync(d_ws, 0, 65536, stream);
    Params p{};
    for (int i = 0; i < 25; ++i) p.in[i] = (const float*)d_in[i];
    p.out = (float*)d_out; p.ws = (unsigned char*)d_ws;
#if ONE_LAUNCH
#ifdef XTRA_LIST
    p.ph_lo = 0; p.ph_hi = NPH + XTRA_N;
#else
    p.ph_lo = 0; p.ph_hi = NPH;
#endif
    void* args[] = {&p};
    hipError_t e = hipLaunchCooperativeKernel((const void*)fwd_kernel, dim3(grid), dim3(NTHR), args, LDS_BYTES, stream);
    if (e != hipSuccess) fprintf(stderr, "cooperative launch failed: %s (grid %d)\n", hipGetErrorString(e), grid);
#else
    for (int ph = 0; ph < NPH; ++ph) { p.ph_lo = ph; p.ph_hi = ph + 1; hipLaunchKernelGGL(fwd_kernel, dim3(grid), dim3(NTHR), LDS_BYTES, stream, p); }
#endif
}
```

```cpp
#include <hip/hip_runtime.h>
#include <hip/hip_cooperative_groups.h>
#include <cstdint>
#include <cstdio>
namespace cg = cooperative_groups;

#ifndef ONE_LAUNCH
#define ONE_LAUNCH 1
#endif

#ifndef EN_ALL
#define EN_ALL 1
#endif
#ifndef EN_PRO
#define EN_PRO EN_ALL
#endif
#ifndef EN_FIN
#define EN_FIN EN_ALL
#endif
#ifndef EN_NORM
#define EN_NORM EN_ALL
#endif
#ifndef EN_CONV
#define EN_CONV EN_ALL
#endif
#ifndef EN_G1
#define EN_G1 EN_ALL
#endif
#ifndef EN_G2
#define EN_G2 EN_ALL
#endif
#ifndef EN_G3
#define EN_G3 EN_ALL
#endif
#ifndef EN_DT
#define EN_DT EN_ALL
#endif
#ifndef EN_SB
#define EN_SB EN_ALL
#endif
#ifndef EN_RKV
#define EN_RKV EN_ALL
#endif
#ifndef EN_SST
#define EN_SST EN_ALL
#endif
#ifndef EN_SCAN
#define EN_SCAN EN_ALL
#endif
#ifndef EN_ROUT
#define EN_ROUT EN_ALL
#endif
#ifndef EN_SOUT
#define EN_SOUT EN_ALL
#endif
#ifndef EN_SINTER
#define EN_SINTER 1
#endif
#ifndef XSEL
#define XSEL 31
#endif
#define XS(m) (ph < NPH || (XSEL & (m)))
#ifndef XMODE
#define XMODE 0
#endif
#define LAS __attribute__((address_space(3)))
#define GAS __attribute__((address_space(1)))
template <class T> __device__ __forceinline__ T* as_global(T* p) {
#if defined(__HIP_DEVICE_COMPILE__)
    __builtin_assume(!__builtin_amdgcn_is_shared((const void*)p)); __builtin_assume(!__builtin_amdgcn_is_private((const void*)p));
#endif
    return p; }
typedef unsigned short bf16_t;
typedef short bf16x8 __attribute__((ext_vector_type(8)));
typedef float f32x4 __attribute__((ext_vector_type(4)));
typedef float f32x2 __attribute__((ext_vector_type(2)));
typedef unsigned u32x4 __attribute__((ext_vector_type(4)));
typedef unsigned u32x2 __attribute__((ext_vector_type(2)));

constexpr int T_TOK = 32768, SEQ = 8192, DM = 1024, DFF = 2816, INW = 5128, PW = 5120;
constexpr int NTHR = 512, NWAVE = 8;
constexpr float EPS = 1e-6f;
constexpr int C_RQ = 0, C_SQ = 512, C_MZ = 1024, C_RK = 1536, C_RV = 2048, C_RG = 2560, C_SK = 3072, C_SV = 3584, C_XBC = 4096;

constexpr size_t MiB = 1u << 20;
constexpr size_t WS_MOD = 1 * MiB, WS_ROPE = 2 * MiB, WS_DT = 6 * MiB, WS_CD = 7 * MiB;
constexpr size_t WS_WFU = 8 * MiB, WS_WFD = 19 * MiB, WS_WIN = 25 * MiB, WS_WOUT = 35 * MiB;
constexpr size_t WS_U = 38 * MiB, WS_RST = 38 * MiB, WS_SST = 102 * MiB, WS_PROJ = 166 * MiB, WS_END = 486 * MiB;
constexpr int FMOD_OFF = 2 * 4 * 9 * 1024;

constexpr size_t PLANE = (size_t)T_TOK * 128;
__device__ __forceinline__ size_t pidx(size_t row, int col) { return (size_t)(col >> 7) * PLANE + row * 128 + (col & 127); }
constexpr int LDS_BYTES = 147456;

struct Params {
    const float* in[25];
    float* out;
    unsigned char* ws;
    int ph_lo, ph_hi;
};

typedef __bf16 bf16x2_t __attribute__((ext_vector_type(2)));
__device__ __forceinline__ unsigned cvt_pk_bf16(float lo, float hi) { const f32x2 v = {lo, hi}; const bf16x2_t b = __builtin_convertvector(v, bf16x2_t); return __builtin_bit_cast(unsigned, b); }
__device__ __forceinline__ float bf_lo(unsigned u) { return __uint_as_float(u << 16); }
__device__ __forceinline__ float bf_hi(unsigned u) { return __uint_as_float(u & 0xffff0000u); }
__device__ __forceinline__ float bf2f(bf16_t x) { return __uint_as_float(((unsigned)x) << 16); }
__device__ __forceinline__ bf16_t f2bf(float f) { return (bf16_t)(cvt_pk_bf16(f, 0.f) & 0xffffu); }
__device__ __forceinline__ float wave_sum(float v) {
#pragma unroll
    for (int o = 1; o < 64; o <<= 1) v += __shfl_xor(v, o);
    return v;
}
__device__ __forceinline__ float wave_max(float v) {
#pragma unroll
    for (int o = 1; o < 64; o <<= 1) v = fmaxf(v, __shfl_xor(v, o));
    return v;
}
__device__ __forceinline__ void lds_barrier() { asm volatile("s_waitcnt lgkmcnt(0)" ::: "memory"); __builtin_amdgcn_s_barrier(); asm volatile("" ::: "memory"); }
__device__ __forceinline__ float silu_f(float g) { return g * __builtin_amdgcn_rcpf(1.0f + __builtin_amdgcn_exp2f(-1.44269504f * g)); }
__device__ __forceinline__ f32x4 mfma16(bf16x8 a, bf16x8 b, f32x4 c) { return __builtin_amdgcn_mfma_f32_16x16x32_bf16(a, b, c, 0, 0, 0); }
__device__ __forceinline__ bf16x8 ldsfrag(const LAS unsigned char* p) { return *(const LAS bf16x8*)p; }
__device__ __forceinline__ u32x2 pack4(f32x4 v) { u32x2 w; w.x = cvt_pk_bf16(v[0], v[1]); w.y = cvt_pk_bf16(v[2], v[3]); return w; }
__device__ __forceinline__ void unpack8(u32x4 v, float* f) {
    f[0] = bf_lo(v.x); f[1] = bf_hi(v.x); f[2] = bf_lo(v.y); f[3] = bf_hi(v.y); f[4] = bf_lo(v.z); f[5] = bf_hi(v.z); f[6] = bf_lo(v.w); f[7] = bf_hi(v.w);
}
__device__ __forceinline__ float log2gamma(int h) { return h == 0 ? -0.04580368961312479f : (h == 1 ? -0.02272007650008353f : (h == 2 ? -0.011315313227834146f : -0.005646563141142063f)); }

namespace pg8 {
constexpr int BM = 256, BK = 64, HALF = 128, HTB = HALF * BK * 2, STAGE_BYTES = 8 * HTB, NXCD = 8, WGM = 8;
__host__ __device__ __forceinline__ int lds_byte(int r, int c) { const int st = (r >> 4) * 2 + (c >> 5), rr = r & 15, cc = c & 31, ob = rr * 64 + cc * 2; return st * 1024 + (ob ^ (((ob >> 9) & 1) << 5)); }
__host__ __device__ __forceinline__ void stage_rc(int b, int& R, int& C) { const int st = b / 1024, sb = b % 1024, swz = sb ^ (((sb >> 9) & 1) << 5); R = (st >> 1) * 16 + swz / 64; C = (st & 1) * 32 + (swz % 64) / 2; }
__host__ __device__ __forceinline__ int perm32(int rho) { const int n = rho >> 4, i = rho & 15; return 8 * (i >> 2) + 4 * n + (i & 3); }
struct Unit { int pm, pn; };
struct Gemm { const bf16_t* A; const bf16_t* Bt; int M, N, K, lda; };
struct StaticOrder {
    int nM, nN, nwg, G, c;
    __device__ void init(int M, int N, int G_, int c_) { nM = M / BM; nN = N / BM; nwg = nM * nN; G = G_; c = c_; }
    __device__ bool next(int i, Unit& u) const {
        const long L = (long)i * G + c; if (L >= nwg) return false;
        int wgid = (int)L; { const int q = nwg / NXCD, r = nwg % NXCD, xcd = wgid % NXCD, off = wgid / NXCD; wgid = (xcd < r ? xcd * (q + 1) : r * (q + 1) + (xcd - r) * q) + off; }
        const int nig = WGM * nN, gid = wgid / nig, fm = gid * WGM, gsz = (nM - fm) < WGM ? (nM - fm) : WGM;
        u.pm = fm + ((wgid % nig) % gsz); u.pn = (wgid % nig) / gsz; return true;
    }
};
struct EpiBf16 {
    bf16_t* O; int ldc;
    __device__ __forceinline__ void operator()(const f32x4 (&acc)[2][2][4][2], const Unit& u, int wr, int wc, int fr, int fq) const {
        const int row0 = u.pm * BM + wr * 64 + fr, col0 = u.pn * BM + wc * 32 + 8 * fq;
#pragma unroll
        for (int ai = 0; ai < 2; ++ai)
#pragma unroll
            for (int m = 0; m < 4; ++m) { bf16_t* rowp = O + (size_t)(2 * u.pn) * PLANE + (size_t)(row0 + ai * HALF + m * 16) * 128 + wc * 32 + 8 * fq;
#pragma unroll
                for (int bj = 0; bj < 2; ++bj) { const f32x4 v0 = acc[ai][bj][m][0], v1 = acc[ai][bj][m][1];
                    u32x4 w; w.x = cvt_pk_bf16(v0[0], v0[1]); w.y = cvt_pk_bf16(v0[2], v0[3]); w.z = cvt_pk_bf16(v1[0], v1[1]); w.w = cvt_pk_bf16(v1[2], v1[3]);
                    *(GAS u32x4*)(rowp + bj * PLANE) = w; } }
    }
};
struct EpiSwiGLU {
    bf16_t* O; int ldo;
    __device__ __forceinline__ void operator()(const f32x4 (&acc)[2][2][4][2], const Unit& u, int wr, int wc, int fr, int fq) const {
        const int row0 = u.pm * BM + wr * 64 + fr, col0 = u.pn * HALF + wc * 32 + 8 * fq;
#pragma unroll
        for (int ai = 0; ai < 2; ++ai)
#pragma unroll
            for (int m = 0; m < 4; ++m) { bf16_t* rowp = O + (size_t)(row0 + ai * HALF + m * 16) * ldo + col0;
                float hv[8];
#pragma unroll
                for (int n = 0; n < 2; ++n)
#pragma unroll
                    for (int i = 0; i < 4; ++i) hv[4 * n + i] = silu_f(acc[ai][0][m][n][i]) * acc[ai][1][m][n][i];
                u32x4 w; w.x = cvt_pk_bf16(hv[0], hv[1]); w.y = cvt_pk_bf16(hv[2], hv[3]); w.z = cvt_pk_bf16(hv[4], hv[5]); w.w = cvt_pk_bf16(hv[6], hv[7]);
                *(GAS u32x4*)rowp = w; }
    }
};
struct EpiResid {
    const float* hin; float* hout; const float* gate; float cmul;
    __device__ __forceinline__ void operator()(const f32x4 (&acc)[2][2][4][2], const Unit& u, int wr, int wc, int fr, int fq) const {
        const int row0 = u.pm * BM + wr * 64 + fr, col0 = u.pn * BM + wc * 32 + 8 * fq;
        const int b = (u.pm * BM) >> 13;
        f32x4 gm[2][2];
#pragma unroll
        for (int bj = 0; bj < 2; ++bj)
#pragma unroll
            for (int n = 0; n < 2; ++n) { const f32x4 g = *(const GAS f32x4*)(gate + (size_t)b * 9216 + col0 + bj * HALF + 4 * n); gm[bj][n] = (g + 1.0f) * cmul; }
#pragma unroll
        for (int ai = 0; ai < 2; ++ai) {
            f32x4 hv[4][2][2];
#pragma unroll
            for (int m = 0; m < 4; ++m) { const size_t off = (size_t)(row0 + ai * HALF + m * 16) * DM + col0;
#pragma unroll
                for (int bj = 0; bj < 2; ++bj)
#pragma unroll
                    for (int n = 0; n < 2; ++n) hv[m][bj][n] = *(const GAS f32x4*)(hin + off + bj * HALF + 4 * n); }
#pragma unroll
            for (int m = 0; m < 4; ++m) { const size_t off = (size_t)(row0 + ai * HALF + m * 16) * DM + col0;
#pragma unroll
                for (int bj = 0; bj < 2; ++bj)
#pragma unroll
                    for (int n = 0; n < 2; ++n) *(GAS f32x4*)(hout + off + bj * HALF + 4 * n) = hv[m][bj][n] + gm[bj][n] * acc[ai][bj][m][n]; }
            asm volatile("" ::: "memory");
        }
    }
};

template <class Epi, bool APL = false>
__device__ __forceinline__ void gemm_phase(LAS unsigned char* lds, const int tid, const Gemm g, const StaticOrder& S, const Epi& E) {
    const int wid = __builtin_amdgcn_readfirstlane(tid >> 6), lane = tid & 63, wr = wid >> 2, wc = wid & 3, fr = lane & 15, fq = lane >> 4;
    const int K = g.K, nt = K / BK, lda = g.lda;
    unsigned voffA[2], voffB[2];
#pragma unroll
    for (int i = 0; i < 2; ++i) { int R, C; stage_rc(tid * 16 + i * 8192, R, C); const int Rb = (R & ~31) + perm32(R & 31);
        voffA[i] = (unsigned)(R * (APL ? 128 : lda) + C) * 2u; voffB[i] = (unsigned)(Rb * K + C) * 2u; }
    const size_t kstep = (size_t)(BK * 2);
    const size_t hstepA = (size_t)HALF * (APL ? 128 : lda) * 2, hstepB = (size_t)HALF * K * 2;
#define PG8_KA(t) (APL ? ((size_t)((t) >> 1) * (PLANE * 2) + (size_t)((t) & 1) * 128) : (size_t)(t) * kstep)
    const size_t tstepA = 2 * hstepA, tstepB = 2 * hstepB;
    const unsigned ldsw = (unsigned)wid * 1024u;
    const int aoff = lds_byte(wr * 64 + fr, fq * 8), boff = lds_byte(wc * 32 + fr, fq * 8);
#define PG8_SA(b, h) (((b) * 2 + (h)) * HTB)
#define PG8_SB(b, h) ((4 + (b) * 2 + (h)) * HTB)
#define PG8_STAGE(bufoff, gbase, voff) do { _Pragma("unroll") for (int _i = 0; _i < 2; ++_i) \
        __builtin_amdgcn_global_load_lds((const unsigned*)((const char*)(gbase) + (voff)[_i]), (LAS unsigned*)(lds + (bufoff) + ldsw + _i * 8192), 16, 0, 0); } while (0)
#define PG8_LDA(dst, b, h) do { _Pragma("unroll") for (int m = 0; m < 4; ++m) _Pragma("unroll") for (int k = 0; k < 2; ++k) dst[m][k] = *(const LAS bf16x8*)(lds + PG8_SA(b, h) + aoff + m * 2048 + k * 1024); } while (0)
#define PG8_LDB(dst, b, h) do { _Pragma("unroll") for (int n = 0; n < 2; ++n) _Pragma("unroll") for (int k = 0; k < 2; ++k) dst[n][k] = *(const LAS bf16x8*)(lds + PG8_SB(b, h) + boff + n * 2048 + k * 1024); } while (0)
#define PG8_MMA(ai, bj, At, Bt) do { __builtin_amdgcn_s_setprio(1); _Pragma("unroll") for (int m = 0; m < 4; ++m) _Pragma("unroll") for (int n = 0; n < 2; ++n) _Pragma("unroll") for (int k = 0; k < 2; ++k) \
        acc[ai][bj][m][n] = __builtin_amdgcn_mfma_f32_16x16x32_bf16(Bt[n][k], At[m][k], acc[ai][bj][m][n], 0, 0, 0); __builtin_amdgcn_s_setprio(0); } while (0)
#define PG8_WAIT_V(n) asm volatile("s_waitcnt vmcnt(" #n ")" ::: "memory")
#define PG8_WAIT_L(n) asm volatile("s_waitcnt lgkmcnt(" #n ")" ::: "memory")
#define PG8_BAR __builtin_amdgcn_s_barrier()
#define PG8_SCHED __builtin_amdgcn_sched_barrier(0)
    Unit cur, nxt; int ui = 0;
    if (!S.next(0, cur)) return;
    f32x4 acc[2][2][4][2];
#pragma unroll
    for (int a = 0; a < 2; ++a)
#pragma unroll
        for (int b = 0; b < 2; ++b)
#pragma unroll
            for (int m = 0; m < 4; ++m)
#pragma unroll
                for (int n = 0; n < 2; ++n) acc[a][b][m][n] = (f32x4){0.f, 0.f, 0.f, 0.f};
    bf16x8 At[4][2], B0[2][2], B1[2][2];
    const char* cA = (const char*)g.A + (size_t)cur.pm * tstepA; const char* cB = (const char*)g.Bt + (size_t)cur.pn * tstepB;
    PG8_STAGE(PG8_SB(0, 0), cB, voffB); PG8_STAGE(PG8_SB(0, 1), cB + hstepB, voffB); PG8_STAGE(PG8_SA(0, 0), cA, voffA); PG8_STAGE(PG8_SA(0, 1), cA + hstepA, voffA);
    if (wr == 1) PG8_BAR;
    PG8_WAIT_V(2); PG8_BAR;
    PG8_STAGE(PG8_SB(1, 0), cB + kstep, voffB); PG8_STAGE(PG8_SA(1, 0), cA + PG8_KA(1), voffA); PG8_STAGE(PG8_SB(1, 1), cB + hstepB + kstep, voffB);
    PG8_WAIT_V(6); PG8_BAR;
    for (;;) {
        const bool has_next = S.next(ui + 1, nxt);
        const char* nA = has_next ? (const char*)g.A + (size_t)nxt.pm * tstepA : cA; const char* nB = has_next ? (const char*)g.Bt + (size_t)nxt.pn * tstepB : cB;
        for (int t = 0; t < nt; t += 2) {
            const bool last = (t == nt - 2);
            const char* a1 = cA + PG8_KA(t + 1);
            const char* a2 = last ? nA : cA + PG8_KA(t + 2); const char* b2 = last ? nB : cB + (size_t)(t + 2) * kstep;
            const char* a3 = last ? nA + PG8_KA(1) : cA + PG8_KA(t + 3); const char* b3 = b2 + kstep;
            PG8_LDB(B0, 0, 0); PG8_LDB(B1, 0, 1); PG8_SCHED; PG8_LDA(At, 0, 0); PG8_STAGE(PG8_SA(1, 1), a1 + hstepA, voffA);
            PG8_WAIT_V(8); PG8_WAIT_L(0); PG8_BAR; PG8_MMA(0, 0, At, B0); PG8_MMA(0, 1, At, B1); PG8_BAR; PG8_SCHED;
            PG8_LDA(At, 0, 1); PG8_STAGE(PG8_SB(0, 0), b2, voffB); PG8_STAGE(PG8_SB(0, 1), b2 + hstepB, voffB); PG8_STAGE(PG8_SA(0, 0), a2, voffA);
            PG8_WAIT_V(8); PG8_WAIT_L(0); PG8_BAR; PG8_MMA(1, 0, At, B0); PG8_MMA(1, 1, At, B1); PG8_BAR; PG8_SCHED;
            PG8_LDB(B0, 1, 0); PG8_LDB(B1, 1, 1); PG8_SCHED; PG8_LDA(At, 1, 0); PG8_STAGE(PG8_SA(0, 1), a2 + hstepA, voffA);
            PG8_WAIT_V(8); PG8_WAIT_L(0); PG8_BAR; PG8_MMA(0, 0, At, B0); PG8_MMA(0, 1, At, B1); PG8_BAR; PG8_SCHED;
            PG8_LDA(At, 1, 1); PG8_STAGE(PG8_SB(1, 0), b3, voffB); PG8_STAGE(PG8_SB(1, 1), b3 + hstepB, voffB); PG8_STAGE(PG8_SA(1, 0), a3, voffA);
            PG8_WAIT_V(8); PG8_WAIT_L(0); PG8_BAR; PG8_MMA(1, 0, At, B0); PG8_MMA(1, 1, At, B1); PG8_BAR; PG8_SCHED;
        }
        if (wr == 0) PG8_BAR;
        E(acc, cur, wr, wc, fr, fq);
        if (!has_next) break;
#pragma unroll
        for (int a = 0; a < 2; ++a)
#pragma unroll
            for (int b = 0; b < 2; ++b)
#pragma unroll
                for (int m = 0; m < 4; ++m)
#pragma unroll
                    for (int n = 0; n < 2; ++n) acc[a][b][m][n] = (f32x4){0.f, 0.f, 0.f, 0.f};
        cur = nxt; cA = nA; cB = nB; ++ui;
        if (wr == 1) PG8_BAR;
    }
    PG8_WAIT_V(0);
    PG8_BAR;
#undef PG8_KA
#undef PG8_SA
#undef PG8_SB
#undef PG8_STAGE
#undef PG8_LDA
#undef PG8_LDB
#undef PG8_MMA
#undef PG8_WAIT_V
#undef PG8_WAIT_L
#undef PG8_BAR
#undef PG8_SCHED
}
}

struct Frame {
    LAS unsigned char* lds;
    int tid, lane, wave, G, bid;
};

__device__ __forceinline__ void conv_item(const float* W, int Nsrc, int K, int src_col0, bf16_t* WT, int dst_row0, int k0, LAS float* scr, int lane) {
#pragma unroll 8
    for (int i = 0; i < 32; ++i) { const int kk = 2 * i + (lane >> 5); scr[kk * 33 + (lane & 31)] = ((const GAS float*)W)[(size_t)(k0 + kk) * Nsrc + src_col0 + (lane & 31)]; }
    asm volatile("s_waitcnt lgkmcnt(0)" ::: "memory");
    const int c = lane & 7;
#pragma unroll
    for (int j = 0; j < 4; ++j) { const int n = (lane >> 3) + 8 * j; const LAS float* s = scr + (8 * c) * 33 + n;
        u32x4 o; o.x = cvt_pk_bf16(s[0 * 33], s[1 * 33]); o.y = cvt_pk_bf16(s[2 * 33], s[3 * 33]); o.z = cvt_pk_bf16(s[4 * 33], s[5 * 33]); o.w = cvt_pk_bf16(s[6 * 33], s[7 * 33]);
        *(GAS u32x4*)(WT + (size_t)(dst_row0 + n) * K + k0 + 8 * c) = o; }
    asm volatile("s_waitcnt lgkmcnt(0)" ::: "memory");
}
__device__ __forceinline__ void convert_ffn(const Frame& F, const float* wg, const float* wu, const float* wd, bf16_t* WFU, bf16_t* WFD) {
    LAS float* scr = (LAS float*)(F.lds + F.wave * 16384);
    const int gw = F.bid * NWAVE + F.wave, NGW = F.G * NWAVE;
    constexpr int I_U = 16 * 176, I_D = 44 * 32;
    for (int it = gw; it < I_U + I_D; it += NGW) {
        if (it < I_U) { const int kb = it / 176, nb = it % 176, r0 = nb * 32, pn = r0 >> 8, i0 = r0 & 255;
            conv_item(i0 < 128 ? wg : wu, DFF, DM, pn * 128 + (i0 & 127), WFU, r0, kb * 64, scr, F.lane); }
        else { const int r = it - I_U, kb = r / 32, nb = r % 32; conv_item(wd, DM, DFF, nb * 32, WFD, nb * 32, kb * 64, scr, F.lane); }
    }
}
__device__ __forceinline__ void convert_mix(const Frame& F, const float* w_in, const float* w_out, bf16_t* WIN, bf16_t* WOUT) {
    LAS float* scr = (LAS float*)(F.lds + F.wave * 16384);
    const int gw = F.bid * NWAVE + F.wave, NGW = F.G * NWAVE;
    constexpr int I_I = 16 * 160, I_O = 24 * 32;
    for (int it = gw; it < I_I + I_O; it += NGW) {
        if (it < I_I) { const int kb = it / 160, nb = it % 160, r0 = nb * 32, blk = r0 >> 9;
            const int sb = blk == 0 ? 0 : blk == 1 ? 4 : blk == 2 ? 7 : blk == 3 ? 1 : blk == 4 ? 2 : blk == 5 ? 3 : blk == 6 ? 5 : blk == 7 ? 6 : blk;
            conv_item(w_in, INW, DM, sb * 512 + (r0 & 511), WIN, r0, kb * 64, scr, F.lane); }
        else { const int r = it - I_I, kb = r / 32, nb = r % 32; conv_item(w_out, DM, 1536, nb * 32, WOUT, nb * 32, kb * 64, scr, F.lane); }
    }
}

__device__ __forceinline__ void sincos_d(double x, double& s, double& c) {
    const double k = rint(x * 0.63661977236758134308);
    double r = fma(-k, 1.57079632679489655800e+00, x); r = fma(-k, 6.12323399573676603587e-17, r);
    const double r2 = r * r;
    double sp = -7.6471637318198164759e-13; sp = sp * r2 + 1.6059043836821614599e-10; sp = sp * r2 - 2.5052108385441718775e-08; sp = sp * r2 + 2.7557319223985890653e-06;
    sp = sp * r2 - 1.9841269841269841270e-04; sp = sp * r2 + 8.3333333333333333333e-03; sp = sp * r2 - 1.6666666666666666667e-01; const double sn = r + r * r2 * sp;
    double cp = 4.7794773323873852974e-14; cp = cp * r2 - 1.1470745597729724714e-11; cp = cp * r2 + 2.0876756987868098979e-09; cp = cp * r2 - 2.7557319223985890653e-07;
    cp = cp * r2 + 2.4801587301587301587e-05; cp = cp * r2 - 1.3888888888888888889e-03; cp = cp * r2 + 4.1666666666666666667e-02; cp = cp * r2 - 0.5; const double cs = 1.0 + r2 * cp;
    const int q = ((int)k) & 3;
    s = (q == 0) ? sn : (q == 1) ? cs : (q == 2) ? -sn : -cs;
    c = (q == 0) ? cs : (q == 1) ? -sn : (q == 2) ? -cs : sn;
}
__device__ __forceinline__ void prologue(const Frame& F, const Params& p, unsigned char* ws, int zi) {
    LAS float* cs = (LAS float*)F.lds;
    LAS float* red = (LAS float*)(F.lds + 16384);
    const float* c = as_global(p.in[1 + zi]);
    for (int i = F.tid; i < 4096; i += NTHR) cs[i] = silu_f(c[i]);
    __syncthreads();
    float* MOD = (float*)(ws + WS_MOD);
    for (int task = F.bid; task < 320; task += F.G) {
        const float* W; const float* bias; int N, n0; float* dst; int dstride;
        if (task < 288) { const int l = task / 144, t = task % 144; W = as_global(p.in[2 + zi]) + (size_t)l * DM * 9216; bias = as_global(p.in[3 + zi]) + l * 9216; N = 9216; n0 = t * 64; dst = MOD + (size_t)l * 4 * 9216; dstride = 9216; }
        else { const int t = task - 288; W = as_global(p.in[22 + zi]); bias = as_global(p.in[23 + zi]); N = 2048; n0 = t * 64; dst = MOD + FMOD_OFF; dstride = 2048; }
        float a0 = 0.f, a1 = 0.f, a2 = 0.f, a3 = 0.f;
        const int kb = F.wave * 128;
#pragma unroll 32
        for (int k = 0; k < 128; ++k) { const float w = ((const GAS float*)W)[(size_t)(kb + k) * N + n0 + F.lane];
            a0 += cs[kb + k] * w; a1 += cs[1024 + kb + k] * w; a2 += cs[2048 + kb + k] * w; a3 += cs[3072 + kb + k] * w; }
        red[(F.wave * 4 + 0) * 64 + F.lane] = a0; red[(F.wave * 4 + 1) * 64 + F.lane] = a1; red[(F.wave * 4 + 2) * 64 + F.lane] = a2; red[(F.wave * 4 + 3) * 64 + F.lane] = a3;
        __syncthreads();
        if (F.tid < 256) { const int b = F.tid >> 6, col = F.tid & 63; float s = bias[n0 + col];
#pragma unroll
            for (int w = 0; w < 8; ++w) s += red[(w * 4 + b) * 64 + col];
            dst[(size_t)b * dstride + n0 + col] = s; }
        __syncthreads();
    }
    f32x2* ROPE = (f32x2*)(ws + WS_ROPE);
    for (int idx = F.bid * NTHR + F.tid; idx < SEQ * 64; idx += F.G * NTHR) {
        const int pos = idx >> 6, i = idx & 63;
        const float invf = (float)exp(-(double)i * (9.210340371976184 / 64.0));
        const float ang = (float)pos * invf;
        double s, cc; sincos_d((double)ang, s, cc);
        ROPE[idx] = (f32x2){(float)cc, (float)s};
    }
}

__device__ __forceinline__ void norm_phase(const Frame& F, const float* h, const float* gain, const float* shift0, const float* scale0, int bstride, bf16_t* U) {
    const int gw = F.bid * NWAVE + F.wave, NGW = F.G * NWAVE;
    for (int m0 = gw; m0 < T_TOK; m0 += 4 * NGW) {
        f32x4 v[4][4];
#pragma unroll
        for (int r = 0; r < 4; ++r) { const int m = m0 + r * NGW; if (m < T_TOK) { const GAS f32x4* xr = (const GAS f32x4*)(h + (size_t)m * DM) + F.lane;
#pragma unroll
            for (int j = 0; j < 4; ++j) v[r][j] = xr[64 * j]; } }
#pragma unroll
        for (int r = 0; r < 4; ++r) { const int m = m0 + r * NGW; if (m < T_TOK) {
            const int b = m >> 13; float s = 0.f;
#pragma unroll
            for (int j = 0; j < 4; ++j) s += (v[r][j].x * v[r][j].x + v[r][j].y * v[r][j].y) + (v[r][j].z * v[r][j].z + v[r][j].w * v[r][j].w);
            const float rstd = rsqrtf(wave_sum(s) * (1.f / DM) + EPS);
            GAS u32x2* o8 = (GAS u32x2*)(U + (size_t)m * DM) + F.lane;
#pragma unroll
            for (int j = 0; j < 4; ++j) {
                const f32x4 g = ((const GAS f32x4*)gain)[F.lane + 64 * j], sh = ((const GAS f32x4*)(shift0 + (size_t)b * bstride))[F.lane + 64 * j], sc = ((const GAS f32x4*)(scale0 + (size_t)b * bstride))[F.lane + 64 * j];
                o8[64 * j] = pack4(v[r][j] * rstd * g * (sc + 1.0f) + sh); } } }
    }
}
__device__ __forceinline__ void final_phase(const Frame& F, float* h, const float* gain, const float* fmod) {
    const int gw = F.bid * NWAVE + F.wave, NGW = F.G * NWAVE;
    for (int m0 = gw; m0 < T_TOK; m0 += 4 * NGW) {
        f32x4 v[4][4];
#pragma unroll
        for (int r = 0; r < 4; ++r) { const int m = m0 + r * NGW; if (m < T_TOK) { const GAS f32x4* xr = (const GAS f32x4*)(h + (size_t)m * DM) + F.lane;
#pragma unroll
            for (int j = 0; j < 4; ++j) v[r][j] = xr[64 * j]; } }
#pragma unroll
        for (int r = 0; r < 4; ++r) { const int m = m0 + r * NGW; if (m < T_TOK) {
            const int b = m >> 13; float s = 0.f;
#pragma unroll
            for (int j = 0; j < 4; ++j) s += (v[r][j].x * v[r][j].x + v[r][j].y * v[r][j].y) + (v[r][j].z * v[r][j].z + v[r][j].w * v[r][j].w);
            const float rstd = rsqrtf(wave_sum(s) * (1.f / DM) + EPS);
            GAS f32x4* xr = (GAS f32x4*)(h + (size_t)m * DM) + F.lane;
#pragma unroll
            for (int j = 0; j < 4; ++j) {
                const f32x4 g = ((const GAS f32x4*)gain)[F.lane + 64 * j], sh = ((const GAS f32x4*)(fmod + (size_t)b * 2048))[F.lane + 64 * j], sc = ((const GAS f32x4*)(fmod + (size_t)b * 2048 + 1024))[F.lane + 64 * j];
                xr[64 * j] = v[r][j] * rstd * g * (sc + 1.0f) + sh; } } }
    }
}

__device__ __forceinline__ void dt_gemv(const Frame& F, const bf16_t* U, const float* w_in, float* DT) {
    LAS float* Wd = (LAS float*)F.lds;
    __syncthreads();
    for (int idx = F.tid; idx < 8192; idx += NTHR) { const int k = idx >> 3, j = idx & 7; Wd[8 * k + 4 * (k >> 3) + j] = ((const GAS float*)w_in)[(size_t)k * INW + 5120 + j]; }
    __syncthreads();
    const int gw = F.bid * NWAVE + F.wave, NGW = F.G * NWAVE;
    for (int m0 = gw; m0 < T_TOK; m0 += 4 * NGW) {
      u32x4 uvr[4][2];
#pragma unroll
      for (int r = 0; r < 4; ++r) { const int mm = (m0 + r * NGW < T_TOK) ? m0 + r * NGW : m0;
#pragma unroll
          for (int hf = 0; hf < 2; ++hf) uvr[r][hf] = *(const GAS u32x4*)(U + (size_t)mm * DM + 512 * hf + 8 * F.lane); }
#pragma unroll
      for (int r = 0; r < 4; ++r) { const int m = m0 + r * NGW; if (m < T_TOK) {
        float acc[8];
#pragma unroll
        for (int j = 0; j < 8; ++j) acc[j] = 0.f;
#pragma unroll
        for (int hf = 0; hf < 2; ++hf) {
            const u32x4 uv = uvr[r][hf];
            float uf[8]; unpack8(uv, uf);
#pragma unroll
            for (int kk = 0; kk < 8; ++kk) { const int k = 512 * hf + 8 * F.lane + kk; const LAS float* wp = Wd + 8 * k + 4 * (k >> 3);
                const f32x4 w0 = *(const LAS f32x4*)wp, w1 = *(const LAS f32x4*)(wp + 4);
                acc[0] += uf[kk] * w0.x; acc[1] += uf[kk] * w0.y; acc[2] += uf[kk] * w0.z; acc[3] += uf[kk] * w0.w;
                acc[4] += uf[kk] * w1.x; acc[5] += uf[kk] * w1.y; acc[6] += uf[kk] * w1.z; acc[7] += uf[kk] * w1.w; }
        }
#pragma unroll
        for (int j = 0; j < 8; ++j) acc[j] = wave_sum(acc[j]);
        if (F.lane < 8) { float v = acc[0];
#pragma unroll
            for (int j = 1; j < 8; ++j) v = (F.lane == j) ? acc[j] : v;
            ((GAS float*)DT)[(size_t)m * 8 + F.lane] = v; }
      } }
    }
    __syncthreads();
}

template <bool MASKED>
__device__ __forceinline__ void sb_elem(const f32x4 (&sc)[4], int key0, int trow, float (&nk)[4][4], float (&lb)[4][4], float (&Tj)[4]) {
#pragma unroll
    for (int j = 0; j < 4; ++j) { float t = 0.f;
#pragma unroll
        for (int i = 0; i < 4; ++i) { const float z2 = sc[j][i] * (0.08838834764831845f * 1.4426950408889634f);
            const float sp2 = fmaxf(z2, 0.f) + __builtin_amdgcn_logf(1.0f + __builtin_amdgcn_exp2f(-fabsf(z2)));
            if (MASKED) { const bool vis = (key0 + 16 * j + i) < trow; nk[j][i] = vis ? sp2 : 0.f; lb[j][i] = vis ? (z2 - sp2) : -1e30f; }
            else { nk[j][i] = sp2; lb[j][i] = z2 - sp2; }
            t += nk[j][i]; }
        Tj[j] = t; }
}
__device__ __forceinline__ void sb_task(const Frame& F, bf16_t* P, int b, int h, int qb) {
    LAS unsigned char* Ks = F.lds;
    LAS unsigned char* Vt = F.lds + 17408;
    LAS unsigned char* Pw = F.lds + 35840 + F.wave * 2304;
    LAS float* red = (LAS float*)(F.lds + 54272);
    int lane = F.lane; asm volatile("" : "+v"(lane)); const int wid = F.wave, fr = lane & 15, fq = lane >> 4;
    const size_t rowbase = (size_t)b * SEQ;
    const int q0 = qb * 128, trow = q0 + 16 * wid + fr;
    bf16x8 qf[4];
    { const bf16_t* qp = P + pidx(rowbase + trow, C_SQ + h * 128) + 8 * fq;
#pragma unroll
      for (int s = 0; s < 4; ++s) qf[s] = *(const GAS bf16x8*)(qp + 32 * s); }
    f32x4 o[8];
#pragma unroll
    for (int i = 0; i < 8; ++i) o[i] = (f32x4){0.f, 0.f, 0.f, 0.f};
    float R = 0.f;
    u32x4 kvr[2], vvr[2];
#pragma unroll
    for (int i = 0; i < 2; ++i) { const int idx = F.tid + NTHR * i, key = idx >> 4, c8 = idx & 15; const size_t kt0 = rowbase + 64 * (2 * qb + 1);
        kvr[i] = *(const GAS u32x4*)(P + pidx(kt0 + key, C_SK + h * 128) + 8 * c8); vvr[i] = *(const GAS u32x4*)(P + pidx(kt0 + lane, C_SV + h * 128) + 8 * (2 * wid + i)); }
    lds_barrier();
    for (int kt = 2 * qb + 1; kt >= 0; --kt) {
#pragma unroll
        for (int i = 0; i < 2; ++i) { const int idx = F.tid + NTHR * i, key = idx >> 4, c8 = idx & 15;
            const u32x4 kv = kvr[i], vv = vvr[i];
            *(LAS u32x4*)(Ks + key * 272 + c8 * 16) = kv;
            LAS bf16_t* vd = (LAS bf16_t*)(Vt + (8 * (2 * wid + i)) * 144 + lane * 2);
            vd[0 * 72] = (bf16_t)(vv.x & 0xffff); vd[1 * 72] = (bf16_t)(vv.x >> 16); vd[2 * 72] = (bf16_t)(vv.y & 0xffff); vd[3 * 72] = (bf16_t)(vv.y >> 16);
            vd[4 * 72] = (bf16_t)(vv.z & 0xffff); vd[5 * 72] = (bf16_t)(vv.z >> 16); vd[6 * 72] = (bf16_t)(vv.w & 0xffff); vd[7 * 72] = (bf16_t)(vv.w >> 16); }
        if (kt > 0) {
#pragma unroll
            for (int i = 0; i < 2; ++i) { const int idx = F.tid + NTHR * i, key = idx >> 4, c8 = idx & 15; const size_t kt1 = rowbase + 64 * (kt - 1);
                kvr[i] = *(const GAS u32x4*)(P + pidx(kt1 + key, C_SK + h * 128) + 8 * c8); vvr[i] = *(const GAS u32x4*)(P + pidx(kt1 + lane, C_SV + h * 128) + 8 * (2 * wid + i)); } }
        lds_barrier();
        if (64 * kt < q0 + 16 * wid + 15) {
            f32x4 sc[4];
#pragma unroll
            for (int j = 0; j < 4; ++j) { sc[j] = (f32x4){0.f, 0.f, 0.f, 0.f};
#pragma unroll
                for (int s = 0; s < 4; ++s) sc[j] = mfma16(ldsfrag(Ks + (16 * j + fr) * 272 + (32 * s + 8 * fq) * 2), qf[s], sc[j]); }
            float nk[4][4], lb[4][4], Tj[4], Wj[4], Gj[4];
            if (64 * kt + 64 <= q0 + 16 * wid) sb_elem<false>(sc, 64 * kt + 4 * fq, trow, nk, lb, Tj);
            else sb_elem<true>(sc, 64 * kt + 4 * fq, trow, nk, lb, Tj);
#pragma unroll
            for (int j = 0; j < 4; ++j) { const float a1 = __shfl_xor(Tj[j], 16), a2 = __shfl_xor(Tj[j], 32), a3 = __shfl_xor(Tj[j], 48);
                Wj[j] = Tj[j] + a1 + a2 + a3;
                Gj[j] = (((fq ^ 1) > fq) ? a1 : 0.f) + (((fq ^ 2) > fq) ? a2 : 0.f) + (((fq ^ 3) > fq) ? a3 : 0.f); }
            float suf = 0.f;
#pragma unroll
            for (int j = 3; j >= 0; --j) { float tl = R - suf - Gj[j]; f32x4 w;
                w[3] = __builtin_amdgcn_exp2f(lb[j][3] + tl); tl -= nk[j][3];
                w[2] = __builtin_amdgcn_exp2f(lb[j][2] + tl); tl -= nk[j][2];
                w[1] = __builtin_amdgcn_exp2f(lb[j][1] + tl); tl -= nk[j][1];
                w[0] = __builtin_amdgcn_exp2f(lb[j][0] + tl);
                *(LAS u32x2*)(Pw + fr * 144 + (16 * j + 4 * fq) * 2) = pack4(w);
                suf += Wj[j]; }
            R -= suf;
#pragma unroll
            for (int ks = 0; ks < 2; ++ks) { const bf16x8 pf = ldsfrag(Pw + fr * 144 + (32 * ks + 8 * fq) * 2);
#pragma unroll
                for (int dt = 0; dt < 8; ++dt) o[dt] = mfma16(ldsfrag(Vt + (16 * dt + fr) * 144 + (32 * ks + 8 * fq) * 2), pf, o[dt]); }
        }
        const float rm = wave_max(R);
        if (lane == 0) red[wid] = rm;
        lds_barrier();
        float mx = red[0];
#pragma unroll
        for (int w = 1; w < 8; ++w) mx = fmaxf(mx, red[w]);
        if (mx < -173.2f) break;
    }
    bf16_t* op = P + pidx(rowbase + trow, C_SQ + h * 128) + 4 * fq;
#pragma unroll
    for (int dt = 0; dt < 8; ++dt) *(GAS u32x2*)(op + 16 * dt) = pack4(o[dt]);
}

__device__ __forceinline__ void ret_kv_task(const Frame& F, const bf16_t* P, const f32x2* ROPE, bf16_t* RST, int b, int c, int h) {
    LAS unsigned char* KT = F.lds;
    LAS unsigned char* VT = F.lds + 18432;
    int lane = F.lane; asm volatile("" : "+v"(lane)); const int fr = lane & 15, fq = lane >> 4;
    const float l2g = log2gamma(h);
    lds_barrier();
    { const int s = lane, g8 = F.wave;     const size_t row = (size_t)b * SEQ + c * 64 + s; const int pos = c * 64 + s;
      const bf16_t* kp = P + pidx(row, C_RK + h * 128) + 8 * g8;
      const u32x4 k1 = *(const GAS u32x4*)kp, k2 = *(const GAS u32x4*)(kp + 64);
      float x1[8], x2[8]; unpack8(k1, x1); unpack8(k2, x2);
      const GAS f32x4* cp = (const GAS f32x4*)(ROPE + pos * 64 + 8 * g8);
      const float dec = __builtin_amdgcn_exp2f(l2g * (float)(63 - s)) * 0.08838834764831845f;
      LAS bf16_t* kd = (LAS bf16_t*)(KT + (8 * g8) * 144 + s * 2);
#pragma unroll
      for (int jj = 0; jj < 4; ++jj) { const f32x4 cs = cp[jj];
          { const int j = 2 * jj; const float y1 = (x1[j] * cs.x - x2[j] * cs.y) * dec, y2 = (x1[j] * cs.y + x2[j] * cs.x) * dec; kd[j * 72] = f2bf(y1); kd[(64 + j) * 72] = f2bf(y2); }
          { const int j = 2 * jj + 1; const float y1 = (x1[j] * cs.z - x2[j] * cs.w) * dec, y2 = (x1[j] * cs.w + x2[j] * cs.z) * dec; kd[j * 72] = f2bf(y1); kd[(64 + j) * 72] = f2bf(y2); } }
      const bf16_t* vp = P + pidx(row, C_RV + h * 128) + 16 * g8;
#pragma unroll
      for (int hh = 0; hh < 2; ++hh) { const u32x4 vv = *(const GAS u32x4*)(vp + 8 * hh);
          LAS bf16_t* vd = (LAS bf16_t*)(VT + (16 * g8 + 8 * hh) * 144 + s * 2);
          vd[0 * 72] = (bf16_t)(vv.x & 0xffff); vd[1 * 72] = (bf16_t)(vv.x >> 16); vd[2 * 72] = (bf16_t)(vv.y & 0xffff); vd[3 * 72] = (bf16_t)(vv.y >> 16);
          vd[4 * 72] = (bf16_t)(vv.z & 0xffff); vd[5 * 72] = (bf16_t)(vv.z >> 16); vd[6 * 72] = (bf16_t)(vv.w & 0xffff); vd[7 * 72] = (bf16_t)(vv.w >> 16); } }
    lds_barrier();
    const int w = F.wave;
    bf16x8 xf[2];
#pragma unroll
    for (int ks = 0; ks < 2; ++ks) xf[ks] = ldsfrag(KT + (16 * w + fr) * 144 + (32 * ks + 8 * fq) * 2);
    bf16_t* dst = RST + (size_t)((b * 128 + c) * 4 + h) * 16384;
#pragma unroll
    for (int et = 0; et < 8; ++et) { f32x4 acc = (f32x4){0.f, 0.f, 0.f, 0.f};
#pragma unroll
        for (int ks = 0; ks < 2; ++ks) acc = mfma16(xf[ks], ldsfrag(VT + (16 * et + fr) * 144 + (32 * ks + 8 * fq) * 2), acc);
        *(GAS u32x2*)(dst + (16 * et + fr) * 128 + 16 * w + 4 * fq) = pack4(acc); }
}

__device__ __forceinline__ void ret_out_task(const Frame& F, bf16_t* P, const f32x2* ROPE, const bf16_t* RST, const float* gn, int b, int c, int h, int xm = 0) {
    LAS unsigned char* Kr = F.lds;
    LAS unsigned char* VT = F.lds + 17408;
    LAS unsigned char* Sx = F.lds + 35840;
    LAS unsigned char* Pw = F.lds + 70656 + F.wave * 2304;
    LAS float* ssq = (LAS float*)(F.lds + 89088);
    int lane = F.lane; asm volatile("" : "+v"(lane)); const int fr = lane & 15, fq = lane >> 4, w = F.wave, lt = w & 3, eh = w >> 2;
    const float l2g = log2gamma(h);
    const int unit = (b * 128 + c) * 4 + h;
    lds_barrier();
    { const int s = F.tid >> 3, g8 = F.tid & 7; const size_t row = (size_t)b * SEQ + c * 64 + s; const int pos = c * 64 + s;
      const bf16_t* kp = P + pidx(row, C_RK + h * 128) + 8 * g8;
      const u32x4 k1 = *(const GAS u32x4*)kp, k2 = *(const GAS u32x4*)(kp + 64);
      float x1[8], x2[8], y1[8], y2[8]; unpack8(k1, x1); unpack8(k2, x2);
      const GAS f32x4* cp = (const GAS f32x4*)(ROPE + pos * 64 + 8 * g8);
#pragma unroll
      for (int jj = 0; jj < 4; ++jj) { const f32x4 cs = cp[jj];
          { const int j = 2 * jj; y1[j] = (x1[j] * cs.x - x2[j] * cs.y) * 0.08838834764831845f; y2[j] = (x1[j] * cs.y + x2[j] * cs.x) * 0.08838834764831845f; }
          { const int j = 2 * jj + 1; y1[j] = (x1[j] * cs.z - x2[j] * cs.w) * 0.08838834764831845f; y2[j] = (x1[j] * cs.w + x2[j] * cs.z) * 0.08838834764831845f; } }
      u32x4 o1, o2; o1.x = cvt_pk_bf16(y1[0], y1[1]); o1.y = cvt_pk_bf16(y1[2], y1[3]); o1.z = cvt_pk_bf16(y1[4], y1[5]); o1.w = cvt_pk_bf16(y1[6], y1[7]);
      o2.x = cvt_pk_bf16(y2[0], y2[1]); o2.y = cvt_pk_bf16(y2[2], y2[3]); o2.z = cvt_pk_bf16(y2[4], y2[5]); o2.w = cvt_pk_bf16(y2[6], y2[7]);
      *(LAS u32x4*)(Kr + s * 272 + (8 * g8) * 2) = o1; *(LAS u32x4*)(Kr + s * 272 + (64 + 8 * g8) * 2) = o2;
      const bf16_t* vp = P + pidx((size_t)b * SEQ + c * 64 + lane, C_RV + h * 128) + 16 * F.wave;
#pragma unroll
      for (int hh = 0; hh < 2; ++hh) { const u32x4 vv = *(const GAS u32x4*)(vp + 8 * hh);
          LAS bf16_t* vd = (LAS bf16_t*)(VT + (16 * F.wave + 8 * hh) * 144 + lane * 2);
          vd[0 * 72] = (bf16_t)(vv.x & 0xffff); vd[1 * 72] = (bf16_t)(vv.x >> 16); vd[2 * 72] = (bf16_t)(vv.y & 0xffff); vd[3 * 72] = (bf16_t)(vv.y >> 16);
          vd[4 * 72] = (bf16_t)(vv.z & 0xffff); vd[5 * 72] = (bf16_t)(vv.z >> 16); vd[6 * 72] = (bf16_t)(vv.w & 0xffff); vd[7 * 72] = (bf16_t)(vv.w >> 16); }
      const bf16_t* sp = RST + (size_t)unit * 16384;
#pragma unroll
      for (int i = 0; i < 4; ++i) { const int idx = F.tid + NTHR * i, e = idx >> 4, c16 = idx & 15;
          *(LAS u32x4*)(Sx + e * 272 + c16 * 16) = *(const GAS u32x4*)(sp + e * 128 + 8 * c16); } }
    const int l = 16 * lt + fr; const size_t qrow = (size_t)b * SEQ + c * 64 + l; const int qpos = c * 64 + l;
    bf16x8 qf[4];
    { const bf16_t* qp = P + pidx(qrow, C_RQ + h * 128) + 8 * fq;
      u32x4 qv[4];
#pragma unroll
      for (int s = 0; s < 4; ++s) qv[s] = *(const GAS u32x4*)(qp + 32 * s);
#pragma unroll
      for (int s = 0; s < 2; ++s) { float x1[8], x2[8], y1[8], y2[8]; unpack8(qv[s], x1); unpack8(qv[s + 2], x2);
          const GAS f32x4* cp = (const GAS f32x4*)(ROPE + qpos * 64 + 32 * s + 8 * fq);
#pragma unroll
          for (int jj = 0; jj < 4; ++jj) { const f32x4 cs = cp[jj];
              { const int j = 2 * jj; y1[j] = x1[j] * cs.x - x2[j] * cs.y; y2[j] = x1[j] * cs.y + x2[j] * cs.x; }
              { const int j = 2 * jj + 1; y1[j] = x1[j] * cs.z - x2[j] * cs.w; y2[j] = x1[j] * cs.w + x2[j] * cs.z; } }
          u32x4 o1, o2; o1.x = cvt_pk_bf16(y1[0], y1[1]); o1.y = cvt_pk_bf16(y1[2], y1[3]); o1.z = cvt_pk_bf16(y1[4], y1[5]); o1.w = cvt_pk_bf16(y1[6], y1[7]);
          o2.x = cvt_pk_bf16(y2[0], y2[1]); o2.y = cvt_pk_bf16(y2[2], y2[3]); o2.z = cvt_pk_bf16(y2[4], y2[5]); o2.w = cvt_pk_bf16(y2[6], y2[7]);
          qf[s] = __builtin_bit_cast(bf16x8, o1); qf[s + 2] = __builtin_bit_cast(bf16x8, o2); } }
    u32x2 gvr[4]; f32x4 ggr[4];
#pragma unroll
    for (int et = 0; et < 4; ++et) { const int e0 = 64 * eh + 16 * et + 4 * fq;
        gvr[et] = *(const GAS u32x2*)(P + pidx(qrow, C_RG + h * 128) + e0); ggr[et] = *(const GAS f32x4*)(gn + h * 128 + e0); }
    lds_barrier();
    if (xm == 1) return;
#pragma unroll
    for (int j = 0; j < 4; ++j) { f32x4 acc = (f32x4){0.f, 0.f, 0.f, 0.f};
#pragma unroll
        for (int ks = 0; ks < 4; ++ks) acc = mfma16(ldsfrag(Kr + (16 * j + fr) * 272 + (32 * ks + 8 * fq) * 2), qf[ks], acc);
#pragma unroll
        for (int i = 0; i < 4; ++i) { const int s = 16 * j + 4 * fq + i; acc[i] *= __builtin_amdgcn_exp2f(l2g * fabsf((float)(l - s))); }
        *(LAS u32x2*)(Pw + fr * 144 + (16 * j + 4 * fq) * 2) = pack4(acc); }
    f32x4 y[4];
    const float qdec = __builtin_amdgcn_exp2f(l2g * (float)(l + 1));
#pragma unroll
    for (int et = 0; et < 4; ++et) { y[et] = (f32x4){0.f, 0.f, 0.f, 0.f};
#pragma unroll
        for (int ks = 0; ks < 4; ++ks) y[et] = mfma16(ldsfrag(Sx + (64 * eh + 16 * et + fr) * 272 + (32 * ks + 8 * fq) * 2), qf[ks], y[et]);
        y[et] = y[et] * qdec; }
#pragma unroll
    for (int ks = 0; ks < 2; ++ks) { const bf16x8 pf = ldsfrag(Pw + fr * 144 + (32 * ks + 8 * fq) * 2);
#pragma unroll
        for (int et = 0; et < 4; ++et) y[et] = mfma16(ldsfrag(VT + (64 * eh + 16 * et + fr) * 144 + (32 * ks + 8 * fq) * 2), pf, y[et]); }
    float ss = 0.f;
#pragma unroll
    for (int et = 0; et < 4; ++et) ss += (y[et][0] * y[et][0] + y[et][1] * y[et][1]) + (y[et][2] * y[et][2] + y[et][3] * y[et][3]);
    ss += __shfl_xor(ss, 16); ss += __shfl_xor(ss, 32);
    if (fq == 0) ssq[w * 16 + fr] = ss;
    lds_barrier();
    const float rstd = rsqrtf((ssq[w * 16 + fr] + ssq[(w ^ 4) * 16 + fr]) * (1.f / 128.f) + EPS);
#pragma unroll
    for (int et = 0; et < 4; ++et) { const int e0 = 64 * eh + 16 * et + 4 * fq;
        const u32x2 gv = gvr[et]; const f32x4 gg = ggr[et];
        f32x4 r;
        r[0] = y[et][0] * rstd * gg[0] * silu_f(bf_lo(gv.x)); r[1] = y[et][1] * rstd * gg[1] * silu_f(bf_hi(gv.x));
        r[2] = y[et][2] * rstd * gg[2] * silu_f(bf_lo(gv.y)); r[3] = y[et][3] * rstd * gg[3] * silu_f(bf_hi(gv.y));
        *(GAS u32x2*)(P + pidx(qrow, C_RQ + h * 128) + e0) = pack4(r); }
}

__device__ __forceinline__ float softplus_f(float x) { return fmaxf(x, 0.f) + log1pf(__expf(-fabsf(x))); }
__device__ __forceinline__ void conv8(const bf16_t* P, const float* cw, const float* cb, int b, int tpos, int col, float* v) {
    const int chan = col - C_XBC;
    { const f32x4 b0 = *(const GAS f32x4*)(cb + chan), b1 = *(const GAS f32x4*)(cb + chan + 4);
      v[0] = b0.x; v[1] = b0.y; v[2] = b0.z; v[3] = b0.w; v[4] = b1.x; v[5] = b1.y; v[6] = b1.z; v[7] = b1.w; }
#pragma unroll
    for (int j = 0; j < 4; ++j) { const int ts = tpos - 3 + j;
        if (ts >= 0) { const u32x4 xv = *(const GAS u32x4*)(P + pidx((size_t)b * SEQ + ts, col)); float xf[8]; unpack8(xv, xf);
            const f32x4 w0 = *(const GAS f32x4*)(cw + j * 1024 + chan), w1 = *(const GAS f32x4*)(cw + j * 1024 + chan + 4);
            v[0] += xf[0] * w0.x; v[1] += xf[1] * w0.y; v[2] += xf[2] * w0.z; v[3] += xf[3] * w0.w; v[4] += xf[4] * w1.x; v[5] += xf[5] * w1.y; v[6] += xf[6] * w1.z; v[7] += xf[7] * w1.w; } }
#pragma unroll
    for (int i = 0; i < 8; ++i) v[i] = silu_f(v[i]);
}

template <bool TR, bool HASF>
__device__ __forceinline__ void conv_tile(const bf16_t* P, const float* cw, const float* cb, int b, int tpos0, int col, const float (&f)[8], u32x4 (&pk)[8]) {
    const int chan = col - C_XBC;
    float w[4][8], bias[8];
#pragma unroll
    for (int j = 0; j < 4; ++j) { const f32x4 w0 = *(const GAS f32x4*)(cw + j * 1024 + chan), w1 = *(const GAS f32x4*)(cw + j * 1024 + chan + 4);
        w[j][0] = w0.x; w[j][1] = w0.y; w[j][2] = w0.z; w[j][3] = w0.w; w[j][4] = w1.x; w[j][5] = w1.y; w[j][6] = w1.z; w[j][7] = w1.w; }
    { const f32x4 b0 = *(const GAS f32x4*)(cb + chan), b1 = *(const GAS f32x4*)(cb + chan + 4);
      bias[0] = b0.x; bias[1] = b0.y; bias[2] = b0.z; bias[3] = b0.w; bias[4] = b1.x; bias[5] = b1.y; bias[6] = b1.z; bias[7] = b1.w; }
    u32x4 rows[11];
    const bf16_t* base = P + pidx((size_t)b * SEQ + tpos0, col);
#pragma unroll
    for (int r = 0; r < 11; ++r) { rows[r] = (u32x4){0u, 0u, 0u, 0u}; if (tpos0 - 3 + r >= 0) rows[r] = *(const GAS u32x4*)(base + (long)(r - 3) * 128); }
    float prev[8];
#pragma unroll
    for (int t = 0; t < 8; ++t) {
        float a[8];
#pragma unroll
        for (int i = 0; i < 8; ++i) a[i] = bias[i];
#pragma unroll
        for (int j = 0; j < 4; ++j) { float xf[8]; unpack8(rows[t + j], xf);
#pragma unroll
            for (int i = 0; i < 8; ++i) a[i] += xf[i] * w[j][i]; }
#pragma unroll
        for (int i = 0; i < 8; ++i) { a[i] = silu_f(a[i]); if (HASF) a[i] *= f[t]; }
        if (TR) {
            if (t & 1) {
#pragma unroll
                for (int i = 0; i < 8; ++i) { const unsigned u = cvt_pk_bf16(prev[i], a[i]);
                    if ((t >> 1) == 0) pk[i].x = u; else if ((t >> 1) == 1) pk[i].y = u; else if ((t >> 1) == 2) pk[i].z = u; else pk[i].w = u; }
            } else {
#pragma unroll
                for (int i = 0; i < 8; ++i) prev[i] = a[i];
            }
        } else {
            pk[t].x = cvt_pk_bf16(a[0], a[1]); pk[t].y = cvt_pk_bf16(a[2], a[3]); pk[t].z = cvt_pk_bf16(a[4], a[5]); pk[t].w = cvt_pk_bf16(a[6], a[7]);
        }
    }
}
__device__ __forceinline__ float dt_scan(const float* DT, const float* dt_bias, const float* a_log, int b, int c, int hd, int lane, float& dtv) {
    const size_t t = (size_t)b * SEQ + c * 64 + lane;
    dtv = softplus_f(((const GAS float*)DT)[t * 8 + hd] + ((const GAS float*)dt_bias)[hd]);
    float x = dtv * (-__expf(((const GAS float*)a_log)[hd]));
#pragma unroll
    for (int o = 1; o < 64; o <<= 1) { const float y = __shfl_up(x, o); if (lane >= o) x += y; }
    return x;
}

__device__ __forceinline__ void ssd_state_task(const Frame& F, const bf16_t* P, const float* DT, const float* cw, const float* cb, const float* dt_bias, const float* a_log,
                                               bf16_t* SST, float* CD, int b, int c, int g) {
    LAS unsigned char* XT = F.lds;
    LAS unsigned char* BT = F.lds + 36864;
    LAS float* dtl = (LAS float*)(F.lds + 55296);
    LAS float* acl = (LAS float*)(F.lds + 56320);
    int lane = F.lane; asm volatile("" : "+v"(lane)); const int fr = lane & 15, fq = lane >> 4, w = F.wave;
    lds_barrier();
    if (w < 4) { float dtv; const float cum = dt_scan(DT, dt_bias, a_log, b, c, 4 * g + w, lane, dtv);
        dtl[lane * 4 + w] = dtv; acl[lane * 4 + w] = cum;
        if (lane == 63) ((GAS float*)CD)[(b * 128 + c) * 8 + 4 * g + w] = __expf(cum); }
    lds_barrier();
    if (F.tid < 384) { int tt = F.tid; asm volatile("" : "+v"(tt)); const int cgi = tt % 48, seg = tt / 48, s0 = 8 * seg;
        const int col = (cgi < 32) ? (C_XBC + g * 256 + 8 * cgi) : (C_XBC + 512 + g * 128 + 8 * (cgi - 32));
        float f[8]; u32x4 pk[8];
        if (cgi < 32) { const int hl = cgi >> 3; const float ae = acl[63 * 4 + hl];
#pragma unroll
            for (int t = 0; t < 8; ++t) f[t] = dtl[(s0 + t) * 4 + hl] * __expf(ae - acl[(s0 + t) * 4 + hl]); }
        else {
#pragma unroll
            for (int t = 0; t < 8; ++t) f[t] = 1.0f; }
        conv_tile<true, true>(P, cw, cb, b, c * 64 + s0, col, f, pk);
        LAS unsigned char* d = (cgi < 32) ? (XT + (8 * cgi) * 144 + s0 * 2) : (BT + (8 * (cgi - 32)) * 144 + s0 * 2);
#pragma unroll
        for (int i = 0; i < 8; ++i) *(LAS u32x4*)(d + i * 144) = pk[i]; }
    lds_barrier();
    const int hl = w >> 1, ph = w & 1;
    bf16x8 yf[2][2];
#pragma unroll
    for (int pt = 0; pt < 2; ++pt)
#pragma unroll
        for (int ks = 0; ks < 2; ++ks) yf[pt][ks] = ldsfrag(XT + (hl * 64 + ph * 32 + 16 * pt + fr) * 144 + (32 * ks + 8 * fq) * 2);
    bf16_t* dst = SST + (size_t)((b * 128 + c) * 8 + 4 * g + hl) * 8192;
#pragma unroll
    for (int nt = 0; nt < 8; ++nt) { f32x4 a0 = (f32x4){0.f, 0.f, 0.f, 0.f}, a1 = a0;
#pragma unroll
        for (int ks = 0; ks < 2; ++ks) { const bf16x8 xf = ldsfrag(BT + (16 * nt + fr) * 144 + (32 * ks + 8 * fq) * 2); a0 = mfma16(xf, yf[0][ks], a0); a1 = mfma16(xf, yf[1][ks], a1); }
#ifdef PROBE_CONST
        a0 = (f32x4){0.01f, 0.02f, 0.03f, 0.04f}; a1 = a0;
#endif
        *(GAS u32x2*)(dst + (ph * 32 + fr) * 128 + 16 * nt + 4 * fq) = pack4(a0);
        *(GAS u32x2*)(dst + (ph * 32 + 16 + fr) * 128 + 16 * nt + 4 * fq) = pack4(a1); }
}

__device__ __forceinline__ void ssd_out_task(const Frame& F, bf16_t* P, const float* DT, const float* cw, const float* cb, const float* dt_bias, const float* a_log,
                                             const float* d_skip, const float* nrm, const bf16_t* SST, int b, int c) {
    LAS unsigned char* Bs = F.lds;
    LAS unsigned char* Cs = F.lds + 17408;
    LAS unsigned char* XT = F.lds + 34816;
    LAS unsigned char* Pw = F.lds + 71680 + F.wave * 2304;
    LAS float* dtl = (LAS float*)(F.lds + 90112);
    LAS float* acl = (LAS float*)(F.lds + 92160);
    LAS float* ssq = (LAS float*)(F.lds + 94208);
    int lane = F.lane; asm volatile("" : "+v"(lane)); const int fr = lane & 15, fq = lane >> 4, w = F.wave, hl = w >> 1, half = w & 1;
    lds_barrier();
    { float dtv; const float cum = dt_scan(DT, dt_bias, a_log, b, c, w, lane, dtv); dtl[lane * 8 + w] = dtv; acl[lane * 8 + w] = cum; }
    float ssl[2] = {0.f, 0.f};
#pragma unroll 1
    for (int g = 0; g < 2; ++g) {
        const int head = 4 * g + hl;
        const bf16_t* hsrc = SST + (size_t)((b * 128 + c) * 8 + head) * 8192;
        bf16x8 hfr[4][4];
#pragma unroll
        for (int ks = 0; ks < 4; ++ks)
#pragma unroll
            for (int pt = 0; pt < 4; ++pt) hfr[ks][pt] = *(const GAS bf16x8*)(hsrc + (16 * pt + fr) * 128 + 32 * ks + 8 * fq);
        lds_barrier();
        { int tt = F.tid; asm volatile("" : "+v"(tt)); const int cgi = tt & 63, seg = tt >> 6, s0 = 8 * seg;
            const int col = (cgi < 32) ? (C_XBC + g * 256 + 8 * cgi) : (cgi < 48) ? (C_XBC + 512 + g * 128 + 8 * (cgi - 32)) : (C_XBC + 768 + g * 128 + 8 * (cgi - 48));
            const float f[8] = {1.f, 1.f, 1.f, 1.f, 1.f, 1.f, 1.f, 1.f}; u32x4 pk[8];
            if (cgi < 32) { conv_tile<true, false>(P, cw, cb, b, c * 64 + s0, col, f, pk);
                LAS unsigned char* d = XT + (8 * cgi) * 144 + s0 * 2;
#pragma unroll
                for (int i = 0; i < 8; ++i) *(LAS u32x4*)(d + i * 144) = pk[i]; }
            else { conv_tile<false, false>(P, cw, cb, b, c * 64 + s0, col, f, pk);
                LAS unsigned char* d = ((cgi < 48) ? (Bs + (8 * (cgi - 32)) * 2) : (Cs + (8 * (cgi - 48)) * 2)) + s0 * 272;
#pragma unroll
                for (int i = 0; i < 8; ++i) *(LAS u32x4*)(d + i * 272) = pk[i]; } }
        u32x2 zvr[2][4];
#pragma unroll
        for (int li = 0; li < 2; ++li)
#pragma unroll
            for (int pt = 0; pt < 4; ++pt) zvr[li][pt] = *(const GAS u32x2*)(P + pidx((size_t)b * SEQ + c * 64 + 16 * (2 * half + li) + fr, C_MZ + head * 64 + 16 * pt + 4 * fq));
        lds_barrier();
        const float dsk = ((const GAS float*)d_skip)[head];
#pragma unroll
        for (int li = 0; li < 2; ++li) {
            asm volatile("" ::: "memory"); __builtin_amdgcn_sched_barrier(0);
            const int lt = 2 * half + li, l = 16 * lt + fr;
            const float al = acl[l * 8 + head];
            bf16x8 cf[4];
#pragma unroll
            for (int ks = 0; ks < 4; ++ks) cf[ks] = ldsfrag(Cs + (16 * lt + fr) * 272 + (32 * ks + 8 * fq) * 2);
            f32x4 y[4];
#pragma unroll
            for (int pt = 0; pt < 4; ++pt) y[pt] = (f32x4){0.f, 0.f, 0.f, 0.f};
#pragma unroll
            for (int ks = 0; ks < 4; ++ks) {
#pragma unroll
                for (int pt = 0; pt < 4; ++pt) y[pt] = mfma16(hfr[ks][pt], cf[ks], y[pt]); }
            { const float eal = __expf(al);
#pragma unroll
              for (int pt = 0; pt < 4; ++pt) y[pt] = y[pt] * eal; }
#pragma unroll
            for (int st = 0; st < 4; ++st) { f32x4 acc = (f32x4){0.f, 0.f, 0.f, 0.f};
#pragma unroll
                for (int ks = 0; ks < 4; ++ks) acc = mfma16(ldsfrag(Bs + (16 * st + fr) * 272 + (32 * ks + 8 * fq) * 2), cf[ks], acc);
#pragma unroll
                for (int i = 0; i < 4; ++i) { const int s = 16 * st + 4 * fq + i;
                    acc[i] = (s <= l) ? acc[i] * __expf(al - acl[s * 8 + head]) * dtl[s * 8 + head] : 0.f; }
                *(LAS u32x2*)(Pw + fr * 144 + (16 * st + 4 * fq) * 2) = pack4(acc); }
#pragma unroll
            for (int ks = 0; ks < 2; ++ks) { if (2 * ks <= lt) { const bf16x8 pf = ldsfrag(Pw + fr * 144 + (32 * ks + 8 * fq) * 2);
#pragma unroll
                for (int pt = 0; pt < 4; ++pt) y[pt] = mfma16(ldsfrag(XT + (hl * 64 + 16 * pt + fr) * 144 + (32 * ks + 8 * fq) * 2), pf, y[pt]); } }
            const size_t row = (size_t)b * SEQ + c * 64 + l;
#pragma unroll
            for (int pt = 0; pt < 4; ++pt) { const int p0 = 16 * pt + 4 * fq;
                const u32x2 zv = zvr[li][pt];
                const LAS bf16_t* xp = (const LAS bf16_t*)(XT + (hl * 64 + p0) * 144 + l * 2);
                f32x4 r;
                r[0] = (y[pt][0] + bf2f(xp[0 * 72]) * dsk) * silu_f(bf_lo(zv.x)); r[1] = (y[pt][1] + bf2f(xp[1 * 72]) * dsk) * silu_f(bf_hi(zv.x));
                r[2] = (y[pt][2] + bf2f(xp[2 * 72]) * dsk) * silu_f(bf_lo(zv.y)); r[3] = (y[pt][3] + bf2f(xp[3 * 72]) * dsk) * silu_f(bf_hi(zv.y));
                ssl[li] += (r[0] * r[0] + r[1] * r[1]) + (r[2] * r[2] + r[3] * r[3]);
                *(GAS u32x2*)(P + pidx(row, C_MZ + head * 64 + p0)) = pack4(r); }
        }
    }
#pragma unroll
    for (int li = 0; li < 2; ++li) { float ss = ssl[li];
        ss += __shfl_xor(ss, 16); ss += __shfl_xor(ss, 32);
        if (fq == 0) ssq[hl * 64 + 16 * (2 * half + li) + fr] = ss; }
    asm volatile("s_waitcnt vmcnt(0)" ::: "memory");
    lds_barrier();
#pragma unroll
    for (int li = 0; li < 2; ++li) { const int l = 16 * (2 * half + li) + fr;
        const float rstd = rsqrtf((ssq[l] + ssq[64 + l] + ssq[128 + l] + ssq[192 + l]) * (1.f / 512.f) + EPS);
        const size_t row = (size_t)b * SEQ + c * 64 + l;
#pragma unroll 1
        for (int g = 0; g < 2; ++g)
#pragma unroll
            for (int pt = 0; pt < 4; ++pt) { const int ch = (4 * g + hl) * 64 + 16 * pt + 4 * fq;
                const f32x4 ng = *(const GAS f32x4*)(nrm + ch);
                GAS u32x2* yp = (GAS u32x2*)(P + pidx(row, C_MZ + ch));
                const u32x2 pk = *yp; const f32x4 r = (f32x4){bf_lo(pk.x), bf_hi(pk.x), bf_lo(pk.y), bf_hi(pk.y)};
                *yp = pack4(r * rstd * ng); } }
}

__device__ __forceinline__ void scan_phase(const Frame& F, bf16_t* RST, bf16_t* SST, const float* CD) {
    for (int task = F.bid * NTHR + F.tid; task < 131072; task += F.G * NTHR) {
        {
          const int pr = task & 8191, bh = task >> 13, b = bh >> 2, h = bh & 3;
          GAS unsigned* p = (GAS unsigned*)(RST + (size_t)((b * 128) * 4 + h) * 16384) + pr;
          const float dec = __builtin_amdgcn_exp2f(64.f * log2gamma(h));
          float s0 = 0.f, s1 = 0.f;
#pragma unroll 1
          for (int c0 = 0; c0 < 128; c0 += 32) { unsigned v[32];
#pragma unroll
              for (int i = 0; i < 32; ++i) v[i] = p[(size_t)(c0 + i) * 32768];
#pragma unroll
              for (int i = 0; i < 32; ++i) { p[(size_t)(c0 + i) * 32768] = cvt_pk_bf16(s0, s1); s0 = s0 * dec + bf_lo(v[i]); s1 = s1 * dec + bf_hi(v[i]); } } }
        {
          const int pr = task & 4095, bh = task >> 12, b = bh >> 3, hd = bh & 7;
          GAS unsigned* p = (GAS unsigned*)(SST + (size_t)((b * 128) * 8 + hd) * 8192) + pr;
          const GAS float* cd = (const GAS float*)(CD + (b * 128) * 8 + hd);
          float s0 = 0.f, s1 = 0.f;
#pragma unroll 1
          for (int c0 = 0; c0 < 128; c0 += 32) { unsigned v[32]; float d[32];
#pragma unroll
              for (int i = 0; i < 32; ++i) { v[i] = p[(size_t)(c0 + i) * 32768]; d[i] = cd[(c0 + i) * 8]; }
#pragma unroll
              for (int i = 0; i < 32; ++i) { p[(size_t)(c0 + i) * 32768] = cvt_pk_bf16(s0, s1); s0 = s0 * d[i] + bf_lo(v[i]); s1 = s1 * d[i] + bf_hi(v[i]); } } }
    }
}


#define XB_TMO      128
#define XB_XCNT(j)  (256  + 64 * (j))
#define XB_XSUB(j)  (1280 + 64 * (j))
#define XB_XGEN(j)  (2304 + 64 * (j))
#define XB_TOP      3328
#define XB_TOPGEN   3392
#define XB_SPIN_CAP (1u << 22)
__device__ __forceinline__ unsigned xb_ld(unsigned* p)              { return __hip_atomic_load(p, __ATOMIC_RELAXED, __HIP_MEMORY_SCOPE_AGENT); }
__device__ __forceinline__ unsigned xb_add(unsigned* p, unsigned v) { return __hip_atomic_fetch_add(p, v, __ATOMIC_RELAXED, __HIP_MEMORY_SCOPE_AGENT); }
__device__ __forceinline__ unsigned xb_xcc_id() { return (unsigned)__builtin_amdgcn_s_getreg((3 << 11) | 20) & 0xFu; }
#define XB_SPIN(cond, bar) do { unsigned _sp = 0; while (cond) { __builtin_amdgcn_s_sleep(1); \
    if ((++_sp & 255u) == 0u) { if (xb_ld(&(bar)[XB_TMO])) break; if (_sp > XB_SPIN_CAP) { atomicAdd(&(bar)[XB_TMO], 1u); break; } } } } while (0)
struct XcdBarrier { unsigned* bar; unsigned x; volatile LAS unsigned* st; };
__device__ __forceinline__ XcdBarrier xcd_barrier_post(unsigned* bar, volatile LAS unsigned* st) {
    XcdBarrier b; b.bar = bar; b.x = xb_xcc_id(); b.st = st;
    if (threadIdx.x == 0) (void)xb_add(&bar[XB_XCNT(b.x)], 1u);
    return b;
}
__device__ __forceinline__ void xcd_barrier_complete(unsigned* bar, unsigned x, unsigned& nloc, unsigned& nx) {
    const unsigned G = gridDim.x * gridDim.y * gridDim.z;
    unsigned sum, cnt, mine, sp = 0u;
    for (;;) {
        sum = 0u; cnt = 0u; mine = 0u;
#pragma unroll
        for (unsigned j = 0; j < 16; ++j) { const unsigned c = xb_ld(&bar[XB_XCNT(j)]); sum += c; cnt += (c > 0u) ? 1u : 0u; mine = (j == x) ? c : mine; }
        if (sum == G) break;
        __builtin_amdgcn_s_sleep(1);
        if ((++sp & 255u) == 0u) { if (xb_ld(&bar[XB_TMO])) break; if (sp > XB_SPIN_CAP) { atomicAdd(&bar[XB_TMO], 1u); break; } }
    }
    nloc = mine > 0u ? mine : 1u; nx = cnt > 0u ? cnt : 1u;
}
__device__ __forceinline__ void xcd_barrier(const XcdBarrier& b) {
    asm volatile("s_waitcnt vmcnt(0)" ::: "memory");
    __syncthreads();
    if (threadIdx.x == 0) {
        unsigned* bar = b.bar;
        __builtin_amdgcn_s_waitcnt(0);
        unsigned nloc = b.st[0], nx = b.st[1];
        if (nloc == 0u) { xcd_barrier_complete(bar, b.x, nloc, nx); b.st[0] = nloc; b.st[1] = nx; }
        const unsigned old = xb_add(&bar[XB_XSUB(b.x)], 1u);
        const unsigned gen = old / nloc;
        if (old + 1u == (gen + 1u) * nloc) {
            __builtin_amdgcn_fence(__ATOMIC_RELEASE, "agent");
            asm volatile("s_waitcnt vmcnt(0)" ::: "memory");
            const unsigned og = xb_add(&bar[XB_TOP], 1u);
            const unsigned tg = og / nx;
            if (og + 1u == (tg + 1u) * nx) xb_add(&bar[XB_TOPGEN], 1u);
            else XB_SPIN(xb_ld(&bar[XB_TOPGEN]) == tg, bar);
            __builtin_amdgcn_fence(__ATOMIC_ACQUIRE, "agent");
            xb_add(&bar[XB_XGEN(b.x)], 1u);
            asm volatile("s_waitcnt vmcnt(0)" ::: "memory");
        } else {
            XB_SPIN(xb_ld(&bar[XB_XGEN(b.x)]) == gen, bar);
            __builtin_amdgcn_fence(__ATOMIC_ACQUIRE, "agent");
            asm volatile("s_waitcnt vmcnt(0)" ::: "memory");
        }
    }
    __syncthreads();
}

constexpr int NPH = 26;
__global__ void __launch_bounds__(NTHR, 2) fwd_kernel(Params p) {
    extern __shared__ __attribute__((aligned(16))) unsigned char lds_raw[];
    volatile LAS unsigned* xb_st = (volatile LAS unsigned*)((LAS unsigned char*)lds_raw + LDS_BYTES - 64);
    if (threadIdx.x == 0) { xb_st[0] = 0u; xb_st[1] = 0u; }
    __syncthreads();
    const XcdBarrier xbar = xcd_barrier_post((unsigned*)p.ws, xb_st);
    if (p.ph_lo == 0) {
        Frame F0; F0.lds = (LAS unsigned char*)lds_raw; F0.tid = threadIdx.x; F0.lane = F0.tid & 63; F0.wave = __builtin_amdgcn_readfirstlane(F0.tid >> 6); F0.G = gridDim.x; F0.bid = blockIdx.x;
        if (EN_PRO) prologue(F0, p, as_global(p.ws), 0);
        if (p.ph_hi > 1) cg::this_grid().sync();
    }
#ifdef TPROBE
    unsigned long long tA = 0, tB = 0;
#endif
    for (int ph_ = (p.ph_lo < 1 ? 1 : p.ph_lo); ph_ < p.ph_hi; ++ph_) {
#ifdef TPROBE
    const unsigned long long tp0 = __builtin_amdgcn_s_memrealtime();
#endif
    int ph = __builtin_amdgcn_readfirstlane(ph_);
#ifdef PH_LIMIT
    if (ph > PH_LIMIT && ph < NPH - 1) continue;
#endif
    int tid_ = threadIdx.x; asm volatile("" : "+v"(tid_));
    unsigned char* ws_ = p.ws; asm volatile("" : "+s"(ws_)); unsigned char* ws = as_global(ws_);
    int zi = 0; asm volatile("" : "+s"(zi));
    Frame F;
    F.lds = (LAS unsigned char*)lds_raw;
    F.tid = tid_; F.lane = F.tid & 63; F.wave = __builtin_amdgcn_readfirstlane(F.tid >> 6); { int g_ = gridDim.x, b_ = blockIdx.x; asm volatile("" : "+s"(g_), "+s"(b_)); F.G = g_; F.bid = b_; }
    float* MOD = (float*)(ws + WS_MOD);
    const f32x2* ROPE = (const f32x2*)(ws + WS_ROPE);
    float* DT = (float*)(ws + WS_DT);
    float* CD = (float*)(ws + WS_CD);
    bf16_t* WFU = (bf16_t*)(ws + WS_WFU); bf16_t* WFD = (bf16_t*)(ws + WS_WFD); bf16_t* WIN = (bf16_t*)(ws + WS_WIN); bf16_t* WOUT = (bf16_t*)(ws + WS_WOUT);
    bf16_t* U = (bf16_t*)(ws + WS_U); bf16_t* RST = (bf16_t*)(ws + WS_RST); bf16_t* SST = (bf16_t*)(ws + WS_SST);
    bf16_t* PROJ = (bf16_t*)(ws + WS_PROJ); bf16_t* HID = PROJ;
    float* hbuf_ = p.out; asm volatile("" : "+s"(hbuf_)); float* hbuf = as_global(hbuf_);
        if (ph == NPH - 1) {
            if (EN_FIN) final_phase(F, hbuf, as_global(p.in[24 + zi]), MOD + FMOD_OFF);
        } else {
#ifdef XTRA_LIST
            static constexpr int xtra[] = XTRA_LIST;
            const int l = (ph >= NPH) ? 1 : (ph - 1) / 12, j = (ph >= NPH) ? xtra[ph - NPH] : (ph - 1) % 12;
#else
            const int l = (ph - 1) / 12, j = (ph - 1) % 12;
#endif
            const float* modl = MOD + (size_t)l * 4 * 9216;
            if (j == 0 || j == 3 || j == 9) {
                const float* hin = (l == 0 && j == 0) ? as_global(p.in[0 + zi]) : hbuf;
                const int gi = (j == 0) ? 4 : (j == 3) ? 8 : 18;
                const int mi = (j == 0) ? 0 : (j == 3) ? 3 : 6;
                if (EN_NORM) norm_phase(F, hin, as_global(p.in[gi + zi]) + l * DM, modl + mi * 1024, modl + (mi + 1) * 1024, 9216, U);
                __syncthreads();
                if (!EN_CONV) {} else if (j == 0) convert_ffn(F, as_global(p.in[5 + zi]) + (size_t)l * DM * DFF, as_global(p.in[6 + zi]) + (size_t)l * DM * DFF, as_global(p.in[7 + zi]) + (size_t)l * DM * DFF, WFU, WFD);
                else if (j == 9) convert_ffn(F, as_global(p.in[19 + zi]) + (size_t)l * DM * DFF, as_global(p.in[20 + zi]) + (size_t)l * DM * DFF, as_global(p.in[21 + zi]) + (size_t)l * DM * DFF, WFU, WFD);
                else convert_mix(F, as_global(p.in[9 + zi]) + (size_t)l * DM * INW, as_global(p.in[17 + zi]) + (size_t)l * 1536 * DM, WIN, WOUT);
            } else if (j == 1 || j == 10) {
                pg8::Gemm g{U, WFU, T_TOK, 2 * DFF, DM, DM}; pg8::StaticOrder S; S.init(T_TOK, 2 * DFF, F.G, F.bid);
                pg8::EpiSwiGLU E{HID, DFF};
                if (EN_G1) pg8::gemm_phase<pg8::EpiSwiGLU>(F.lds, F.tid, g, S, E);
            } else if (j == 2 || j == 11 || j == 8) {
                pg8::Gemm g; pg8::EpiResid E;
                if (j == 8) { g = pg8::Gemm{PROJ, WOUT, T_TOK, DM, 1536, PW}; E = pg8::EpiResid{hbuf, hbuf, modl + 5 * 1024, 1.0f}; }
                else { g = pg8::Gemm{HID, WFD, T_TOK, DM, DFF, DFF}; E = pg8::EpiResid{(l == 0 && j == 2) ? as_global(p.in[0 + zi]) : hbuf, hbuf, modl + (j == 2 ? 2 : 8) * 1024, 0.5f}; }
                pg8::StaticOrder S; S.init(T_TOK, DM, F.G, F.bid);
                if (EN_G2) { if (j == 8) pg8::gemm_phase<pg8::EpiResid, true>(F.lds, F.tid, g, S, E); else pg8::gemm_phase<pg8::EpiResid, false>(F.lds, F.tid, g, S, E); }
            } else if (j == 4) {
                pg8::Gemm g{U, WIN, T_TOK, PW, DM, DM}; pg8::StaticOrder S; S.init(T_TOK, PW, F.G, F.bid);
                pg8::EpiBf16 E{PROJ, PW};
                if (EN_G3) pg8::gemm_phase<pg8::EpiBf16>(F.lds, F.tid, g, S, E);
                if (EN_DT) dt_gemv(F, U, as_global(p.in[9 + zi]) + (size_t)l * DM * INW, DT);
            } else if (j == 5) {
                if (EN_SB && XS(1)) for (int t = F.bid; t < 1024; t += F.G) { const int qb = 63 - (t >> 4), bh = t & 15; sb_task(F, PROJ, bh >> 2, bh & 3, qb); }
                if (EN_RKV && XS(2)) for (int t = F.bid; t < 2048; t += F.G) { const int h = t & 3, bc = t >> 2; ret_kv_task(F, PROJ, ROPE, RST, bc >> 7, bc & 127, h); }
                if (EN_SST && XS(4)) for (int t = F.bid; t < 1024; t += F.G) { const int g = t & 1, bc = t >> 1;
                    ssd_state_task(F, PROJ, DT, as_global(p.in[10 + zi]) + l * 4096, as_global(p.in[11 + zi]) + l * 1024, as_global(p.in[12 + zi]) + l * 8, as_global(p.in[13 + zi]) + l * 8, SST, CD, bc >> 7, bc & 127, g); }
            } else if (j == 6) {
                if (EN_SCAN) scan_phase(F, RST, SST, CD);
            } else if (j == 7) {
                if (EN_ROUT && XS(8)) for (int t = F.bid; t < 2048; t += F.G) { const int h = t & 3, bc = t >> 2; ret_out_task(F, PROJ, ROPE, RST, as_global(p.in[15 + zi]) + l * 512, bc >> 7, bc & 127, h, ph >= NPH ? XMODE : 0); }
                if (EN_SOUT && XS(16)) for (int t = F.bid; t < 512; t += F.G) {
                    ssd_out_task(F, PROJ, DT, as_global(p.in[10 + zi]) + l * 4096, as_global(p.in[11 + zi]) + l * 1024, as_global(p.in[12 + zi]) + l * 8, as_global(p.in[13 + zi]) + l * 8, as_global(p.in[14 + zi]) + l * 8, as_global(p.in[16 + zi]) + l * 512, SST, t >> 7, t & 127); }
            }
        }
        if (ph + 1 < p.ph_hi) { xcd_barrier(xbar); }
#ifdef TPROBE
        { const unsigned long long tp1 = __builtin_amdgcn_s_memrealtime(); const int jj = (ph - 1) % 12;
          if (ph < NPH - 1) { if (TPROBE_A(jj)) tA += tp1 - tp0; if (TPROBE_B(jj)) tB += tp1 - tp0; } }
#endif
    }
#ifdef TPROBE
    cg::this_grid().sync();
    if (blockIdx.x == 0) { const float a = (float)tA * 0.01f, b = (float)tB * 0.01f * TPROBE_BS;
        if (threadIdx.x == 0) p.out[0] += a;
        for (int i = threadIdx.x; i < (1 << 20); i += NTHR) p.out[1024 + i] += b; }
#endif
}

extern "C" void kernel_launch(void* const* d_in, const int* in_sizes, int n_in, void* d_out, int out_size, void* d_ws, size_t ws_size, hipStream_t stream) {
    static int grid = 0;
    if (grid == 0) {
        if (n_in != 25 || out_size != T_TOK * DM || ws_size < WS_END) { fprintf(stderr, "kernel_launch: unexpected shapes (n_in %d out %d ws %zu)\n", n_in, out_size, ws_size); grid = -1; return; }
        int dev = 0, cus = 0, per_cu = 0;
        hipGetDevice(&dev);
        hipDeviceGetAttribute(&cus, hipDeviceAttributeMultiprocessorCount, dev);
        hipFuncSetAttribute((const void*)fwd_kernel, hipFuncAttributeMaxDynamicSharedMemorySize, LDS_BYTES);
        hipOccupancyMaxActiveBlocksPerMultiprocessor(&per_cu, (const void*)fwd_kernel, NTHR, LDS_BYTES);
        if (per_cu < 1) per_cu = 1;
        (void)hipGetLastError();
        grid = cus * per_cu;
    }
    if (grid < 0) return;
    (void)hipMemsetAsync(d_ws, 0, 65536, stream);
    Params p{};
    for (int i = 0; i < 25; ++i) p.in[i] = (const float*)d_in[i];
    p.out = (float*)d_out; p.ws = (unsigned char*)d_ws;
#if ONE_LAUNCH
#ifdef XTRA_LIST
    p.ph_lo = 0; p.ph_hi = NPH + XTRA_N;
#else
    p.ph_lo = 0; p.ph_hi = NPH;
#endif
    void* args[] = {&p};
    hipError_t e = hipLaunchCooperativeKernel((const void*)fwd_kernel, dim3(grid), dim3(NTHR), args, LDS_BYTES, stream);
    if (e != hipSuccess) fprintf(stderr, "cooperative launch failed: %s (grid %d)\n", hipGetErrorString(e), grid);
#else
    for (int ph = 0; ph < NPH; ++ph) { p.ph_lo = ph; p.ph_hi = ph + 1; hipLaunchKernelGGL(fwd_kernel, dim3(grid), dim3(NTHR), LDS_BYTES, stream, p); }
#endif
}
```

```cpp
#include <hip/hip_runtime.h>
#include <hip/hip_cooperative_groups.h>
#include <cstdint>
#include <cstdio>
namespace cg = cooperative_groups;

#ifndef ONE_LAUNCH
#define ONE_LAUNCH 1
#endif

#ifndef EN_ALL
#define EN_ALL 1
#endif
#ifndef EN_PRO
#define EN_PRO EN_ALL
#endif
#ifndef EN_FIN
#define EN_FIN EN_ALL
#endif
#ifndef EN_NORM
#define EN_NORM EN_ALL
#endif
#ifndef EN_CONV
#define EN_CONV EN_ALL
#endif
#ifndef EN_G1
#define EN_G1 EN_ALL
#endif
#ifndef EN_G2
#define EN_G2 EN_ALL
#endif
#ifndef EN_G3
#define EN_G3 EN_ALL
#endif
#ifndef EN_DT
#define EN_DT EN_ALL
#endif
#ifndef EN_SB
#define EN_SB EN_ALL
#endif
#ifndef EN_RKV
#define EN_RKV EN_ALL
#endif
#ifndef EN_SST
#define EN_SST EN_ALL
#endif
#ifndef EN_SCAN
#define EN_SCAN EN_ALL
#endif
#ifndef EN_ROUT
#define EN_ROUT EN_ALL
#endif
#ifndef EN_SOUT
#define EN_SOUT EN_ALL
#endif
#ifndef EN_SINTER
#define EN_SINTER 1
#endif
#ifndef XSEL
#define XSEL 31
#endif
#define XS(m) (ph < NPH || (XSEL & (m)))
#ifndef XMODE
#define XMODE 0
#endif
#define LAS __attribute__((address_space(3)))
#define GAS __attribute__((address_space(1)))
template <class T> __device__ __forceinline__ T* as_global(T* p) {
#if defined(__HIP_DEVICE_COMPILE__)
    __builtin_assume(!__builtin_amdgcn_is_shared((const void*)p)); __builtin_assume(!__builtin_amdgcn_is_private((const void*)p));
#endif
    return p; }
typedef unsigned short bf16_t;
typedef short bf16x8 __attribute__((ext_vector_type(8)));
typedef float f32x4 __attribute__((ext_vector_type(4)));
typedef float f32x2 __attribute__((ext_vector_type(2)));
typedef unsigned u32x4 __attribute__((ext_vector_type(4)));
typedef unsigned u32x2 __attribute__((ext_vector_type(2)));

constexpr int T_TOK = 32768, SEQ = 8192, DM = 1024, DFF = 2816, INW = 5128, PW = 5120;
constexpr int NTHR = 512, NWAVE = 8;
constexpr float EPS = 1e-6f;
constexpr int C_RQ = 0, C_SQ = 512, C_MZ = 1024, C_RK = 1536, C_RV = 2048, C_RG = 2560, C_SK = 3072, C_SV = 3584, C_XBC = 4096;

constexpr size_t MiB = 1u << 20;
constexpr size_t WS_MOD = 1 * MiB, WS_ROPE = 2 * MiB, WS_DT = 6 * MiB, WS_CD = 7 * MiB;
constexpr size_t WS_WFU = 8 * MiB, WS_WFD = 19 * MiB, WS_WIN = 25 * MiB, WS_WOUT = 35 * MiB;
constexpr size_t WS_U = 38 * MiB, WS_RST = 38 * MiB, WS_SST = 102 * MiB, WS_PROJ = 166 * MiB, WS_END = 486 * MiB;
constexpr int FMOD_OFF = 2 * 4 * 9 * 1024;

constexpr size_t PLANE = (size_t)T_TOK * 128;
__device__ __forceinline__ size_t pidx(size_t row, int col) { return (size_t)(col >> 7) * PLANE + row * 128 + (col & 127); }
constexpr int LDS_BYTES = 147456;

struct Params {
    const float* in[25];
    float* out;
    unsigned char* ws;
    int ph_lo, ph_hi;
};

typedef __bf16 bf16x2_t __attribute__((ext_vector_type(2)));
__device__ __forceinline__ unsigned cvt_pk_bf16(float lo, float hi) { const f32x2 v = {lo, hi}; const bf16x2_t b = __builtin_convertvector(v, bf16x2_t); return __builtin_bit_cast(unsigned, b); }
__device__ __forceinline__ float bf_lo(unsigned u) { return __uint_as_float(u << 16); }
__device__ __forceinline__ float bf_hi(unsigned u) { return __uint_as_float(u & 0xffff0000u); }
__device__ __forceinline__ float bf2f(bf16_t x) { return __uint_as_float(((unsigned)x) << 16); }
__device__ __forceinline__ bf16_t f2bf(float f) { return (bf16_t)(cvt_pk_bf16(f, 0.f) & 0xffffu); }
__device__ __forceinline__ float wave_sum(float v) {
#pragma unroll
    for (int o = 1; o < 64; o <<= 1) v += __shfl_xor(v, o);
    return v;
}
__device__ __forceinline__ float wave_max(float v) {
#pragma unroll
    for (int o = 1; o < 64; o <<= 1) v = fmaxf(v, __shfl_xor(v, o));
    return v;
}
__device__ __forceinline__ void lds_barrier() { asm volatile("s_waitcnt lgkmcnt(0)" ::: "memory"); __builtin_amdgcn_s_barrier(); asm volatile("" ::: "memory"); }
__device__ __forceinline__ float silu_f(float g) { return g * __builtin_amdgcn_rcpf(1.0f + __builtin_amdgcn_exp2f(-1.44269504f * g)); }
__device__ __forceinline__ f32x4 mfma16(bf16x8 a, bf16x8 b, f32x4 c) { return __builtin_amdgcn_mfma_f32_16x16x32_bf16(a, b, c, 0, 0, 0); }
__device__ __forceinline__ bf16x8 ldsfrag(const LAS unsigned char* p) { return *(const LAS bf16x8*)p; }
__device__ __forceinline__ u32x2 pack4(f32x4 v) { u32x2 w; w.x = cvt_pk_bf16(v[0], v[1]); w.y = cvt_pk_bf16(v[2], v[3]); return w; }
__device__ __forceinline__ void unpack8(u32x4 v, float* f) {
    f[0] = bf_lo(v.x); f[1] = bf_hi(v.x); f[2] = bf_lo(v.y); f[3] = bf_hi(v.y); f[4] = bf_lo(v.z); f[5] = bf_hi(v.z); f[6] = bf_lo(v.w); f[7] = bf_hi(v.w);
}
__device__ __forceinline__ float log2gamma(int h) { return h == 0 ? -0.04580368961312479f : (h == 1 ? -0.02272007650008353f : (h == 2 ? -0.011315313227834146f : -0.005646563141142063f)); }

namespace pg8 {
constexpr int BM = 256, BK = 64, HALF = 128, HTB = HALF * BK * 2, STAGE_BYTES = 8 * HTB, NXCD = 8, WGM = 8;
__host__ __device__ __forceinline__ int lds_byte(int r, int c) { const int st = (r >> 4) * 2 + (c >> 5), rr = r & 15, cc = c & 31, ob = rr * 64 + cc * 2; return st * 1024 + (ob ^ (((ob >> 9) & 1) << 5)); }
__host__ __device__ __forceinline__ void stage_rc(int b, int& R, int& C) { const int st = b / 1024, sb = b % 1024, swz = sb ^ (((sb >> 9) & 1) << 5); R = (st >> 1) * 16 + swz / 64; C = (st & 1) * 32 + (swz % 64) / 2; }
__host__ __device__ __forceinline__ int perm32(int rho) { const int n = rho >> 4, i = rho & 15; return 8 * (i >> 2) + 4 * n + (i & 3); }
struct Unit { int pm, pn; };
struct Gemm { const bf16_t* A; const bf16_t* Bt; int M, N, K, lda; };
struct StaticOrder {
    int nM, nN, nwg, G, c;
    __device__ void init(int M, int N, int G_, int c_) { nM = M / BM; nN = N / BM; nwg = nM * nN; G = G_; c = c_; }
    __device__ bool next(int i, Unit& u) const {
        const long L = (long)i * G + c; if (L >= nwg) return false;
        int wgid = (int)L; { const int q = nwg / NXCD, r = nwg % NXCD, xcd = wgid % NXCD, off = wgid / NXCD; wgid = (xcd < r ? xcd * (q + 1) : r * (q + 1) + (xcd - r) * q) + off; }
        const int nig = WGM * nN, gid = wgid / nig, fm = gid * WGM, gsz = (nM - fm) < WGM ? (nM - fm) : WGM;
        u.pm = fm + ((wgid % nig) % gsz); u.pn = (wgid % nig) / gsz; return true;
    }
};
struct EpiBf16 {
    bf16_t* O; int ldc;
    __device__ __forceinline__ void operator()(const f32x4 (&acc)[2][2][4][2], const Unit& u, int wr, int wc, int fr, int fq) const {
        const int row0 = u.pm * BM + wr * 64 + fr, col0 = u.pn * BM + wc * 32 + 8 * fq;
#pragma unroll
        for (int ai = 0; ai < 2; ++ai)
#pragma unroll
            for (int m = 0; m < 4; ++m) { bf16_t* rowp = O + (size_t)(2 * u.pn) * PLANE + (size_t)(row0 + ai * HALF + m * 16) * 128 + wc * 32 + 8 * fq;
#pragma unroll
                for (int bj = 0; bj < 2; ++bj) { const f32x4 v0 = acc[ai][bj][m][0], v1 = acc[ai][bj][m][1];
                    u32x4 w; w.x = cvt_pk_bf16(v0[0], v0[1]); w.y = cvt_pk_bf16(v0[2], v0[3]); w.z = cvt_pk_bf16(v1[0], v1[1]); w.w = cvt_pk_bf16(v1[2], v1[3]);
                    *(GAS u32x4*)(rowp + bj * PLANE) = w; } }
    }
};
struct EpiSwiGLU {
    bf16_t* O; int ldo;
    __device__ __forceinline__ void operator()(const f32x4 (&acc)[2][2][4][2], const Unit& u, int wr, int wc, int fr, int fq) const {
        const int row0 = u.pm * BM + wr * 64 + fr, col0 = u.pn * HALF + wc * 32 + 8 * fq;
#pragma unroll
        for (int ai = 0; ai < 2; ++ai)
#pragma unroll
            for (int m = 0; m < 4; ++m) { bf16_t* rowp = O + (size_t)(row0 + ai * HALF + m * 16) * ldo + col0;
                float hv[8];
#pragma unroll
                for (int n = 0; n < 2; ++n)
#pragma unroll
                    for (int i = 0; i < 4; ++i) hv[4 * n + i] = silu_f(acc[ai][0][m][n][i]) * acc[ai][1][m][n][i];
                u32x4 w; w.x = cvt_pk_bf16(hv[0], hv[1]); w.y = cvt_pk_bf16(hv[2], hv[3]); w.z = cvt_pk_bf16(hv[4], hv[5]); w.w = cvt_pk_bf16(hv[6], hv[7]);
                *(GAS u32x4*)rowp = w; }
    }
};
struct EpiResid {
    const float* hin; float* hout; const float* gate; float cmul;
    __device__ __forceinline__ void operator()(const f32x4 (&acc)[2][2][4][2], const Unit& u, int wr, int wc, int fr, int fq) const {
        const int row0 = u.pm * BM + wr * 64 + fr, col0 = u.pn * BM + wc * 32 + 8 * fq;
        const int b = (u.pm * BM) >> 13;
        f32x4 gm[2][2];
#pragma unroll
        for (int bj = 0; bj < 2; ++bj)
#pragma unroll
            for (int n = 0; n < 2; ++n) { const f32x4 g = *(const GAS f32x4*)(gate + (size_t)b * 9216 + col0 + bj * HALF + 4 * n); gm[bj][n] = (g + 1.0f) * cmul; }
#pragma unroll
        for (int ai = 0; ai < 2; ++ai) {
            f32x4 hv[4][2][2];
#pragma unroll
            for (int m = 0; m < 4; ++m) { const size_t off = (size_t)(row0 + ai * HALF + m * 16) * DM + col0;
#pragma unroll
                for (int bj = 0; bj < 2; ++bj)
#pragma unroll
                    for (int n = 0; n < 2; ++n) hv[m][bj][n] = *(const GAS f32x4*)(hin + off + bj * HALF + 4 * n); }
#pragma unroll
            for (int m = 0; m < 4; ++m) { const size_t off = (size_t)(row0 + ai * HALF + m * 16) * DM + col0;
#pragma unroll
                for (int bj = 0; bj < 2; ++bj)
#pragma unroll
                    for (int n = 0; n < 2; ++n) *(GAS f32x4*)(hout + off + bj * HALF + 4 * n) = hv[m][bj][n] + gm[bj][n] * acc[ai][bj][m][n]; }
        }
    }
};

template <class Epi, bool APL = false>
__device__ __forceinline__ void gemm_phase(LAS unsigned char* lds, const int tid, const Gemm g, const StaticOrder& S, const Epi& E) {
    const int wid = __builtin_amdgcn_readfirstlane(tid >> 6), lane = tid & 63, wr = wid >> 2, wc = wid & 3, fr = lane & 15, fq = lane >> 4;
    const int K = g.K, nt = K / BK, lda = g.lda;
    unsigned voffA[2], voffB[2];
#pragma unroll
    for (int i = 0; i < 2; ++i) { int R, C; stage_rc(tid * 16 + i * 8192, R, C); const int Rb = (R & ~31) + perm32(R & 31);
        voffA[i] = (unsigned)(R * (APL ? 128 : lda) + C) * 2u; voffB[i] = (unsigned)(Rb * K + C) * 2u; }
    const size_t kstep = (size_t)(BK * 2);
    const size_t hstepA = (size_t)HALF * (APL ? 128 : lda) * 2, hstepB = (size_t)HALF * K * 2;
#define PG8_KA(t) (APL ? ((size_t)((t) >> 1) * (PLANE * 2) + (size_t)((t) & 1) * 128) : (size_t)(t) * kstep)
    const size_t tstepA = 2 * hstepA, tstepB = 2 * hstepB;
    const unsigned ldsw = (unsigned)wid * 1024u;
    const int aoff = lds_byte(wr * 64 + fr, fq * 8), boff = lds_byte(wc * 32 + fr, fq * 8);
#define PG8_SA(b, h) (((b) * 2 + (h)) * HTB)
#define PG8_SB(b, h) ((4 + (b) * 2 + (h)) * HTB)
#define PG8_STAGE(bufoff, gbase, voff) do { _Pragma("unroll") for (int _i = 0; _i < 2; ++_i) \
        __builtin_amdgcn_global_load_lds((const unsigned*)((const char*)(gbase) + (voff)[_i]), (LAS unsigned*)(lds + (bufoff) + ldsw + _i * 8192), 16, 0, 0); } while (0)
#define PG8_LDA(dst, b, h) do { _Pragma("unroll") for (int m = 0; m < 4; ++m) _Pragma("unroll") for (int k = 0; k < 2; ++k) dst[m][k] = *(const LAS bf16x8*)(lds + PG8_SA(b, h) + aoff + m * 2048 + k * 1024); } while (0)
#define PG8_LDB(dst, b, h) do { _Pragma("unroll") for (int n = 0; n < 2; ++n) _Pragma("unroll") for (int k = 0; k < 2; ++k) dst[n][k] = *(const LAS bf16x8*)(lds + PG8_SB(b, h) + boff + n * 2048 + k * 1024); } while (0)
#define PG8_MMA(ai, bj, At, Bt) do { __builtin_amdgcn_s_setprio(1); _Pragma("unroll") for (int m = 0; m < 4; ++m) _Pragma("unroll") for (int n = 0; n < 2; ++n) _Pragma("unroll") for (int k = 0; k < 2; ++k) \
        acc[ai][bj][m][n] = __builtin_amdgcn_mfma_f32_16x16x32_bf16(Bt[n][k], At[m][k], acc[ai][bj][m][n], 0, 0, 0); __builtin_amdgcn_s_setprio(0); } while (0)
#define PG8_WAIT_V(n) asm volatile("s_waitcnt vmcnt(" #n ")" ::: "memory")
#define PG8_WAIT_L(n) asm volatile("s_waitcnt lgkmcnt(" #n ")" ::: "memory")
#define PG8_BAR __builtin_amdgcn_s_barrier()
#define PG8_SCHED __builtin_amdgcn_sched_barrier(0)
    Unit cur, nxt; int ui = 0;
    if (!S.next(0, cur)) return;
    f32x4 acc[2][2][4][2];
#pragma unroll
    for (int a = 0; a < 2; ++a)
#pragma unroll
        for (int b = 0; b < 2; ++b)
#pragma unroll
            for (int m = 0; m < 4; ++m)
#pragma unroll
                for (int n = 0; n < 2; ++n) acc[a][b][m][n] = (f32x4){0.f, 0.f, 0.f, 0.f};
    bf16x8 At[4][2], B0[2][2], B1[2][2];
    const char* cA = (const char*)g.A + (size_t)cur.pm * tstepA; const char* cB = (const char*)g.Bt + (size_t)cur.pn * tstepB;
    PG8_STAGE(PG8_SB(0, 0), cB, voffB); PG8_STAGE(PG8_SB(0, 1), cB + hstepB, voffB); PG8_STAGE(PG8_SA(0, 0), cA, voffA); PG8_STAGE(PG8_SA(0, 1), cA + hstepA, voffA);
    if (wr == 1) PG8_BAR;
    PG8_WAIT_V(2); PG8_BAR;
    PG8_STAGE(PG8_SB(1, 0), cB + kstep, voffB); PG8_STAGE(PG8_SA(1, 0), cA + PG8_KA(1), voffA); PG8_STAGE(PG8_SB(1, 1), cB + hstepB + kstep, voffB);
    PG8_WAIT_V(6); PG8_BAR;
    for (;;) {
        const bool has_next = S.next(ui + 1, nxt);
        const char* nA = has_next ? (const char*)g.A + (size_t)nxt.pm * tstepA : cA; const char* nB = has_next ? (const char*)g.Bt + (size_t)nxt.pn * tstepB : cB;
        for (int t = 0; t < nt; t += 2) {
            const bool last = (t == nt - 2);
            const char* a1 = cA + PG8_KA(t + 1);
            const char* a2 = last ? nA : cA + PG8_KA(t + 2); const char* b2 = last ? nB : cB + (size_t)(t + 2) * kstep;
            const char* a3 = last ? nA + PG8_KA(1) : cA + PG8_KA(t + 3); const char* b3 = b2 + kstep;
            PG8_LDB(B0, 0, 0); PG8_LDB(B1, 0, 1); PG8_SCHED; PG8_LDA(At, 0, 0); PG8_STAGE(PG8_SA(1, 1), a1 + hstepA, voffA);
            PG8_WAIT_V(8); PG8_WAIT_L(0); PG8_BAR; PG8_MMA(0, 0, At, B0); PG8_MMA(0, 1, At, B1); PG8_BAR; PG8_SCHED;
            PG8_LDA(At, 0, 1); PG8_STAGE(PG8_SB(0, 0), b2, voffB); PG8_STAGE(PG8_SB(0, 1), b2 + hstepB, voffB); PG8_STAGE(PG8_SA(0, 0), a2, voffA);
            PG8_WAIT_V(8); PG8_WAIT_L(0); PG8_BAR; PG8_MMA(1, 0, At, B0); PG8_MMA(1, 1, At, B1); PG8_BAR; PG8_SCHED;
            PG8_LDB(B0, 1, 0); PG8_LDB(B1, 1, 1); PG8_SCHED; PG8_LDA(At, 1, 0); PG8_STAGE(PG8_SA(0, 1), a2 + hstepA, voffA);
            PG8_WAIT_V(8); PG8_WAIT_L(0); PG8_BAR; PG8_MMA(0, 0, At, B0); PG8_MMA(0, 1, At, B1); PG8_BAR; PG8_SCHED;
            PG8_LDA(At, 1, 1); PG8_STAGE(PG8_SB(1, 0), b3, voffB); PG8_STAGE(PG8_SB(1, 1), b3 + hstepB, voffB); PG8_STAGE(PG8_SA(1, 0), a3, voffA);
            PG8_WAIT_V(8); PG8_WAIT_L(0); PG8_BAR; PG8_MMA(1, 0, At, B0); PG8_MMA(1, 1, At, B1); PG8_BAR; PG8_SCHED;
        }
        if (wr == 0) PG8_BAR;
        E(acc, cur, wr, wc, fr, fq);
        if (!has_next) break;
#pragma unroll
        for (int a = 0; a < 2; ++a)
#pragma unroll
            for (int b = 0; b < 2; ++b)
#pragma unroll
                for (int m = 0; m < 4; ++m)
#pragma unroll
                    for (int n = 0; n < 2; ++n) acc[a][b][m][n] = (f32x4){0.f, 0.f, 0.f, 0.f};
        cur = nxt; cA = nA; cB = nB; ++ui;
        if (wr == 1) PG8_BAR;
    }
    PG8_WAIT_V(0);
    PG8_BAR;
#undef PG8_KA
#undef PG8_SA
#undef PG8_SB
#undef PG8_STAGE
#undef PG8_LDA
#undef PG8_LDB
#undef PG8_MMA
#undef PG8_WAIT_V
#undef PG8_WAIT_L
#undef PG8_BAR
#undef PG8_SCHED
}
}

struct Frame {
    LAS unsigned char* lds;
    int tid, lane, wave, G, bid;
};

__device__ __forceinline__ void conv_item(const float* W, int Nsrc, int K, int src_col0, bf16_t* WT, int dst_row0, int k0, LAS float* scr, int lane) {
#pragma unroll 8
    for (int i = 0; i < 32; ++i) { const int kk = 2 * i + (lane >> 5); scr[kk * 33 + (lane & 31)] = ((const GAS float*)W)[(size_t)(k0 + kk) * Nsrc + src_col0 + (lane & 31)]; }
    asm volatile("s_waitcnt lgkmcnt(0)" ::: "memory");
    const int c = lane & 7;
#pragma unroll
    for (int j = 0; j < 4; ++j) { const int n = (lane >> 3) + 8 * j; const LAS float* s = scr + (8 * c) * 33 + n;
        u32x4 o; o.x = cvt_pk_bf16(s[0 * 33], s[1 * 33]); o.y = cvt_pk_bf16(s[2 * 33], s[3 * 33]); o.z = cvt_pk_bf16(s[4 * 33], s[5 * 33]); o.w = cvt_pk_bf16(s[6 * 33], s[7 * 33]);
        *(GAS u32x4*)(WT + (size_t)(dst_row0 + n) * K + k0 + 8 * c) = o; }
    asm volatile("s_waitcnt lgkmcnt(0)" ::: "memory");
}
__device__ __forceinline__ void convert_ffn(const Frame& F, const float* wg, const float* wu, const float* wd, bf16_t* WFU, bf16_t* WFD) {
    LAS float* scr = (LAS float*)(F.lds + F.wave * 16384);
    const int gw = F.bid * NWAVE + F.wave, NGW = F.G * NWAVE;
    constexpr int I_U = 16 * 176, I_D = 44 * 32;
    for (int it = gw; it < I_U + I_D; it += NGW) {
        if (it < I_U) { const int kb = it / 176, nb = it % 176, r0 = nb * 32, pn = r0 >> 8, i0 = r0 & 255;
            conv_item(i0 < 128 ? wg : wu, DFF, DM, pn * 128 + (i0 & 127), WFU, r0, kb * 64, scr, F.lane); }
        else { const int r = it - I_U, kb = r / 32, nb = r % 32; conv_item(wd, DM, DFF, nb * 32, WFD, nb * 32, kb * 64, scr, F.lane); }
    }
}
__device__ __forceinline__ void convert_mix(const Frame& F, const float* w_in, const float* w_out, bf16_t* WIN, bf16_t* WOUT) {
    LAS float* scr = (LAS float*)(F.lds + F.wave * 16384);
    const int gw = F.bid * NWAVE + F.wave, NGW = F.G * NWAVE;
    constexpr int I_I = 16 * 160, I_O = 24 * 32;
    for (int it = gw; it < I_I + I_O; it += NGW) {
        if (it < I_I) { const int kb = it / 160, nb = it % 160, r0 = nb * 32, blk = r0 >> 9;
            const int sb = blk == 0 ? 0 : blk == 1 ? 4 : blk == 2 ? 7 : blk == 3 ? 1 : blk == 4 ? 2 : blk == 5 ? 3 : blk == 6 ? 5 : blk == 7 ? 6 : blk;
            conv_item(w_in, INW, DM, sb * 512 + (r0 & 511), WIN, r0, kb * 64, scr, F.lane); }
        else { const int r = it - I_I, kb = r / 32, nb = r % 32; conv_item(w_out, DM, 1536, nb * 32, WOUT, nb * 32, kb * 64, scr, F.lane); }
    }
}

__device__ __forceinline__ void sincos_d(double x, double& s, double& c) {
    const double k = rint(x * 0.63661977236758134308);
    double r = fma(-k, 1.57079632679489655800e+00, x); r = fma(-k, 6.12323399573676603587e-17, r);
    const double r2 = r * r;
    double sp = -7.6471637318198164759e-13; sp = sp * r2 + 1.6059043836821614599e-10; sp = sp * r2 - 2.5052108385441718775e-08; sp = sp * r2 + 2.7557319223985890653e-06;
    sp = sp * r2 - 1.9841269841269841270e-04; sp = sp * r2 + 8.3333333333333333333e-03; sp = sp * r2 - 1.6666666666666666667e-01; const double sn = r + r * r2 * sp;
    double cp = 4.7794773323873852974e-14; cp = cp * r2 - 1.1470745597729724714e-11; cp = cp * r2 + 2.0876756987868098979e-09; cp = cp * r2 - 2.7557319223985890653e-07;
    cp = cp * r2 + 2.4801587301587301587e-05; cp = cp * r2 - 1.3888888888888888889e-03; cp = cp * r2 + 4.1666666666666666667e-02; cp = cp * r2 - 0.5; const double cs = 1.0 + r2 * cp;
    const int q = ((int)k) & 3;
    s = (q == 0) ? sn : (q == 1) ? cs : (q == 2) ? -sn : -cs;
    c = (q == 0) ? cs : (q == 1) ? -sn : (q == 2) ? -cs : sn;
}
__device__ __forceinline__ void prologue(const Frame& F, const Params& p, unsigned char* ws, int zi) {
    LAS float* cs = (LAS float*)F.lds;
    LAS float* red = (LAS float*)(F.lds + 16384);
    const float* c = as_global(p.in[1 + zi]);
    for (int i = F.tid; i < 4096; i += NTHR) cs[i] = silu_f(c[i]);
    __syncthreads();
    float* MOD = (float*)(ws + WS_MOD);
    for (int task = F.bid; task < 320; task += F.G) {
        const float* W; const float* bias; int N, n0; float* dst; int dstride;
        if (task < 288) { const int l = task / 144, t = task % 144; W = as_global(p.in[2 + zi]) + (size_t)l * DM * 9216; bias = as_global(p.in[3 + zi]) + l * 9216; N = 9216; n0 = t * 64; dst = MOD + (size_t)l * 4 * 9216; dstride = 9216; }
        else { const int t = task - 288; W = as_global(p.in[22 + zi]); bias = as_global(p.in[23 + zi]); N = 2048; n0 = t * 64; dst = MOD + FMOD_OFF; dstride = 2048; }
        float a0 = 0.f, a1 = 0.f, a2 = 0.f, a3 = 0.f;
        const int kb = F.wave * 128;
#pragma unroll 32
        for (int k = 0; k < 128; ++k) { const float w = ((const GAS float*)W)[(size_t)(kb + k) * N + n0 + F.lane];
            a0 += cs[kb + k] * w; a1 += cs[1024 + kb + k] * w; a2 += cs[2048 + kb + k] * w; a3 += cs[3072 + kb + k] * w; }
        red[(F.wave * 4 + 0) * 64 + F.lane] = a0; red[(F.wave * 4 + 1) * 64 + F.lane] = a1; red[(F.wave * 4 + 2) * 64 + F.lane] = a2; red[(F.wave * 4 + 3) * 64 + F.lane] = a3;
        __syncthreads();
        if (F.tid < 256) { const int b = F.tid >> 6, col = F.tid & 63; float s = bias[n0 + col];
#pragma unroll
            for (int w = 0; w < 8; ++w) s += red[(w * 4 + b) * 64 + col];
            dst[(size_t)b * dstride + n0 + col] = s; }
        __syncthreads();
    }
    f32x2* ROPE = (f32x2*)(ws + WS_ROPE);
    for (int idx = F.bid * NTHR + F.tid; idx < SEQ * 64; idx += F.G * NTHR) {
        const int pos = idx >> 6, i = idx & 63;
        const float invf = (float)exp(-(double)i * (9.210340371976184 / 64.0));
        const float ang = (float)pos * invf;
        double s, cc; sincos_d((double)ang, s, cc);
        ROPE[idx] = (f32x2){(float)cc, (float)s};
    }
}

__device__ __forceinline__ void norm_phase(const Frame& F, const float* h, const float* gain, const float* shift0, const float* scale0, int bstride, bf16_t* U) {
    const int gw = F.bid * NWAVE + F.wave, NGW = F.G * NWAVE;
    for (int m0 = gw; m0 < T_TOK; m0 += 4 * NGW) {
        f32x4 v[4][4];
#pragma unroll
        for (int r = 0; r < 4; ++r) { const int m = m0 + r * NGW; if (m < T_TOK) { const GAS f32x4* xr = (const GAS f32x4*)(h + (size_t)m * DM) + F.lane;
#pragma unroll
            for (int j = 0; j < 4; ++j) v[r][j] = xr[64 * j]; } }
#pragma unroll
        for (int r = 0; r < 4; ++r) { const int m = m0 + r * NGW; if (m < T_TOK) {
            const int b = m >> 13; float s = 0.f;
#pragma unroll
            for (int j = 0; j < 4; ++j) s += (v[r][j].x * v[r][j].x + v[r][j].y * v[r][j].y) + (v[r][j].z * v[r][j].z + v[r][j].w * v[r][j].w);
            const float rstd = rsqrtf(wave_sum(s) * (1.f / DM) + EPS);
            GAS u32x2* o8 = (GAS u32x2*)(U + (size_t)m * DM) + F.lane;
#pragma unroll
            for (int j = 0; j < 4; ++j) {
                const f32x4 g = ((const GAS f32x4*)gain)[F.lane + 64 * j], sh = ((const GAS f32x4*)(shift0 + (size_t)b * bstride))[F.lane + 64 * j], sc = ((const GAS f32x4*)(scale0 + (size_t)b * bstride))[F.lane + 64 * j];
                o8[64 * j] = pack4(v[r][j] * rstd * g * (sc + 1.0f) + sh); } } }
    }
}
__device__ __forceinline__ void final_phase(const Frame& F, float* h, const float* gain, const float* fmod) {
    const int gw = F.bid * NWAVE + F.wave, NGW = F.G * NWAVE;
    for (int m0 = gw; m0 < T_TOK; m0 += 4 * NGW) {
        f32x4 v[4][4];
#pragma unroll
        for (int r = 0; r < 4; ++r) { const int m = m0 + r * NGW; if (m < T_TOK) { const GAS f32x4* xr = (const GAS f32x4*)(h + (size_t)m * DM) + F.lane;
#pragma unroll
            for (int j = 0; j < 4; ++j) v[r][j] = xr[64 * j]; } }
#pragma unroll
        for (int r = 0; r < 4; ++r) { const int m = m0 + r * NGW; if (m < T_TOK) {
            const int b = m >> 13; float s = 0.f;
#pragma unroll
            for (int j = 0; j < 4; ++j) s += (v[r][j].x * v[r][j].x + v[r][j].y * v[r][j].y) + (v[r][j].z * v[r][j].z + v[r][j].w * v[r][j].w);
            const float rstd = rsqrtf(wave_sum(s) * (1.f / DM) + EPS);
            GAS f32x4* xr = (GAS f32x4*)(h + (size_t)m * DM) + F.lane;
#pragma unroll
            for (int j = 0; j < 4; ++j) {
                const f32x4 g = ((const GAS f32x4*)gain)[F.lane + 64 * j], sh = ((const GAS f32x4*)(fmod + (size_t)b * 2048))[F.lane + 64 * j], sc = ((const GAS f32x4*)(fmod + (size_t)b * 2048 + 1024))[F.lane + 64 * j];
                xr[64 * j] = v[r][j] * rstd * g * (sc + 1.0f) + sh; } } }
    }
}

__device__ __forceinline__ void dt_gemv(const Frame& F, const bf16_t* U, const float* w_in, float* DT) {
    LAS float* Wd = (LAS float*)F.lds;
    __syncthreads();
    for (int idx = F.tid; idx < 8192; idx += NTHR) { const int k = idx >> 3, j = idx & 7; Wd[8 * k + 4 * (k >> 3) + j] = ((const GAS float*)w_in)[(size_t)k * INW + 5120 + j]; }
    __syncthreads();
    const int gw = F.bid * NWAVE + F.wave, NGW = F.G * NWAVE;
    for (int m0 = gw; m0 < T_TOK; m0 += 4 * NGW) {
      u32x4 uvr[4][2];
#pragma unroll
      for (int r = 0; r < 4; ++r) { const int mm = (m0 + r * NGW < T_TOK) ? m0 + r * NGW : m0;
#pragma unroll
          for (int hf = 0; hf < 2; ++hf) uvr[r][hf] = *(const GAS u32x4*)(U + (size_t)mm * DM + 512 * hf + 8 * F.lane); }
#pragma unroll
      for (int r = 0; r < 4; ++r) { const int m = m0 + r * NGW; if (m < T_TOK) {
        float acc[8];
#pragma unroll
        for (int j = 0; j < 8; ++j) acc[j] = 0.f;
#pragma unroll
        for (int hf = 0; hf < 2; ++hf) {
            const u32x4 uv = uvr[r][hf];
            float uf[8]; unpack8(uv, uf);
#pragma unroll
            for (int kk = 0; kk < 8; ++kk) { const int k = 512 * hf + 8 * F.lane + kk; const LAS float* wp = Wd + 8 * k + 4 * (k >> 3);
                const f32x4 w0 = *(const LAS f32x4*)wp, w1 = *(const LAS f32x4*)(wp + 4);
                acc[0] += uf[kk] * w0.x; acc[1] += uf[kk] * w0.y; acc[2] += uf[kk] * w0.z; acc[3] += uf[kk] * w0.w;
                acc[4] += uf[kk] * w1.x; acc[5] += uf[kk] * w1.y; acc[6] += uf[kk] * w1.z; acc[7] += uf[kk] * w1.w; }
        }
#pragma unroll
        for (int j = 0; j < 8; ++j) acc[j] = wave_sum(acc[j]);
        if (F.lane < 8) { float v = acc[0];
#pragma unroll
            for (int j = 1; j < 8; ++j) v = (F.lane == j) ? acc[j] : v;
            ((GAS float*)DT)[(size_t)m * 8 + F.lane] = v; }
      } }
    }
    __syncthreads();
}

template <bool MASKED>
__device__ __forceinline__ void sb_elem(const f32x4 (&sc)[4], int key0, int trow, float (&nk)[4][4], float (&lb)[4][4], float (&Tj)[4]) {
#pragma unroll
    for (int j = 0; j < 4; ++j) { float t = 0.f;
#pragma unroll
        for (int i = 0; i < 4; ++i) { const float z2 = sc[j][i] * (0.08838834764831845f * 1.4426950408889634f);
            const float sp2 = fmaxf(z2, 0.f) + __builtin_amdgcn_logf(1.0f + __builtin_amdgcn_exp2f(-fabsf(z2)));
            if (MASKED) { const bool vis = (key0 + 16 * j + i) < trow; nk[j][i] = vis ? sp2 : 0.f; lb[j][i] = vis ? (z2 - sp2) : -1e30f; }
            else { nk[j][i] = sp2; lb[j][i] = z2 - sp2; }
            t += nk[j][i]; }
        Tj[j] = t; }
}
__device__ __forceinline__ void sb_task(const Frame& F, bf16_t* P, int b, int h, int qb) {
    LAS unsigned char* Ks = F.lds;
    LAS unsigned char* Vt = F.lds + 17408;
    LAS unsigned char* Pw = F.lds + 35840 + F.wave * 2304;
    LAS float* red = (LAS float*)(F.lds + 54272);
    int lane = F.lane; asm volatile("" : "+v"(lane)); const int wid = F.wave, fr = lane & 15, fq = lane >> 4;
    const size_t rowbase = (size_t)b * SEQ;
    const int q0 = qb * 128, trow = q0 + 16 * wid + fr;
    bf16x8 qf[4];
    { const bf16_t* qp = P + pidx(rowbase + trow, C_SQ + h * 128) + 8 * fq;
#pragma unroll
      for (int s = 0; s < 4; ++s) qf[s] = *(const GAS bf16x8*)(qp + 32 * s); }
    f32x4 o[8];
#pragma unroll
    for (int i = 0; i < 8; ++i) o[i] = (f32x4){0.f, 0.f, 0.f, 0.f};
    float R = 0.f;
    u32x4 kvr[2], vvr[2];
#pragma unroll
    for (int i = 0; i < 2; ++i) { const int idx = F.tid + NTHR * i, key = idx >> 4, c8 = idx & 15; const size_t kt0 = rowbase + 64 * (2 * qb + 1);
        kvr[i] = *(const GAS u32x4*)(P + pidx(kt0 + key, C_SK + h * 128) + 8 * c8); vvr[i] = *(const GAS u32x4*)(P + pidx(kt0 + lane, C_SV + h * 128) + 8 * (2 * wid + i)); }
    lds_barrier();
    for (int kt = 2 * qb + 1; kt >= 0; --kt) {
#pragma unroll
        for (int i = 0; i < 2; ++i) { const int idx = F.tid + NTHR * i, key = idx >> 4, c8 = idx & 15;
            const u32x4 kv = kvr[i], vv = vvr[i];
            *(LAS u32x4*)(Ks + key * 272 + c8 * 16) = kv;
            LAS bf16_t* vd = (LAS bf16_t*)(Vt + (8 * (2 * wid + i)) * 144 + lane * 2);
            vd[0 * 72] = (bf16_t)(vv.x & 0xffff); vd[1 * 72] = (bf16_t)(vv.x >> 16); vd[2 * 72] = (bf16_t)(vv.y & 0xffff); vd[3 * 72] = (bf16_t)(vv.y >> 16);
            vd[4 * 72] = (bf16_t)(vv.z & 0xffff); vd[5 * 72] = (bf16_t)(vv.z >> 16); vd[6 * 72] = (bf16_t)(vv.w & 0xffff); vd[7 * 72] = (bf16_t)(vv.w >> 16); }
        if (kt > 0) {
#pragma unroll
            for (int i = 0; i < 2; ++i) { const int idx = F.tid + NTHR * i, key = idx >> 4, c8 = idx & 15; const size_t kt1 = rowbase + 64 * (kt - 1);
                kvr[i] = *(const GAS u32x4*)(P + pidx(kt1 + key, C_SK + h * 128) + 8 * c8); vvr[i] = *(const GAS u32x4*)(P + pidx(kt1 + lane, C_SV + h * 128) + 8 * (2 * wid + i)); } }
        lds_barrier();
        if (64 * kt < q0 + 16 * wid + 15) {
            f32x4 sc[4];
#pragma unroll
            for (int j = 0; j < 4; ++j) { sc[j] = (f32x4){0.f, 0.f, 0.f, 0.f};
#pragma unroll
                for (int s = 0; s < 4; ++s) sc[j] = mfma16(ldsfrag(Ks + (16 * j + fr) * 272 + (32 * s + 8 * fq) * 2), qf[s], sc[j]); }
            float nk[4][4], lb[4][4], Tj[4], Wj[4], Gj[4];
            if (64 * kt + 64 <= q0 + 16 * wid) sb_elem<false>(sc, 64 * kt + 4 * fq, trow, nk, lb, Tj);
            else sb_elem<true>(sc, 64 * kt + 4 * fq, trow, nk, lb, Tj);
#pragma unroll
            for (int j = 0; j < 4; ++j) { const float a1 = __shfl_xor(Tj[j], 16), a2 = __shfl_xor(Tj[j], 32), a3 = __shfl_xor(Tj[j], 48);
                Wj[j] = Tj[j] + a1 + a2 + a3;
                Gj[j] = (((fq ^ 1) > fq) ? a1 : 0.f) + (((fq ^ 2) > fq) ? a2 : 0.f) + (((fq ^ 3) > fq) ? a3 : 0.f); }
            float suf = 0.f;
#pragma unroll
            for (int j = 3; j >= 0; --j) { float tl = R - suf - Gj[j]; f32x4 w;
                w[3] = __builtin_amdgcn_exp2f(lb[j][3] + tl); tl -= nk[j][3];
                w[2] = __builtin_amdgcn_exp2f(lb[j][2] + tl); tl -= nk[j][2];
                w[1] = __builtin_amdgcn_exp2f(lb[j][1] + tl); tl -= nk[j][1];
                w[0] = __builtin_amdgcn_exp2f(lb[j][0] + tl);
                *(LAS u32x2*)(Pw + fr * 144 + (16 * j + 4 * fq) * 2) = pack4(w);
                suf += Wj[j]; }
            R -= suf;
#pragma unroll
            for (int ks = 0; ks < 2; ++ks) { const bf16x8 pf = ldsfrag(Pw + fr * 144 + (32 * ks + 8 * fq) * 2);
#pragma unroll
                for (int dt = 0; dt < 8; ++dt) o[dt] = mfma16(ldsfrag(Vt + (16 * dt + fr) * 144 + (32 * ks + 8 * fq) * 2), pf, o[dt]); }
        }
        const float rm = wave_max(R);
        if (lane == 0) red[wid] = rm;
        lds_barrier();
        float mx = red[0];
#pragma unroll
        for (int w = 1; w < 8; ++w) mx = fmaxf(mx, red[w]);
        if (mx < -173.2f) break;
    }
    bf16_t* op = P + pidx(rowbase + trow, C_SQ + h * 128) + 4 * fq;
#pragma unroll
    for (int dt = 0; dt < 8; ++dt) *(GAS u32x2*)(op + 16 * dt) = pack4(o[dt]);
}

__device__ __forceinline__ void ret_kv_task(const Frame& F, const bf16_t* P, const f32x2* ROPE, bf16_t* RST, int b, int c, int h) {
    LAS unsigned char* KT = F.lds;
    LAS unsigned char* VT = F.lds + 18432;
    int lane = F.lane; asm volatile("" : "+v"(lane)); const int fr = lane & 15, fq = lane >> 4;
    const float l2g = log2gamma(h);
    lds_barrier();
    { const int s = lane, g8 = F.wave;     const size_t row = (size_t)b * SEQ + c * 64 + s; const int pos = c * 64 + s;
      const bf16_t* kp = P + pidx(row, C_RK + h * 128) + 8 * g8;
      const u32x4 k1 = *(const GAS u32x4*)kp, k2 = *(const GAS u32x4*)(kp + 64);
      float x1[8], x2[8]; unpack8(k1, x1); unpack8(k2, x2);
      const GAS f32x4* cp = (const GAS f32x4*)(ROPE + pos * 64 + 8 * g8);
      const float dec = __builtin_amdgcn_exp2f(l2g * (float)(63 - s)) * 0.08838834764831845f;
      LAS bf16_t* kd = (LAS bf16_t*)(KT + (8 * g8) * 144 + s * 2);
#pragma unroll
      for (int jj = 0; jj < 4; ++jj) { const f32x4 cs = cp[jj];
          { const int j = 2 * jj; const float y1 = (x1[j] * cs.x - x2[j] * cs.y) * dec, y2 = (x1[j] * cs.y + x2[j] * cs.x) * dec; kd[j * 72] = f2bf(y1); kd[(64 + j) * 72] = f2bf(y2); }
          { const int j = 2 * jj + 1; const float y1 = (x1[j] * cs.z - x2[j] * cs.w) * dec, y2 = (x1[j] * cs.w + x2[j] * cs.z) * dec; kd[j * 72] = f2bf(y1); kd[(64 + j) * 72] = f2bf(y2); } }
      const bf16_t* vp = P + pidx(row, C_RV + h * 128) + 16 * g8;
#pragma unroll
      for (int hh = 0; hh < 2; ++hh) { const u32x4 vv = *(const GAS u32x4*)(vp + 8 * hh);
          LAS bf16_t* vd = (LAS bf16_t*)(VT + (16 * g8 + 8 * hh) * 144 + s * 2);
          vd[0 * 72] = (bf16_t)(vv.x & 0xffff); vd[1 * 72] = (bf16_t)(vv.x >> 16); vd[2 * 72] = (bf16_t)(vv.y & 0xffff); vd[3 * 72] = (bf16_t)(vv.y >> 16);
          vd[4 * 72] = (bf16_t)(vv.z & 0xffff); vd[5 * 72] = (bf16_t)(vv.z >> 16); vd[6 * 72] = (bf16_t)(vv.w & 0xffff); vd[7 * 72] = (bf16_t)(vv.w >> 16); } }
    lds_barrier();
    const int w = F.wave;
    bf16x8 xf[2];
#pragma unroll
    for (int ks = 0; ks < 2; ++ks) xf[ks] = ldsfrag(KT + (16 * w + fr) * 144 + (32 * ks + 8 * fq) * 2);
    bf16_t* dst = RST + (size_t)((b * 128 + c) * 4 + h) * 16384;
#pragma unroll
    for (int et = 0; et < 8; ++et) { f32x4 acc = (f32x4){0.f, 0.f, 0.f, 0.f};
#pragma unroll
        for (int ks = 0; ks < 2; ++ks) acc = mfma16(xf[ks], ldsfrag(VT + (16 * et + fr) * 144 + (32 * ks + 8 * fq) * 2), acc);
        *(GAS u32x2*)(dst + (16 * et + fr) * 128 + 16 * w + 4 * fq) = pack4(acc); }
}

__device__ __forceinline__ void ret_out_task(const Frame& F, bf16_t* P, const f32x2* ROPE, const bf16_t* RST, const float* gn, int b, int c, int h, int xm = 0) {
    LAS unsigned char* Kr = F.lds;
    LAS unsigned char* VT = F.lds + 17408;
    LAS unsigned char* Sx = F.lds + 35840;
    LAS unsigned char* Pw = F.lds + 70656 + F.wave * 2304;
    LAS float* ssq = (LAS float*)(F.lds + 89088);
    int lane = F.lane; asm volatile("" : "+v"(lane)); const int fr = lane & 15, fq = lane >> 4, w = F.wave, lt = w & 3, eh = w >> 2;
    const float l2g = log2gamma(h);
    const int unit = (b * 128 + c) * 4 + h;
    lds_barrier();
    { const int s = F.tid >> 3, g8 = F.tid & 7; const size_t row = (size_t)b * SEQ + c * 64 + s; const int pos = c * 64 + s;
      const bf16_t* kp = P + pidx(row, C_RK + h * 128) + 8 * g8;
      const u32x4 k1 = *(const GAS u32x4*)kp, k2 = *(const GAS u32x4*)(kp + 64);
      float x1[8], x2[8], y1[8], y2[8]; unpack8(k1, x1); unpack8(k2, x2);
      const GAS f32x4* cp = (const GAS f32x4*)(ROPE + pos * 64 + 8 * g8);
#pragma unroll
      for (int jj = 0; jj < 4; ++jj) { const f32x4 cs = cp[jj];
          { const int j = 2 * jj; y1[j] = (x1[j] * cs.x - x2[j] * cs.y) * 0.08838834764831845f; y2[j] = (x1[j] * cs.y + x2[j] * cs.x) * 0.08838834764831845f; }
          { const int j = 2 * jj + 1; y1[j] = (x1[j] * cs.z - x2[j] * cs.w) * 0.08838834764831845f; y2[j] = (x1[j] * cs.w + x2[j] * cs.z) * 0.08838834764831845f; } }
      u32x4 o1, o2; o1.x = cvt_pk_bf16(y1[0], y1[1]); o1.y = cvt_pk_bf16(y1[2], y1[3]); o1.z = cvt_pk_bf16(y1[4], y1[5]); o1.w = cvt_pk_bf16(y1[6], y1[7]);
      o2.x = cvt_pk_bf16(y2[0], y2[1]); o2.y = cvt_pk_bf16(y2[2], y2[3]); o2.z = cvt_pk_bf16(y2[4], y2[5]); o2.w = cvt_pk_bf16(y2[6], y2[7]);
      *(LAS u32x4*)(Kr + s * 272 + (8 * g8) * 2) = o1; *(LAS u32x4*)(Kr + s * 272 + (64 + 8 * g8) * 2) = o2;
      const bf16_t* vp = P + pidx((size_t)b * SEQ + c * 64 + lane, C_RV + h * 128) + 16 * F.wave;
#pragma unroll
      for (int hh = 0; hh < 2; ++hh) { const u32x4 vv = *(const GAS u32x4*)(vp + 8 * hh);
          LAS bf16_t* vd = (LAS bf16_t*)(VT + (16 * F.wave + 8 * hh) * 144 + lane * 2);
          vd[0 * 72] = (bf16_t)(vv.x & 0xffff); vd[1 * 72] = (bf16_t)(vv.x >> 16); vd[2 * 72] = (bf16_t)(vv.y & 0xffff); vd[3 * 72] = (bf16_t)(vv.y >> 16);
          vd[4 * 72] = (bf16_t)(vv.z & 0xffff); vd[5 * 72] = (bf16_t)(vv.z >> 16); vd[6 * 72] = (bf16_t)(vv.w & 0xffff); vd[7 * 72] = (bf16_t)(vv.w >> 16); }
      const bf16_t* sp = RST + (size_t)unit * 16384;
#pragma unroll
      for (int i = 0; i < 4; ++i) { const int idx = F.tid + NTHR * i, e = idx >> 4, c16 = idx & 15;
          *(LAS u32x4*)(Sx + e * 272 + c16 * 16) = *(const GAS u32x4*)(sp + e * 128 + 8 * c16); } }
    const int l = 16 * lt + fr; const size_t qrow = (size_t)b * SEQ + c * 64 + l; const int qpos = c * 64 + l;
    bf16x8 qf[4];
    { const bf16_t* qp = P + pidx(qrow, C_RQ + h * 128) + 8 * fq;
      u32x4 qv[4];
#pragma unroll
      for (int s = 0; s < 4; ++s) qv[s] = *(const GAS u32x4*)(qp + 32 * s);
#pragma unroll
      for (int s = 0; s < 2; ++s) { float x1[8], x2[8], y1[8], y2[8]; unpack8(qv[s], x1); unpack8(qv[s + 2], x2);
          const GAS f32x4* cp = (const GAS f32x4*)(ROPE + qpos * 64 + 32 * s + 8 * fq);
#pragma unroll
          for (int jj = 0; jj < 4; ++jj) { const f32x4 cs = cp[jj];
              { const int j = 2 * jj; y1[j] = x1[j] * cs.x - x2[j] * cs.y; y2[j] = x1[j] * cs.y + x2[j] * cs.x; }
              { const int j = 2 * jj + 1; y1[j] = x1[j] * cs.z - x2[j] * cs.w; y2[j] = x1[j] * cs.w + x2[j] * cs.z; } }
          u32x4 o1, o2; o1.x = cvt_pk_bf16(y1[0], y1[1]); o1.y = cvt_pk_bf16(y1[2], y1[3]); o1.z = cvt_pk_bf16(y1[4], y1[5]); o1.w = cvt_pk_bf16(y1[6], y1[7]);
          o2.x = cvt_pk_bf16(y2[0], y2[1]); o2.y = cvt_pk_bf16(y2[2], y2[3]); o2.z = cvt_pk_bf16(y2[4], y2[5]); o2.w = cvt_pk_bf16(y2[6], y2[7]);
          qf[s] = __builtin_bit_cast(bf16x8, o1); qf[s + 2] = __builtin_bit_cast(bf16x8, o2); } }
    u32x2 gvr[4]; f32x4 ggr[4];
#pragma unroll
    for (int et = 0; et < 4; ++et) { const int e0 = 64 * eh + 16 * et + 4 * fq;
        gvr[et] = *(const GAS u32x2*)(P + pidx(qrow, C_RG + h * 128) + e0); ggr[et] = *(const GAS f32x4*)(gn + h * 128 + e0); }
    lds_barrier();
    if (xm == 1) return;
#pragma unroll
    for (int j = 0; j < 4; ++j) { f32x4 acc = (f32x4){0.f, 0.f, 0.f, 0.f};
#pragma unroll
        for (int ks = 0; ks < 4; ++ks) acc = mfma16(ldsfrag(Kr + (16 * j + fr) * 272 + (32 * ks + 8 * fq) * 2), qf[ks], acc);
#pragma unroll
        for (int i = 0; i < 4; ++i) { const int s = 16 * j + 4 * fq + i; acc[i] *= __builtin_amdgcn_exp2f(l2g * fabsf((float)(l - s))); }
        *(LAS u32x2*)(Pw + fr * 144 + (16 * j + 4 * fq) * 2) = pack4(acc); }
    f32x4 y[4];
    const float qdec = __builtin_amdgcn_exp2f(l2g * (float)(l + 1));
#pragma unroll
    for (int et = 0; et < 4; ++et) { y[et] = (f32x4){0.f, 0.f, 0.f, 0.f};
#pragma unroll
        for (int ks = 0; ks < 4; ++ks) y[et] = mfma16(ldsfrag(Sx + (64 * eh + 16 * et + fr) * 272 + (32 * ks + 8 * fq) * 2), qf[ks], y[et]);
        y[et] = y[et] * qdec; }
#pragma unroll
    for (int ks = 0; ks < 2; ++ks) { const bf16x8 pf = ldsfrag(Pw + fr * 144 + (32 * ks + 8 * fq) * 2);
#pragma unroll
        for (int et = 0; et < 4; ++et) y[et] = mfma16(ldsfrag(VT + (64 * eh + 16 * et + fr) * 144 + (32 * ks + 8 * fq) * 2), pf, y[et]); }
    float ss = 0.f;
#pragma unroll
    for (int et = 0; et < 4; ++et) ss += (y[et][0] * y[et][0] + y[et][1] * y[et][1]) + (y[et][2] * y[et][2] + y[et][3] * y[et][3]);
    ss += __shfl_xor(ss, 16); ss += __shfl_xor(ss, 32);
    if (fq == 0) ssq[w * 16 + fr] = ss;
    lds_barrier();
    const float rstd = rsqrtf((ssq[w * 16 + fr] + ssq[(w ^ 4) * 16 + fr]) * (1.f / 128.f) + EPS);
#pragma unroll
    for (int et = 0; et < 4; ++et) { const int e0 = 64 * eh + 16 * et + 4 * fq;
        const u32x2 gv = gvr[et]; const f32x4 gg = ggr[et];
        f32x4 r;
        r[0] = y[et][0] * rstd * gg[0] * silu_f(bf_lo(gv.x)); r[1] = y[et][1] * rstd * gg[1] * silu_f(bf_hi(gv.x));
        r[2] = y[et][2] * rstd * gg[2] * silu_f(bf_lo(gv.y)); r[3] = y[et][3] * rstd * gg[3] * silu_f(bf_hi(gv.y));
        *(GAS u32x2*)(P + pidx(qrow, C_RQ + h * 128) + e0) = pack4(r); }
}

__device__ __forceinline__ float softplus_f(float x) { return fmaxf(x, 0.f) + log1pf(__expf(-fabsf(x))); }
__device__ __forceinline__ void conv8(const bf16_t* P, const float* cw, const float* cb, int b, int tpos, int col, float* v) {
    const int chan = col - C_XBC;
    { const f32x4 b0 = *(const GAS f32x4*)(cb + chan), b1 = *(const GAS f32x4*)(cb + chan + 4);
      v[0] = b0.x; v[1] = b0.y; v[2] = b0.z; v[3] = b0.w; v[4] = b1.x; v[5] = b1.y; v[6] = b1.z; v[7] = b1.w; }
#pragma unroll
    for (int j = 0; j < 4; ++j) { const int ts = tpos - 3 + j;
        if (ts >= 0) { const u32x4 xv = *(const GAS u32x4*)(P + pidx((size_t)b * SEQ + ts, col)); float xf[8]; unpack8(xv, xf);
            const f32x4 w0 = *(const GAS f32x4*)(cw + j * 1024 + chan), w1 = *(const GAS f32x4*)(cw + j * 1024 + chan + 4);
            v[0] += xf[0] * w0.x; v[1] += xf[1] * w0.y; v[2] += xf[2] * w0.z; v[3] += xf[3] * w0.w; v[4] += xf[4] * w1.x; v[5] += xf[5] * w1.y; v[6] += xf[6] * w1.z; v[7] += xf[7] * w1.w; } }
#pragma unroll
    for (int i = 0; i < 8; ++i) v[i] = silu_f(v[i]);
}

__device__ __forceinline__ void conv_load(const bf16_t* P, const float* cw, const float* cb, int b, int tpos0, int col, float (&w)[4][8], float (&bias)[8], u32x4 (&rows)[11]) {
    const int chan = col - C_XBC;
#pragma unroll
    for (int j = 0; j < 4; ++j) { const f32x4 w0 = *(const GAS f32x4*)(cw + j * 1024 + chan), w1 = *(const GAS f32x4*)(cw + j * 1024 + chan + 4);
        w[j][0] = w0.x; w[j][1] = w0.y; w[j][2] = w0.z; w[j][3] = w0.w; w[j][4] = w1.x; w[j][5] = w1.y; w[j][6] = w1.z; w[j][7] = w1.w; }
    { const f32x4 b0 = *(const GAS f32x4*)(cb + chan), b1 = *(const GAS f32x4*)(cb + chan + 4);
      bias[0] = b0.x; bias[1] = b0.y; bias[2] = b0.z; bias[3] = b0.w; bias[4] = b1.x; bias[5] = b1.y; bias[6] = b1.z; bias[7] = b1.w; }
    const bf16_t* base = P + pidx((size_t)b * SEQ + tpos0, col);
#pragma unroll
    for (int r = 0; r < 11; ++r) { rows[r] = (u32x4){0u, 0u, 0u, 0u}; if (tpos0 - 3 + r >= 0) rows[r] = *(const GAS u32x4*)(base + (long)(r - 3) * 128); }
}
template <bool TR, bool HASF>
__device__ __forceinline__ void conv_compute(const float (&w)[4][8], const float (&bias)[8], const u32x4 (&rows)[11], const float (&f)[8], u32x4 (&pk)[8]) {
    float prev[8];
#pragma unroll
    for (int t = 0; t < 8; ++t) {
        float a[8];
#pragma unroll
        for (int i = 0; i < 8; ++i) a[i] = bias[i];
#pragma unroll
        for (int j = 0; j < 4; ++j) { float xf[8]; unpack8(rows[t + j], xf);
#pragma unroll
            for (int i = 0; i < 8; ++i) a[i] += xf[i] * w[j][i]; }
#pragma unroll
        for (int i = 0; i < 8; ++i) { a[i] = silu_f(a[i]); if (HASF) a[i] *= f[t]; }
        if (TR) {
            if (t & 1) {
#pragma unroll
                for (int i = 0; i < 8; ++i) { const unsigned u = cvt_pk_bf16(prev[i], a[i]);
                    if ((t >> 1) == 0) pk[i].x = u; else if ((t >> 1) == 1) pk[i].y = u; else if ((t >> 1) == 2) pk[i].z = u; else pk[i].w = u; }
            } else {
#pragma unroll
                for (int i = 0; i < 8; ++i) prev[i] = a[i];
            }
        } else {
            pk[t].x = cvt_pk_bf16(a[0], a[1]); pk[t].y = cvt_pk_bf16(a[2], a[3]); pk[t].z = cvt_pk_bf16(a[4], a[5]); pk[t].w = cvt_pk_bf16(a[6], a[7]);
        }
    }
}
template <bool TR, bool HASF>
__device__ __forceinline__ void conv_tile(const bf16_t* P, const float* cw, const float* cb, int b, int tpos0, int col, const float (&f)[8], u32x4 (&pk)[8]) {
    float w[4][8], bias[8]; u32x4 rows[11];
    conv_load(P, cw, cb, b, tpos0, col, w, bias, rows);
    conv_compute<TR, HASF>(w, bias, rows, f, pk);
}
__device__ __forceinline__ float dt_scan(const float* DT, const float* dt_bias, const float* a_log, int b, int c, int hd, int lane, float& dtv) {
    const size_t t = (size_t)b * SEQ + c * 64 + lane;
    dtv = softplus_f(((const GAS float*)DT)[t * 8 + hd] + ((const GAS float*)dt_bias)[hd]);
    float x = dtv * (-__expf(((const GAS float*)a_log)[hd]));
#pragma unroll
    for (int o = 1; o < 64; o <<= 1) { const float y = __shfl_up(x, o); if (lane >= o) x += y; }
    return x;
}

__device__ __forceinline__ void ssd_state_task(const Frame& F, const bf16_t* P, const float* DT, const float* cw, const float* cb, const float* dt_bias, const float* a_log,
                                               bf16_t* SST, float* CD, int b, int c, int g) {
    LAS unsigned char* XT = F.lds;
    LAS unsigned char* BT = F.lds + 36864;
    LAS float* dtl = (LAS float*)(F.lds + 55296);
    LAS float* acl = (LAS float*)(F.lds + 56320);
    int lane = F.lane; asm volatile("" : "+v"(lane)); const int fr = lane & 15, fq = lane >> 4, w = F.wave;
    lds_barrier();
    int tt = F.tid; asm volatile("" : "+v"(tt)); const int cgi = tt % 48, seg = tt / 48, s0 = 8 * seg;
    const int ccol = (cgi < 32) ? (C_XBC + g * 256 + 8 * cgi) : (C_XBC + 512 + g * 128 + 8 * (cgi - 32));
    float cwr[4][8], cbr[8]; u32x4 crow[11];
    if (tt < 384) conv_load(P, cw, cb, b, c * 64 + s0, ccol, cwr, cbr, crow);
    if (w < 4) { float dtv; const float cum = dt_scan(DT, dt_bias, a_log, b, c, 4 * g + w, lane, dtv);
        dtl[lane * 4 + w] = dtv; acl[lane * 4 + w] = cum;
        if (lane == 63) ((GAS float*)CD)[(b * 128 + c) * 8 + 4 * g + w] = __expf(cum); }
    lds_barrier();
    if (tt < 384) {
        float f[8]; u32x4 pk[8];
        if (cgi < 32) { const int hl = cgi >> 3; const float ae = acl[63 * 4 + hl];
#pragma unroll
            for (int t = 0; t < 8; ++t) f[t] = dtl[(s0 + t) * 4 + hl] * __expf(ae - acl[(s0 + t) * 4 + hl]); }
        else {
#pragma unroll
            for (int t = 0; t < 8; ++t) f[t] = 1.0f; }
        conv_compute<true, true>(cwr, cbr, crow, f, pk);
        LAS unsigned char* d = (cgi < 32) ? (XT + (8 * cgi) * 144 + s0 * 2) : (BT + (8 * (cgi - 32)) * 144 + s0 * 2);
#pragma unroll
        for (int i = 0; i < 8; ++i) *(LAS u32x4*)(d + i * 144) = pk[i]; }
    lds_barrier();
    const int hl = w >> 1, ph = w & 1;
    bf16x8 yf[2][2];
#pragma unroll
    for (int pt = 0; pt < 2; ++pt)
#pragma unroll
        for (int ks = 0; ks < 2; ++ks) yf[pt][ks] = ldsfrag(XT + (hl * 64 + ph * 32 + 16 * pt + fr) * 144 + (32 * ks + 8 * fq) * 2);
    bf16_t* dst = SST + (size_t)((b * 128 + c) * 8 + 4 * g + hl) * 8192;
#pragma unroll
    for (int nt = 0; nt < 8; ++nt) { f32x4 a0 = (f32x4){0.f, 0.f, 0.f, 0.f}, a1 = a0;
#pragma unroll
        for (int ks = 0; ks < 2; ++ks) { const bf16x8 xf = ldsfrag(BT + (16 * nt + fr) * 144 + (32 * ks + 8 * fq) * 2); a0 = mfma16(xf, yf[0][ks], a0); a1 = mfma16(xf, yf[1][ks], a1); }
#ifdef PROBE_CONST
        a0 = (f32x4){0.01f, 0.02f, 0.03f, 0.04f}; a1 = a0;
#endif
        *(GAS u32x2*)(dst + (ph * 32 + fr) * 128 + 16 * nt + 4 * fq) = pack4(a0);
        *(GAS u32x2*)(dst + (ph * 32 + 16 + fr) * 128 + 16 * nt + 4 * fq) = pack4(a1); }
}

__device__ __forceinline__ void ssd_out_task(const Frame& F, bf16_t* P, const float* DT, const float* cw, const float* cb, const float* dt_bias, const float* a_log,
                                             const float* d_skip, const float* nrm, const bf16_t* SST, int b, int c) {
    LAS unsigned char* Bs = F.lds;
    LAS unsigned char* Cs = F.lds + 17408;
    LAS unsigned char* XT = F.lds + 34816;
    LAS unsigned char* Pw = F.lds + 71680 + F.wave * 2304;
    LAS float* dtl = (LAS float*)(F.lds + 90112);
    LAS float* acl = (LAS float*)(F.lds + 92160);
    LAS float* ssq = (LAS float*)(F.lds + 94208);
    int lane = F.lane; asm volatile("" : "+v"(lane)); const int fr = lane & 15, fq = lane >> 4, w = F.wave, hl = w >> 1, half = w & 1;
    lds_barrier();
    { float dtv; const float cum = dt_scan(DT, dt_bias, a_log, b, c, w, lane, dtv); dtl[lane * 8 + w] = dtv; acl[lane * 8 + w] = cum; }
    float ssl[2] = {0.f, 0.f};
#pragma unroll 1
    for (int g = 0; g < 2; ++g) {
        const int head = 4 * g + hl;
        const bf16_t* hsrc = SST + (size_t)((b * 128 + c) * 8 + head) * 8192;
        bf16x8 hfr[4][4];
#pragma unroll
        for (int ks = 0; ks < 4; ++ks)
#pragma unroll
            for (int pt = 0; pt < 4; ++pt) hfr[ks][pt] = *(const GAS bf16x8*)(hsrc + (16 * pt + fr) * 128 + 32 * ks + 8 * fq);
        lds_barrier();
        { int tt = F.tid; asm volatile("" : "+v"(tt)); const int cgi = tt & 63, seg = tt >> 6, s0 = 8 * seg;
            const int col = (cgi < 32) ? (C_XBC + g * 256 + 8 * cgi) : (cgi < 48) ? (C_XBC + 512 + g * 128 + 8 * (cgi - 32)) : (C_XBC + 768 + g * 128 + 8 * (cgi - 48));
            const float f[8] = {1.f, 1.f, 1.f, 1.f, 1.f, 1.f, 1.f, 1.f}; u32x4 pk[8];
            if (cgi < 32) { conv_tile<true, false>(P, cw, cb, b, c * 64 + s0, col, f, pk);
                LAS unsigned char* d = XT + (8 * cgi) * 144 + s0 * 2;
#pragma unroll
                for (int i = 0; i < 8; ++i) *(LAS u32x4*)(d + i * 144) = pk[i]; }
            else { conv_tile<false, false>(P, cw, cb, b, c * 64 + s0, col, f, pk);
                LAS unsigned char* d = ((cgi < 48) ? (Bs + (8 * (cgi - 32)) * 2) : (Cs + (8 * (cgi - 48)) * 2)) + s0 * 272;
#pragma unroll
                for (int i = 0; i < 8; ++i) *(LAS u32x4*)(d + i * 272) = pk[i]; } }
        u32x2 zvr[2][4];
#pragma unroll
        for (int li = 0; li < 2; ++li)
#pragma unroll
            for (int pt = 0; pt < 4; ++pt) zvr[li][pt] = *(const GAS u32x2*)(P + pidx((size_t)b * SEQ + c * 64 + 16 * (2 * half + li) + fr, C_MZ + head * 64 + 16 * pt + 4 * fq));
        lds_barrier();
        const float dsk = ((const GAS float*)d_skip)[head];
#pragma unroll
        for (int li = 0; li < 2; ++li) {
            asm volatile("" ::: "memory"); __builtin_amdgcn_sched_barrier(0);
            const int lt = 2 * half + li, l = 16 * lt + fr;
            const float al = acl[l * 8 + head];
            bf16x8 cf[4];
#pragma unroll
            for (int ks = 0; ks < 4; ++ks) cf[ks] = ldsfrag(Cs + (16 * lt + fr) * 272 + (32 * ks + 8 * fq) * 2);
            f32x4 y[4];
#pragma unroll
            for (int pt = 0; pt < 4; ++pt) y[pt] = (f32x4){0.f, 0.f, 0.f, 0.f};
#pragma unroll
            for (int ks = 0; ks < 4; ++ks) {
#pragma unroll
                for (int pt = 0; pt < 4; ++pt) y[pt] = mfma16(hfr[ks][pt], cf[ks], y[pt]); }
            { const float eal = __expf(al);
#pragma unroll
              for (int pt = 0; pt < 4; ++pt) y[pt] = y[pt] * eal; }
#pragma unroll
            for (int st = 0; st < 4; ++st) { f32x4 acc = (f32x4){0.f, 0.f, 0.f, 0.f};
#pragma unroll
                for (int ks = 0; ks < 4; ++ks) acc = mfma16(ldsfrag(Bs + (16 * st + fr) * 272 + (32 * ks + 8 * fq) * 2), cf[ks], acc);
#pragma unroll
                for (int i = 0; i < 4; ++i) { const int s = 16 * st + 4 * fq + i;
                    acc[i] = (s <= l) ? acc[i] * __expf(al - acl[s * 8 + head]) * dtl[s * 8 + head] : 0.f; }
                *(LAS u32x2*)(Pw + fr * 144 + (16 * st + 4 * fq) * 2) = pack4(acc); }
#pragma unroll
            for (int ks = 0; ks < 2; ++ks) { if (2 * ks <= lt) { const bf16x8 pf = ldsfrag(Pw + fr * 144 + (32 * ks + 8 * fq) * 2);
#pragma unroll
                for (int pt = 0; pt < 4; ++pt) y[pt] = mfma16(ldsfrag(XT + (hl * 64 + 16 * pt + fr) * 144 + (32 * ks + 8 * fq) * 2), pf, y[pt]); } }
            const size_t row = (size_t)b * SEQ + c * 64 + l;
#pragma unroll
            for (int pt = 0; pt < 4; ++pt) { const int p0 = 16 * pt + 4 * fq;
                const u32x2 zv = zvr[li][pt];
                const LAS bf16_t* xp = (const LAS bf16_t*)(XT + (hl * 64 + p0) * 144 + l * 2);
                f32x4 r;
                r[0] = (y[pt][0] + bf2f(xp[0 * 72]) * dsk) * silu_f(bf_lo(zv.x)); r[1] = (y[pt][1] + bf2f(xp[1 * 72]) * dsk) * silu_f(bf_hi(zv.x));
                r[2] = (y[pt][2] + bf2f(xp[2 * 72]) * dsk) * silu_f(bf_lo(zv.y)); r[3] = (y[pt][3] + bf2f(xp[3 * 72]) * dsk) * silu_f(bf_hi(zv.y));
                ssl[li] += (r[0] * r[0] + r[1] * r[1]) + (r[2] * r[2] + r[3] * r[3]);
                *(GAS u32x2*)(P + pidx(row, C_MZ + head * 64 + p0)) = pack4(r); }
        }
    }
#pragma unroll
    for (int li = 0; li < 2; ++li) { float ss = ssl[li];
        ss += __shfl_xor(ss, 16); ss += __shfl_xor(ss, 32);
        if (fq == 0) ssq[hl * 64 + 16 * (2 * half + li) + fr] = ss; }
    asm volatile("s_waitcnt vmcnt(0)" ::: "memory");
    u32x2 ypk[2][2][4]; f32x4 ngv[2][4];
#pragma unroll
    for (int g = 0; g < 2; ++g)
#pragma unroll
        for (int pt = 0; pt < 4; ++pt) { const int ch = (4 * g + hl) * 64 + 16 * pt + 4 * fq; ngv[g][pt] = *(const GAS f32x4*)(nrm + ch);
#pragma unroll
            for (int li = 0; li < 2; ++li) ypk[li][g][pt] = *(const GAS u32x2*)(P + pidx((size_t)b * SEQ + c * 64 + 16 * (2 * half + li) + fr, C_MZ + ch)); }
    lds_barrier();
#pragma unroll
    for (int li = 0; li < 2; ++li) { const int l = 16 * (2 * half + li) + fr;
        const float rstd = rsqrtf((ssq[l] + ssq[64 + l] + ssq[128 + l] + ssq[192 + l]) * (1.f / 512.f) + EPS);
        const size_t row = (size_t)b * SEQ + c * 64 + l;
#pragma unroll
        for (int g = 0; g < 2; ++g)
#pragma unroll
            for (int pt = 0; pt < 4; ++pt) { const int ch = (4 * g + hl) * 64 + 16 * pt + 4 * fq;
                const u32x2 pk = ypk[li][g][pt]; const f32x4 r = (f32x4){bf_lo(pk.x), bf_hi(pk.x), bf_lo(pk.y), bf_hi(pk.y)};
                *(GAS u32x2*)(P + pidx(row, C_MZ + ch)) = pack4(r * rstd * ngv[g][pt]); } }
}

__device__ __forceinline__ void scan_phase(const Frame& F, bf16_t* RST, bf16_t* SST, const float* CD) {
    for (int task = F.bid * NTHR + F.tid; task < 131072; task += F.G * NTHR) {
        {
          const int pr = task & 8191, bh = task >> 13, b = bh >> 2, h = bh & 3;
          GAS unsigned* p = (GAS unsigned*)(RST + (size_t)((b * 128) * 4 + h) * 16384) + pr;
          const float dec = __builtin_amdgcn_exp2f(64.f * log2gamma(h));
          float s0 = 0.f, s1 = 0.f;
#pragma unroll 1
          for (int c0 = 0; c0 < 128; c0 += 32) { unsigned v[32];
#pragma unroll
              for (int i = 0; i < 32; ++i) v[i] = p[(size_t)(c0 + i) * 32768];
#pragma unroll
              for (int i = 0; i < 32; ++i) { p[(size_t)(c0 + i) * 32768] = cvt_pk_bf16(s0, s1); s0 = s0 * dec + bf_lo(v[i]); s1 = s1 * dec + bf_hi(v[i]); } } }
        {
          const int pr = task & 4095, bh = task >> 12, b = bh >> 3, hd = bh & 7;
          GAS unsigned* p = (GAS unsigned*)(SST + (size_t)((b * 128) * 8 + hd) * 8192) + pr;
          const GAS float* cd = (const GAS float*)(CD + (b * 128) * 8 + hd);
          float s0 = 0.f, s1 = 0.f;
#pragma unroll 1
          for (int c0 = 0; c0 < 128; c0 += 32) { unsigned v[32]; float d[32];
#pragma unroll
              for (int i = 0; i < 32; ++i) { v[i] = p[(size_t)(c0 + i) * 32768]; d[i] = cd[(c0 + i) * 8]; }
#pragma unroll
              for (int i = 0; i < 32; ++i) { p[(size_t)(c0 + i) * 32768] = cvt_pk_bf16(s0, s1); s0 = s0 * d[i] + bf_lo(v[i]); s1 = s1 * d[i] + bf_hi(v[i]); } } }
    }
}


#define XB_TMO      128
#define XB_XCNT(j)  (256  + 64 * (j))
#define XB_XSUB(j)  (1280 + 64 * (j))
#define XB_XGEN(j)  (2304 + 64 * (j))
#define XB_TOP      3328
#define XB_TOPGEN   3392
#define XB_SPIN_CAP (1u << 22)
__device__ __forceinline__ unsigned xb_ld(unsigned* p)              { return __hip_atomic_load(p, __ATOMIC_RELAXED, __HIP_MEMORY_SCOPE_AGENT); }
__device__ __forceinline__ unsigned xb_add(unsigned* p, unsigned v) { return __hip_atomic_fetch_add(p, v, __ATOMIC_RELAXED, __HIP_MEMORY_SCOPE_AGENT); }
__device__ __forceinline__ unsigned xb_xcc_id() { return (unsigned)__builtin_amdgcn_s_getreg((3 << 11) | 20) & 0xFu; }
#define XB_SPIN(cond, bar) do { unsigned _sp = 0; while (cond) { __builtin_amdgcn_s_sleep(1); \
    if ((++_sp & 255u) == 0u) { if (xb_ld(&(bar)[XB_TMO])) break; if (_sp > XB_SPIN_CAP) { atomicAdd(&(bar)[XB_TMO], 1u); break; } } } } while (0)
struct XcdBarrier { unsigned* bar; unsigned x; volatile LAS unsigned* st; };
__device__ __forceinline__ XcdBarrier xcd_barrier_post(unsigned* bar, volatile LAS unsigned* st) {
    XcdBarrier b; b.bar = bar; b.x = xb_xcc_id(); b.st = st;
    if (threadIdx.x == 0) (void)xb_add(&bar[XB_XCNT(b.x)], 1u);
    return b;
}
__device__ __forceinline__ void xcd_barrier_complete(unsigned* bar, unsigned x, unsigned& nloc, unsigned& nx) {
    const unsigned G = gridDim.x * gridDim.y * gridDim.z;
    unsigned sum, cnt, mine, sp = 0u;
    for (;;) {
        sum = 0u; cnt = 0u; mine = 0u;
#pragma unroll
        for (unsigned j = 0; j < 16; ++j) { const unsigned c = xb_ld(&bar[XB_XCNT(j)]); sum += c; cnt += (c > 0u) ? 1u : 0u; mine = (j == x) ? c : mine; }
        if (sum == G) break;
        __builtin_amdgcn_s_sleep(1);
        if ((++sp & 255u) == 0u) { if (xb_ld(&bar[XB_TMO])) break; if (sp > XB_SPIN_CAP) { atomicAdd(&bar[XB_TMO], 1u); break; } }
    }
    nloc = mine > 0u ? mine : 1u; nx = cnt > 0u ? cnt : 1u;
}
__device__ __forceinline__ void xcd_barrier(const XcdBarrier& b) {
    asm volatile("s_waitcnt vmcnt(0)" ::: "memory");
    __syncthreads();
    if (threadIdx.x == 0) {
        unsigned* bar = b.bar;
        __builtin_amdgcn_s_waitcnt(0);
        unsigned nloc = b.st[0], nx = b.st[1];
        if (nloc == 0u) { xcd_barrier_complete(bar, b.x, nloc, nx); b.st[0] = nloc; b.st[1] = nx; }
        const unsigned old = xb_add(&bar[XB_XSUB(b.x)], 1u);
        const unsigned gen = old / nloc;
        if (old + 1u == (gen + 1u) * nloc) {
            __builtin_amdgcn_fence(__ATOMIC_RELEASE, "agent");
            asm volatile("s_waitcnt vmcnt(0)" ::: "memory");
            const unsigned og = xb_add(&bar[XB_TOP], 1u);
            const unsigned tg = og / nx;
            if (og + 1u == (tg + 1u) * nx) xb_add(&bar[XB_TOPGEN], 1u);
            else XB_SPIN(xb_ld(&bar[XB_TOPGEN]) == tg, bar);
            __builtin_amdgcn_fence(__ATOMIC_ACQUIRE, "agent");
            xb_add(&bar[XB_XGEN(b.x)], 1u);
            asm volatile("s_waitcnt vmcnt(0)" ::: "memory");
        } else {
            XB_SPIN(xb_ld(&bar[XB_XGEN(b.x)]) == gen, bar);
            __builtin_amdgcn_fence(__ATOMIC_ACQUIRE, "agent");
            asm volatile("s_waitcnt vmcnt(0)" ::: "memory");
        }
    }
    __syncthreads();
}

constexpr int NPH = 26;
__global__ void __launch_bounds__(NTHR, 2) fwd_kernel(Params p) {
    extern __shared__ __attribute__((aligned(16))) unsigned char lds_raw[];
    volatile LAS unsigned* xb_st = (volatile LAS unsigned*)((LAS unsigned char*)lds_raw + LDS_BYTES - 64);
    if (threadIdx.x == 0) { xb_st[0] = 0u; xb_st[1] = 0u; }
    __syncthreads();
    const XcdBarrier xbar = xcd_barrier_post((unsigned*)p.ws, xb_st);
    if (p.ph_lo == 0) {
        Frame F0; F0.lds = (LAS unsigned char*)lds_raw; F0.tid = threadIdx.x; F0.lane = F0.tid & 63; F0.wave = __builtin_amdgcn_readfirstlane(F0.tid >> 6); F0.G = gridDim.x; F0.bid = blockIdx.x;
        if (EN_PRO) prologue(F0, p, as_global(p.ws), 0);
        if (p.ph_hi > 1) cg::this_grid().sync();
    }
#ifdef TPROBE
    unsigned long long tA = 0, tB = 0;
#endif
    for (int ph_ = (p.ph_lo < 1 ? 1 : p.ph_lo); ph_ < p.ph_hi; ++ph_) {
#ifdef TPROBE
    const unsigned long long tp0 = __builtin_amdgcn_s_memrealtime();
#endif
    int ph = __builtin_amdgcn_readfirstlane(ph_);
#ifdef PH_LIMIT
    if (ph > PH_LIMIT && ph < NPH - 1) continue;
#endif
    int tid_ = threadIdx.x; asm volatile("" : "+v"(tid_));
    unsigned char* ws_ = p.ws; asm volatile("" : "+s"(ws_)); unsigned char* ws = as_global(ws_);
    int zi = 0; asm volatile("" : "+s"(zi));
    Frame F;
    F.lds = (LAS unsigned char*)lds_raw;
    F.tid = tid_; F.lane = F.tid & 63; F.wave = __builtin_amdgcn_readfirstlane(F.tid >> 6); { int g_ = gridDim.x, b_ = blockIdx.x; asm volatile("" : "+s"(g_), "+s"(b_)); F.G = g_; F.bid = b_; }
    float* MOD = (float*)(ws + WS_MOD);
    const f32x2* ROPE = (const f32x2*)(ws + WS_ROPE);
    float* DT = (float*)(ws + WS_DT);
    float* CD = (float*)(ws + WS_CD);
    bf16_t* WFU = (bf16_t*)(ws + WS_WFU); bf16_t* WFD = (bf16_t*)(ws + WS_WFD); bf16_t* WIN = (bf16_t*)(ws + WS_WIN); bf16_t* WOUT = (bf16_t*)(ws + WS_WOUT);
    bf16_t* U = (bf16_t*)(ws + WS_U); bf16_t* RST = (bf16_t*)(ws + WS_RST); bf16_t* SST = (bf16_t*)(ws + WS_SST);
    bf16_t* PROJ = (bf16_t*)(ws + WS_PROJ); bf16_t* HID = PROJ;
    float* hbuf_ = p.out; asm volatile("" : "+s"(hbuf_)); float* hbuf = as_global(hbuf_);
        if (ph == NPH - 1) {
            if (EN_FIN) final_phase(F, hbuf, as_global(p.in[24 + zi]), MOD + FMOD_OFF);
        } else {
#ifdef XTRA_LIST
            static constexpr int xtra[] = XTRA_LIST;
            const int l = (ph >= NPH) ? 1 : (ph - 1) / 12, j = (ph >= NPH) ? xtra[ph - NPH] : (ph - 1) % 12;
#else
            const int l = (ph - 1) / 12, j = (ph - 1) % 12;
#endif
            const float* modl = MOD + (size_t)l * 4 * 9216;
            if (j == 0 || j == 3 || j == 9) {
                const float* hin = (l == 0 && j == 0) ? as_global(p.in[0 + zi]) : hbuf;
                const int gi = (j == 0) ? 4 : (j == 3) ? 8 : 18;
                const int mi = (j == 0) ? 0 : (j == 3) ? 3 : 6;
                if (EN_NORM) norm_phase(F, hin, as_global(p.in[gi + zi]) + l * DM, modl + mi * 1024, modl + (mi + 1) * 1024, 9216, U);
                __syncthreads();
                if (!EN_CONV) {} else if (j == 0) convert_ffn(F, as_global(p.in[5 + zi]) + (size_t)l * DM * DFF, as_global(p.in[6 + zi]) + (size_t)l * DM * DFF, as_global(p.in[7 + zi]) + (size_t)l * DM * DFF, WFU, WFD);
                else if (j == 9) convert_ffn(F, as_global(p.in[19 + zi]) + (size_t)l * DM * DFF, as_global(p.in[20 + zi]) + (size_t)l * DM * DFF, as_global(p.in[21 + zi]) + (size_t)l * DM * DFF, WFU, WFD);
                else convert_mix(F, as_global(p.in[9 + zi]) + (size_t)l * DM * INW, as_global(p.in[17 + zi]) + (size_t)l * 1536 * DM, WIN, WOUT);
            } else if (j == 1 || j == 10) {
                pg8::Gemm g{U, WFU, T_TOK, 2 * DFF, DM, DM}; pg8::StaticOrder S; S.init(T_TOK, 2 * DFF, F.G, F.bid);
                pg8::EpiSwiGLU E{HID, DFF};
                if (EN_G1) pg8::gemm_phase<pg8::EpiSwiGLU>(F.lds, F.tid, g, S, E);
            } else if (j == 2 || j == 11 || j == 8) {
                pg8::Gemm g; pg8::EpiResid E;
                if (j == 8) { g = pg8::Gemm{PROJ, WOUT, T_TOK, DM, 1536, PW}; E = pg8::EpiResid{hbuf, hbuf, modl + 5 * 1024, 1.0f}; }
                else { g = pg8::Gemm{HID, WFD, T_TOK, DM, DFF, DFF}; E = pg8::EpiResid{(l == 0 && j == 2) ? as_global(p.in[0 + zi]) : hbuf, hbuf, modl + (j == 2 ? 2 : 8) * 1024, 0.5f}; }
                pg8::StaticOrder S; S.init(T_TOK, DM, F.G, F.bid);
                if (EN_G2) { if (j == 8) pg8::gemm_phase<pg8::EpiResid, true>(F.lds, F.tid, g, S, E); else pg8::gemm_phase<pg8::EpiResid, false>(F.lds, F.tid, g, S, E); }
            } else if (j == 4) {
                pg8::Gemm g{U, WIN, T_TOK, PW, DM, DM}; pg8::StaticOrder S; S.init(T_TOK, PW, F.G, F.bid);
                pg8::EpiBf16 E{PROJ, PW};
                if (EN_G3) pg8::gemm_phase<pg8::EpiBf16>(F.lds, F.tid, g, S, E);
                if (EN_DT) dt_gemv(F, U, as_global(p.in[9 + zi]) + (size_t)l * DM * INW, DT);
            } else if (j == 5) {
                if (EN_SB && XS(1)) for (int t = F.bid; t < 1024; t += F.G) { const int qb = 63 - (t >> 4), bh = t & 15; sb_task(F, PROJ, bh >> 2, bh & 3, qb); }
                if (EN_RKV && XS(2)) for (int t = F.bid; t < 2048; t += F.G) { const int h = t & 3, bc = t >> 2; ret_kv_task(F, PROJ, ROPE, RST, bc >> 7, bc & 127, h); }
                if (EN_SST && XS(4)) for (int t = F.bid; t < 1024; t += F.G) { const int g = t & 1, bc = t >> 1;
                    ssd_state_task(F, PROJ, DT, as_global(p.in[10 + zi]) + l * 4096, as_global(p.in[11 + zi]) + l * 1024, as_global(p.in[12 + zi]) + l * 8, as_global(p.in[13 + zi]) + l * 8, SST, CD, bc >> 7, bc & 127, g); }
            } else if (j == 6) {
                if (EN_SCAN) scan_phase(F, RST, SST, CD);
            } else if (j == 7) {
                if (EN_ROUT && XS(8)) for (int t = F.bid; t < 2048; t += F.G) { const int h = t & 3, bc = t >> 2; ret_out_task(F, PROJ, ROPE, RST, as_global(p.in[15 + zi]) + l * 512, bc >> 7, bc & 127, h, ph >= NPH ? XMODE : 0); }
                if (EN_SOUT && XS(16)) for (int t = F.bid; t < 512; t += F.G) {
                    ssd_out_task(F, PROJ, DT, as_global(p.in[10 + zi]) + l * 4096, as_global(p.in[11 + zi]) + l * 1024, as_global(p.in[12 + zi]) + l * 8, as_global(p.in[13 + zi]) + l * 8, as_global(p.in[14 + zi]) + l * 8, as_global(p.in[16 + zi]) + l * 512, SST, t >> 7, t & 127); }
            }
        }
        if (ph + 1 < p.ph_hi) { xcd_barrier(xbar); }
#ifdef TPROBE
        { const unsigned long long tp1 = __builtin_amdgcn_s_memrealtime(); const int jj = (ph - 1) % 12;
          if (ph < NPH - 1) { if (TPROBE_A(jj)) tA += tp1 - tp0; if (TPROBE_B(jj)) tB += tp1 - tp0; } }
#endif
    }
#ifdef TPROBE
    cg::this_grid().sync();
    if (blockIdx.x == 0) { const float a = (float)tA * 0.01f, b = (float)tB * 0.01f * TPROBE_BS;
        if (threadIdx.x == 0) p.out[0] += a;
        for (int i = threadIdx.x; i < (1 << 20); i += NTHR) p.out[1024 + i] += b; }
#endif
}

extern "C" void kernel_launch(void* const* d_in, const int* in_sizes, int n_in, void* d_out, int out_size, void* d_ws, size_t ws_size, hipStream_t stream) {
    static int grid = 0;
    if (grid == 0) {
        if (n_in != 25 || out_size != T_TOK * DM || ws_size < WS_END) { fprintf(stderr, "kernel_launch: unexpected shapes (n_in %d out %d ws %zu)\n", n_in, out_size, ws_size); grid = -1; return; }
        int dev = 0, cus = 0, per_cu = 0;
        hipGetDevice(&dev);
        hipDeviceGetAttribute(&cus, hipDeviceAttributeMultiprocessorCount, dev);
        hipFuncSetAttribute((const void*)fwd_kernel, hipFuncAttributeMaxDynamicSharedMemorySize, LDS_BYTES);
        hipOccupancyMaxActiveBlocksPerMultiprocessor(&per_cu, (const void*)fwd_kernel, NTHR, LDS_BYTES);
        if (per_cu < 1) per_cu = 1;
        (void)hipGetLastError();
        grid = cus * per_cu;
    }
    if (grid < 0) return;
    (void)hipMemsetAsync(d_ws, 0, 65536, stream);
    Params p{};
    for (int i = 0; i < 25; ++i) p.in[i] = (const float*)d_in[i];
    p.out = (float*)d_out; p.ws = (unsigned char*)d_ws;
#if ONE_LAUNCH
#ifdef XTRA_LIST
    p.ph_lo = 0; p.ph_hi = NPH + XTRA_N;
#else
    p.ph_lo = 0; p.ph_hi = NPH;
#endif
    void* args[] = {&p};
    hipError_t e = hipLaunchCooperativeKernel((const void*)fwd_kernel, dim3(grid), dim3(NTHR), args, LDS_BYTES, stream);
    if (e != hipSuccess) fprintf(stderr, "cooperative launch failed: %s (grid %d)\n", hipGetErrorString(e), grid);
#else
    for (int ph = 0; ph < NPH; ++ph) { p.ph_lo = ph; p.ph_hi = ph + 1; hipLaunchKernelGGL(fwd_kernel, dim3(grid), dim3(NTHR), LDS_BYTES, stream, p); }
#endif
}
```

```cpp
#include <hip/hip_runtime.h>
#include <hip/hip_cooperative_groups.h>
#include <cstdint>
#include <cstdio>
namespace cg = cooperative_groups;

#ifndef ONE_LAUNCH
#define ONE_LAUNCH 1
#endif

#ifndef EN_ALL
#define EN_ALL 1
#endif
#ifndef EN_PRO
#define EN_PRO EN_ALL
#endif
#ifndef EN_FIN
#define EN_FIN EN_ALL
#endif
#ifndef EN_NORM
#define EN_NORM EN_ALL
#endif
#ifndef EN_CONV
#define EN_CONV EN_ALL
#endif
#ifndef EN_G1
#define EN_G1 EN_ALL
#endif
#ifndef EN_G2
#define EN_G2 EN_ALL
#endif
#ifndef EN_G3
#define EN_G3 EN_ALL
#endif
#ifndef EN_DT
#define EN_DT EN_ALL
#endif
#ifndef EN_SB
#define EN_SB EN_ALL
#endif
#ifndef EN_RKV
#define EN_RKV EN_ALL
#endif
#ifndef EN_SST
#define EN_SST EN_ALL
#endif
#ifndef EN_SCAN
#define EN_SCAN EN_ALL
#endif
#ifndef EN_ROUT
#define EN_ROUT EN_ALL
#endif
#ifndef EN_SOUT
#define EN_SOUT EN_ALL
#endif
#ifndef EN_SINTER
#define EN_SINTER 1
#endif
#ifndef XSEL
#define XSEL 31
#endif
#define XS(m) (ph < NPH || (XSEL & (m)))
#ifndef XMODE
#define XMODE 0
#endif
#define LAS __attribute__((address_space(3)))
#define GAS __attribute__((address_space(1)))
template <class T> __device__ __forceinline__ T* as_global(T* p) {
#if defined(__HIP_DEVICE_COMPILE__)
    __builtin_assume(!__builtin_amdgcn_is_shared((const void*)p)); __builtin_assume(!__builtin_amdgcn_is_private((const void*)p));
#endif
    return p; }
typedef unsigned short bf16_t;
typedef short bf16x8 __attribute__((ext_vector_type(8)));
typedef float f32x4 __attribute__((ext_vector_type(4)));
typedef float f32x2 __attribute__((ext_vector_type(2)));
typedef unsigned u32x4 __attribute__((ext_vector_type(4)));
typedef unsigned u32x2 __attribute__((ext_vector_type(2)));

constexpr int T_TOK = 32768, SEQ = 8192, DM = 1024, DFF = 2816, INW = 5128, PW = 5120;
constexpr int NTHR = 512, NWAVE = 8;
constexpr float EPS = 1e-6f;
constexpr int C_RQ = 0, C_SQ = 512, C_MZ = 1024, C_RK = 1536, C_RV = 2048, C_RG = 2560, C_SK = 3072, C_SV = 3584, C_XBC = 4096;

constexpr size_t MiB = 1u << 20;
constexpr size_t WS_MOD = 1 * MiB, WS_ROPE = 2 * MiB, WS_DT = 6 * MiB, WS_CD = 7 * MiB;
constexpr size_t WS_WFU = 8 * MiB, WS_WFD = 19 * MiB, WS_WIN = 25 * MiB, WS_WOUT = 35 * MiB;
constexpr size_t WS_U = 38 * MiB, WS_RST = 38 * MiB, WS_SST = 102 * MiB, WS_PROJ = 166 * MiB, WS_END = 486 * MiB;
constexpr int FMOD_OFF = 2 * 4 * 9 * 1024;

constexpr size_t PLANE = (size_t)T_TOK * 128;
__device__ __forceinline__ size_t pidx(size_t row, int col) { return (size_t)(col >> 7) * PLANE + row * 128 + (col & 127); }
constexpr int LDS_BYTES = 147456;

struct Params {
    const float* in[25];
    float* out;
    unsigned char* ws;
    int ph_lo, ph_hi;
};

typedef __bf16 bf16x2_t __attribute__((ext_vector_type(2)));
__device__ __forceinline__ unsigned cvt_pk_bf16(float lo, float hi) { const f32x2 v = {lo, hi}; const bf16x2_t b = __builtin_convertvector(v, bf16x2_t); return __builtin_bit_cast(unsigned, b); }
__device__ __forceinline__ float bf_lo(unsigned u) { return __uint_as_float(u << 16); }
__device__ __forceinline__ float bf_hi(unsigned u) { return __uint_as_float(u & 0xffff0000u); }
__device__ __forceinline__ float bf2f(bf16_t x) { return __uint_as_float(((unsigned)x) << 16); }
__device__ __forceinline__ bf16_t f2bf(float f) { return (bf16_t)(cvt_pk_bf16(f, 0.f) & 0xffffu); }
__device__ __forceinline__ float wave_sum(float v) {
#pragma unroll
    for (int o = 1; o < 64; o <<= 1) v += __shfl_xor(v, o);
    return v;
}
__device__ __forceinline__ float wave_max(float v) {
#pragma unroll
    for (int o = 1; o < 64; o <<= 1) v = fmaxf(v, __shfl_xor(v, o));
    return v;
}
__device__ __forceinline__ void lds_barrier() { asm volatile("s_waitcnt lgkmcnt(0)" ::: "memory"); __builtin_amdgcn_s_barrier(); asm volatile("" ::: "memory"); }
__device__ __forceinline__ float silu_f(float g) { return g * __builtin_amdgcn_rcpf(1.0f + __builtin_amdgcn_exp2f(-1.44269504f * g)); }
__device__ __forceinline__ f32x4 mfma16(bf16x8 a, bf16x8 b, f32x4 c) { return __builtin_amdgcn_mfma_f32_16x16x32_bf16(a, b, c, 0, 0, 0); }
__device__ __forceinline__ bf16x8 ldsfrag(const LAS unsigned char* p) { return *(const LAS bf16x8*)p; }
__device__ __forceinline__ u32x2 pack4(f32x4 v) { u32x2 w; w.x = cvt_pk_bf16(v[0], v[1]); w.y = cvt_pk_bf16(v[2], v[3]); return w; }
__device__ __forceinline__ void unpack8(u32x4 v, float* f) {
    f[0] = bf_lo(v.x); f[1] = bf_hi(v.x); f[2] = bf_lo(v.y); f[3] = bf_hi(v.y); f[4] = bf_lo(v.z); f[5] = bf_hi(v.z); f[6] = bf_lo(v.w); f[7] = bf_hi(v.w);
}
__device__ __forceinline__ float log2gamma(int h) { return h == 0 ? -0.04580368961312479f : (h == 1 ? -0.02272007650008353f : (h == 2 ? -0.011315313227834146f : -0.005646563141142063f)); }

namespace pg8 {
constexpr int BM = 256, BK = 64, HALF = 128, HTB = HALF * BK * 2, STAGE_BYTES = 8 * HTB, NXCD = 8, WGM = 8;
__host__ __device__ __forceinline__ int lds_byte(int r, int c) { const int st = (r >> 4) * 2 + (c >> 5), rr = r & 15, cc = c & 31, ob = rr * 64 + cc * 2; return st * 1024 + (ob ^ (((ob >> 9) & 1) << 5)); }
__host__ __device__ __forceinline__ void stage_rc(int b, int& R, int& C) { const int st = b / 1024, sb = b % 1024, swz = sb ^ (((sb >> 9) & 1) << 5); R = (st >> 1) * 16 + swz / 64; C = (st & 1) * 32 + (swz % 64) / 2; }
__host__ __device__ __forceinline__ int perm32(int rho) { const int n = rho >> 4, i = rho & 15; return 8 * (i >> 2) + 4 * n + (i & 3); }
struct Unit { int pm, pn; };
struct Gemm { const bf16_t* A; const bf16_t* Bt; int M, N, K, lda; };
struct StaticOrder {
    int nM, nN, nwg, G, c;
    __device__ void init(int M, int N, int G_, int c_) { nM = M / BM; nN = N / BM; nwg = nM * nN; G = G_; c = c_; }
    __device__ bool next(int i, Unit& u) const {
        const long L = (long)i * G + c; if (L >= nwg) return false;
        int wgid = (int)L; { const int q = nwg / NXCD, r = nwg % NXCD, xcd = wgid % NXCD, off = wgid / NXCD; wgid = (xcd < r ? xcd * (q + 1) : r * (q + 1) + (xcd - r) * q) + off; }
        const int nig = WGM * nN, gid = wgid / nig, fm = gid * WGM, gsz = (nM - fm) < WGM ? (nM - fm) : WGM;
        u.pm = fm + ((wgid % nig) % gsz); u.pn = (wgid % nig) / gsz; return true;
    }
};
struct EpiBf16 {
    bf16_t* O; int ldc;
    __device__ __forceinline__ void operator()(const f32x4 (&acc)[2][2][4][2], const Unit& u, int wr, int wc, int fr, int fq) const {
        const int row0 = u.pm * BM + wr * 64 + fr, col0 = u.pn * BM + wc * 32 + 8 * fq;
#pragma unroll
        for (int ai = 0; ai < 2; ++ai)
#pragma unroll
            for (int m = 0; m < 4; ++m) { bf16_t* rowp = O + (size_t)(2 * u.pn) * PLANE + (size_t)(row0 + ai * HALF + m * 16) * 128 + wc * 32 + 8 * fq;
#pragma unroll
                for (int bj = 0; bj < 2; ++bj) { const f32x4 v0 = acc[ai][bj][m][0], v1 = acc[ai][bj][m][1];
                    u32x4 w; w.x = cvt_pk_bf16(v0[0], v0[1]); w.y = cvt_pk_bf16(v0[2], v0[3]); w.z = cvt_pk_bf16(v1[0], v1[1]); w.w = cvt_pk_bf16(v1[2], v1[3]);
                    *(GAS u32x4*)(rowp + bj * PLANE) = w; } }
    }
};
struct EpiSwiGLU {
    bf16_t* O; int ldo;
    __device__ __forceinline__ void operator()(const f32x4 (&acc)[2][2][4][2], const Unit& u, int wr, int wc, int fr, int fq) const {
        const int row0 = u.pm * BM + wr * 64 + fr, col0 = u.pn * HALF + wc * 32 + 8 * fq;
#pragma unroll
        for (int ai = 0; ai < 2; ++ai)
#pragma unroll
            for (int m = 0; m < 4; ++m) { bf16_t* rowp = O + (size_t)(row0 + ai * HALF + m * 16) * ldo + col0;
                float hv[8];
#pragma unroll
                for (int n = 0; n < 2; ++n)
#pragma unroll
                    for (int i = 0; i < 4; ++i) hv[4 * n + i] = silu_f(acc[ai][0][m][n][i]) * acc[ai][1][m][n][i];
                u32x4 w; w.x = cvt_pk_bf16(hv[0], hv[1]); w.y = cvt_pk_bf16(hv[2], hv[3]); w.z = cvt_pk_bf16(hv[4], hv[5]); w.w = cvt_pk_bf16(hv[6], hv[7]);
                *(GAS u32x4*)rowp = w; }
    }
};
struct EpiResid {
    bf16_t* hb; const float* gate; float cmul;
    __device__ __forceinline__ void operator()(const f32x4 (&acc)[2][2][4][2], const Unit& u, int wr, int wc, int fr, int fq) const {
        const int row0 = u.pm * BM + wr * 64 + fr, col0 = u.pn * BM + wc * 32 + 8 * fq;
        const int b = (u.pm * BM) >> 13;
        f32x4 gm[2][2];
#pragma unroll
        for (int bj = 0; bj < 2; ++bj)
#pragma unroll
            for (int n = 0; n < 2; ++n) { const f32x4 g = *(const GAS f32x4*)(gate + (size_t)b * 9216 + col0 + bj * HALF + 4 * n); gm[bj][n] = (g + 1.0f) * cmul; }
#pragma unroll
        for (int ai = 0; ai < 2; ++ai) {
            u32x4 hv[4][2];
#pragma unroll
            for (int m = 0; m < 4; ++m) { const size_t off = (size_t)(row0 + ai * HALF + m * 16) * DM + col0;
#pragma unroll
                for (int bj = 0; bj < 2; ++bj) hv[m][bj] = *(const GAS u32x4*)(hb + off + bj * HALF); }
#pragma unroll
            for (int m = 0; m < 4; ++m) { const size_t off = (size_t)(row0 + ai * HALF + m * 16) * DM + col0;
#pragma unroll
                for (int bj = 0; bj < 2; ++bj) { const u32x4 hh = hv[m][bj];
                    const f32x4 h0 = (f32x4){bf_lo(hh.x), bf_hi(hh.x), bf_lo(hh.y), bf_hi(hh.y)}, h1 = (f32x4){bf_lo(hh.z), bf_hi(hh.z), bf_lo(hh.w), bf_hi(hh.w)};
                    const f32x4 v0 = h0 + gm[bj][0] * acc[ai][bj][m][0], v1 = h1 + gm[bj][1] * acc[ai][bj][m][1];
                    u32x4 w; w.x = cvt_pk_bf16(v0[0], v0[1]); w.y = cvt_pk_bf16(v0[2], v0[3]); w.z = cvt_pk_bf16(v1[0], v1[1]); w.w = cvt_pk_bf16(v1[2], v1[3]);
                    *(GAS u32x4*)(hb + off + bj * HALF) = w; } }
        }
    }
};

template <class Epi, bool APL = false>
__device__ __forceinline__ void gemm_phase(LAS unsigned char* lds, const int tid, const Gemm g, const StaticOrder& S, const Epi& E) {
    const int wid = __builtin_amdgcn_readfirstlane(tid >> 6), lane = tid & 63, wr = wid >> 2, wc = wid & 3, fr = lane & 15, fq = lane >> 4;
    const int K = g.K, nt = K / BK, lda = g.lda;
    unsigned voffA[2], voffB[2];
#pragma unroll
    for (int i = 0; i < 2; ++i) { int R, C; stage_rc(tid * 16 + i * 8192, R, C); const int Rb = (R & ~31) + perm32(R & 31);
        voffA[i] = (unsigned)(R * (APL ? 128 : lda) + C) * 2u; voffB[i] = (unsigned)(Rb * K + C) * 2u; }
    const size_t kstep = (size_t)(BK * 2);
    const size_t hstepA = (size_t)HALF * (APL ? 128 : lda) * 2, hstepB = (size_t)HALF * K * 2;
#define PG8_KA(t) (APL ? ((size_t)((t) >> 1) * (PLANE * 2) + (size_t)((t) & 1) * 128) : (size_t)(t) * kstep)
    const size_t tstepA = 2 * hstepA, tstepB = 2 * hstepB;
    const unsigned ldsw = (unsigned)wid * 1024u;
    const int aoff = lds_byte(wr * 64 + fr, fq * 8), boff = lds_byte(wc * 32 + fr, fq * 8);
#define PG8_SA(b, h) (((b) * 2 + (h)) * HTB)
#define PG8_SB(b, h) ((4 + (b) * 2 + (h)) * HTB)
#define PG8_STAGE(bufoff, gbase, voff) do { _Pragma("unroll") for (int _i = 0; _i < 2; ++_i) \
        __builtin_amdgcn_global_load_lds((const unsigned*)((const char*)(gbase) + (voff)[_i]), (LAS unsigned*)(lds + (bufoff) + ldsw + _i * 8192), 16, 0, 0); } while (0)
#define PG8_LDA(dst, b, h) do { _Pragma("unroll") for (int m = 0; m < 4; ++m) _Pragma("unroll") for (int k = 0; k < 2; ++k) dst[m][k] = *(const LAS bf16x8*)(lds + PG8_SA(b, h) + aoff + m * 2048 + k * 1024); } while (0)
#define PG8_LDB(dst, b, h) do { _Pragma("unroll") for (int n = 0; n < 2; ++n) _Pragma("unroll") for (int k = 0; k < 2; ++k) dst[n][k] = *(const LAS bf16x8*)(lds + PG8_SB(b, h) + boff + n * 2048 + k * 1024); } while (0)
#define PG8_MMA(ai, bj, At, Bt) do { __builtin_amdgcn_s_setprio(1); _Pragma("unroll") for (int m = 0; m < 4; ++m) _Pragma("unroll") for (int n = 0; n < 2; ++n) _Pragma("unroll") for (int k = 0; k < 2; ++k) \
        acc[ai][bj][m][n] = __builtin_amdgcn_mfma_f32_16x16x32_bf16(Bt[n][k], At[m][k], acc[ai][bj][m][n], 0, 0, 0); __builtin_amdgcn_s_setprio(0); } while (0)
#define PG8_WAIT_V(n) asm volatile("s_waitcnt vmcnt(" #n ")" ::: "memory")
#define PG8_WAIT_L(n) asm volatile("s_waitcnt lgkmcnt(" #n ")" ::: "memory")
#define PG8_BAR __builtin_amdgcn_s_barrier()
#define PG8_SCHED __builtin_amdgcn_sched_barrier(0)
    Unit cur, nxt; int ui = 0;
    if (!S.next(0, cur)) return;
    f32x4 acc[2][2][4][2];
#pragma unroll
    for (int a = 0; a < 2; ++a)
#pragma unroll
        for (int b = 0; b < 2; ++b)
#pragma unroll
            for (int m = 0; m < 4; ++m)
#pragma unroll
                for (int n = 0; n < 2; ++n) acc[a][b][m][n] = (f32x4){0.f, 0.f, 0.f, 0.f};
    bf16x8 At[4][2], B0[2][2], B1[2][2];
    const char* cA = (const char*)g.A + (size_t)cur.pm * tstepA; const char* cB = (const char*)g.Bt + (size_t)cur.pn * tstepB;
    PG8_STAGE(PG8_SB(0, 0), cB, voffB); PG8_STAGE(PG8_SB(0, 1), cB + hstepB, voffB); PG8_STAGE(PG8_SA(0, 0), cA, voffA); PG8_STAGE(PG8_SA(0, 1), cA + hstepA, voffA);
    if (wr == 1) PG8_BAR;
    PG8_WAIT_V(2); PG8_BAR;
    PG8_STAGE(PG8_SB(1, 0), cB + kstep, voffB); PG8_STAGE(PG8_SA(1, 0), cA + PG8_KA(1), voffA); PG8_STAGE(PG8_SB(1, 1), cB + hstepB + kstep, voffB);
    PG8_WAIT_V(6); PG8_BAR;
    for (;;) {
        const bool has_next = S.next(ui + 1, nxt);
        const char* nA = has_next ? (const char*)g.A + (size_t)nxt.pm * tstepA : cA; const char* nB = has_next ? (const char*)g.Bt + (size_t)nxt.pn * tstepB : cB;
        for (int t = 0; t < nt; t += 2) {
            const bool last = (t == nt - 2);
            const char* a1 = cA + PG8_KA(t + 1);
            const char* a2 = last ? nA : cA + PG8_KA(t + 2); const char* b2 = last ? nB : cB + (size_t)(t + 2) * kstep;
            const char* a3 = last ? nA + PG8_KA(1) : cA + PG8_KA(t + 3); const char* b3 = b2 + kstep;
            PG8_LDB(B0, 0, 0); PG8_LDB(B1, 0, 1); PG8_SCHED; PG8_LDA(At, 0, 0); PG8_STAGE(PG8_SA(1, 1), a1 + hstepA, voffA);
            PG8_WAIT_V(8); PG8_WAIT_L(0); PG8_BAR; PG8_MMA(0, 0, At, B0); PG8_MMA(0, 1, At, B1); PG8_BAR; PG8_SCHED;
            PG8_LDA(At, 0, 1); PG8_STAGE(PG8_SB(0, 0), b2, voffB); PG8_STAGE(PG8_SB(0, 1), b2 + hstepB, voffB); PG8_STAGE(PG8_SA(0, 0), a2, voffA);
            PG8_WAIT_V(8); PG8_WAIT_L(0); PG8_BAR; PG8_MMA(1, 0, At, B0); PG8_MMA(1, 1, At, B1); PG8_BAR; PG8_SCHED;
            PG8_LDB(B0, 1, 0); PG8_LDB(B1, 1, 1); PG8_SCHED; PG8_LDA(At, 1, 0); PG8_STAGE(PG8_SA(0, 1), a2 + hstepA, voffA);
            PG8_WAIT_V(8); PG8_WAIT_L(0); PG8_BAR; PG8_MMA(0, 0, At, B0); PG8_MMA(0, 1, At, B1); PG8_BAR; PG8_SCHED;
            PG8_LDA(At, 1, 1); PG8_STAGE(PG8_SB(1, 0), b3, voffB); PG8_STAGE(PG8_SB(1, 1), b3 + hstepB, voffB); PG8_STAGE(PG8_SA(1, 0), a3, voffA);
            PG8_WAIT_V(8); PG8_WAIT_L(0); PG8_BAR; PG8_MMA(1, 0, At, B0); PG8_MMA(1, 1, At, B1); PG8_BAR; PG8_SCHED;
        }
        if (wr == 0) PG8_BAR;
        E(acc, cur, wr, wc, fr, fq);
        if (!has_next) break;
#pragma unroll
        for (int a = 0; a < 2; ++a)
#pragma unroll
            for (int b = 0; b < 2; ++b)
#pragma unroll
                for (int m = 0; m < 4; ++m)
#pragma unroll
                    for (int n = 0; n < 2; ++n) acc[a][b][m][n] = (f32x4){0.f, 0.f, 0.f, 0.f};
        cur = nxt; cA = nA; cB = nB; ++ui;
        if (wr == 1) PG8_BAR;
    }
    PG8_WAIT_V(0);
    PG8_BAR;
#undef PG8_KA
#undef PG8_SA
#undef PG8_SB
#undef PG8_STAGE
#undef PG8_LDA
#undef PG8_LDB
#undef PG8_MMA
#undef PG8_WAIT_V
#undef PG8_WAIT_L
#undef PG8_BAR
#undef PG8_SCHED
}
}

struct Frame {
    LAS unsigned char* lds;
    int tid, lane, wave, G, bid;
};

__device__ __forceinline__ void conv_item(const float* W, int Nsrc, int K, int src_col0, bf16_t* WT, int dst_row0, int k0, LAS float* scr, int lane) {
#pragma unroll 8
    for (int i = 0; i < 32; ++i) { const int kk = 2 * i + (lane >> 5); scr[kk * 33 + (lane & 31)] = ((const GAS float*)W)[(size_t)(k0 + kk) * Nsrc + src_col0 + (lane & 31)]; }
    asm volatile("s_waitcnt lgkmcnt(0)" ::: "memory");
    const int c = lane & 7;
#pragma unroll
    for (int j = 0; j < 4; ++j) { const int n = (lane >> 3) + 8 * j; const LAS float* s = scr + (8 * c) * 33 + n;
        u32x4 o; o.x = cvt_pk_bf16(s[0 * 33], s[1 * 33]); o.y = cvt_pk_bf16(s[2 * 33], s[3 * 33]); o.z = cvt_pk_bf16(s[4 * 33], s[5 * 33]); o.w = cvt_pk_bf16(s[6 * 33], s[7 * 33]);
        *(GAS u32x4*)(WT + (size_t)(dst_row0 + n) * K + k0 + 8 * c) = o; }
    asm volatile("s_waitcnt lgkmcnt(0)" ::: "memory");
}
__device__ __forceinline__ void convert_ffn(const Frame& F, const float* wg, const float* wu, const float* wd, bf16_t* WFU, bf16_t* WFD) {
    LAS float* scr = (LAS float*)(F.lds + F.wave * 16384);
    const int gw = F.bid * NWAVE + F.wave, NGW = F.G * NWAVE;
    constexpr int I_U = 16 * 176, I_D = 44 * 32;
    for (int it = gw; it < I_U + I_D; it += NGW) {
        if (it < I_U) { const int kb = it / 176, nb = it % 176, r0 = nb * 32, pn = r0 >> 8, i0 = r0 & 255;
            conv_item(i0 < 128 ? wg : wu, DFF, DM, pn * 128 + (i0 & 127), WFU, r0, kb * 64, scr, F.lane); }
        else { const int r = it - I_U, kb = r / 32, nb = r % 32; conv_item(wd, DM, DFF, nb * 32, WFD, nb * 32, kb * 64, scr, F.lane); }
    }
}
__device__ __forceinline__ void convert_mix(const Frame& F, const float* w_in, const float* w_out, bf16_t* WIN, bf16_t* WOUT) {
    LAS float* scr = (LAS float*)(F.lds + F.wave * 16384);
    const int gw = F.bid * NWAVE + F.wave, NGW = F.G * NWAVE;
    constexpr int I_I = 16 * 160, I_O = 24 * 32;
    for (int it = gw; it < I_I + I_O; it += NGW) {
        if (it < I_I) { const int kb = it / 160, nb = it % 160, r0 = nb * 32, blk = r0 >> 9;
            const int sb = blk == 0 ? 0 : blk == 1 ? 4 : blk == 2 ? 7 : blk == 3 ? 1 : blk == 4 ? 2 : blk == 5 ? 3 : blk == 6 ? 5 : blk == 7 ? 6 : blk;
            conv_item(w_in, INW, DM, sb * 512 + (r0 & 511), WIN, r0, kb * 64, scr, F.lane); }
        else { const int r = it - I_I, kb = r / 32, nb = r % 32; conv_item(w_out, DM, 1536, nb * 32, WOUT, nb * 32, kb * 64, scr, F.lane); }
    }
}

__device__ __forceinline__ void sincos_d(double x, double& s, double& c) {
    const double k = rint(x * 0.63661977236758134308);
    double r = fma(-k, 1.57079632679489655800e+00, x); r = fma(-k, 6.12323399573676603587e-17, r);
    const double r2 = r * r;
    double sp = -7.6471637318198164759e-13; sp = sp * r2 + 1.6059043836821614599e-10; sp = sp * r2 - 2.5052108385441718775e-08; sp = sp * r2 + 2.7557319223985890653e-06;
    sp = sp * r2 - 1.9841269841269841270e-04; sp = sp * r2 + 8.3333333333333333333e-03; sp = sp * r2 - 1.6666666666666666667e-01; const double sn = r + r * r2 * sp;
    double cp = 4.7794773323873852974e-14; cp = cp * r2 - 1.1470745597729724714e-11; cp = cp * r2 + 2.0876756987868098979e-09; cp = cp * r2 - 2.7557319223985890653e-07;
    cp = cp * r2 + 2.4801587301587301587e-05; cp = cp * r2 - 1.3888888888888888889e-03; cp = cp * r2 + 4.1666666666666666667e-02; cp = cp * r2 - 0.5; const double cs = 1.0 + r2 * cp;
    const int q = ((int)k) & 3;
    s = (q == 0) ? sn : (q == 1) ? cs : (q == 2) ? -sn : -cs;
    c = (q == 0) ? cs : (q == 1) ? -sn : (q == 2) ? -cs : sn;
}
__device__ __forceinline__ void prologue(const Frame& F, const Params& p, unsigned char* ws, int zi) {
    LAS float* cs = (LAS float*)F.lds;
    LAS float* red = (LAS float*)(F.lds + 16384);
    const float* c = as_global(p.in[1 + zi]);
    for (int i = F.tid; i < 4096; i += NTHR) cs[i] = silu_f(c[i]);
    __syncthreads();
    float* MOD = (float*)(ws + WS_MOD);
    for (int task = F.bid; task < 320; task += F.G) {
        const float* W; const float* bias; int N, n0; float* dst; int dstride;
        if (task < 288) { const int l = task / 144, t = task % 144; W = as_global(p.in[2 + zi]) + (size_t)l * DM * 9216; bias = as_global(p.in[3 + zi]) + l * 9216; N = 9216; n0 = t * 64; dst = MOD + (size_t)l * 4 * 9216; dstride = 9216; }
        else { const int t = task - 288; W = as_global(p.in[22 + zi]); bias = as_global(p.in[23 + zi]); N = 2048; n0 = t * 64; dst = MOD + FMOD_OFF; dstride = 2048; }
        float a0 = 0.f, a1 = 0.f, a2 = 0.f, a3 = 0.f;
        const int kb = F.wave * 128;
#pragma unroll 32
        for (int k = 0; k < 128; ++k) { const float w = ((const GAS float*)W)[(size_t)(kb + k) * N + n0 + F.lane];
            a0 += cs[kb + k] * w; a1 += cs[1024 + kb + k] * w; a2 += cs[2048 + kb + k] * w; a3 += cs[3072 + kb + k] * w; }
        red[(F.wave * 4 + 0) * 64 + F.lane] = a0; red[(F.wave * 4 + 1) * 64 + F.lane] = a1; red[(F.wave * 4 + 2) * 64 + F.lane] = a2; red[(F.wave * 4 + 3) * 64 + F.lane] = a3;
        __syncthreads();
        if (F.tid < 256) { const int b = F.tid >> 6, col = F.tid & 63; float s = bias[n0 + col];
#pragma unroll
            for (int w = 0; w < 8; ++w) s += red[(w * 4 + b) * 64 + col];
            dst[(size_t)b * dstride + n0 + col] = s; }
        __syncthreads();
    }
    f32x2* ROPE = (f32x2*)(ws + WS_ROPE);
    for (int idx = F.bid * NTHR + F.tid; idx < SEQ * 64; idx += F.G * NTHR) {
        const int pos = idx >> 6, i = idx & 63;
        const float invf = (float)exp(-(double)i * (9.210340371976184 / 64.0));
        const float ang = (float)pos * invf;
        double s, cc; sincos_d((double)ang, s, cc);
        ROPE[idx] = (f32x2){(float)cc, (float)s};
    }
}

__device__ __forceinline__ void norm_phase(const Frame& F, const float* xin, bf16_t* hb, const float* gain, const float* shift0, const float* scale0, int bstride, bf16_t* U) {
    const int gw = F.bid * NWAVE + F.wave, NGW = F.G * NWAVE;
    for (int m0 = gw; m0 < T_TOK; m0 += 4 * NGW) {
        f32x4 v[4][4];
#pragma unroll
        for (int r = 0; r < 4; ++r) { const int m = m0 + r * NGW; if (m < T_TOK) {
            if (xin != nullptr) { const GAS f32x4* xr = (const GAS f32x4*)(xin + (size_t)m * DM) + F.lane; GAS u32x2* hs = (GAS u32x2*)(hb + (size_t)m * DM) + F.lane;
#pragma unroll
                for (int j = 0; j < 4; ++j) { v[r][j] = xr[64 * j]; hs[64 * j] = pack4(v[r][j]); } }
            else { const GAS u32x2* xr = (const GAS u32x2*)(hb + (size_t)m * DM) + F.lane;
#pragma unroll
                for (int j = 0; j < 4; ++j) { const u32x2 t = xr[64 * j]; v[r][j] = (f32x4){bf_lo(t.x), bf_hi(t.x), bf_lo(t.y), bf_hi(t.y)}; } } } }
#pragma unroll
        for (int r = 0; r < 4; ++r) { const int m = m0 + r * NGW; if (m < T_TOK) {
            const int b = m >> 13; float s = 0.f;
#pragma unroll
            for (int j = 0; j < 4; ++j) s += (v[r][j].x * v[r][j].x + v[r][j].y * v[r][j].y) + (v[r][j].z * v[r][j].z + v[r][j].w * v[r][j].w);
            const float rstd = rsqrtf(wave_sum(s) * (1.f / DM) + EPS);
            GAS u32x2* o8 = (GAS u32x2*)(U + (size_t)m * DM) + F.lane;
#pragma unroll
            for (int j = 0; j < 4; ++j) {
                const f32x4 g = ((const GAS f32x4*)gain)[F.lane + 64 * j], sh = ((const GAS f32x4*)(shift0 + (size_t)b * bstride))[F.lane + 64 * j], sc = ((const GAS f32x4*)(scale0 + (size_t)b * bstride))[F.lane + 64 * j];
                o8[64 * j] = pack4(v[r][j] * rstd * g * (sc + 1.0f) + sh); } } }
    }
}
__device__ __forceinline__ void dt_gemv(const Frame& F, const bf16_t* U, const float* w_in, float* DT) {
    LAS float* Wd = (LAS float*)F.lds;
    __syncthreads();
    for (int idx = F.tid; idx < 8192; idx += NTHR) { const int k = idx >> 3, j = idx & 7; Wd[8 * k + 4 * (k >> 3) + j] = ((const GAS float*)w_in)[(size_t)k * INW + 5120 + j]; }
    __syncthreads();
    const int gw = F.bid * NWAVE + F.wave, NGW = F.G * NWAVE;
    for (int m0 = gw; m0 < T_TOK; m0 += 4 * NGW) {
      u32x4 uvr[4][2];
#pragma unroll
      for (int r = 0; r < 4; ++r) { const int mm = (m0 + r * NGW < T_TOK) ? m0 + r * NGW : m0;
#pragma unroll
          for (int hf = 0; hf < 2; ++hf) uvr[r][hf] = *(const GAS u32x4*)(U + (size_t)mm * DM + 512 * hf + 8 * F.lane); }
#pragma unroll
      for (int r = 0; r < 4; ++r) { const int m = m0 + r * NGW; if (m < T_TOK) {
        float acc[8];
#pragma unroll
        for (int j = 0; j < 8; ++j) acc[j] = 0.f;
#pragma unroll
        for (int hf = 0; hf < 2; ++hf) {
            const u32x4 uv = uvr[r][hf];
            float uf[8]; unpack8(uv, uf);
#pragma unroll
            for (int kk = 0; kk < 8; ++kk) { const int k = 512 * hf + 8 * F.lane + kk; const LAS float* wp = Wd + 8 * k + 4 * (k >> 3);
                const f32x4 w0 = *(const LAS f32x4*)wp, w1 = *(const LAS f32x4*)(wp + 4);
                acc[0] += uf[kk] * w0.x; acc[1] += uf[kk] * w0.y; acc[2] += uf[kk] * w0.z; acc[3] += uf[kk] * w0.w;
                acc[4] += uf[kk] * w1.x; acc[5] += uf[kk] * w1.y; acc[6] += uf[kk] * w1.z; acc[7] += uf[kk] * w1.w; }
        }
#pragma unroll
        for (int j = 0; j < 8; ++j) acc[j] = wave_sum(acc[j]);
        if (F.lane < 8) { float v = acc[0];
#pragma unroll
            for (int j = 1; j < 8; ++j) v = (F.lane == j) ? acc[j] : v;
            ((GAS float*)DT)[(size_t)m * 8 + F.lane] = v; }
      } }
    }
    __syncthreads();
}

template <bool MASKED>
__device__ __forceinline__ void sb_elem(const f32x4 (&sc)[4], int key0, int trow, float (&nk)[4][4], float (&lb)[4][4], float (&Tj)[4]) {
#pragma unroll
    for (int j = 0; j < 4; ++j) { float t = 0.f;
#pragma unroll
        for (int i = 0; i < 4; ++i) { const float z2 = sc[j][i] * (0.08838834764831845f * 1.4426950408889634f);
            const float sp2 = fmaxf(z2, 0.f) + __builtin_amdgcn_logf(1.0f + __builtin_amdgcn_exp2f(-fabsf(z2)));
            if (MASKED) { const bool vis = (key0 + 16 * j + i) < trow; nk[j][i] = vis ? sp2 : 0.f; lb[j][i] = vis ? (z2 - sp2) : -1e30f; }
            else { nk[j][i] = sp2; lb[j][i] = z2 - sp2; }
            t += nk[j][i]; }
        Tj[j] = t; }
}
__device__ __forceinline__ void sb_task(const Frame& F, bf16_t* P, int b, int h, int qb) {
    LAS unsigned char* Ks = F.lds;
    LAS unsigned char* Vt = F.lds + 17408;
    LAS unsigned char* Pw = F.lds + 35840 + F.wave * 2304;
    LAS float* red = (LAS float*)(F.lds + 54272);
    int lane = F.lane; asm volatile("" : "+v"(lane)); const int wid = F.wave, fr = lane & 15, fq = lane >> 4;
    const size_t rowbase = (size_t)b * SEQ;
    const int q0 = qb * 128, trow = q0 + 16 * wid + fr;
    bf16x8 qf[4];
    { const bf16_t* qp = P + pidx(rowbase + trow, C_SQ + h * 128) + 8 * fq;
#pragma unroll
      for (int s = 0; s < 4; ++s) qf[s] = *(const GAS bf16x8*)(qp + 32 * s); }
    f32x4 o[8];
#pragma unroll
    for (int i = 0; i < 8; ++i) o[i] = (f32x4){0.f, 0.f, 0.f, 0.f};
    float R = 0.f;
    u32x4 kvr[2], vvr[2];
#pragma unroll
    for (int i = 0; i < 2; ++i) { const int idx = F.tid + NTHR * i, key = idx >> 4, c8 = idx & 15; const size_t kt0 = rowbase + 64 * (2 * qb + 1);
        kvr[i] = *(const GAS u32x4*)(P + pidx(kt0 + key, C_SK + h * 128) + 8 * c8); vvr[i] = *(const GAS u32x4*)(P + pidx(kt0 + lane, C_SV + h * 128) + 8 * (2 * wid + i)); }
    lds_barrier();
    for (int kt = 2 * qb + 1; kt >= 0; --kt) {
#pragma unroll
        for (int i = 0; i < 2; ++i) { const int idx = F.tid + NTHR * i, key = idx >> 4, c8 = idx & 15;
            const u32x4 kv = kvr[i], vv = vvr[i];
            *(LAS u32x4*)(Ks + key * 272 + c8 * 16) = kv;
            LAS bf16_t* vd = (LAS bf16_t*)(Vt + (8 * (2 * wid + i)) * 144 + lane * 2);
            vd[0 * 72] = (bf16_t)(vv.x & 0xffff); vd[1 * 72] = (bf16_t)(vv.x >> 16); vd[2 * 72] = (bf16_t)(vv.y & 0xffff); vd[3 * 72] = (bf16_t)(vv.y >> 16);
            vd[4 * 72] = (bf16_t)(vv.z & 0xffff); vd[5 * 72] = (bf16_t)(vv.z >> 16); vd[6 * 72] = (bf16_t)(vv.w & 0xffff); vd[7 * 72] = (bf16_t)(vv.w >> 16); }
        if (kt > 0) {
#pragma unroll
            for (int i = 0; i < 2; ++i) { const int idx = F.tid + NTHR * i, key = idx >> 4, c8 = idx & 15; const size_t kt1 = rowbase + 64 * (kt - 1);
                kvr[i] = *(const GAS u32x4*)(P + pidx(kt1 + key, C_SK + h * 128) + 8 * c8); vvr[i] = *(const GAS u32x4*)(P + pidx(kt1 + lane, C_SV + h * 128) + 8 * (2 * wid + i)); } }
        lds_barrier();
        if (64 * kt < q0 + 16 * wid + 15) {
            f32x4 sc[4];
#pragma unroll
            for (int j = 0; j < 4; ++j) { sc[j] = (f32x4){0.f, 0.f, 0.f, 0.f};
#pragma unroll
                for (int s = 0; s < 4; ++s) sc[j] = mfma16(ldsfrag(Ks + (16 * j + fr) * 272 + (32 * s + 8 * fq) * 2), qf[s], sc[j]); }
            float nk[4][4], lb[4][4], Tj[4], Wj[4], Gj[4];
            if (64 * kt + 64 <= q0 + 16 * wid) sb_elem<false>(sc, 64 * kt + 4 * fq, trow, nk, lb, Tj);
            else sb_elem<true>(sc, 64 * kt + 4 * fq, trow, nk, lb, Tj);
#pragma unroll
            for (int j = 0; j < 4; ++j) { const float a1 = __shfl_xor(Tj[j], 16), a2 = __shfl_xor(Tj[j], 32), a3 = __shfl_xor(Tj[j], 48);
                Wj[j] = Tj[j] + a1 + a2 + a3;
                Gj[j] = (((fq ^ 1) > fq) ? a1 : 0.f) + (((fq ^ 2) > fq) ? a2 : 0.f) + (((fq ^ 3) > fq) ? a3 : 0.f); }
            float suf = 0.f;
#pragma unroll
            for (int j = 3; j >= 0; --j) { float tl = R - suf - Gj[j]; f32x4 w;
                w[3] = __builtin_amdgcn_exp2f(lb[j][3] + tl); tl -= nk[j][3];
                w[2] = __builtin_amdgcn_exp2f(lb[j][2] + tl); tl -= nk[j][2];
                w[1] = __builtin_amdgcn_exp2f(lb[j][1] + tl); tl -= nk[j][1];
                w[0] = __builtin_amdgcn_exp2f(lb[j][0] + tl);
                *(LAS u32x2*)(Pw + fr * 144 + (16 * j + 4 * fq) * 2) = pack4(w);
                suf += Wj[j]; }
            R -= suf;
#pragma unroll
            for (int ks = 0; ks < 2; ++ks) { const bf16x8 pf = ldsfrag(Pw + fr * 144 + (32 * ks + 8 * fq) * 2);
#pragma unroll
                for (int dt = 0; dt < 8; ++dt) o[dt] = mfma16(ldsfrag(Vt + (16 * dt + fr) * 144 + (32 * ks + 8 * fq) * 2), pf, o[dt]); }
        }
        const float rm = wave_max(R);
        if (lane == 0) red[wid] = rm;
        lds_barrier();
        float mx = red[0];
#pragma unroll
        for (int w = 1; w < 8; ++w) mx = fmaxf(mx, red[w]);
        if (mx < -173.2f) break;
    }
    bf16_t* op = P + pidx(rowbase + trow, C_SQ + h * 128) + 4 * fq;
#pragma unroll
    for (int dt = 0; dt < 8; ++dt) *(GAS u32x2*)(op + 16 * dt) = pack4(o[dt]);
}

__device__ __forceinline__ void ret_kv_task(const Frame& F, const bf16_t* P, const f32x2* ROPE, bf16_t* RST, int b, int c, int h) {
    LAS unsigned char* KT = F.lds;
    LAS unsigned char* VT = F.lds + 18432;
    int lane = F.lane; asm volatile("" : "+v"(lane)); const int fr = lane & 15, fq = lane >> 4;
    const float l2g = log2gamma(h);
    lds_barrier();
    { const int s = lane, g8 = F.wave;     const size_t row = (size_t)b * SEQ + c * 64 + s; const int pos = c * 64 + s;
      const bf16_t* kp = P + pidx(row, C_RK + h * 128) + 8 * g8;
      const u32x4 k1 = *(const GAS u32x4*)kp, k2 = *(const GAS u32x4*)(kp + 64);
      float x1[8], x2[8]; unpack8(k1, x1); unpack8(k2, x2);
      const GAS f32x4* cp = (const GAS f32x4*)(ROPE + pos * 64 + 8 * g8);
      const float dec = __builtin_amdgcn_exp2f(l2g * (float)(63 - s)) * 0.08838834764831845f;
      LAS bf16_t* kd = (LAS bf16_t*)(KT + (8 * g8) * 144 + s * 2);
#pragma unroll
      for (int jj = 0; jj < 4; ++jj) { const f32x4 cs = cp[jj];
          { const int j = 2 * jj; const float y1 = (x1[j] * cs.x - x2[j] * cs.y) * dec, y2 = (x1[j] * cs.y + x2[j] * cs.x) * dec; kd[j * 72] = f2bf(y1); kd[(64 + j) * 72] = f2bf(y2); }
          { const int j = 2 * jj + 1; const float y1 = (x1[j] * cs.z - x2[j] * cs.w) * dec, y2 = (x1[j] * cs.w + x2[j] * cs.z) * dec; kd[j * 72] = f2bf(y1); kd[(64 + j) * 72] = f2bf(y2); } }
      const bf16_t* vp = P + pidx(row, C_RV + h * 128) + 16 * g8;
#pragma unroll
      for (int hh = 0; hh < 2; ++hh) { const u32x4 vv = *(const GAS u32x4*)(vp + 8 * hh);
          LAS bf16_t* vd = (LAS bf16_t*)(VT + (16 * g8 + 8 * hh) * 144 + s * 2);
          vd[0 * 72] = (bf16_t)(vv.x & 0xffff); vd[1 * 72] = (bf16_t)(vv.x >> 16); vd[2 * 72] = (bf16_t)(vv.y & 0xffff); vd[3 * 72] = (bf16_t)(vv.y >> 16);
          vd[4 * 72] = (bf16_t)(vv.z & 0xffff); vd[5 * 72] = (bf16_t)(vv.z >> 16); vd[6 * 72] = (bf16_t)(vv.w & 0xffff); vd[7 * 72] = (bf16_t)(vv.w >> 16); } }
    lds_barrier();
    const int w = F.wave;
    bf16x8 xf[2];
#pragma unroll
    for (int ks = 0; ks < 2; ++ks) xf[ks] = ldsfrag(KT + (16 * w + fr) * 144 + (32 * ks + 8 * fq) * 2);
    bf16_t* dst = RST + (size_t)((b * 128 + c) * 4 + h) * 16384;
#pragma unroll
    for (int et = 0; et < 8; ++et) { f32x4 acc = (f32x4){0.f, 0.f, 0.f, 0.f};
#pragma unroll
        for (int ks = 0; ks < 2; ++ks) acc = mfma16(xf[ks], ldsfrag(VT + (16 * et + fr) * 144 + (32 * ks + 8 * fq) * 2), acc);
        *(GAS u32x2*)(dst + (16 * et + fr) * 128 + 16 * w + 4 * fq) = pack4(acc); }
}

__device__ __forceinline__ void ret_out_task(const Frame& F, bf16_t* P, const f32x2* ROPE, const bf16_t* RST, const float* gn, int b, int c, int h, int xm = 0) {
    LAS unsigned char* Kr = F.lds;
    LAS unsigned char* VT = F.lds + 17408;
    LAS unsigned char* Sx = F.lds + 35840;
    LAS unsigned char* Pw = F.lds + 70656 + F.wave * 2304;
    LAS float* ssq = (LAS float*)(F.lds + 89088);
    int lane = F.lane; asm volatile("" : "+v"(lane)); const int fr = lane & 15, fq = lane >> 4, w = F.wave, lt = w & 3, eh = w >> 2;
    const float l2g = log2gamma(h);
    const int unit = (b * 128 + c) * 4 + h;
    lds_barrier();
    { const int s = F.tid >> 3, g8 = F.tid & 7; const size_t row = (size_t)b * SEQ + c * 64 + s; const int pos = c * 64 + s;
      const bf16_t* kp = P + pidx(row, C_RK + h * 128) + 8 * g8;
      const u32x4 k1 = *(const GAS u32x4*)kp, k2 = *(const GAS u32x4*)(kp + 64);
      float x1[8], x2[8], y1[8], y2[8]; unpack8(k1, x1); unpack8(k2, x2);
      const GAS f32x4* cp = (const GAS f32x4*)(ROPE + pos * 64 + 8 * g8);
#pragma unroll
      for (int jj = 0; jj < 4; ++jj) { const f32x4 cs = cp[jj];
          { const int j = 2 * jj; y1[j] = (x1[j] * cs.x - x2[j] * cs.y) * 0.08838834764831845f; y2[j] = (x1[j] * cs.y + x2[j] * cs.x) * 0.08838834764831845f; }
          { const int j = 2 * jj + 1; y1[j] = (x1[j] * cs.z - x2[j] * cs.w) * 0.08838834764831845f; y2[j] = (x1[j] * cs.w + x2[j] * cs.z) * 0.08838834764831845f; } }
      u32x4 o1, o2; o1.x = cvt_pk_bf16(y1[0], y1[1]); o1.y = cvt_pk_bf16(y1[2], y1[3]); o1.z = cvt_pk_bf16(y1[4], y1[5]); o1.w = cvt_pk_bf16(y1[6], y1[7]);
      o2.x = cvt_pk_bf16(y2[0], y2[1]); o2.y = cvt_pk_bf16(y2[2], y2[3]); o2.z = cvt_pk_bf16(y2[4], y2[5]); o2.w = cvt_pk_bf16(y2[6], y2[7]);
      *(LAS u32x4*)(Kr + s * 272 + (8 * g8) * 2) = o1; *(LAS u32x4*)(Kr + s * 272 + (64 + 8 * g8) * 2) = o2;
      const bf16_t* vp = P + pidx((size_t)b * SEQ + c * 64 + lane, C_RV + h * 128) + 16 * F.wave;
#pragma unroll
      for (int hh = 0; hh < 2; ++hh) { const u32x4 vv = *(const GAS u32x4*)(vp + 8 * hh);
          LAS bf16_t* vd = (LAS bf16_t*)(VT + (16 * F.wave + 8 * hh) * 144 + lane * 2);
          vd[0 * 72] = (bf16_t)(vv.x & 0xffff); vd[1 * 72] = (bf16_t)(vv.x >> 16); vd[2 * 72] = (bf16_t)(vv.y & 0xffff); vd[3 * 72] = (bf16_t)(vv.y >> 16);
          vd[4 * 72] = (bf16_t)(vv.z & 0xffff); vd[5 * 72] = (bf16_t)(vv.z >> 16); vd[6 * 72] = (bf16_t)(vv.w & 0xffff); vd[7 * 72] = (bf16_t)(vv.w >> 16); }
      const bf16_t* sp = RST + (size_t)unit * 16384;
#pragma unroll
      for (int i = 0; i < 4; ++i) { const int idx = F.tid + NTHR * i, e = idx >> 4, c16 = idx & 15;
          *(LAS u32x4*)(Sx + e * 272 + c16 * 16) = *(const GAS u32x4*)(sp + e * 128 + 8 * c16); } }
    const int l = 16 * lt + fr; const size_t qrow = (size_t)b * SEQ + c * 64 + l; const int qpos = c * 64 + l;
    bf16x8 qf[4];
    { const bf16_t* qp = P + pidx(qrow, C_RQ + h * 128) + 8 * fq;
      u32x4 qv[4];
#pragma unroll
      for (int s = 0; s < 4; ++s) qv[s] = *(const GAS u32x4*)(qp + 32 * s);
#pragma unroll
      for (int s = 0; s < 2; ++s) { float x1[8], x2[8], y1[8], y2[8]; unpack8(qv[s], x1); unpack8(qv[s + 2], x2);
          const GAS f32x4* cp = (const GAS f32x4*)(ROPE + qpos * 64 + 32 * s + 8 * fq);
#pragma unroll
          for (int jj = 0; jj < 4; ++jj) { const f32x4 cs = cp[jj];
              { const int j = 2 * jj; y1[j] = x1[j] * cs.x - x2[j] * cs.y; y2[j] = x1[j] * cs.y + x2[j] * cs.x; }
              { const int j = 2 * jj + 1; y1[j] = x1[j] * cs.z - x2[j] * cs.w; y2[j] = x1[j] * cs.w + x2[j] * cs.z; } }
          u32x4 o1, o2; o1.x = cvt_pk_bf16(y1[0], y1[1]); o1.y = cvt_pk_bf16(y1[2], y1[3]); o1.z = cvt_pk_bf16(y1[4], y1[5]); o1.w = cvt_pk_bf16(y1[6], y1[7]);
          o2.x = cvt_pk_bf16(y2[0], y2[1]); o2.y = cvt_pk_bf16(y2[2], y2[3]); o2.z = cvt_pk_bf16(y2[4], y2[5]); o2.w = cvt_pk_bf16(y2[6], y2[7]);
          qf[s] = __builtin_bit_cast(bf16x8, o1); qf[s + 2] = __builtin_bit_cast(bf16x8, o2); } }
    u32x2 gvr[4]; f32x4 ggr[4];
#pragma unroll
    for (int et = 0; et < 4; ++et) { const int e0 = 64 * eh + 16 * et + 4 * fq;
        gvr[et] = *(const GAS u32x2*)(P + pidx(qrow, C_RG + h * 128) + e0); ggr[et] = *(const GAS f32x4*)(gn + h * 128 + e0); }
    lds_barrier();
    if (xm == 1) return;
#pragma unroll
    for (int j = 0; j < 4; ++j) { f32x4 acc = (f32x4){0.f, 0.f, 0.f, 0.f};
#pragma unroll
        for (int ks = 0; ks < 4; ++ks) acc = mfma16(ldsfrag(Kr + (16 * j + fr) * 272 + (32 * ks + 8 * fq) * 2), qf[ks], acc);
#pragma unroll
        for (int i = 0; i < 4; ++i) { const int s = 16 * j + 4 * fq + i; acc[i] *= __builtin_amdgcn_exp2f(l2g * fabsf((float)(l - s))); }
        *(LAS u32x2*)(Pw + fr * 144 + (16 * j + 4 * fq) * 2) = pack4(acc); }
    f32x4 y[4];
    const float qdec = __builtin_amdgcn_exp2f(l2g * (float)(l + 1));
#pragma unroll
    for (int et = 0; et < 4; ++et) { y[et] = (f32x4){0.f, 0.f, 0.f, 0.f};
#pragma unroll
        for (int ks = 0; ks < 4; ++ks) y[et] = mfma16(ldsfrag(Sx + (64 * eh + 16 * et + fr) * 272 + (32 * ks + 8 * fq) * 2), qf[ks], y[et]);
        y[et] = y[et] * qdec; }
#pragma unroll
    for (int ks = 0; ks < 2; ++ks) { const bf16x8 pf = ldsfrag(Pw + fr * 144 + (32 * ks + 8 * fq) * 2);
#pragma unroll
        for (int et = 0; et < 4; ++et) y[et] = mfma16(ldsfrag(VT + (64 * eh + 16 * et + fr) * 144 + (32 * ks + 8 * fq) * 2), pf, y[et]); }
    float ss = 0.f;
#pragma unroll
    for (int et = 0; et < 4; ++et) ss += (y[et][0] * y[et][0] + y[et][1] * y[et][1]) + (y[et][2] * y[et][2] + y[et][3] * y[et][3]);
    ss += __shfl_xor(ss, 16); ss += __shfl_xor(ss, 32);
    if (fq == 0) ssq[w * 16 + fr] = ss;
    lds_barrier();
    const float rstd = rsqrtf((ssq[w * 16 + fr] + ssq[(w ^ 4) * 16 + fr]) * (1.f / 128.f) + EPS);
#pragma unroll
    for (int et = 0; et < 4; ++et) { const int e0 = 64 * eh + 16 * et + 4 * fq;
        const u32x2 gv = gvr[et]; const f32x4 gg = ggr[et];
        f32x4 r;
        r[0] = y[et][0] * rstd * gg[0] * silu_f(bf_lo(gv.x)); r[1] = y[et][1] * rstd * gg[1] * silu_f(bf_hi(gv.x));
        r[2] = y[et][2] * rstd * gg[2] * silu_f(bf_lo(gv.y)); r[3] = y[et][3] * rstd * gg[3] * silu_f(bf_hi(gv.y));
        *(GAS u32x2*)(P + pidx(qrow, C_RQ + h * 128) + e0) = pack4(r); }
}

__device__ __forceinline__ float softplus_f(float x) { return fmaxf(x, 0.f) + log1pf(__expf(-fabsf(x))); }
__device__ __forceinline__ void conv8(const bf16_t* P, const float* cw, const float* cb, int b, int tpos, int col, float* v) {
    const int chan = col - C_XBC;
    { const f32x4 b0 = *(const GAS f32x4*)(cb + chan), b1 = *(const GAS f32x4*)(cb + chan + 4);
      v[0] = b0.x; v[1] = b0.y; v[2] = b0.z; v[3] = b0.w; v[4] = b1.x; v[5] = b1.y; v[6] = b1.z; v[7] = b1.w; }
#pragma unroll
    for (int j = 0; j < 4; ++j) { const int ts = tpos - 3 + j;
        if (ts >= 0) { const u32x4 xv = *(const GAS u32x4*)(P + pidx((size_t)b * SEQ + ts, col)); float xf[8]; unpack8(xv, xf);
            const f32x4 w0 = *(const GAS f32x4*)(cw + j * 1024 + chan), w1 = *(const GAS f32x4*)(cw + j * 1024 + chan + 4);
            v[0] += xf[0] * w0.x; v[1] += xf[1] * w0.y; v[2] += xf[2] * w0.z; v[3] += xf[3] * w0.w; v[4] += xf[4] * w1.x; v[5] += xf[5] * w1.y; v[6] += xf[6] * w1.z; v[7] += xf[7] * w1.w; } }
#pragma unroll
    for (int i = 0; i < 8; ++i) v[i] = silu_f(v[i]);
}

__device__ __forceinline__ void conv_load(const bf16_t* P, const float* cw, const float* cb, int b, int tpos0, int col, float (&w)[4][8], float (&bias)[8], u32x4 (&rows)[11]) {
    const int chan = col - C_XBC;
#pragma unroll
    for (int j = 0; j < 4; ++j) { const f32x4 w0 = *(const GAS f32x4*)(cw + j * 1024 + chan), w1 = *(const GAS f32x4*)(cw + j * 1024 + chan + 4);
        w[j][0] = w0.x; w[j][1] = w0.y; w[j][2] = w0.z; w[j][3] = w0.w; w[j][4] = w1.x; w[j][5] = w1.y; w[j][6] = w1.z; w[j][7] = w1.w; }
    { const f32x4 b0 = *(const GAS f32x4*)(cb + chan), b1 = *(const GAS f32x4*)(cb + chan + 4);
      bias[0] = b0.x; bias[1] = b0.y; bias[2] = b0.z; bias[3] = b0.w; bias[4] = b1.x; bias[5] = b1.y; bias[6] = b1.z; bias[7] = b1.w; }
    const bf16_t* base = P + pidx((size_t)b * SEQ + tpos0, col);
#pragma unroll
    for (int r = 0; r < 11; ++r) { rows[r] = (u32x4){0u, 0u, 0u, 0u}; if (tpos0 - 3 + r >= 0) rows[r] = *(const GAS u32x4*)(base + (long)(r - 3) * 128); }
}
template <bool TR, bool HASF>
__device__ __forceinline__ void conv_compute(const float (&w)[4][8], const float (&bias)[8], const u32x4 (&rows)[11], const float (&f)[8], u32x4 (&pk)[8]) {
    float prev[8];
#pragma unroll
    for (int t = 0; t < 8; ++t) {
        float a[8];
#pragma unroll
        for (int i = 0; i < 8; ++i) a[i] = bias[i];
#pragma unroll
        for (int j = 0; j < 4; ++j) { float xf[8]; unpack8(rows[t + j], xf);
#pragma unroll
            for (int i = 0; i < 8; ++i) a[i] += xf[i] * w[j][i]; }
#pragma unroll
        for (int i = 0; i < 8; ++i) { a[i] = silu_f(a[i]); if (HASF) a[i] *= f[t]; }
        if (TR) {
            if (t & 1) {
#pragma unroll
                for (int i = 0; i < 8; ++i) { const unsigned u = cvt_pk_bf16(prev[i], a[i]);
                    if ((t >> 1) == 0) pk[i].x = u; else if ((t >> 1) == 1) pk[i].y = u; else if ((t >> 1) == 2) pk[i].z = u; else pk[i].w = u; }
            } else {
#pragma unroll
                for (int i = 0; i < 8; ++i) prev[i] = a[i];
            }
        } else {
            pk[t].x = cvt_pk_bf16(a[0], a[1]); pk[t].y = cvt_pk_bf16(a[2], a[3]); pk[t].z = cvt_pk_bf16(a[4], a[5]); pk[t].w = cvt_pk_bf16(a[6], a[7]);
        }
    }
}
template <bool TR, bool HASF>
__device__ __forceinline__ void conv_tile(const bf16_t* P, const float* cw, const float* cb, int b, int tpos0, int col, const float (&f)[8], u32x4 (&pk)[8]) {
    float w[4][8], bias[8]; u32x4 rows[11];
    conv_load(P, cw, cb, b, tpos0, col, w, bias, rows);
    conv_compute<TR, HASF>(w, bias, rows, f, pk);
}
__device__ __forceinline__ float dt_scan(const float* DT, const float* dt_bias, const float* a_log, int b, int c, int hd, int lane, float& dtv) {
    const size_t t = (size_t)b * SEQ + c * 64 + lane;
    dtv = softplus_f(((const GAS float*)DT)[t * 8 + hd] + ((const GAS float*)dt_bias)[hd]);
    float x = dtv * (-__expf(((const GAS float*)a_log)[hd]));
#pragma unroll
    for (int o = 1; o < 64; o <<= 1) { const float y = __shfl_up(x, o); if (lane >= o) x += y; }
    return x;
}

__device__ __forceinline__ void ssd_state_task(const Frame& F, const bf16_t* P, const float* DT, const float* cw, const float* cb, const float* dt_bias, const float* a_log,
                                               bf16_t* SST, float* CD, int b, int c, int g) {
    LAS unsigned char* XT = F.lds;
    LAS unsigned char* BT = F.lds + 36864;
    LAS float* dtl = (LAS float*)(F.lds + 55296);
    LAS float* acl = (LAS float*)(F.lds + 56320);
    int lane = F.lane; asm volatile("" : "+v"(lane)); const int fr = lane & 15, fq = lane >> 4, w = F.wave;
    lds_barrier();
    int tt = F.tid; asm volatile("" : "+v"(tt)); const int cgi = tt % 48, seg = tt / 48, s0 = 8 * seg;
    const int ccol = (cgi < 32) ? (C_XBC + g * 256 + 8 * cgi) : (C_XBC + 512 + g * 128 + 8 * (cgi - 32));
    float cwr[4][8], cbr[8]; u32x4 crow[11];
    if (tt < 384) conv_load(P, cw, cb, b, c * 64 + s0, ccol, cwr, cbr, crow);
    if (w < 4) { float dtv; const float cum = dt_scan(DT, dt_bias, a_log, b, c, 4 * g + w, lane, dtv);
        dtl[lane * 4 + w] = dtv; acl[lane * 4 + w] = cum;
        if (lane == 63) ((GAS float*)CD)[(b * 128 + c) * 8 + 4 * g + w] = __expf(cum); }
    lds_barrier();
    if (tt < 384) {
        float f[8]; u32x4 pk[8];
        if (cgi < 32) { const int hl = cgi >> 3; const float ae = acl[63 * 4 + hl];
#pragma unroll
            for (int t = 0; t < 8; ++t) f[t] = dtl[(s0 + t) * 4 + hl] * __expf(ae - acl[(s0 + t) * 4 + hl]); }
        else {
#pragma unroll
            for (int t = 0; t < 8; ++t) f[t] = 1.0f; }
        conv_compute<true, true>(cwr, cbr, crow, f, pk);
        LAS unsigned char* d = (cgi < 32) ? (XT + (8 * cgi) * 144 + s0 * 2) : (BT + (8 * (cgi - 32)) * 144 + s0 * 2);
#pragma unroll
        for (int i = 0; i < 8; ++i) *(LAS u32x4*)(d + i * 144) = pk[i]; }
    lds_barrier();
    const int hl = w >> 1, ph = w & 1;
    bf16x8 yf[2][2];
#pragma unroll
    for (int pt = 0; pt < 2; ++pt)
#pragma unroll
        for (int ks = 0; ks < 2; ++ks) yf[pt][ks] = ldsfrag(XT + (hl * 64 + ph * 32 + 16 * pt + fr) * 144 + (32 * ks + 8 * fq) * 2);
    bf16_t* dst = SST + (size_t)((b * 128 + c) * 8 + 4 * g + hl) * 8192;
#pragma unroll
    for (int nt = 0; nt < 8; ++nt) { f32x4 a0 = (f32x4){0.f, 0.f, 0.f, 0.f}, a1 = a0;
#pragma unroll
        for (int ks = 0; ks < 2; ++ks) { const bf16x8 xf = ldsfrag(BT + (16 * nt + fr) * 144 + (32 * ks + 8 * fq) * 2); a0 = mfma16(xf, yf[0][ks], a0); a1 = mfma16(xf, yf[1][ks], a1); }
#ifdef PROBE_CONST
        a0 = (f32x4){0.01f, 0.02f, 0.03f, 0.04f}; a1 = a0;
#endif
        *(GAS u32x2*)(dst + (ph * 32 + fr) * 128 + 16 * nt + 4 * fq) = pack4(a0);
        *(GAS u32x2*)(dst + (ph * 32 + 16 + fr) * 128 + 16 * nt + 4 * fq) = pack4(a1); }
}

__device__ __forceinline__ void ssd_out_task(const Frame& F, bf16_t* P, const float* DT, const float* cw, const float* cb, const float* dt_bias, const float* a_log,
                                             const float* d_skip, const float* nrm, const bf16_t* SST, int b, int c) {
    LAS unsigned char* Bs = F.lds;
    LAS unsigned char* Cs = F.lds + 17408;
    LAS unsigned char* XT = F.lds + 34816;
    LAS unsigned char* Pw = F.lds + 71680 + F.wave * 2304;
    LAS float* dtl = (LAS float*)(F.lds + 90112);
    LAS float* acl = (LAS float*)(F.lds + 92160);
    LAS float* ssq = (LAS float*)(F.lds + 94208);
    int lane = F.lane; asm volatile("" : "+v"(lane)); const int fr = lane & 15, fq = lane >> 4, w = F.wave, hl = w >> 1, half = w & 1;
    lds_barrier();
    { float dtv; const float cum = dt_scan(DT, dt_bias, a_log, b, c, w, lane, dtv); dtl[lane * 8 + w] = dtv; acl[lane * 8 + w] = cum; }
    float ssl[2] = {0.f, 0.f};
#pragma unroll 1
    for (int g = 0; g < 2; ++g) {
        const int head = 4 * g + hl;
        const bf16_t* hsrc = SST + (size_t)((b * 128 + c) * 8 + head) * 8192;
        bf16x8 hfr[4][4];
#pragma unroll
        for (int ks = 0; ks < 4; ++ks)
#pragma unroll
            for (int pt = 0; pt < 4; ++pt) hfr[ks][pt] = *(const GAS bf16x8*)(hsrc + (16 * pt + fr) * 128 + 32 * ks + 8 * fq);
        lds_barrier();
        { int tt = F.tid; asm volatile("" : "+v"(tt)); const int cgi = tt & 63, seg = tt >> 6, s0 = 8 * seg;
            const int col = (cgi < 32) ? (C_XBC + g * 256 + 8 * cgi) : (cgi < 48) ? (C_XBC + 512 + g * 128 + 8 * (cgi - 32)) : (C_XBC + 768 + g * 128 + 8 * (cgi - 48));
            const float f[8] = {1.f, 1.f, 1.f, 1.f, 1.f, 1.f, 1.f, 1.f}; u32x4 pk[8];
            if (cgi < 32) { conv_tile<true, false>(P, cw, cb, b, c * 64 + s0, col, f, pk);
                LAS unsigned char* d = XT + (8 * cgi) * 144 + s0 * 2;
#pragma unroll
                for (int i = 0; i < 8; ++i) *(LAS u32x4*)(d + i * 144) = pk[i]; }
            else { conv_tile<false, false>(P, cw, cb, b, c * 64 + s0, col, f, pk);
                LAS unsigned char* d = ((cgi < 48) ? (Bs + (8 * (cgi - 32)) * 2) : (Cs + (8 * (cgi - 48)) * 2)) + s0 * 272;
#pragma unroll
                for (int i = 0; i < 8; ++i) *(LAS u32x4*)(d + i * 272) = pk[i]; } }
        u32x2 zvr[2][4];
#pragma unroll
        for (int li = 0; li < 2; ++li)
#pragma unroll
            for (int pt = 0; pt < 4; ++pt) zvr[li][pt] = *(const GAS u32x2*)(P + pidx((size_t)b * SEQ + c * 64 + 16 * (2 * half + li) + fr, C_MZ + head * 64 + 16 * pt + 4 * fq));
        lds_barrier();
        const float dsk = ((const GAS float*)d_skip)[head];
#pragma unroll
        for (int li = 0; li < 2; ++li) {
            asm volatile("" ::: "memory"); __builtin_amdgcn_sched_barrier(0);
            const int lt = 2 * half + li, l = 16 * lt + fr;
            const float al = acl[l * 8 + head];
            bf16x8 cf[4];
#pragma unroll
            for (int ks = 0; ks < 4; ++ks) cf[ks] = ldsfrag(Cs + (16 * lt + fr) * 272 + (32 * ks + 8 * fq) * 2);
            f32x4 y[4];
#pragma unroll
            for (int pt = 0; pt < 4; ++pt) y[pt] = (f32x4){0.f, 0.f, 0.f, 0.f};
#pragma unroll
            for (int ks = 0; ks < 4; ++ks) {
#pragma unroll
                for (int pt = 0; pt < 4; ++pt) y[pt] = mfma16(hfr[ks][pt], cf[ks], y[pt]); }
            { const float eal = __expf(al);
#pragma unroll
              for (int pt = 0; pt < 4; ++pt) y[pt] = y[pt] * eal; }
#pragma unroll
            for (int st = 0; st < 4; ++st) { f32x4 acc = (f32x4){0.f, 0.f, 0.f, 0.f};
#pragma unroll
                for (int ks = 0; ks < 4; ++ks) acc = mfma16(ldsfrag(Bs + (16 * st + fr) * 272 + (32 * ks + 8 * fq) * 2), cf[ks], acc);
#pragma unroll
                for (int i = 0; i < 4; ++i) { const int s = 16 * st + 4 * fq + i;
                    acc[i] = (s <= l) ? acc[i] * __expf(al - acl[s * 8 + head]) * dtl[s * 8 + head] : 0.f; }
                *(LAS u32x2*)(Pw + fr * 144 + (16 * st + 4 * fq) * 2) = pack4(acc); }
#pragma unroll
            for (int ks = 0; ks < 2; ++ks) { if (2 * ks <= lt) { const bf16x8 pf = ldsfrag(Pw + fr * 144 + (32 * ks + 8 * fq) * 2);
#pragma unroll
                for (int pt = 0; pt < 4; ++pt) y[pt] = mfma16(ldsfrag(XT + (hl * 64 + 16 * pt + fr) * 144 + (32 * ks + 8 * fq) * 2), pf, y[pt]); } }
            const size_t row = (size_t)b * SEQ + c * 64 + l;
#pragma unroll
            for (int pt = 0; pt < 4; ++pt) { const int p0 = 16 * pt + 4 * fq;
                const u32x2 zv = zvr[li][pt];
                const LAS bf16_t* xp = (const LAS bf16_t*)(XT + (hl * 64 + p0) * 144 + l * 2);
                f32x4 r;
                r[0] = (y[pt][0] + bf2f(xp[0 * 72]) * dsk) * silu_f(bf_lo(zv.x)); r[1] = (y[pt][1] + bf2f(xp[1 * 72]) * dsk) * silu_f(bf_hi(zv.x));
                r[2] = (y[pt][2] + bf2f(xp[2 * 72]) * dsk) * silu_f(bf_lo(zv.y)); r[3] = (y[pt][3] + bf2f(xp[3 * 72]) * dsk) * silu_f(bf_hi(zv.y));
                ssl[li] += (r[0] * r[0] + r[1] * r[1]) + (r[2] * r[2] + r[3] * r[3]);
                *(GAS u32x2*)(P + pidx(row, C_MZ + head * 64 + p0)) = pack4(r); }
        }
    }
#pragma unroll
    for (int li = 0; li < 2; ++li) { float ss = ssl[li];
        ss += __shfl_xor(ss, 16); ss += __shfl_xor(ss, 32);
        if (fq == 0) ssq[hl * 64 + 16 * (2 * half + li) + fr] = ss; }
    asm volatile("s_waitcnt vmcnt(0)" ::: "memory");
    u32x2 ypk[2][2][4]; f32x4 ngv[2][4];
#pragma unroll
    for (int g = 0; g < 2; ++g)
#pragma unroll
        for (int pt = 0; pt < 4; ++pt) { const int ch = (4 * g + hl) * 64 + 16 * pt + 4 * fq; ngv[g][pt] = *(const GAS f32x4*)(nrm + ch);
#pragma unroll
            for (int li = 0; li < 2; ++li) ypk[li][g][pt] = *(const GAS u32x2*)(P + pidx((size_t)b * SEQ + c * 64 + 16 * (2 * half + li) + fr, C_MZ + ch)); }
    lds_barrier();
#pragma unroll
    for (int li = 0; li < 2; ++li) { const int l = 16 * (2 * half + li) + fr;
        const float rstd = rsqrtf((ssq[l] + ssq[64 + l] + ssq[128 + l] + ssq[192 + l]) * (1.f / 512.f) + EPS);
        const size_t row = (size_t)b * SEQ + c * 64 + l;
#pragma unroll
        for (int g = 0; g < 2; ++g)
#pragma unroll
            for (int pt = 0; pt < 4; ++pt) { const int ch = (4 * g + hl) * 64 + 16 * pt + 4 * fq;
                const u32x2 pk = ypk[li][g][pt]; const f32x4 r = (f32x4){bf_lo(pk.x), bf_hi(pk.x), bf_lo(pk.y), bf_hi(pk.y)};
                *(GAS u32x2*)(P + pidx(row, C_MZ + ch)) = pack4(r * rstd * ngv[g][pt]); } }
}

__device__ __forceinline__ void scan_phase(const Frame& F, bf16_t* RST, bf16_t* SST, const float* CD) {
    for (int task = F.bid * NTHR + F.tid; task < 131072; task += F.G * NTHR) {
        {
          const int pr = task & 8191, bh = task >> 13, b = bh >> 2, h = bh & 3;
          GAS unsigned* p = (GAS unsigned*)(RST + (size_t)((b * 128) * 4 + h) * 16384) + pr;
          const float dec = __builtin_amdgcn_exp2f(64.f * log2gamma(h));
          float s0 = 0.f, s1 = 0.f;
#pragma unroll 1
          for (int c0 = 0; c0 < 128; c0 += 32) { unsigned v[32];
#pragma unroll
              for (int i = 0; i < 32; ++i) v[i] = p[(size_t)(c0 + i) * 32768];
#pragma unroll
              for (int i = 0; i < 32; ++i) { p[(size_t)(c0 + i) * 32768] = cvt_pk_bf16(s0, s1); s0 = s0 * dec + bf_lo(v[i]); s1 = s1 * dec + bf_hi(v[i]); } } }
        {
          const int pr = task & 4095, bh = task >> 12, b = bh >> 3, hd = bh & 7;
          GAS unsigned* p = (GAS unsigned*)(SST + (size_t)((b * 128) * 8 + hd) * 8192) + pr;
          const GAS float* cd = (const GAS float*)(CD + (b * 128) * 8 + hd);
          float s0 = 0.f, s1 = 0.f;
#pragma unroll 1
          for (int c0 = 0; c0 < 128; c0 += 32) { unsigned v[32]; float d[32];
#pragma unroll
              for (int i = 0; i < 32; ++i) { v[i] = p[(size_t)(c0 + i) * 32768]; d[i] = cd[(c0 + i) * 8]; }
#pragma unroll
              for (int i = 0; i < 32; ++i) { p[(size_t)(c0 + i) * 32768] = cvt_pk_bf16(s0, s1); s0 = s0 * d[i] + bf_lo(v[i]); s1 = s1 * d[i] + bf_hi(v[i]); } } }
    }
}


#define XB_TMO      128
#define XB_XCNT(j)  (256  + 64 * (j))
#define XB_XSUB(j)  (1280 + 64 * (j))
#define XB_XGEN(j)  (2304 + 64 * (j))
#define XB_TOP      3328
#define XB_TOPGEN   3392
#define XB_SPIN_CAP (1u << 22)
__device__ __forceinline__ unsigned xb_ld(unsigned* p)              { return __hip_atomic_load(p, __ATOMIC_RELAXED, __HIP_MEMORY_SCOPE_AGENT); }
__device__ __forceinline__ unsigned xb_add(unsigned* p, unsigned v) { return __hip_atomic_fetch_add(p, v, __ATOMIC_RELAXED, __HIP_MEMORY_SCOPE_AGENT); }
__device__ __forceinline__ unsigned xb_xcc_id() { return (unsigned)__builtin_amdgcn_s_getreg((3 << 11) | 20) & 0xFu; }
#define XB_SPIN(cond, bar) do { unsigned _sp = 0; while (cond) { __builtin_amdgcn_s_sleep(1); \
    if ((++_sp & 255u) == 0u) { if (xb_ld(&(bar)[XB_TMO])) break; if (_sp > XB_SPIN_CAP) { atomicAdd(&(bar)[XB_TMO], 1u); break; } } } } while (0)
struct XcdBarrier { unsigned* bar; unsigned x; volatile LAS unsigned* st; };
__device__ __forceinline__ XcdBarrier xcd_barrier_post(unsigned* bar, volatile LAS unsigned* st) {
    XcdBarrier b; b.bar = bar; b.x = xb_xcc_id(); b.st = st;
    if (threadIdx.x == 0) (void)xb_add(&bar[XB_XCNT(b.x)], 1u);
    return b;
}
__device__ __forceinline__ void xcd_barrier_complete(unsigned* bar, unsigned x, unsigned& nloc, unsigned& nx) {
    const unsigned G = gridDim.x * gridDim.y * gridDim.z;
    unsigned sum, cnt, mine, sp = 0u;
    for (;;) {
        sum = 0u; cnt = 0u; mine = 0u;
#pragma unroll
        for (unsigned j = 0; j < 16; ++j) { const unsigned c = xb_ld(&bar[XB_XCNT(j)]); sum += c; cnt += (c > 0u) ? 1u : 0u; mine = (j == x) ? c : mine; }
        if (sum == G) break;
        __builtin_amdgcn_s_sleep(1);
        if ((++sp & 255u) == 0u) { if (xb_ld(&bar[XB_TMO])) break; if (sp > XB_SPIN_CAP) { atomicAdd(&bar[XB_TMO], 1u); break; } }
    }
    nloc = mine > 0u ? mine : 1u; nx = cnt > 0u ? cnt : 1u;
}
__device__ __forceinline__ void xcd_barrier(const XcdBarrier& b) {
    asm volatile("s_waitcnt vmcnt(0)" ::: "memory");
    __syncthreads();
    if (threadIdx.x == 0) {
        unsigned* bar = b.bar;
        __builtin_amdgcn_s_waitcnt(0);
        unsigned nloc = b.st[0], nx = b.st[1];
        if (nloc == 0u) { xcd_barrier_complete(bar, b.x, nloc, nx); b.st[0] = nloc; b.st[1] = nx; }
        const unsigned old = xb_add(&bar[XB_XSUB(b.x)], 1u);
        const unsigned gen = old / nloc;
        if (old + 1u == (gen + 1u) * nloc) {
            __builtin_amdgcn_fence(__ATOMIC_RELEASE, "agent");
            asm volatile("s_waitcnt vmcnt(0)" ::: "memory");
            const unsigned og = xb_add(&bar[XB_TOP], 1u);
            const unsigned tg = og / nx;
            if (og + 1u == (tg + 1u) * nx) xb_add(&bar[XB_TOPGEN], 1u);
            else XB_SPIN(xb_ld(&bar[XB_TOPGEN]) == tg, bar);
            __builtin_amdgcn_fence(__ATOMIC_ACQUIRE, "agent");
            xb_add(&bar[XB_XGEN(b.x)], 1u);
            asm volatile("s_waitcnt vmcnt(0)" ::: "memory");
        } else {
            XB_SPIN(xb_ld(&bar[XB_XGEN(b.x)]) == gen, bar);
            __builtin_amdgcn_fence(__ATOMIC_ACQUIRE, "agent");
            asm volatile("s_waitcnt vmcnt(0)" ::: "memory");
        }
    }
    __syncthreads();
}

__device__ __forceinline__ void final_phase(const Frame& F, const bf16_t* hb, float* out, const float* gain, const float* fmod, const XcdBarrier& xbar) {
    const int gw = F.bid * NWAVE + F.wave, NGW = F.G * NWAVE;
    u32x2 hv[16][4];
#pragma unroll
    for (int r = 0; r < 16; ++r) { const int m = gw + r * NGW; const int mm = m < T_TOK ? m : gw;
        const GAS u32x2* xr = (const GAS u32x2*)(hb + (size_t)mm * DM) + F.lane;
#pragma unroll
        for (int j = 0; j < 4; ++j) hv[r][j] = xr[64 * j]; }
    xcd_barrier(xbar);
#pragma unroll
    for (int r = 0; r < 16; ++r) { const int m = gw + r * NGW; if (m < T_TOK) {
        const int b = m >> 13; f32x4 v[4]; float s = 0.f;
#pragma unroll
        for (int j = 0; j < 4; ++j) { const u32x2 t = hv[r][j]; v[j] = (f32x4){bf_lo(t.x), bf_hi(t.x), bf_lo(t.y), bf_hi(t.y)};
            s += (v[j].x * v[j].x + v[j].y * v[j].y) + (v[j].z * v[j].z + v[j].w * v[j].w); }
        const float rstd = rsqrtf(wave_sum(s) * (1.f / DM) + EPS);
        GAS f32x4* xo = (GAS f32x4*)(out + (size_t)m * DM) + F.lane;
#pragma unroll
        for (int j = 0; j < 4; ++j) {
            const f32x4 g = ((const GAS f32x4*)gain)[F.lane + 64 * j], sh = ((const GAS f32x4*)(fmod + (size_t)b * 2048))[F.lane + 64 * j], sc = ((const GAS f32x4*)(fmod + (size_t)b * 2048 + 1024))[F.lane + 64 * j];
            xo[64 * j] = v[j] * rstd * g * (sc + 1.0f) + sh; } } }
}

constexpr int NPH = 26;
__global__ void __launch_bounds__(NTHR, 2) fwd_kernel(Params p) {
    extern __shared__ __attribute__((aligned(16))) unsigned char lds_raw[];
    volatile LAS unsigned* xb_st = (volatile LAS unsigned*)((LAS unsigned char*)lds_raw + LDS_BYTES - 64);
    if (threadIdx.x == 0) { xb_st[0] = 0u; xb_st[1] = 0u; }
    __syncthreads();
    const XcdBarrier xbar = xcd_barrier_post((unsigned*)p.ws, xb_st);
    if (p.ph_lo == 0) {
        Frame F0; F0.lds = (LAS unsigned char*)lds_raw; F0.tid = threadIdx.x; F0.lane = F0.tid & 63; F0.wave = __builtin_amdgcn_readfirstlane(F0.tid >> 6); F0.G = gridDim.x; F0.bid = blockIdx.x;
        if (EN_PRO) prologue(F0, p, as_global(p.ws), 0);
        if (p.ph_hi > 1) cg::this_grid().sync();
    }
#ifdef TPROBE
    unsigned long long tA = 0, tB = 0;
#endif
    for (int ph_ = (p.ph_lo < 1 ? 1 : p.ph_lo); ph_ < p.ph_hi; ++ph_) {
#ifdef TPROBE
    const unsigned long long tp0 = __builtin_amdgcn_s_memrealtime();
#endif
    int ph = __builtin_amdgcn_readfirstlane(ph_);
#ifdef PH_LIMIT
    if (ph > PH_LIMIT && ph < NPH - 1) continue;
#endif
    int tid_ = threadIdx.x; asm volatile("" : "+v"(tid_));
    unsigned char* ws_ = p.ws; asm volatile("" : "+s"(ws_)); unsigned char* ws = as_global(ws_);
    int zi = 0; asm volatile("" : "+s"(zi));
    Frame F;
    F.lds = (LAS unsigned char*)lds_raw;
    F.tid = tid_; F.lane = F.tid & 63; F.wave = __builtin_amdgcn_readfirstlane(F.tid >> 6); { int g_ = gridDim.x, b_ = blockIdx.x; asm volatile("" : "+s"(g_), "+s"(b_)); F.G = g_; F.bid = b_; }
    float* MOD = (float*)(ws + WS_MOD);
    const f32x2* ROPE = (const f32x2*)(ws + WS_ROPE);
    float* DT = (float*)(ws + WS_DT);
    float* CD = (float*)(ws + WS_CD);
    bf16_t* WFU = (bf16_t*)(ws + WS_WFU); bf16_t* WFD = (bf16_t*)(ws + WS_WFD); bf16_t* WIN = (bf16_t*)(ws + WS_WIN); bf16_t* WOUT = (bf16_t*)(ws + WS_WOUT);
    bf16_t* U = (bf16_t*)(ws + WS_U); bf16_t* RST = (bf16_t*)(ws + WS_RST); bf16_t* SST = (bf16_t*)(ws + WS_SST);
    bf16_t* PROJ = (bf16_t*)(ws + WS_PROJ); bf16_t* HID = PROJ;
    float* hbuf_ = p.out; asm volatile("" : "+s"(hbuf_)); float* hbuf = as_global(hbuf_);
    bf16_t* HB = (bf16_t*)((unsigned char*)hbuf + 64 * MiB);
        if (ph == NPH - 1) {
            if (EN_FIN) final_phase(F, HB, hbuf, as_global(p.in[24 + zi]), MOD + FMOD_OFF, xbar);
        } else {
#ifdef XTRA_LIST
            static constexpr int xtra[] = XTRA_LIST;
            const int l = (ph >= NPH) ? 1 : (ph - 1) / 12, j = (ph >= NPH) ? xtra[ph - NPH] : (ph - 1) % 12;
#else
            const int l = (ph - 1) / 12, j = (ph - 1) % 12;
#endif
            const float* modl = MOD + (size_t)l * 4 * 9216;
            if (j == 0 || j == 3 || j == 9) {
                const float* hin = (l == 0 && j == 0) ? as_global(p.in[0 + zi]) : nullptr;
                const int gi = (j == 0) ? 4 : (j == 3) ? 8 : 18;
                const int mi = (j == 0) ? 0 : (j == 3) ? 3 : 6;
                if (EN_NORM) norm_phase(F, hin, HB, as_global(p.in[gi + zi]) + l * DM, modl + mi * 1024, modl + (mi + 1) * 1024, 9216, U);
                __syncthreads();
                if (!EN_CONV) {} else if (j == 0) convert_ffn(F, as_global(p.in[5 + zi]) + (size_t)l * DM * DFF, as_global(p.in[6 + zi]) + (size_t)l * DM * DFF, as_global(p.in[7 + zi]) + (size_t)l * DM * DFF, WFU, WFD);
                else if (j == 9) convert_ffn(F, as_global(p.in[19 + zi]) + (size_t)l * DM * DFF, as_global(p.in[20 + zi]) + (size_t)l * DM * DFF, as_global(p.in[21 + zi]) + (size_t)l * DM * DFF, WFU, WFD);
                else convert_mix(F, as_global(p.in[9 + zi]) + (size_t)l * DM * INW, as_global(p.in[17 + zi]) + (size_t)l * 1536 * DM, WIN, WOUT);
            } else if (j == 1 || j == 10) {
                pg8::Gemm g{U, WFU, T_TOK, 2 * DFF, DM, DM}; pg8::StaticOrder S; S.init(T_TOK, 2 * DFF, F.G, F.bid);
                pg8::EpiSwiGLU E{HID, DFF};
                if (EN_G1) pg8::gemm_phase<pg8::EpiSwiGLU>(F.lds, F.tid, g, S, E);
            } else if (j == 2 || j == 11 || j == 8) {
                pg8::Gemm g; pg8::EpiResid E;
                if (j == 8) { g = pg8::Gemm{PROJ, WOUT, T_TOK, DM, 1536, PW}; E = pg8::EpiResid{HB, modl + 5 * 1024, 1.0f}; }
                else { g = pg8::Gemm{HID, WFD, T_TOK, DM, DFF, DFF}; E = pg8::EpiResid{HB, modl + (j == 2 ? 2 : 8) * 1024, 0.5f}; }
                pg8::StaticOrder S; S.init(T_TOK, DM, F.G, F.bid);
                if (EN_G2) { if (j == 8) pg8::gemm_phase<pg8::EpiResid, true>(F.lds, F.tid, g, S, E); else pg8::gemm_phase<pg8::EpiResid, false>(F.lds, F.tid, g, S, E); }
            } else if (j == 4) {
                pg8::Gemm g{U, WIN, T_TOK, PW, DM, DM}; pg8::StaticOrder S; S.init(T_TOK, PW, F.G, F.bid);
                pg8::EpiBf16 E{PROJ, PW};
                if (EN_G3) pg8::gemm_phase<pg8::EpiBf16>(F.lds, F.tid, g, S, E);
                if (EN_DT) dt_gemv(F, U, as_global(p.in[9 + zi]) + (size_t)l * DM * INW, DT);
            } else if (j == 5) {
                if (EN_SB && XS(1)) for (int t = F.bid; t < 1024; t += F.G) { const int qb = 63 - (t >> 4), bh = t & 15; sb_task(F, PROJ, bh >> 2, bh & 3, qb); }
                if (EN_RKV && XS(2)) for (int t = F.bid; t < 2048; t += F.G) { const int h = t & 3, bc = t >> 2; ret_kv_task(F, PROJ, ROPE, RST, bc >> 7, bc & 127, h); }
                if (EN_SST && XS(4)) for (int t = F.bid; t < 1024; t += F.G) { const int g = t & 1, bc = t >> 1;
                    ssd_state_task(F, PROJ, DT, as_global(p.in[10 + zi]) + l * 4096, as_global(p.in[11 + zi]) + l * 1024, as_global(p.in[12 + zi]) + l * 8, as_global(p.in[13 + zi]) + l * 8, SST, CD, bc >> 7, bc & 127, g); }
            } else if (j == 6) {
                if (EN_SCAN) scan_phase(F, RST, SST, CD);
            } else if (j == 7) {
                if (EN_ROUT && XS(8)) for (int t = F.bid; t < 2048; t += F.G) { const int h = t & 3, bc = t >> 2; ret_out_task(F, PROJ, ROPE, RST, as_global(p.in[15 + zi]) + l * 512, bc >> 7, bc & 127, h, ph >= NPH ? XMODE : 0); }
                if (EN_SOUT && XS(16)) for (int t = F.bid; t < 512; t += F.G) {
                    ssd_out_task(F, PROJ, DT, as_global(p.in[10 + zi]) + l * 4096, as_global(p.in[11 + zi]) + l * 1024, as_global(p.in[12 + zi]) + l * 8, as_global(p.in[13 + zi]) + l * 8, as_global(p.in[14 + zi]) + l * 8, as_global(p.in[16 + zi]) + l * 512, SST, t >> 7, t & 127); }
            }
        }
        if (ph + 1 < p.ph_hi) { xcd_barrier(xbar); }
#ifdef TPROBE
        { const unsigned long long tp1 = __builtin_amdgcn_s_memrealtime(); const int jj = (ph - 1) % 12;
          if (ph < NPH - 1) { if (TPROBE_A(jj)) tA += tp1 - tp0; if (TPROBE_B(jj)) tB += tp1 - tp0; } }
#endif
    }
#ifdef TPROBE
    cg::this_grid().sync();
    if (blockIdx.x == 0) { const float a = (float)tA * 0.01f, b = (float)tB * 0.01f * TPROBE_BS;
        if (threadIdx.x == 0) p.out[0] += a;
        for (int i = threadIdx.x; i < (1 << 20); i += NTHR) p.out[1024 + i] += b; }
#endif
}

extern "C" void kernel_launch(void* const* d_in, const int* in_sizes, int n_in, void* d_out, int out_size, void* d_ws, size_t ws_size, hipStream_t stream) {
    static int grid = 0;
    if (grid == 0) {
        if (n_in != 25 || out_size != T_TOK * DM || ws_size < WS_END) { fprintf(stderr, "kernel_launch: unexpected shapes (n_in %d out %d ws %zu)\n", n_in, out_size, ws_size); grid = -1; return; }
        int dev = 0, cus = 0, per_cu = 0;
        hipGetDevice(&dev);
        hipDeviceGetAttribute(&cus, hipDeviceAttributeMultiprocessorCount, dev);
        hipFuncSetAttribute((const void*)fwd_kernel, hipFuncAttributeMaxDynamicSharedMemorySize, LDS_BYTES);
        hipOccupancyMaxActiveBlocksPerMultiprocessor(&per_cu, (const void*)fwd_kernel, NTHR, LDS_BYTES);
        if (per_cu < 1) per_cu = 1;
        (void)hipGetLastError();
        grid = cus * per_cu;
    }
    if (grid < 0) return;
    (void)hipMemsetAsync(d_ws, 0, 65536, stream);
    Params p{};
    for (int i = 0; i < 25; ++i) p.in[i] = (const float*)d_in[i];
    p.out = (float*)d_out; p.ws = (unsigned char*)d_ws;
#if ONE_LAUNCH
#ifdef XTRA_LIST
    p.ph_lo = 0; p.ph_hi = NPH + XTRA_N;
#else
    p.ph_lo = 0; p.ph_hi = NPH;
#endif
    void* args[] = {&p};
    hipError_t e = hipLaunchCooperativeKernel((const void*)fwd_kernel, dim3(grid), dim3(NTHR), args, LDS_BYTES, stream);
    if (e != hipSuccess) fprintf(stderr, "cooperative launch failed: %s (grid %d)\n", hipGetErrorString(e), grid);
#else
    for (int ph = 0; ph < NPH; ++ph) { p.ph_lo = ph; p.ph_hi = ph + 1; hipLaunchKernelGGL(fwd_kernel, dim3(grid), dim3(NTHR), LDS_BYTES, stream, p); }
#endif
}
```

```cpp
#include <hip/hip_runtime.h>
#include <hip/hip_cooperative_groups.h>
#include <cstdint>
#include <cstdio>
namespace cg = cooperative_groups;

#ifndef ONE_LAUNCH
#define ONE_LAUNCH 1
#endif

#ifndef EN_ALL
#define EN_ALL 1
#endif
#ifndef EN_PRO
#define EN_PRO EN_ALL
#endif
#ifndef EN_FIN
#define EN_FIN EN_ALL
#endif
#ifndef EN_NORM
#define EN_NORM EN_ALL
#endif
#ifndef EN_CONV
#define EN_CONV EN_ALL
#endif
#ifndef EN_G1
#define EN_G1 EN_ALL
#endif
#ifndef EN_G2
#define EN_G2 EN_ALL
#endif
#ifndef EN_G3
#define EN_G3 EN_ALL
#endif
#ifndef EN_DT
#define EN_DT EN_ALL
#endif
#ifndef EN_SB
#define EN_SB EN_ALL
#endif
#ifndef EN_RKV
#define EN_RKV EN_ALL
#endif
#ifndef EN_SST
#define EN_SST EN_ALL
#endif
#ifndef EN_SCAN
#define EN_SCAN EN_ALL
#endif
#ifndef EN_ROUT
#define EN_ROUT EN_ALL
#endif
#ifndef EN_SOUT
#define EN_SOUT EN_ALL
#endif
#ifndef EN_SINTER
#define EN_SINTER 1
#endif
#ifndef XSEL
#define XSEL 31
#endif
#define XS(m) (ph < NPH || (XSEL & (m)))
#ifndef XMODE
#define XMODE 0
#endif
#define LAS __attribute__((address_space(3)))
#define GAS __attribute__((address_space(1)))
template <class T> __device__ __forceinline__ T* as_global(T* p) {
#if defined(__HIP_DEVICE_COMPILE__)
    __builtin_assume(!__builtin_amdgcn_is_shared((const void*)p)); __builtin_assume(!__builtin_amdgcn_is_private((const void*)p));
#endif
    return p; }
typedef unsigned short bf16_t;
typedef short bf16x8 __attribute__((ext_vector_type(8)));
typedef float f32x4 __attribute__((ext_vector_type(4)));
typedef float f32x2 __attribute__((ext_vector_type(2)));
typedef unsigned u32x4 __attribute__((ext_vector_type(4)));
typedef unsigned u32x2 __attribute__((ext_vector_type(2)));

constexpr int T_TOK = 32768, SEQ = 8192, DM = 1024, DFF = 2816, INW = 5128, PW = 5120;
constexpr int NTHR = 512, NWAVE = 8;
constexpr float EPS = 1e-6f;
constexpr int C_RQ = 0, C_SQ = 512, C_MZ = 1024, C_RK = 1536, C_RV = 2048, C_RG = 2560, C_SK = 3072, C_SV = 3584, C_XBC = 4096;

constexpr size_t MiB = 1u << 20;
constexpr size_t WS_MOD = 1 * MiB, WS_ROPE = 2 * MiB, WS_DT = 6 * MiB, WS_CD = 7 * MiB;
constexpr size_t WS_WFU = 8 * MiB, WS_WFD = 19 * MiB, WS_WIN = 25 * MiB, WS_WOUT = 35 * MiB;
constexpr size_t WS_U = 38 * MiB, WS_RST = 38 * MiB, WS_SST = 102 * MiB, WS_PROJ = 166 * MiB, WS_END = 486 * MiB;
constexpr int FMOD_OFF = 2 * 4 * 9 * 1024;

constexpr size_t PLANE = (size_t)T_TOK * 128;
__device__ __forceinline__ size_t pidx(size_t row, int col) { return (size_t)(col >> 7) * PLANE + row * 128 + (col & 127); }
constexpr int LDS_BYTES = 147456;

struct Params {
    const float* in[25];
    float* out;
    unsigned char* ws;
    int ph_lo, ph_hi;
};

typedef __bf16 bf16x2_t __attribute__((ext_vector_type(2)));
__device__ __forceinline__ unsigned cvt_pk_bf16(float lo, float hi) { const f32x2 v = {lo, hi}; const bf16x2_t b = __builtin_convertvector(v, bf16x2_t); return __builtin_bit_cast(unsigned, b); }
__device__ __forceinline__ float bf_lo(unsigned u) { return __uint_as_float(u << 16); }
__device__ __forceinline__ float bf_hi(unsigned u) { return __uint_as_float(u & 0xffff0000u); }
__device__ __forceinline__ float bf2f(bf16_t x) { return __uint_as_float(((unsigned)x) << 16); }
__device__ __forceinline__ bf16_t f2bf(float f) { return (bf16_t)(cvt_pk_bf16(f, 0.f) & 0xffffu); }
__device__ __forceinline__ float wave_sum(float v) {
#pragma unroll
    for (int o = 1; o < 64; o <<= 1) v += __shfl_xor(v, o);
    return v;
}
__device__ __forceinline__ float wave_max(float v) {
#pragma unroll
    for (int o = 1; o < 64; o <<= 1) v = fmaxf(v, __shfl_xor(v, o));
    return v;
}
__device__ __forceinline__ void lds_barrier() { asm volatile("s_waitcnt lgkmcnt(0)" ::: "memory"); __builtin_amdgcn_s_barrier(); asm volatile("" ::: "memory"); }
__device__ __forceinline__ float silu_f(float g) { return g * __builtin_amdgcn_rcpf(1.0f + __builtin_amdgcn_exp2f(-1.44269504f * g)); }
__device__ __forceinline__ f32x4 mfma16(bf16x8 a, bf16x8 b, f32x4 c) { return __builtin_amdgcn_mfma_f32_16x16x32_bf16(a, b, c, 0, 0, 0); }
__device__ __forceinline__ bf16x8 ldsfrag(const LAS unsigned char* p) { return *(const LAS bf16x8*)p; }
__device__ __forceinline__ u32x2 pack4(f32x4 v) { u32x2 w; w.x = cvt_pk_bf16(v[0], v[1]); w.y = cvt_pk_bf16(v[2], v[3]); return w; }
__device__ __forceinline__ void unpack8(u32x4 v, float* f) {
    f[0] = bf_lo(v.x); f[1] = bf_hi(v.x); f[2] = bf_lo(v.y); f[3] = bf_hi(v.y); f[4] = bf_lo(v.z); f[5] = bf_hi(v.z); f[6] = bf_lo(v.w); f[7] = bf_hi(v.w);
}
__device__ __forceinline__ float log2gamma(int h) { return h == 0 ? -0.04580368961312479f : (h == 1 ? -0.02272007650008353f : (h == 2 ? -0.011315313227834146f : -0.005646563141142063f)); }

namespace pg8 {
constexpr int BM = 256, BK = 64, HALF = 128, HTB = HALF * BK * 2, STAGE_BYTES = 8 * HTB, NXCD = 8, WGM = 8;
__host__ __device__ __forceinline__ int lds_byte(int r, int c) { const int st = (r >> 4) * 2 + (c >> 5), rr = r & 15, cc = c & 31, ob = rr * 64 + cc * 2; return st * 1024 + (ob ^ (((ob >> 9) & 1) << 5)); }
__host__ __device__ __forceinline__ void stage_rc(int b, int& R, int& C) { const int st = b / 1024, sb = b % 1024, swz = sb ^ (((sb >> 9) & 1) << 5); R = (st >> 1) * 16 + swz / 64; C = (st & 1) * 32 + (swz % 64) / 2; }
__host__ __device__ __forceinline__ int perm32(int rho) { const int n = rho >> 4, i = rho & 15; return 8 * (i >> 2) + 4 * n + (i & 3); }
struct Unit { int pm, pn; };
struct Gemm { const bf16_t* A; const bf16_t* Bt; int M, N, K, lda; };
struct StaticOrder {
    int nM, nN, nwg, G, c;
    __device__ void init(int M, int N, int G_, int c_) { nM = M / BM; nN = N / BM; nwg = nM * nN; G = G_; c = c_; }
    __device__ bool next(int i, Unit& u) const {
        const long L = (long)i * G + c; if (L >= nwg) return false;
        int wgid = (int)L; { const int q = nwg / NXCD, r = nwg % NXCD, xcd = wgid % NXCD, off = wgid / NXCD; wgid = (xcd < r ? xcd * (q + 1) : r * (q + 1) + (xcd - r) * q) + off; }
        const int nig = WGM * nN, gid = wgid / nig, fm = gid * WGM, gsz = (nM - fm) < WGM ? (nM - fm) : WGM;
        u.pm = fm + ((wgid % nig) % gsz); u.pn = (wgid % nig) / gsz; return true;
    }
};
struct EpiBf16 {
    bf16_t* O; int ldc;
    __device__ __forceinline__ void operator()(const f32x4 (&acc)[2][2][4][2], const Unit& u, int wr, int wc, int fr, int fq) const {
        const int row0 = u.pm * BM + wr * 64 + fr, col0 = u.pn * BM + wc * 32 + 8 * fq;
#pragma unroll
        for (int ai = 0; ai < 2; ++ai)
#pragma unroll
            for (int m = 0; m < 4; ++m) { bf16_t* rowp = O + (size_t)(2 * u.pn) * PLANE + (size_t)(row0 + ai * HALF + m * 16) * 128 + wc * 32 + 8 * fq;
#pragma unroll
                for (int bj = 0; bj < 2; ++bj) { const f32x4 v0 = acc[ai][bj][m][0], v1 = acc[ai][bj][m][1];
                    u32x4 w; w.x = cvt_pk_bf16(v0[0], v0[1]); w.y = cvt_pk_bf16(v0[2], v0[3]); w.z = cvt_pk_bf16(v1[0], v1[1]); w.w = cvt_pk_bf16(v1[2], v1[3]);
                    *(GAS u32x4*)(rowp + bj * PLANE) = w; } }
    }
};
struct EpiSwiGLU {
    bf16_t* O; int ldo;
    __device__ __forceinline__ void operator()(const f32x4 (&acc)[2][2][4][2], const Unit& u, int wr, int wc, int fr, int fq) const {
        const int row0 = u.pm * BM + wr * 64 + fr, col0 = u.pn * HALF + wc * 32 + 8 * fq;
#pragma unroll
        for (int ai = 0; ai < 2; ++ai)
#pragma unroll
            for (int m = 0; m < 4; ++m) { bf16_t* rowp = O + (size_t)(row0 + ai * HALF + m * 16) * ldo + col0;
                float hv[8];
#pragma unroll
                for (int n = 0; n < 2; ++n)
#pragma unroll
                    for (int i = 0; i < 4; ++i) hv[4 * n + i] = silu_f(acc[ai][0][m][n][i]) * acc[ai][1][m][n][i];
                u32x4 w; w.x = cvt_pk_bf16(hv[0], hv[1]); w.y = cvt_pk_bf16(hv[2], hv[3]); w.z = cvt_pk_bf16(hv[4], hv[5]); w.w = cvt_pk_bf16(hv[6], hv[7]);
                *(GAS u32x4*)rowp = w; }
    }
};
struct EpiResid {
    bf16_t* hb; const float* gate; float cmul;
    __device__ __forceinline__ void operator()(const f32x4 (&acc)[2][2][4][2], const Unit& u, int wr, int wc, int fr, int fq) const {
        const int row0 = u.pm * BM + wr * 64 + fr, col0 = u.pn * BM + wc * 32 + 8 * fq;
        const int b = (u.pm * BM) >> 13;
        f32x4 gm[2][2];
#pragma unroll
        for (int bj = 0; bj < 2; ++bj)
#pragma unroll
            for (int n = 0; n < 2; ++n) { const f32x4 g = *(const GAS f32x4*)(gate + (size_t)b * 9216 + col0 + bj * HALF + 4 * n); gm[bj][n] = (g + 1.0f) * cmul; }
#pragma unroll
        for (int ai = 0; ai < 2; ++ai) {
            u32x4 hv[4][2];
#pragma unroll
            for (int m = 0; m < 4; ++m) { const size_t off = (size_t)(row0 + ai * HALF + m * 16) * DM + col0;
#pragma unroll
                for (int bj = 0; bj < 2; ++bj) hv[m][bj] = *(const GAS u32x4*)(hb + off + bj * HALF); }
#pragma unroll
            for (int m = 0; m < 4; ++m) { const size_t off = (size_t)(row0 + ai * HALF + m * 16) * DM + col0;
#pragma unroll
                for (int bj = 0; bj < 2; ++bj) { const u32x4 hh = hv[m][bj];
                    const f32x4 h0 = (f32x4){bf_lo(hh.x), bf_hi(hh.x), bf_lo(hh.y), bf_hi(hh.y)}, h1 = (f32x4){bf_lo(hh.z), bf_hi(hh.z), bf_lo(hh.w), bf_hi(hh.w)};
                    const f32x4 v0 = h0 + gm[bj][0] * acc[ai][bj][m][0], v1 = h1 + gm[bj][1] * acc[ai][bj][m][1];
                    u32x4 w; w.x = cvt_pk_bf16(v0[0], v0[1]); w.y = cvt_pk_bf16(v0[2], v0[3]); w.z = cvt_pk_bf16(v1[0], v1[1]); w.w = cvt_pk_bf16(v1[2], v1[3]);
                    *(GAS u32x4*)(hb + off + bj * HALF) = w; } }
        }
    }
};

template <class Epi, bool APL = false>
__device__ __forceinline__ void gemm_phase(LAS unsigned char* lds, const int tid, const Gemm g, const StaticOrder& S, const Epi& E) {
    const int wid = __builtin_amdgcn_readfirstlane(tid >> 6), lane = tid & 63, wr = wid >> 2, wc = wid & 3, fr = lane & 15, fq = lane >> 4;
    const int K = g.K, nt = K / BK, lda = g.lda;
    unsigned voffA[2], voffB[2];
#pragma unroll
    for (int i = 0; i < 2; ++i) { int R, C; stage_rc(tid * 16 + i * 8192, R, C); const int Rb = (R & ~31) + perm32(R & 31);
        voffA[i] = (unsigned)(R * (APL ? 128 : lda) + C) * 2u; voffB[i] = (unsigned)(Rb * K + C) * 2u; }
    const size_t kstep = (size_t)(BK * 2);
    const size_t hstepA = (size_t)HALF * (APL ? 128 : lda) * 2, hstepB = (size_t)HALF * K * 2;
#define PG8_KA(t) (APL ? ((size_t)((t) >> 1) * (PLANE * 2) + (size_t)((t) & 1) * 128) : (size_t)(t) * kstep)
    const size_t tstepA = 2 * hstepA, tstepB = 2 * hstepB;
    const unsigned ldsw = (unsigned)wid * 1024u;
    const int aoff = lds_byte(wr * 64 + fr, fq * 8), boff = lds_byte(wc * 32 + fr, fq * 8);
#define PG8_SA(b, h) (((b) * 2 + (h)) * HTB)
#define PG8_SB(b, h) ((4 + (b) * 2 + (h)) * HTB)
#define PG8_STAGE(bufoff, gbase, voff) do { _Pragma("unroll") for (int _i = 0; _i < 2; ++_i) \
        __builtin_amdgcn_global_load_lds((const unsigned*)((const char*)(gbase) + (voff)[_i]), (LAS unsigned*)(lds + (bufoff) + ldsw + _i * 8192), 16, 0, 0); } while (0)
#define PG8_LDA(dst, b, h) do { _Pragma("unroll") for (int m = 0; m < 4; ++m) _Pragma("unroll") for (int k = 0; k < 2; ++k) dst[m][k] = *(const LAS bf16x8*)(lds + PG8_SA(b, h) + aoff + m * 2048 + k * 1024); } while (0)
#define PG8_LDB(dst, b, h) do { _Pragma("unroll") for (int n = 0; n < 2; ++n) _Pragma("unroll") for (int k = 0; k < 2; ++k) dst[n][k] = *(const LAS bf16x8*)(lds + PG8_SB(b, h) + boff + n * 2048 + k * 1024); } while (0)
#define PG8_MMA(ai, bj, At, Bt) do { __builtin_amdgcn_s_setprio(1); _Pragma("unroll") for (int m = 0; m < 4; ++m) _Pragma("unroll") for (int n = 0; n < 2; ++n) _Pragma("unroll") for (int k = 0; k < 2; ++k) \
        acc[ai][bj][m][n] = __builtin_amdgcn_mfma_f32_16x16x32_bf16(Bt[n][k], At[m][k], acc[ai][bj][m][n], 0, 0, 0); __builtin_amdgcn_s_setprio(0); } while (0)
#define PG8_WAIT_V(n) asm volatile("s_waitcnt vmcnt(" #n ")" ::: "memory")
#define PG8_WAIT_L(n) asm volatile("s_waitcnt lgkmcnt(" #n ")" ::: "memory")
#define PG8_BAR __builtin_amdgcn_s_barrier()
#define PG8_SCHED __builtin_amdgcn_sched_barrier(0)
    Unit cur, nxt; int ui = 0;
    if (!S.next(0, cur)) return;
    f32x4 acc[2][2][4][2];
#pragma unroll
    for (int a = 0; a < 2; ++a)
#pragma unroll
        for (int b = 0; b < 2; ++b)
#pragma unroll
            for (int m = 0; m < 4; ++m)
#pragma unroll
                for (int n = 0; n < 2; ++n) acc[a][b][m][n] = (f32x4){0.f, 0.f, 0.f, 0.f};
    bf16x8 At[4][2], B0[2][2], B1[2][2];
    const char* cA = (const char*)g.A + (size_t)cur.pm * tstepA; const char* cB = (const char*)g.Bt + (size_t)cur.pn * tstepB;
    PG8_STAGE(PG8_SB(0, 0), cB, voffB); PG8_STAGE(PG8_SB(0, 1), cB + hstepB, voffB); PG8_STAGE(PG8_SA(0, 0), cA, voffA); PG8_STAGE(PG8_SA(0, 1), cA + hstepA, voffA);
    if (wr == 1) PG8_BAR;
    PG8_WAIT_V(2); PG8_BAR;
    PG8_STAGE(PG8_SB(1, 0), cB + kstep, voffB); PG8_STAGE(PG8_SA(1, 0), cA + PG8_KA(1), voffA); PG8_STAGE(PG8_SB(1, 1), cB + hstepB + kstep, voffB);
    PG8_WAIT_V(6); PG8_BAR;
    for (;;) {
        const bool has_next = S.next(ui + 1, nxt);
        const char* nA = has_next ? (const char*)g.A + (size_t)nxt.pm * tstepA : cA; const char* nB = has_next ? (const char*)g.Bt + (size_t)nxt.pn * tstepB : cB;
        for (int t = 0; t < nt; t += 2) {
            const bool last = (t == nt - 2);
            const char* a1 = cA + PG8_KA(t + 1);
            const char* a2 = last ? nA : cA + PG8_KA(t + 2); const char* b2 = last ? nB : cB + (size_t)(t + 2) * kstep;
            const char* a3 = last ? nA + PG8_KA(1) : cA + PG8_KA(t + 3); const char* b3 = b2 + kstep;
            PG8_LDB(B0, 0, 0); PG8_LDB(B1, 0, 1); PG8_SCHED; PG8_LDA(At, 0, 0); PG8_STAGE(PG8_SA(1, 1), a1 + hstepA, voffA);
            PG8_WAIT_V(8); PG8_WAIT_L(0); PG8_BAR; PG8_MMA(0, 0, At, B0); PG8_MMA(0, 1, At, B1); PG8_BAR; PG8_SCHED;
            PG8_LDA(At, 0, 1); PG8_STAGE(PG8_SB(0, 0), b2, voffB); PG8_STAGE(PG8_SB(0, 1), b2 + hstepB, voffB); PG8_STAGE(PG8_SA(0, 0), a2, voffA);
            PG8_WAIT_V(8); PG8_WAIT_L(0); PG8_BAR; PG8_MMA(1, 0, At, B0); PG8_MMA(1, 1, At, B1); PG8_BAR; PG8_SCHED;
            PG8_LDB(B0, 1, 0); PG8_LDB(B1, 1, 1); PG8_SCHED; PG8_LDA(At, 1, 0); PG8_STAGE(PG8_SA(0, 1), a2 + hstepA, voffA);
            PG8_WAIT_V(8); PG8_WAIT_L(0); PG8_BAR; PG8_MMA(0, 0, At, B0); PG8_MMA(0, 1, At, B1); PG8_BAR; PG8_SCHED;
            PG8_LDA(At, 1, 1); PG8_STAGE(PG8_SB(1, 0), b3, voffB); PG8_STAGE(PG8_SB(1, 1), b3 + hstepB, voffB); PG8_STAGE(PG8_SA(1, 0), a3, voffA);
            PG8_WAIT_V(8); PG8_WAIT_L(0); PG8_BAR; PG8_MMA(1, 0, At, B0); PG8_MMA(1, 1, At, B1); PG8_BAR; PG8_SCHED;
        }
        if (wr == 0) PG8_BAR;
        E(acc, cur, wr, wc, fr, fq);
        if (!has_next) break;
#pragma unroll
        for (int a = 0; a < 2; ++a)
#pragma unroll
            for (int b = 0; b < 2; ++b)
#pragma unroll
                for (int m = 0; m < 4; ++m)
#pragma unroll
                    for (int n = 0; n < 2; ++n) acc[a][b][m][n] = (f32x4){0.f, 0.f, 0.f, 0.f};
        cur = nxt; cA = nA; cB = nB; ++ui;
        if (wr == 1) PG8_BAR;
    }
    PG8_WAIT_V(0);
    PG8_BAR;
#undef PG8_KA
#undef PG8_SA
#undef PG8_SB
#undef PG8_STAGE
#undef PG8_LDA
#undef PG8_LDB
#undef PG8_MMA
#undef PG8_WAIT_V
#undef PG8_WAIT_L
#undef PG8_BAR
#undef PG8_SCHED
}
}

struct Frame {
    LAS unsigned char* lds;
    int tid, lane, wave, G, bid;
};

__device__ __forceinline__ void conv_item(const float* W, int Nsrc, int K, int src_col0, bf16_t* WT, int dst_row0, int k0, LAS float* scr, int lane) {
    { f32x4 wv[8];
#pragma unroll
      for (int i = 0; i < 8; ++i) { const int idx = lane + 64 * i, kk = idx >> 3, n4 = (idx & 7) * 4; wv[i] = *(const GAS f32x4*)(W + (size_t)(k0 + kk) * Nsrc + src_col0 + n4); }
#pragma unroll
      for (int i = 0; i < 8; ++i) { const int idx = lane + 64 * i, kk = idx >> 3, n4 = (idx & 7) * 4; LAS float* d = scr + kk * 33 + n4;
          d[0] = wv[i].x; d[1] = wv[i].y; d[2] = wv[i].z; d[3] = wv[i].w; } }
    asm volatile("s_waitcnt lgkmcnt(0)" ::: "memory");
    const int c = lane & 7;
#pragma unroll
    for (int j = 0; j < 4; ++j) { const int n = (lane >> 3) + 8 * j; const LAS float* s = scr + (8 * c) * 33 + n;
        u32x4 o; o.x = cvt_pk_bf16(s[0 * 33], s[1 * 33]); o.y = cvt_pk_bf16(s[2 * 33], s[3 * 33]); o.z = cvt_pk_bf16(s[4 * 33], s[5 * 33]); o.w = cvt_pk_bf16(s[6 * 33], s[7 * 33]);
        *(GAS u32x4*)(WT + (size_t)(dst_row0 + n) * K + k0 + 8 * c) = o; }
    asm volatile("s_waitcnt lgkmcnt(0)" ::: "memory");
}
__device__ __forceinline__ void convert_ffn(const Frame& F, const float* wg, const float* wu, const float* wd, bf16_t* WFU, bf16_t* WFD) {
    LAS float* scr = (LAS float*)(F.lds + F.wave * 16384);
    const int gw = F.bid * NWAVE + F.wave, NGW = F.G * NWAVE;
    constexpr int I_U = 16 * 176, I_D = 44 * 32;
    for (int it = gw; it < I_U + I_D; it += NGW) {
        if (it < I_U) { const int kb = it / 176, nb = it % 176, r0 = nb * 32, pn = r0 >> 8, i0 = r0 & 255;
            conv_item(i0 < 128 ? wg : wu, DFF, DM, pn * 128 + (i0 & 127), WFU, r0, kb * 64, scr, F.lane); }
        else { const int r = it - I_U, kb = r / 32, nb = r % 32; conv_item(wd, DM, DFF, nb * 32, WFD, nb * 32, kb * 64, scr, F.lane); }
    }
}
__device__ __forceinline__ void convert_mix(const Frame& F, const float* w_in, const float* w_out, bf16_t* WIN, bf16_t* WOUT) {
    LAS float* scr = (LAS float*)(F.lds + F.wave * 16384);
    const int gw = F.bid * NWAVE + F.wave, NGW = F.G * NWAVE;
    constexpr int I_I = 16 * 160, I_O = 24 * 32;
    for (int it = gw; it < I_I + I_O; it += NGW) {
        if (it < I_I) { const int kb = it / 160, nb = it % 160, r0 = nb * 32, blk = r0 >> 9;
            const int sb = blk == 0 ? 0 : blk == 1 ? 4 : blk == 2 ? 7 : blk == 3 ? 1 : blk == 4 ? 2 : blk == 5 ? 3 : blk == 6 ? 5 : blk == 7 ? 6 : blk;
            conv_item(w_in, INW, DM, sb * 512 + (r0 & 511), WIN, r0, kb * 64, scr, F.lane); }
        else { const int r = it - I_I, kb = r / 32, nb = r % 32; conv_item(w_out, DM, 1536, nb * 32, WOUT, nb * 32, kb * 64, scr, F.lane); }
    }
}

__device__ __forceinline__ void sincos_d(double x, double& s, double& c) {
    const double k = rint(x * 0.63661977236758134308);
    double r = fma(-k, 1.57079632679489655800e+00, x); r = fma(-k, 6.12323399573676603587e-17, r);
    const double r2 = r * r;
    double sp = -7.6471637318198164759e-13; sp = sp * r2 + 1.6059043836821614599e-10; sp = sp * r2 - 2.5052108385441718775e-08; sp = sp * r2 + 2.7557319223985890653e-06;
    sp = sp * r2 - 1.9841269841269841270e-04; sp = sp * r2 + 8.3333333333333333333e-03; sp = sp * r2 - 1.6666666666666666667e-01; const double sn = r + r * r2 * sp;
    double cp = 4.7794773323873852974e-14; cp = cp * r2 - 1.1470745597729724714e-11; cp = cp * r2 + 2.0876756987868098979e-09; cp = cp * r2 - 2.7557319223985890653e-07;
    cp = cp * r2 + 2.4801587301587301587e-05; cp = cp * r2 - 1.3888888888888888889e-03; cp = cp * r2 + 4.1666666666666666667e-02; cp = cp * r2 - 0.5; const double cs = 1.0 + r2 * cp;
    const int q = ((int)k) & 3;
    s = (q == 0) ? sn : (q == 1) ? cs : (q == 2) ? -sn : -cs;
    c = (q == 0) ? cs : (q == 1) ? -sn : (q == 2) ? -cs : sn;
}
__device__ __forceinline__ void prologue(const Frame& F, const Params& p, unsigned char* ws, int zi) {
    LAS float* cs = (LAS float*)F.lds;
    LAS float* red = (LAS float*)(F.lds + 16384);
    const float* c = as_global(p.in[1 + zi]);
    for (int i = F.tid; i < 4096; i += NTHR) cs[i] = silu_f(c[i]);
    __syncthreads();
    float* MOD = (float*)(ws + WS_MOD);
    for (int task = F.bid; task < 320; task += F.G) {
        const float* W; const float* bias; int N, n0; float* dst; int dstride;
        if (task < 288) { const int l = task / 144, t = task % 144; W = as_global(p.in[2 + zi]) + (size_t)l * DM * 9216; bias = as_global(p.in[3 + zi]) + l * 9216; N = 9216; n0 = t * 64; dst = MOD + (size_t)l * 4 * 9216; dstride = 9216; }
        else { const int t = task - 288; W = as_global(p.in[22 + zi]); bias = as_global(p.in[23 + zi]); N = 2048; n0 = t * 64; dst = MOD + FMOD_OFF; dstride = 2048; }
        float a0 = 0.f, a1 = 0.f, a2 = 0.f, a3 = 0.f;
        const int kb = F.wave * 128;
#pragma unroll 32
        for (int k = 0; k < 128; ++k) { const float w = ((const GAS float*)W)[(size_t)(kb + k) * N + n0 + F.lane];
            a0 += cs[kb + k] * w; a1 += cs[1024 + kb + k] * w; a2 += cs[2048 + kb + k] * w; a3 += cs[3072 + kb + k] * w; }
        red[(F.wave * 4 + 0) * 64 + F.lane] = a0; red[(F.wave * 4 + 1) * 64 + F.lane] = a1; red[(F.wave * 4 + 2) * 64 + F.lane] = a2; red[(F.wave * 4 + 3) * 64 + F.lane] = a3;
        __syncthreads();
        if (F.tid < 256) { const int b = F.tid >> 6, col = F.tid & 63; float s = bias[n0 + col];
#pragma unroll
            for (int w = 0; w < 8; ++w) s += red[(w * 4 + b) * 64 + col];
            dst[(size_t)b * dstride + n0 + col] = s; }
        __syncthreads();
    }
    f32x2* ROPE = (f32x2*)(ws + WS_ROPE);
    for (int idx = F.bid * NTHR + F.tid; idx < SEQ * 64; idx += F.G * NTHR) {
        const int pos = idx >> 6, i = idx & 63;
        const float invf = (float)exp(-(double)i * (9.210340371976184 / 64.0));
        const float ang = (float)pos * invf;
        double s, cc; sincos_d((double)ang, s, cc);
        ROPE[idx] = (f32x2){(float)cc, (float)s};
    }
}

__device__ __forceinline__ void norm_phase(const Frame& F, const float* xin, bf16_t* hb, const float* gain, const float* shift0, const float* scale0, int bstride, bf16_t* U) {
    const int gw = F.bid * NWAVE + F.wave, NGW = F.G * NWAVE;
    for (int m0 = gw; m0 < T_TOK; m0 += 4 * NGW) {
        f32x4 v[4][4];
#pragma unroll
        for (int r = 0; r < 4; ++r) { const int m = m0 + r * NGW; if (m < T_TOK) {
            if (xin != nullptr) { const GAS f32x4* xr = (const GAS f32x4*)(xin + (size_t)m * DM) + F.lane; GAS u32x2* hs = (GAS u32x2*)(hb + (size_t)m * DM) + F.lane;
#pragma unroll
                for (int j = 0; j < 4; ++j) { v[r][j] = xr[64 * j]; hs[64 * j] = pack4(v[r][j]); } }
            else { const GAS u32x2* xr = (const GAS u32x2*)(hb + (size_t)m * DM) + F.lane;
#pragma unroll
                for (int j = 0; j < 4; ++j) { const u32x2 t = xr[64 * j]; v[r][j] = (f32x4){bf_lo(t.x), bf_hi(t.x), bf_lo(t.y), bf_hi(t.y)}; } } } }
#pragma unroll
        for (int r = 0; r < 4; ++r) { const int m = m0 + r * NGW; if (m < T_TOK) {
            const int b = m >> 13; float s = 0.f;
#pragma unroll
            for (int j = 0; j < 4; ++j) s += (v[r][j].x * v[r][j].x + v[r][j].y * v[r][j].y) + (v[r][j].z * v[r][j].z + v[r][j].w * v[r][j].w);
            const float rstd = rsqrtf(wave_sum(s) * (1.f / DM) + EPS);
            GAS u32x2* o8 = (GAS u32x2*)(U + (size_t)m * DM) + F.lane;
#pragma unroll
            for (int j = 0; j < 4; ++j) {
                const f32x4 g = ((const GAS f32x4*)gain)[F.lane + 64 * j], sh = ((const GAS f32x4*)(shift0 + (size_t)b * bstride))[F.lane + 64 * j], sc = ((const GAS f32x4*)(scale0 + (size_t)b * bstride))[F.lane + 64 * j];
                o8[64 * j] = pack4(v[r][j] * rstd * g * (sc + 1.0f) + sh); } } }
    }
}
__device__ __forceinline__ void dt_gemv(const Frame& F, const bf16_t* U, const float* w_in, float* DT) {
    LAS float* Wd = (LAS float*)F.lds;
    __syncthreads();
    for (int idx = F.tid; idx < 8192; idx += NTHR) { const int k = idx >> 3, j = idx & 7; Wd[8 * k + 4 * (k >> 3) + j] = ((const GAS float*)w_in)[(size_t)k * INW + 5120 + j]; }
    __syncthreads();
    const int gw = F.bid * NWAVE + F.wave, NGW = F.G * NWAVE;
    for (int m0 = gw; m0 < T_TOK; m0 += 4 * NGW) {
      u32x4 uvr[4][2];
#pragma unroll
      for (int r = 0; r < 4; ++r) { const int mm = (m0 + r * NGW < T_TOK) ? m0 + r * NGW : m0;
#pragma unroll
          for (int hf = 0; hf < 2; ++hf) uvr[r][hf] = *(const GAS u32x4*)(U + (size_t)mm * DM + 512 * hf + 8 * F.lane); }
#pragma unroll
      for (int r = 0; r < 4; ++r) { const int m = m0 + r * NGW; if (m < T_TOK) {
        float acc[8];
#pragma unroll
        for (int j = 0; j < 8; ++j) acc[j] = 0.f;
#pragma unroll
        for (int hf = 0; hf < 2; ++hf) {
            const u32x4 uv = uvr[r][hf];
            float uf[8]; unpack8(uv, uf);
#pragma unroll
            for (int kk = 0; kk < 8; ++kk) { const int k = 512 * hf + 8 * F.lane + kk; const LAS float* wp = Wd + 8 * k + 4 * (k >> 3);
                const f32x4 w0 = *(const LAS f32x4*)wp, w1 = *(const LAS f32x4*)(wp + 4);
                acc[0] += uf[kk] * w0.x; acc[1] += uf[kk] * w0.y; acc[2] += uf[kk] * w0.z; acc[3] += uf[kk] * w0.w;
                acc[4] += uf[kk] * w1.x; acc[5] += uf[kk] * w1.y; acc[6] += uf[kk] * w1.z; acc[7] += uf[kk] * w1.w; }
        }
#pragma unroll
        for (int j = 0; j < 8; ++j) acc[j] = wave_sum(acc[j]);
        if (F.lane < 8) { float v = acc[0];
#pragma unroll
            for (int j = 1; j < 8; ++j) v = (F.lane == j) ? acc[j] : v;
            ((GAS float*)DT)[(size_t)m * 8 + F.lane] = v; }
      } }
    }
    __syncthreads();
}

template <bool MASKED>
__device__ __forceinline__ void sb_elem(const f32x4 (&sc)[4], int key0, int trow, float (&nk)[4][4], float (&lb)[4][4], float (&Tj)[4]) {
#pragma unroll
    for (int j = 0; j < 4; ++j) { float t = 0.f;
#pragma unroll
        for (int i = 0; i < 4; ++i) { const float z2 = sc[j][i] * (0.08838834764831845f * 1.4426950408889634f);
            const float sp2 = fmaxf(z2, 0.f) + __builtin_amdgcn_logf(1.0f + __builtin_amdgcn_exp2f(-fabsf(z2)));
            if (MASKED) { const bool vis = (key0 + 16 * j + i) < trow; nk[j][i] = vis ? sp2 : 0.f; lb[j][i] = vis ? (z2 - sp2) : -1e30f; }
            else { nk[j][i] = sp2; lb[j][i] = z2 - sp2; }
            t += nk[j][i]; }
        Tj[j] = t; }
}
__device__ __forceinline__ void sb_task(const Frame& F, bf16_t* P, int b, int h, int qb) {
    LAS unsigned char* Ks = F.lds;
    LAS unsigned char* Vt = F.lds + 17408;
    LAS unsigned char* Pw = F.lds + 35840 + F.wave * 2304;
    LAS float* red = (LAS float*)(F.lds + 54272);
    int lane = F.lane; asm volatile("" : "+v"(lane)); const int wid = F.wave, fr = lane & 15, fq = lane >> 4;
    const size_t rowbase = (size_t)b * SEQ;
    const int q0 = qb * 128, trow = q0 + 16 * wid + fr;
    bf16x8 qf[4];
    { const bf16_t* qp = P + pidx(rowbase + trow, C_SQ + h * 128) + 8 * fq;
#pragma unroll
      for (int s = 0; s < 4; ++s) qf[s] = *(const GAS bf16x8*)(qp + 32 * s); }
    f32x4 o[8];
#pragma unroll
    for (int i = 0; i < 8; ++i) o[i] = (f32x4){0.f, 0.f, 0.f, 0.f};
    float R = 0.f;
    u32x4 kvr[2], vvr[2];
#pragma unroll
    for (int i = 0; i < 2; ++i) { const int idx = F.tid + NTHR * i, key = idx >> 4, c8 = idx & 15; const size_t kt0 = rowbase + 64 * (2 * qb + 1);
        kvr[i] = *(const GAS u32x4*)(P + pidx(kt0 + key, C_SK + h * 128) + 8 * c8); vvr[i] = *(const GAS u32x4*)(P + pidx(kt0 + lane, C_SV + h * 128) + 8 * (2 * wid + i)); }
    lds_barrier();
    for (int kt = 2 * qb + 1; kt >= 0; --kt) {
#pragma unroll
        for (int i = 0; i < 2; ++i) { const int idx = F.tid + NTHR * i, key = idx >> 4, c8 = idx & 15;
            const u32x4 kv = kvr[i], vv = vvr[i];
            *(LAS u32x4*)(Ks + key * 272 + c8 * 16) = kv;
            LAS bf16_t* vd = (LAS bf16_t*)(Vt + (8 * (2 * wid + i)) * 144 + lane * 2);
            vd[0 * 72] = (bf16_t)(vv.x & 0xffff); vd[1 * 72] = (bf16_t)(vv.x >> 16); vd[2 * 72] = (bf16_t)(vv.y & 0xffff); vd[3 * 72] = (bf16_t)(vv.y >> 16);
            vd[4 * 72] = (bf16_t)(vv.z & 0xffff); vd[5 * 72] = (bf16_t)(vv.z >> 16); vd[6 * 72] = (bf16_t)(vv.w & 0xffff); vd[7 * 72] = (bf16_t)(vv.w >> 16); }
        if (kt > 0) {
#pragma unroll
            for (int i = 0; i < 2; ++i) { const int idx = F.tid + NTHR * i, key = idx >> 4, c8 = idx & 15; const size_t kt1 = rowbase + 64 * (kt - 1);
                kvr[i] = *(const GAS u32x4*)(P + pidx(kt1 + key, C_SK + h * 128) + 8 * c8); vvr[i] = *(const GAS u32x4*)(P + pidx(kt1 + lane, C_SV + h * 128) + 8 * (2 * wid + i)); } }
        lds_barrier();
        if (64 * kt < q0 + 16 * wid + 15) {
            f32x4 sc[4];
#pragma unroll
            for (int j = 0; j < 4; ++j) { sc[j] = (f32x4){0.f, 0.f, 0.f, 0.f};
#pragma unroll
                for (int s = 0; s < 4; ++s) sc[j] = mfma16(ldsfrag(Ks + (16 * j + fr) * 272 + (32 * s + 8 * fq) * 2), qf[s], sc[j]); }
            float nk[4][4], lb[4][4], Tj[4], Wj[4], Gj[4];
            if (64 * kt + 64 <= q0 + 16 * wid) sb_elem<false>(sc, 64 * kt + 4 * fq, trow, nk, lb, Tj);
            else sb_elem<true>(sc, 64 * kt + 4 * fq, trow, nk, lb, Tj);
#pragma unroll
            for (int j = 0; j < 4; ++j) { const float a1 = __shfl_xor(Tj[j], 16), a2 = __shfl_xor(Tj[j], 32), a3 = __shfl_xor(Tj[j], 48);
                Wj[j] = Tj[j] + a1 + a2 + a3;
                Gj[j] = (((fq ^ 1) > fq) ? a1 : 0.f) + (((fq ^ 2) > fq) ? a2 : 0.f) + (((fq ^ 3) > fq) ? a3 : 0.f); }
            float suf = 0.f;
#pragma unroll
            for (int j = 3; j >= 0; --j) { float tl = R - suf - Gj[j]; f32x4 w;
                w[3] = __builtin_amdgcn_exp2f(lb[j][3] + tl); tl -= nk[j][3];
                w[2] = __builtin_amdgcn_exp2f(lb[j][2] + tl); tl -= nk[j][2];
                w[1] = __builtin_amdgcn_exp2f(lb[j][1] + tl); tl -= nk[j][1];
                w[0] = __builtin_amdgcn_exp2f(lb[j][0] + tl);
                *(LAS u32x2*)(Pw + fr * 144 + (16 * j + 4 * fq) * 2) = pack4(w);
                suf += Wj[j]; }
            R -= suf;
#pragma unroll
            for (int ks = 0; ks < 2; ++ks) { const bf16x8 pf = ldsfrag(Pw + fr * 144 + (32 * ks + 8 * fq) * 2);
#pragma unroll
                for (int dt = 0; dt < 8; ++dt) o[dt] = mfma16(ldsfrag(Vt + (16 * dt + fr) * 144 + (32 * ks + 8 * fq) * 2), pf, o[dt]); }
        }
        const float rm = wave_max(R);
        if (lane == 0) red[wid] = rm;
        lds_barrier();
        float mx = red[0];
#pragma unroll
        for (int w = 1; w < 8; ++w) mx = fmaxf(mx, red[w]);
        if (mx < -173.2f) break;
    }
    bf16_t* op = P + pidx(rowbase + trow, C_SQ + h * 128) + 4 * fq;
#pragma unroll
    for (int dt = 0; dt < 8; ++dt) *(GAS u32x2*)(op + 16 * dt) = pack4(o[dt]);
}

__device__ __forceinline__ void ret_kv_task(const Frame& F, const bf16_t* P, const f32x2* ROPE, bf16_t* RST, int b, int c, int h) {
    LAS unsigned char* KT = F.lds;
    LAS unsigned char* VT = F.lds + 18432;
    int lane = F.lane; asm volatile("" : "+v"(lane)); const int fr = lane & 15, fq = lane >> 4;
    const float l2g = log2gamma(h);
    lds_barrier();
    { const int s = lane, g8 = F.wave;     const size_t row = (size_t)b * SEQ + c * 64 + s; const int pos = c * 64 + s;
      const bf16_t* kp = P + pidx(row, C_RK + h * 128) + 8 * g8;
      const u32x4 k1 = *(const GAS u32x4*)kp, k2 = *(const GAS u32x4*)(kp + 64);
      float x1[8], x2[8]; unpack8(k1, x1); unpack8(k2, x2);
      const GAS f32x4* cp = (const GAS f32x4*)(ROPE + pos * 64 + 8 * g8);
      const float dec = __builtin_amdgcn_exp2f(l2g * (float)(63 - s)) * 0.08838834764831845f;
      LAS bf16_t* kd = (LAS bf16_t*)(KT + (8 * g8) * 144 + s * 2);
#pragma unroll
      for (int jj = 0; jj < 4; ++jj) { const f32x4 cs = cp[jj];
          { const int j = 2 * jj; const float y1 = (x1[j] * cs.x - x2[j] * cs.y) * dec, y2 = (x1[j] * cs.y + x2[j] * cs.x) * dec; kd[j * 72] = f2bf(y1); kd[(64 + j) * 72] = f2bf(y2); }
          { const int j = 2 * jj + 1; const float y1 = (x1[j] * cs.z - x2[j] * cs.w) * dec, y2 = (x1[j] * cs.w + x2[j] * cs.z) * dec; kd[j * 72] = f2bf(y1); kd[(64 + j) * 72] = f2bf(y2); } }
      const bf16_t* vp = P + pidx(row, C_RV + h * 128) + 16 * g8;
#pragma unroll
      for (int hh = 0; hh < 2; ++hh) { const u32x4 vv = *(const GAS u32x4*)(vp + 8 * hh);
          LAS bf16_t* vd = (LAS bf16_t*)(VT + (16 * g8 + 8 * hh) * 144 + s * 2);
          vd[0 * 72] = (bf16_t)(vv.x & 0xffff); vd[1 * 72] = (bf16_t)(vv.x >> 16); vd[2 * 72] = (bf16_t)(vv.y & 0xffff); vd[3 * 72] = (bf16_t)(vv.y >> 16);
          vd[4 * 72] = (bf16_t)(vv.z & 0xffff); vd[5 * 72] = (bf16_t)(vv.z >> 16); vd[6 * 72] = (bf16_t)(vv.w & 0xffff); vd[7 * 72] = (bf16_t)(vv.w >> 16); } }
    lds_barrier();
    const int w = F.wave;
    bf16x8 xf[2];
#pragma unroll
    for (int ks = 0; ks < 2; ++ks) xf[ks] = ldsfrag(KT + (16 * w + fr) * 144 + (32 * ks + 8 * fq) * 2);
    bf16_t* dst = RST + (size_t)((b * 128 + c) * 4 + h) * 16384;
#pragma unroll
    for (int et = 0; et < 8; ++et) { f32x4 acc = (f32x4){0.f, 0.f, 0.f, 0.f};
#pragma unroll
        for (int ks = 0; ks < 2; ++ks) acc = mfma16(xf[ks], ldsfrag(VT + (16 * et + fr) * 144 + (32 * ks + 8 * fq) * 2), acc);
        *(GAS u32x2*)(dst + (16 * et + fr) * 128 + 16 * w + 4 * fq) = pack4(acc); }
}

__device__ __forceinline__ void ret_out_task(const Frame& F, bf16_t* P, const f32x2* ROPE, const bf16_t* RST, const float* gn, int b, int c, int h, int xm = 0) {
    LAS unsigned char* Kr = F.lds;
    LAS unsigned char* VT = F.lds + 17408;
    LAS unsigned char* Sx = F.lds + 35840;
    LAS unsigned char* Pw = F.lds + 70656 + F.wave * 2304;
    LAS float* ssq = (LAS float*)(F.lds + 89088);
    int lane = F.lane; asm volatile("" : "+v"(lane)); const int fr = lane & 15, fq = lane >> 4, w = F.wave, lt = w & 3, eh = w >> 2;
    const float l2g = log2gamma(h);
    const int unit = (b * 128 + c) * 4 + h;
    lds_barrier();
    { const int s = F.tid >> 3, g8 = F.tid & 7; const size_t row = (size_t)b * SEQ + c * 64 + s; const int pos = c * 64 + s;
      const bf16_t* kp = P + pidx(row, C_RK + h * 128) + 8 * g8;
      const u32x4 k1 = *(const GAS u32x4*)kp, k2 = *(const GAS u32x4*)(kp + 64);
      float x1[8], x2[8], y1[8], y2[8]; unpack8(k1, x1); unpack8(k2, x2);
      const GAS f32x4* cp = (const GAS f32x4*)(ROPE + pos * 64 + 8 * g8);
#pragma unroll
      for (int jj = 0; jj < 4; ++jj) { const f32x4 cs = cp[jj];
          { const int j = 2 * jj; y1[j] = (x1[j] * cs.x - x2[j] * cs.y) * 0.08838834764831845f; y2[j] = (x1[j] * cs.y + x2[j] * cs.x) * 0.08838834764831845f; }
          { const int j = 2 * jj + 1; y1[j] = (x1[j] * cs.z - x2[j] * cs.w) * 0.08838834764831845f; y2[j] = (x1[j] * cs.w + x2[j] * cs.z) * 0.08838834764831845f; } }
      u32x4 o1, o2; o1.x = cvt_pk_bf16(y1[0], y1[1]); o1.y = cvt_pk_bf16(y1[2], y1[3]); o1.z = cvt_pk_bf16(y1[4], y1[5]); o1.w = cvt_pk_bf16(y1[6], y1[7]);
      o2.x = cvt_pk_bf16(y2[0], y2[1]); o2.y = cvt_pk_bf16(y2[2], y2[3]); o2.z = cvt_pk_bf16(y2[4], y2[5]); o2.w = cvt_pk_bf16(y2[6], y2[7]);
      *(LAS u32x4*)(Kr + s * 272 + (8 * g8) * 2) = o1; *(LAS u32x4*)(Kr + s * 272 + (64 + 8 * g8) * 2) = o2;
      const bf16_t* vp = P + pidx((size_t)b * SEQ + c * 64 + lane, C_RV + h * 128) + 16 * F.wave;
#pragma unroll
      for (int hh = 0; hh < 2; ++hh) { const u32x4 vv = *(const GAS u32x4*)(vp + 8 * hh);
          LAS bf16_t* vd = (LAS bf16_t*)(VT + (16 * F.wave + 8 * hh) * 144 + lane * 2);
          vd[0 * 72] = (bf16_t)(vv.x & 0xffff); vd[1 * 72] = (bf16_t)(vv.x >> 16); vd[2 * 72] = (bf16_t)(vv.y & 0xffff); vd[3 * 72] = (bf16_t)(vv.y >> 16);
          vd[4 * 72] = (bf16_t)(vv.z & 0xffff); vd[5 * 72] = (bf16_t)(vv.z >> 16); vd[6 * 72] = (bf16_t)(vv.w & 0xffff); vd[7 * 72] = (bf16_t)(vv.w >> 16); }
      const bf16_t* sp = RST + (size_t)unit * 16384;
#pragma unroll
      for (int i = 0; i < 4; ++i) { const int idx = F.tid + NTHR * i, e = idx >> 4, c16 = idx & 15;
          *(LAS u32x4*)(Sx + e * 272 + c16 * 16) = *(const GAS u32x4*)(sp + e * 128 + 8 * c16); } }
    const int l = 16 * lt + fr; const size_t qrow = (size_t)b * SEQ + c * 64 + l; const int qpos = c * 64 + l;
    bf16x8 qf[4];
    { const bf16_t* qp = P + pidx(qrow, C_RQ + h * 128) + 8 * fq;
      u32x4 qv[4];
#pragma unroll
      for (int s = 0; s < 4; ++s) qv[s] = *(const GAS u32x4*)(qp + 32 * s);
#pragma unroll
      for (int s = 0; s < 2; ++s) { float x1[8], x2[8], y1[8], y2[8]; unpack8(qv[s], x1); unpack8(qv[s + 2], x2);
          const GAS f32x4* cp = (const GAS f32x4*)(ROPE + qpos * 64 + 32 * s + 8 * fq);
#pragma unroll
          for (int jj = 0; jj < 4; ++jj) { const f32x4 cs = cp[jj];
              { const int j = 2 * jj; y1[j] = x1[j] * cs.x - x2[j] * cs.y; y2[j] = x1[j] * cs.y + x2[j] * cs.x; }
              { const int j = 2 * jj + 1; y1[j] = x1[j] * cs.z - x2[j] * cs.w; y2[j] = x1[j] * cs.w + x2[j] * cs.z; } }
          u32x4 o1, o2; o1.x = cvt_pk_bf16(y1[0], y1[1]); o1.y = cvt_pk_bf16(y1[2], y1[3]); o1.z = cvt_pk_bf16(y1[4], y1[5]); o1.w = cvt_pk_bf16(y1[6], y1[7]);
          o2.x = cvt_pk_bf16(y2[0], y2[1]); o2.y = cvt_pk_bf16(y2[2], y2[3]); o2.z = cvt_pk_bf16(y2[4], y2[5]); o2.w = cvt_pk_bf16(y2[6], y2[7]);
          qf[s] = __builtin_bit_cast(bf16x8, o1); qf[s + 2] = __builtin_bit_cast(bf16x8, o2); } }
    u32x2 gvr[4]; f32x4 ggr[4];
#pragma unroll
    for (int et = 0; et < 4; ++et) { const int e0 = 64 * eh + 16 * et + 4 * fq;
        gvr[et] = *(const GAS u32x2*)(P + pidx(qrow, C_RG + h * 128) + e0); ggr[et] = *(const GAS f32x4*)(gn + h * 128 + e0); }
    lds_barrier();
    if (xm == 1) return;
#pragma unroll
    for (int j = 0; j < 4; ++j) { f32x4 acc = (f32x4){0.f, 0.f, 0.f, 0.f};
#pragma unroll
        for (int ks = 0; ks < 4; ++ks) acc = mfma16(ldsfrag(Kr + (16 * j + fr) * 272 + (32 * ks + 8 * fq) * 2), qf[ks], acc);
#pragma unroll
        for (int i = 0; i < 4; ++i) { const int s = 16 * j + 4 * fq + i; acc[i] *= __builtin_amdgcn_exp2f(l2g * fabsf((float)(l - s))); }
        *(LAS u32x2*)(Pw + fr * 144 + (16 * j + 4 * fq) * 2) = pack4(acc); }
    f32x4 y[4];
    const float qdec = __builtin_amdgcn_exp2f(l2g * (float)(l + 1));
#pragma unroll
    for (int et = 0; et < 4; ++et) { y[et] = (f32x4){0.f, 0.f, 0.f, 0.f};
#pragma unroll
        for (int ks = 0; ks < 4; ++ks) y[et] = mfma16(ldsfrag(Sx + (64 * eh + 16 * et + fr) * 272 + (32 * ks + 8 * fq) * 2), qf[ks], y[et]);
        y[et] = y[et] * qdec; }
#pragma unroll
    for (int ks = 0; ks < 2; ++ks) { const bf16x8 pf = ldsfrag(Pw + fr * 144 + (32 * ks + 8 * fq) * 2);
#pragma unroll
        for (int et = 0; et < 4; ++et) y[et] = mfma16(ldsfrag(VT + (64 * eh + 16 * et + fr) * 144 + (32 * ks + 8 * fq) * 2), pf, y[et]); }
    float ss = 0.f;
#pragma unroll
    for (int et = 0; et < 4; ++et) ss += (y[et][0] * y[et][0] + y[et][1] * y[et][1]) + (y[et][2] * y[et][2] + y[et][3] * y[et][3]);
    ss += __shfl_xor(ss, 16); ss += __shfl_xor(ss, 32);
    if (fq == 0) ssq[w * 16 + fr] = ss;
    lds_barrier();
    const float rstd = rsqrtf((ssq[w * 16 + fr] + ssq[(w ^ 4) * 16 + fr]) * (1.f / 128.f) + EPS);
#pragma unroll
    for (int et = 0; et < 4; ++et) { const int e0 = 64 * eh + 16 * et + 4 * fq;
        const u32x2 gv = gvr[et]; const f32x4 gg = ggr[et];
        f32x4 r;
        r[0] = y[et][0] * rstd * gg[0] * silu_f(bf_lo(gv.x)); r[1] = y[et][1] * rstd * gg[1] * silu_f(bf_hi(gv.x));
        r[2] = y[et][2] * rstd * gg[2] * silu_f(bf_lo(gv.y)); r[3] = y[et][3] * rstd * gg[3] * silu_f(bf_hi(gv.y));
        *(GAS u32x2*)(P + pidx(qrow, C_RQ + h * 128) + e0) = pack4(r); }
}

__device__ __forceinline__ float softplus_f(float x) { return fmaxf(x, 0.f) + log1pf(__expf(-fabsf(x))); }
__device__ __forceinline__ void conv8(const bf16_t* P, const float* cw, const float* cb, int b, int tpos, int col, float* v) {
    const int chan = col - C_XBC;
    { const f32x4 b0 = *(const GAS f32x4*)(cb + chan), b1 = *(const GAS f32x4*)(cb + chan + 4);
      v[0] = b0.x; v[1] = b0.y; v[2] = b0.z; v[3] = b0.w; v[4] = b1.x; v[5] = b1.y; v[6] = b1.z; v[7] = b1.w; }
#pragma unroll
    for (int j = 0; j < 4; ++j) { const int ts = tpos - 3 + j;
        if (ts >= 0) { const u32x4 xv = *(const GAS u32x4*)(P + pidx((size_t)b * SEQ + ts, col)); float xf[8]; unpack8(xv, xf);
            const f32x4 w0 = *(const GAS f32x4*)(cw + j * 1024 + chan), w1 = *(const GAS f32x4*)(cw + j * 1024 + chan + 4);
            v[0] += xf[0] * w0.x; v[1] += xf[1] * w0.y; v[2] += xf[2] * w0.z; v[3] += xf[3] * w0.w; v[4] += xf[4] * w1.x; v[5] += xf[5] * w1.y; v[6] += xf[6] * w1.z; v[7] += xf[7] * w1.w; } }
#pragma unroll
    for (int i = 0; i < 8; ++i) v[i] = silu_f(v[i]);
}

__device__ __forceinline__ void conv_load(const bf16_t* P, const float* cw, const float* cb, int b, int tpos0, int col, float (&w)[4][8], float (&bias)[8], u32x4 (&rows)[11]) {
    const int chan = col - C_XBC;
#pragma unroll
    for (int j = 0; j < 4; ++j) { const f32x4 w0 = *(const GAS f32x4*)(cw + j * 1024 + chan), w1 = *(const GAS f32x4*)(cw + j * 1024 + chan + 4);
        w[j][0] = w0.x; w[j][1] = w0.y; w[j][2] = w0.z; w[j][3] = w0.w; w[j][4] = w1.x; w[j][5] = w1.y; w[j][6] = w1.z; w[j][7] = w1.w; }
    { const f32x4 b0 = *(const GAS f32x4*)(cb + chan), b1 = *(const GAS f32x4*)(cb + chan + 4);
      bias[0] = b0.x; bias[1] = b0.y; bias[2] = b0.z; bias[3] = b0.w; bias[4] = b1.x; bias[5] = b1.y; bias[6] = b1.z; bias[7] = b1.w; }
    const bf16_t* base = P + pidx((size_t)b * SEQ + tpos0, col);
#pragma unroll
    for (int r = 0; r < 11; ++r) { rows[r] = (u32x4){0u, 0u, 0u, 0u}; if (tpos0 - 3 + r >= 0) rows[r] = *(const GAS u32x4*)(base + (long)(r - 3) * 128); }
}
template <bool TR, bool HASF>
__device__ __forceinline__ void conv_compute(const float (&w)[4][8], const float (&bias)[8], const u32x4 (&rows)[11], const float (&f)[8], u32x4 (&pk)[8]) {
    float prev[8];
#pragma unroll
    for (int t = 0; t < 8; ++t) {
        float a[8];
#pragma unroll
        for (int i = 0; i < 8; ++i) a[i] = bias[i];
#pragma unroll
        for (int j = 0; j < 4; ++j) { float xf[8]; unpack8(rows[t + j], xf);
#pragma unroll
            for (int i = 0; i < 8; ++i) a[i] += xf[i] * w[j][i]; }
#pragma unroll
        for (int i = 0; i < 8; ++i) { a[i] = silu_f(a[i]); if (HASF) a[i] *= f[t]; }
        if (TR) {
            if (t & 1) {
#pragma unroll
                for (int i = 0; i < 8; ++i) { const unsigned u = cvt_pk_bf16(prev[i], a[i]);
                    if ((t >> 1) == 0) pk[i].x = u; else if ((t >> 1) == 1) pk[i].y = u; else if ((t >> 1) == 2) pk[i].z = u; else pk[i].w = u; }
            } else {
#pragma unroll
                for (int i = 0; i < 8; ++i) prev[i] = a[i];
            }
        } else {
            pk[t].x = cvt_pk_bf16(a[0], a[1]); pk[t].y = cvt_pk_bf16(a[2], a[3]); pk[t].z = cvt_pk_bf16(a[4], a[5]); pk[t].w = cvt_pk_bf16(a[6], a[7]);
        }
    }
}
template <bool TR, bool HASF>
__device__ __forceinline__ void conv_tile(const bf16_t* P, const float* cw, const float* cb, int b, int tpos0, int col, const float (&f)[8], u32x4 (&pk)[8]) {
    float w[4][8], bias[8]; u32x4 rows[11];
    conv_load(P, cw, cb, b, tpos0, col, w, bias, rows);
    conv_compute<TR, HASF>(w, bias, rows, f, pk);
}
__device__ __forceinline__ float dt_scan(const float* DT, const float* dt_bias, const float* a_log, int b, int c, int hd, int lane, float& dtv) {
    const size_t t = (size_t)b * SEQ + c * 64 + lane;
    dtv = softplus_f(((const GAS float*)DT)[t * 8 + hd] + ((const GAS float*)dt_bias)[hd]);
    float x = dtv * (-__expf(((const GAS float*)a_log)[hd]));
#pragma unroll
    for (int o = 1; o < 64; o <<= 1) { const float y = __shfl_up(x, o); if (lane >= o) x += y; }
    return x;
}

__device__ __forceinline__ void ssd_state_task(const Frame& F, const bf16_t* P, const float* DT, const float* cw, const float* cb, const float* dt_bias, const float* a_log,
                                               bf16_t* SST, float* CD, int b, int c, int g) {
    LAS unsigned char* XT = F.lds;
    LAS unsigned char* BT = F.lds + 36864;
    LAS float* dtl = (LAS float*)(F.lds + 55296);
    LAS float* acl = (LAS float*)(F.lds + 56320);
    int lane = F.lane; asm volatile("" : "+v"(lane)); const int fr = lane & 15, fq = lane >> 4, w = F.wave;
    lds_barrier();
    int tt = F.tid; asm volatile("" : "+v"(tt)); const int cgi = tt % 48, seg = tt / 48, s0 = 8 * seg;
    const int ccol = (cgi < 32) ? (C_XBC + g * 256 + 8 * cgi) : (C_XBC + 512 + g * 128 + 8 * (cgi - 32));
    float cwr[4][8], cbr[8]; u32x4 crow[11];
    if (tt < 384) conv_load(P, cw, cb, b, c * 64 + s0, ccol, cwr, cbr, crow);
    if (w < 4) { float dtv; const float cum = dt_scan(DT, dt_bias, a_log, b, c, 4 * g + w, lane, dtv);
        dtl[lane * 4 + w] = dtv; acl[lane * 4 + w] = cum;
        if (lane == 63) ((GAS float*)CD)[(b * 128 + c) * 8 + 4 * g + w] = __expf(cum); }
    lds_barrier();
    if (tt < 384) {
        float f[8]; u32x4 pk[8];
        if (cgi < 32) { const int hl = cgi >> 3; const float ae = acl[63 * 4 + hl];
#pragma unroll
            for (int t = 0; t < 8; ++t) f[t] = dtl[(s0 + t) * 4 + hl] * __expf(ae - acl[(s0 + t) * 4 + hl]); }
        else {
#pragma unroll
            for (int t = 0; t < 8; ++t) f[t] = 1.0f; }
        conv_compute<true, true>(cwr, cbr, crow, f, pk);
        LAS unsigned char* d = (cgi < 32) ? (XT + (8 * cgi) * 144 + s0 * 2) : (BT + (8 * (cgi - 32)) * 144 + s0 * 2);
#pragma unroll
        for (int i = 0; i < 8; ++i) *(LAS u32x4*)(d + i * 144) = pk[i]; }
    lds_barrier();
    const int hl = w >> 1, ph = w & 1;
    bf16x8 yf[2][2];
#pragma unroll
    for (int pt = 0; pt < 2; ++pt)
#pragma unroll
        for (int ks = 0; ks < 2; ++ks) yf[pt][ks] = ldsfrag(XT + (hl * 64 + ph * 32 + 16 * pt + fr) * 144 + (32 * ks + 8 * fq) * 2);
    bf16_t* dst = SST + (size_t)((b * 128 + c) * 8 + 4 * g + hl) * 8192;
#pragma unroll
    for (int nt = 0; nt < 8; ++nt) { f32x4 a0 = (f32x4){0.f, 0.f, 0.f, 0.f}, a1 = a0;
#pragma unroll
        for (int ks = 0; ks < 2; ++ks) { const bf16x8 xf = ldsfrag(BT + (16 * nt + fr) * 144 + (32 * ks + 8 * fq) * 2); a0 = mfma16(xf, yf[0][ks], a0); a1 = mfma16(xf, yf[1][ks], a1); }
#ifdef PROBE_CONST
        a0 = (f32x4){0.01f, 0.02f, 0.03f, 0.04f}; a1 = a0;
#endif
        *(GAS u32x2*)(dst + (ph * 32 + fr) * 128 + 16 * nt + 4 * fq) = pack4(a0);
        *(GAS u32x2*)(dst + (ph * 32 + 16 + fr) * 128 + 16 * nt + 4 * fq) = pack4(a1); }
}

__device__ __forceinline__ void ssd_out_task(const Frame& F, bf16_t* P, const float* DT, const float* cw, const float* cb, const float* dt_bias, const float* a_log,
                                             const float* d_skip, const float* nrm, const bf16_t* SST, int b, int c) {
    LAS unsigned char* Bs = F.lds;
    LAS unsigned char* Cs = F.lds + 17408;
    LAS unsigned char* XT = F.lds + 34816;
    LAS unsigned char* Pw = F.lds + 71680 + F.wave * 2304;
    LAS float* dtl = (LAS float*)(F.lds + 90112);
    LAS float* acl = (LAS float*)(F.lds + 92160);
    LAS float* ssq = (LAS float*)(F.lds + 94208);
    int lane = F.lane; asm volatile("" : "+v"(lane)); const int fr = lane & 15, fq = lane >> 4, w = F.wave, hl = w >> 1, half = w & 1;
    lds_barrier();
    { float dtv; const float cum = dt_scan(DT, dt_bias, a_log, b, c, w, lane, dtv); dtl[lane * 8 + w] = dtv; acl[lane * 8 + w] = cum; }
    float ssl[2] = {0.f, 0.f};
#pragma unroll 1
    for (int g = 0; g < 2; ++g) {
        const int head = 4 * g + hl;
        const bf16_t* hsrc = SST + (size_t)((b * 128 + c) * 8 + head) * 8192;
        bf16x8 hfr[4][4];
#pragma unroll
        for (int ks = 0; ks < 4; ++ks)
#pragma unroll
            for (int pt = 0; pt < 4; ++pt) hfr[ks][pt] = *(const GAS bf16x8*)(hsrc + (16 * pt + fr) * 128 + 32 * ks + 8 * fq);
        lds_barrier();
        { int tt = F.tid; asm volatile("" : "+v"(tt)); const int cgi = tt & 63, seg = tt >> 6, s0 = 8 * seg;
            const int col = (cgi < 32) ? (C_XBC + g * 256 + 8 * cgi) : (cgi < 48) ? (C_XBC + 512 + g * 128 + 8 * (cgi - 32)) : (C_XBC + 768 + g * 128 + 8 * (cgi - 48));
            const float f[8] = {1.f, 1.f, 1.f, 1.f, 1.f, 1.f, 1.f, 1.f}; u32x4 pk[8];
            if (cgi < 32) { conv_tile<true, false>(P, cw, cb, b, c * 64 + s0, col, f, pk);
                LAS unsigned char* d = XT + (8 * cgi) * 144 + s0 * 2;
#pragma unroll
                for (int i = 0; i < 8; ++i) *(LAS u32x4*)(d + i * 144) = pk[i]; }
            else { conv_tile<false, false>(P, cw, cb, b, c * 64 + s0, col, f, pk);
                LAS unsigned char* d = ((cgi < 48) ? (Bs + (8 * (cgi - 32)) * 2) : (Cs + (8 * (cgi - 48)) * 2)) + s0 * 272;
#pragma unroll
                for (int i = 0; i < 8; ++i) *(LAS u32x4*)(d + i * 272) = pk[i]; } }
        u32x2 zvr[2][4];
#pragma unroll
        for (int li = 0; li < 2; ++li)
#pragma unroll
            for (int pt = 0; pt < 4; ++pt) zvr[li][pt] = *(const GAS u32x2*)(P + pidx((size_t)b * SEQ + c * 64 + 16 * (2 * half + li) + fr, C_MZ + head * 64 + 16 * pt + 4 * fq));
        lds_barrier();
        const float dsk = ((const GAS float*)d_skip)[head];
#pragma unroll
        for (int li = 0; li < 2; ++li) {
            asm volatile("" ::: "memory"); __builtin_amdgcn_sched_barrier(0);
            const int lt = 2 * half + li, l = 16 * lt + fr;
            const float al = acl[l * 8 + head];
            bf16x8 cf[4];
#pragma unroll
            for (int ks = 0; ks < 4; ++ks) cf[ks] = ldsfrag(Cs + (16 * lt + fr) * 272 + (32 * ks + 8 * fq) * 2);
            f32x4 y[4];
#pragma unroll
            for (int pt = 0; pt < 4; ++pt) y[pt] = (f32x4){0.f, 0.f, 0.f, 0.f};
#pragma unroll
            for (int ks = 0; ks < 4; ++ks) {
#pragma unroll
                for (int pt = 0; pt < 4; ++pt) y[pt] = mfma16(hfr[ks][pt], cf[ks], y[pt]); }
            { const float eal = __expf(al);
#pragma unroll
              for (int pt = 0; pt < 4; ++pt) y[pt] = y[pt] * eal; }
#pragma unroll
            for (int st = 0; st < 4; ++st) { f32x4 acc = (f32x4){0.f, 0.f, 0.f, 0.f};
#pragma unroll
                for (int ks = 0; ks < 4; ++ks) acc = mfma16(ldsfrag(Bs + (16 * st + fr) * 272 + (32 * ks + 8 * fq) * 2), cf[ks], acc);
#pragma unroll
                for (int i = 0; i < 4; ++i) { const int s = 16 * st + 4 * fq + i;
                    acc[i] = (s <= l) ? acc[i] * __expf(al - acl[s * 8 + head]) * dtl[s * 8 + head] : 0.f; }
                *(LAS u32x2*)(Pw + fr * 144 + (16 * st + 4 * fq) * 2) = pack4(acc); }
#pragma unroll
            for (int ks = 0; ks < 2; ++ks) { if (2 * ks <= lt) { const bf16x8 pf = ldsfrag(Pw + fr * 144 + (32 * ks + 8 * fq) * 2);
#pragma unroll
                for (int pt = 0; pt < 4; ++pt) y[pt] = mfma16(ldsfrag(XT + (hl * 64 + 16 * pt + fr) * 144 + (32 * ks + 8 * fq) * 2), pf, y[pt]); } }
            const size_t row = (size_t)b * SEQ + c * 64 + l;
#pragma unroll
            for (int pt = 0; pt < 4; ++pt) { const int p0 = 16 * pt + 4 * fq;
                const u32x2 zv = zvr[li][pt];
                const LAS bf16_t* xp = (const LAS bf16_t*)(XT + (hl * 64 + p0) * 144 + l * 2);
                f32x4 r;
                r[0] = (y[pt][0] + bf2f(xp[0 * 72]) * dsk) * silu_f(bf_lo(zv.x)); r[1] = (y[pt][1] + bf2f(xp[1 * 72]) * dsk) * silu_f(bf_hi(zv.x));
                r[2] = (y[pt][2] + bf2f(xp[2 * 72]) * dsk) * silu_f(bf_lo(zv.y)); r[3] = (y[pt][3] + bf2f(xp[3 * 72]) * dsk) * silu_f(bf_hi(zv.y));
                ssl[li] += (r[0] * r[0] + r[1] * r[1]) + (r[2] * r[2] + r[3] * r[3]);
                *(GAS u32x2*)(P + pidx(row, C_MZ + head * 64 + p0)) = pack4(r); }
        }
    }
#pragma unroll
    for (int li = 0; li < 2; ++li) { float ss = ssl[li];
        ss += __shfl_xor(ss, 16); ss += __shfl_xor(ss, 32);
        if (fq == 0) ssq[hl * 64 + 16 * (2 * half + li) + fr] = ss; }
    asm volatile("s_waitcnt vmcnt(0)" ::: "memory");
    u32x2 ypk[2][2][4]; f32x4 ngv[2][4];
#pragma unroll
    for (int g = 0; g < 2; ++g)
#pragma unroll
        for (int pt = 0; pt < 4; ++pt) { const int ch = (4 * g + hl) * 64 + 16 * pt + 4 * fq; ngv[g][pt] = *(const GAS f32x4*)(nrm + ch);
#pragma unroll
            for (int li = 0; li < 2; ++li) ypk[li][g][pt] = *(const GAS u32x2*)(P + pidx((size_t)b * SEQ + c * 64 + 16 * (2 * half + li) + fr, C_MZ + ch)); }
    lds_barrier();
#pragma unroll
    for (int li = 0; li < 2; ++li) { const int l = 16 * (2 * half + li) + fr;
        const float rstd = rsqrtf((ssq[l] + ssq[64 + l] + ssq[128 + l] + ssq[192 + l]) * (1.f / 512.f) + EPS);
        const size_t row = (size_t)b * SEQ + c * 64 + l;
#pragma unroll
        for (int g = 0; g < 2; ++g)
#pragma unroll
            for (int pt = 0; pt < 4; ++pt) { const int ch = (4 * g + hl) * 64 + 16 * pt + 4 * fq;
                const u32x2 pk = ypk[li][g][pt]; const f32x4 r = (f32x4){bf_lo(pk.x), bf_hi(pk.x), bf_lo(pk.y), bf_hi(pk.y)};
                *(GAS u32x2*)(P + pidx(row, C_MZ + ch)) = pack4(r * rstd * ngv[g][pt]); } }
}

__device__ __forceinline__ void scan_phase(const Frame& F, bf16_t* RST, bf16_t* SST, const float* CD) {
    for (int task = F.bid * NTHR + F.tid; task < 131072; task += F.G * NTHR) {
        {
          const int pr = task & 8191, bh = task >> 13, b = bh >> 2, h = bh & 3;
          GAS unsigned* p = (GAS unsigned*)(RST + (size_t)((b * 128) * 4 + h) * 16384) + pr;
          const float dec = __builtin_amdgcn_exp2f(64.f * log2gamma(h));
          float s0 = 0.f, s1 = 0.f;
#pragma unroll 1
          for (int c0 = 0; c0 < 128; c0 += 32) { unsigned v[32];
#pragma unroll
              for (int i = 0; i < 32; ++i) v[i] = p[(size_t)(c0 + i) * 32768];
#pragma unroll
              for (int i = 0; i < 32; ++i) { p[(size_t)(c0 + i) * 32768] = cvt_pk_bf16(s0, s1); s0 = s0 * dec + bf_lo(v[i]); s1 = s1 * dec + bf_hi(v[i]); } } }
        {
          const int pr = task & 4095, bh = task >> 12, b = bh >> 3, hd = bh & 7;
          GAS unsigned* p = (GAS unsigned*)(SST + (size_t)((b * 128) * 8 + hd) * 8192) + pr;
          const GAS float* cd = (const GAS float*)(CD + (b * 128) * 8 + hd);
          float s0 = 0.f, s1 = 0.f;
#pragma unroll 1
          for (int c0 = 0; c0 < 128; c0 += 32) { unsigned v[32]; float d[32];
#pragma unroll
              for (int i = 0; i < 32; ++i) { v[i] = p[(size_t)(c0 + i) * 32768]; d[i] = cd[(c0 + i) * 8]; }
#pragma unroll
              for (int i = 0; i < 32; ++i) { p[(size_t)(c0 + i) * 32768] = cvt_pk_bf16(s0, s1); s0 = s0 * d[i] + bf_lo(v[i]); s1 = s1 * d[i] + bf_hi(v[i]); } } }
    }
}


#define XB_TMO      128
#define XB_XCNT(j)  (256  + 64 * (j))
#define XB_XSUB(j)  (1280 + 64 * (j))
#define XB_XGEN(j)  (2304 + 64 * (j))
#define XB_TOP      3328
#define XB_TOPGEN   3392
#define XB_SPIN_CAP (1u << 22)
__device__ __forceinline__ unsigned xb_ld(unsigned* p)              { return __hip_atomic_load(p, __ATOMIC_RELAXED, __HIP_MEMORY_SCOPE_AGENT); }
__device__ __forceinline__ unsigned xb_add(unsigned* p, unsigned v) { return __hip_atomic_fetch_add(p, v, __ATOMIC_RELAXED, __HIP_MEMORY_SCOPE_AGENT); }
__device__ __forceinline__ unsigned xb_xcc_id() { return (unsigned)__builtin_amdgcn_s_getreg((3 << 11) | 20) & 0xFu; }
#define XB_SPIN(cond, bar) do { unsigned _sp = 0; while (cond) { __builtin_amdgcn_s_sleep(1); \
    if ((++_sp & 255u) == 0u) { if (xb_ld(&(bar)[XB_TMO])) break; if (_sp > XB_SPIN_CAP) { atomicAdd(&(bar)[XB_TMO], 1u); break; } } } } while (0)
struct XcdBarrier { unsigned* bar; unsigned x; volatile LAS unsigned* st; };
__device__ __forceinline__ XcdBarrier xcd_barrier_post(unsigned* bar, volatile LAS unsigned* st) {
    XcdBarrier b; b.bar = bar; b.x = xb_xcc_id(); b.st = st;
    if (threadIdx.x == 0) (void)xb_add(&bar[XB_XCNT(b.x)], 1u);
    return b;
}
__device__ __forceinline__ void xcd_barrier_complete(unsigned* bar, unsigned x, unsigned& nloc, unsigned& nx) {
    const unsigned G = gridDim.x * gridDim.y * gridDim.z;
    unsigned sum, cnt, mine, sp = 0u;
    for (;;) {
        sum = 0u; cnt = 0u; mine = 0u;
#pragma unroll
        for (unsigned j = 0; j < 16; ++j) { const unsigned c = xb_ld(&bar[XB_XCNT(j)]); sum += c; cnt += (c > 0u) ? 1u : 0u; mine = (j == x) ? c : mine; }
        if (sum == G) break;
        __builtin_amdgcn_s_sleep(1);
        if ((++sp & 255u) == 0u) { if (xb_ld(&bar[XB_TMO])) break; if (sp > XB_SPIN_CAP) { atomicAdd(&bar[XB_TMO], 1u); break; } }
    }
    nloc = mine > 0u ? mine : 1u; nx = cnt > 0u ? cnt : 1u;
}
__device__ __forceinline__ void xcd_barrier(const XcdBarrier& b) {
    asm volatile("s_waitcnt vmcnt(0)" ::: "memory");
    __syncthreads();
    if (threadIdx.x == 0) {
        unsigned* bar = b.bar;
        __builtin_amdgcn_s_waitcnt(0);
        unsigned nloc = b.st[0], nx = b.st[1];
        if (nloc == 0u) { xcd_barrier_complete(bar, b.x, nloc, nx); b.st[0] = nloc; b.st[1] = nx; }
        const unsigned old = xb_add(&bar[XB_XSUB(b.x)], 1u);
        const unsigned gen = old / nloc;
        if (old + 1u == (gen + 1u) * nloc) {
            __builtin_amdgcn_fence(__ATOMIC_RELEASE, "agent");
            asm volatile("s_waitcnt vmcnt(0)" ::: "memory");
            const unsigned og = xb_add(&bar[XB_TOP], 1u);
            const unsigned tg = og / nx;
            if (og + 1u == (tg + 1u) * nx) xb_add(&bar[XB_TOPGEN], 1u);
            else XB_SPIN(xb_ld(&bar[XB_TOPGEN]) == tg, bar);
            __builtin_amdgcn_fence(__ATOMIC_ACQUIRE, "agent");
            xb_add(&bar[XB_XGEN(b.x)], 1u);
            asm volatile("s_waitcnt vmcnt(0)" ::: "memory");
        } else {
            XB_SPIN(xb_ld(&bar[XB_XGEN(b.x)]) == gen, bar);
            __builtin_amdgcn_fence(__ATOMIC_ACQUIRE, "agent");
            asm volatile("s_waitcnt vmcnt(0)" ::: "memory");
        }
    }
    __syncthreads();
}

__device__ __forceinline__ void final_phase(const Frame& F, const bf16_t* hb, float* out, const float* gain, const float* fmod, const XcdBarrier& xbar) {
    const int gw = F.bid * NWAVE + F.wave, NGW = F.G * NWAVE;
    u32x2 hv[16][4];
#pragma unroll
    for (int r = 0; r < 16; ++r) { const int m = gw + r * NGW; const int mm = m < T_TOK ? m : gw;
        const GAS u32x2* xr = (const GAS u32x2*)(hb + (size_t)mm * DM) + F.lane;
#pragma unroll
        for (int j = 0; j < 4; ++j) hv[r][j] = xr[64 * j]; }
    xcd_barrier(xbar);
#pragma unroll
    for (int r = 0; r < 16; ++r) { const int m = gw + r * NGW; if (m < T_TOK) {
        const int b = m >> 13; f32x4 v[4]; float s = 0.f;
#pragma unroll
        for (int j = 0; j < 4; ++j) { const u32x2 t = hv[r][j]; v[j] = (f32x4){bf_lo(t.x), bf_hi(t.x), bf_lo(t.y), bf_hi(t.y)};
            s += (v[j].x * v[j].x + v[j].y * v[j].y) + (v[j].z * v[j].z + v[j].w * v[j].w); }
        const float rstd = rsqrtf(wave_sum(s) * (1.f / DM) + EPS);
        GAS f32x4* xo = (GAS f32x4*)(out + (size_t)m * DM) + F.lane;
#pragma unroll
        for (int j = 0; j < 4; ++j) {
            const f32x4 g = ((const GAS f32x4*)gain)[F.lane + 64 * j], sh = ((const GAS f32x4*)(fmod + (size_t)b * 2048))[F.lane + 64 * j], sc = ((const GAS f32x4*)(fmod + (size_t)b * 2048 + 1024))[F.lane + 64 * j];
            xo[64 * j] = v[j] * rstd * g * (sc + 1.0f) + sh; } } }
}

constexpr int NPH = 26;
__global__ void __launch_bounds__(NTHR, 2) fwd_kernel(Params p) {
    extern __shared__ __attribute__((aligned(16))) unsigned char lds_raw[];
    volatile LAS unsigned* xb_st = (volatile LAS unsigned*)((LAS unsigned char*)lds_raw + LDS_BYTES - 64);
    if (threadIdx.x == 0) { xb_st[0] = 0u; xb_st[1] = 0u; }
    __syncthreads();
    const XcdBarrier xbar = xcd_barrier_post((unsigned*)p.ws, xb_st);
    if (p.ph_lo == 0) {
        Frame F0; F0.lds = (LAS unsigned char*)lds_raw; F0.tid = threadIdx.x; F0.lane = F0.tid & 63; F0.wave = __builtin_amdgcn_readfirstlane(F0.tid >> 6); F0.G = gridDim.x; F0.bid = blockIdx.x;
        if (EN_PRO) prologue(F0, p, as_global(p.ws), 0);
        if (p.ph_hi > 1) cg::this_grid().sync();
    }
#ifdef TPROBE
    unsigned long long tA = 0, tB = 0;
#endif
    for (int ph_ = (p.ph_lo < 1 ? 1 : p.ph_lo); ph_ < p.ph_hi; ++ph_) {
#ifdef TPROBE
    const unsigned long long tp0 = __builtin_amdgcn_s_memrealtime();
#endif
    int ph = __builtin_amdgcn_readfirstlane(ph_);
#ifdef PH_LIMIT
    if (ph > PH_LIMIT && ph < NPH - 1) continue;
#endif
    int tid_ = threadIdx.x; asm volatile("" : "+v"(tid_));
    unsigned char* ws_ = p.ws; asm volatile("" : "+s"(ws_)); unsigned char* ws = as_global(ws_);
    int zi = 0; asm volatile("" : "+s"(zi));
    Frame F;
    F.lds = (LAS unsigned char*)lds_raw;
    F.tid = tid_; F.lane = F.tid & 63; F.wave = __builtin_amdgcn_readfirstlane(F.tid >> 6); { int g_ = gridDim.x, b_ = blockIdx.x; asm volatile("" : "+s"(g_), "+s"(b_)); F.G = g_; F.bid = b_; }
    float* MOD = (float*)(ws + WS_MOD);
    const f32x2* ROPE = (const f32x2*)(ws + WS_ROPE);
    float* DT = (float*)(ws + WS_DT);
    float* CD = (float*)(ws + WS_CD);
    bf16_t* WFU = (bf16_t*)(ws + WS_WFU); bf16_t* WFD = (bf16_t*)(ws + WS_WFD); bf16_t* WIN = (bf16_t*)(ws + WS_WIN); bf16_t* WOUT = (bf16_t*)(ws + WS_WOUT);
    bf16_t* U = (bf16_t*)(ws + WS_U); bf16_t* RST = (bf16_t*)(ws + WS_RST); bf16_t* SST = (bf16_t*)(ws + WS_SST);
    bf16_t* PROJ = (bf16_t*)(ws + WS_PROJ); bf16_t* HID = PROJ;
    float* hbuf_ = p.out; asm volatile("" : "+s"(hbuf_)); float* hbuf = as_global(hbuf_);
    bf16_t* HB = (bf16_t*)((unsigned char*)hbuf + 64 * MiB);
        if (ph == NPH - 1) {
            if (EN_FIN) final_phase(F, HB, hbuf, as_global(p.in[24 + zi]), MOD + FMOD_OFF, xbar);
        } else {
#ifdef XTRA_LIST
            static constexpr int xtra[] = XTRA_LIST;
            const int l = (ph >= NPH) ? 1 : (ph - 1) / 12, j = (ph >= NPH) ? xtra[ph - NPH] : (ph - 1) % 12;
#else
            const int l = (ph - 1) / 12, j = (ph - 1) % 12;
#endif
            const float* modl = MOD + (size_t)l * 4 * 9216;
            if (j == 0 || j == 3 || j == 9) {
                const float* hin = (l == 0 && j == 0) ? as_global(p.in[0 + zi]) : nullptr;
                const int gi = (j == 0) ? 4 : (j == 3) ? 8 : 18;
                const int mi = (j == 0) ? 0 : (j == 3) ? 3 : 6;
                if (EN_NORM) norm_phase(F, hin, HB, as_global(p.in[gi + zi]) + l * DM, modl + mi * 1024, modl + (mi + 1) * 1024, 9216, U);
                __syncthreads();
                if (!EN_CONV) {} else if (j == 0) convert_ffn(F, as_global(p.in[5 + zi]) + (size_t)l * DM * DFF, as_global(p.in[6 + zi]) + (size_t)l * DM * DFF, as_global(p.in[7 + zi]) + (size_t)l * DM * DFF, WFU, WFD);
                else if (j == 9) convert_ffn(F, as_global(p.in[19 + zi]) + (size_t)l * DM * DFF, as_global(p.in[20 + zi]) + (size_t)l * DM * DFF, as_global(p.in[21 + zi]) + (size_t)l * DM * DFF, WFU, WFD);
                else convert_mix(F, as_global(p.in[9 + zi]) + (size_t)l * DM * INW, as_global(p.in[17 + zi]) + (size_t)l * 1536 * DM, WIN, WOUT);
            } else if (j == 1 || j == 10) {
                pg8::Gemm g{U, WFU, T_TOK, 2 * DFF, DM, DM}; pg8::StaticOrder S; S.init(T_TOK, 2 * DFF, F.G, F.bid);
                pg8::EpiSwiGLU E{HID, DFF};
                if (EN_G1) pg8::gemm_phase<pg8::EpiSwiGLU>(F.lds, F.tid, g, S, E);
            } else if (j == 2 || j == 11 || j == 8) {
                pg8::Gemm g; pg8::EpiResid E;
                if (j == 8) { g = pg8::Gemm{PROJ, WOUT, T_TOK, DM, 1536, PW}; E = pg8::EpiResid{HB, modl + 5 * 1024, 1.0f}; }
                else { g = pg8::Gemm{HID, WFD, T_TOK, DM, DFF, DFF}; E = pg8::EpiResid{HB, modl + (j == 2 ? 2 : 8) * 1024, 0.5f}; }
                pg8::StaticOrder S; S.init(T_TOK, DM, F.G, F.bid);
                if (EN_G2) { if (j == 8) pg8::gemm_phase<pg8::EpiResid, true>(F.lds, F.tid, g, S, E); else pg8::gemm_phase<pg8::EpiResid, false>(F.lds, F.tid, g, S, E); }
            } else if (j == 4) {
                pg8::Gemm g{U, WIN, T_TOK, PW, DM, DM}; pg8::StaticOrder S; S.init(T_TOK, PW, F.G, F.bid);
                pg8::EpiBf16 E{PROJ, PW};
                if (EN_G3) pg8::gemm_phase<pg8::EpiBf16>(F.lds, F.tid, g, S, E);
                if (EN_DT) dt_gemv(F, U, as_global(p.in[9 + zi]) + (size_t)l * DM * INW, DT);
            } else if (j == 5) {
                if (EN_SB && XS(1)) for (int t = F.bid; t < 1024; t += F.G) { const int qb = 63 - (t >> 4), bh = t & 15; sb_task(F, PROJ, bh >> 2, bh & 3, qb); }
                if (EN_RKV && XS(2)) for (int t = F.bid; t < 2048; t += F.G) { const int h = t & 3, bc = t >> 2; ret_kv_task(F, PROJ, ROPE, RST, bc >> 7, bc & 127, h); }
                if (EN_SST && XS(4)) for (int t = F.bid; t < 1024; t += F.G) { const int g = t & 1, bc = t >> 1;
                    ssd_state_task(F, PROJ, DT, as_global(p.in[10 + zi]) + l * 4096, as_global(p.in[11 + zi]) + l * 1024, as_global(p.in[12 + zi]) + l * 8, as_global(p.in[13 + zi]) + l * 8, SST, CD, bc >> 7, bc & 127, g); }
            } else if (j == 6) {
                if (EN_SCAN) scan_phase(F, RST, SST, CD);
            } else if (j == 7) {
                if (EN_ROUT && XS(8)) for (int t = F.bid; t < 2048; t += F.G) { const int h = t & 3, bc = t >> 2; ret_out_task(F, PROJ, ROPE, RST, as_global(p.in[15 + zi]) + l * 512, bc >> 7, bc & 127, h, ph >= NPH ? XMODE : 0); }
                if (EN_SOUT && XS(16)) for (int t = F.bid; t < 512; t += F.G) {
                    ssd_out_task(F, PROJ, DT, as_global(p.in[10 + zi]) + l * 4096, as_global(p.in[11 + zi]) + l * 1024, as_global(p.in[12 + zi]) + l * 8, as_global(p.in[13 + zi]) + l * 8, as_global(p.in[14 + zi]) + l * 8, as_global(p.in[16 + zi]) + l * 512, SST, t >> 7, t & 127); }
            }
        }
        if (ph + 1 < p.ph_hi) { xcd_barrier(xbar); }
#ifdef TPROBE
        { const unsigned long long tp1 = __builtin_amdgcn_s_memrealtime(); const int jj = (ph - 1) % 12;
          if (ph < NPH - 1) { if (TPROBE_A(jj)) tA += tp1 - tp0; if (TPROBE_B(jj)) tB += tp1 - tp0; } }
#endif
    }
#ifdef TPROBE
    cg::this_grid().sync();
    if (blockIdx.x == 0) { const float a = (float)tA * 0.01f, b = (float)tB * 0.01f * TPROBE_BS;
        if (threadIdx.x == 0) p.out[0] += a;
        for (int i = threadIdx.x; i < (1 << 20); i += NTHR) p.out[1024 + i] += b; }
#endif
}

extern "C" void kernel_launch(void* const* d_in, const int* in_sizes, int n_in, void* d_out, int out_size, void* d_ws, size_t ws_size, hipStream_t stream) {
    static int grid = 0;
    if (grid == 0) {
        if (n_in != 25 || out_size != T_TOK * DM || ws_size < WS_END) { fprintf(stderr, "kernel_launch: unexpected shapes (n_in %d out %d ws %zu)\n", n_in, out_size, ws_size); grid = -1; return; }
        int dev = 0, cus = 0, per_cu = 0;
        hipGetDevice(&dev);
        hipDeviceGetAttribute(&cus, hipDeviceAttributeMultiprocessorCount, dev);
        hipFuncSetAttribute((const void*)fwd_kernel, hipFuncAttributeMaxDynamicSharedMemorySize, LDS_BYTES);
        hipOccupancyMaxActiveBlocksPerMultiprocessor(&per_cu, (const void*)fwd_kernel, NTHR, LDS_BYTES);
        if (per_cu < 1) per_cu = 1;
        (void)hipGetLastError();
        grid = cus * per_cu;
    }
    if (grid < 0) return;
    (void)hipMemsetAsync(d_ws, 0, 65536, stream);
    Params p{};
    for (int i = 0; i < 25; ++i) p.in[i] = (const float*)d_in[i];
    p.out = (float*)d_out; p.ws = (unsigned char*)d_ws;
#if ONE_LAUNCH
#ifdef XTRA_LIST
    p.ph_lo = 0; p.ph_hi = NPH + XTRA_N;
#else
    p.ph_lo = 0; p.ph_hi = NPH;
#endif
    void* args[] = {&p};
    hipError_t e = hipLaunchCooperativeKernel((const void*)fwd_kernel, dim3(grid), dim3(NTHR), args, LDS_BYTES, stream);
    if (e != hipSuccess) fprintf(stderr, "cooperative launch failed: %s (grid %d)\n", hipGetErrorString(e), grid);
#else
    for (int ph = 0; ph < NPH; ++ph) { p.ph_lo = ph; p.ph_hi = ph + 1; hipLaunchKernelGGL(fwd_kernel, dim3(grid), dim3(NTHR), LDS_BYTES, stream, p); }
#endif
}
```

```cpp
#include <hip/hip_runtime.h>
#include <hip/hip_cooperative_groups.h>
#include <cstdint>
#include <cstdio>
namespace cg = cooperative_groups;

#ifndef ONE_LAUNCH
#define ONE_LAUNCH 1
#endif

#ifndef EN_ALL
#define EN_ALL 1
#endif
#ifndef EN_PRO
#define EN_PRO EN_ALL
#endif
#ifndef EN_FIN
#define EN_FIN EN_ALL
#endif
#ifndef EN_NORM
#define EN_NORM EN_ALL
#endif
#ifndef EN_CONV
#define EN_CONV EN_ALL
#endif
#ifndef EN_G1
#define EN_G1 EN_ALL
#endif
#ifndef EN_G2
#define EN_G2 EN_ALL
#endif
#ifndef EN_G3
#define EN_G3 EN_ALL
#endif
#ifndef EN_DT
#define EN_DT EN_ALL
#endif
#ifndef EN_SB
#define EN_SB EN_ALL
#endif
#ifndef EN_RKV
#define EN_RKV EN_ALL
#endif
#ifndef EN_SST
#define EN_SST EN_ALL
#endif
#ifndef EN_SCAN
#define EN_SCAN EN_ALL
#endif
#ifndef EN_ROUT
#define EN_ROUT EN_ALL
#endif
#ifndef EN_SOUT
#define EN_SOUT EN_ALL
#endif
#ifndef EN_SINTER
#define EN_SINTER 1
#endif
#ifndef XSEL
#define XSEL 31
#endif
#define XS(m) (ph < NPH || (XSEL & (m)))
#ifndef XMODE
#define XMODE 0
#endif
#define LAS __attribute__((address_space(3)))
#define GAS __attribute__((address_space(1)))
template <class T> __device__ __forceinline__ T* as_global(T* p) {
#if defined(__HIP_DEVICE_COMPILE__)
    __builtin_assume(!__builtin_amdgcn_is_shared((const void*)p)); __builtin_assume(!__builtin_amdgcn_is_private((const void*)p));
#endif
    return p; }
typedef unsigned short bf16_t;
typedef short bf16x8 __attribute__((ext_vector_type(8)));
typedef float f32x4 __attribute__((ext_vector_type(4)));
typedef float f32x2 __attribute__((ext_vector_type(2)));
typedef unsigned u32x4 __attribute__((ext_vector_type(4)));
typedef unsigned u32x2 __attribute__((ext_vector_type(2)));

constexpr int T_TOK = 32768, SEQ = 8192, DM = 1024, DFF = 2816, INW = 5128, PW = 5120;
constexpr int NTHR = 512, NWAVE = 8;
constexpr float EPS = 1e-6f;
constexpr int C_RQ = 0, C_SQ = 512, C_MZ = 1024, C_RK = 1536, C_RV = 2048, C_RG = 2560, C_SK = 3072, C_SV = 3584, C_XBC = 4096;

constexpr size_t MiB = 1u << 20;
constexpr size_t WS_MOD = 1 * MiB, WS_ROPE = 2 * MiB, WS_DT = 6 * MiB, WS_CD = 7 * MiB;
constexpr size_t WS_WFU = 8 * MiB, WS_WFD = 19 * MiB, WS_WIN = 25 * MiB, WS_WOUT = 35 * MiB;
constexpr size_t WS_U = 38 * MiB, WS_RST = 38 * MiB, WS_SST = 102 * MiB, WS_PROJ = 166 * MiB, WS_END = 486 * MiB;
constexpr int FMOD_OFF = 2 * 4 * 9 * 1024;

constexpr size_t PLANE = (size_t)T_TOK * 128;
__device__ __forceinline__ size_t pidx(size_t row, int col) { return (size_t)(col >> 7) * PLANE + row * 128 + (col & 127); }
constexpr int LDS_BYTES = 147456;

struct Params {
    const float* in[25];
    float* out;
    unsigned char* ws;
    int ph_lo, ph_hi;
};

typedef __bf16 bf16x2_t __attribute__((ext_vector_type(2)));
__device__ __forceinline__ unsigned cvt_pk_bf16(float lo, float hi) { const f32x2 v = {lo, hi}; const bf16x2_t b = __builtin_convertvector(v, bf16x2_t); return __builtin_bit_cast(unsigned, b); }
__device__ __forceinline__ float bf_lo(unsigned u) { return __uint_as_float(u << 16); }
__device__ __forceinline__ float bf_hi(unsigned u) { return __uint_as_float(u & 0xffff0000u); }
__device__ __forceinline__ float bf2f(bf16_t x) { return __uint_as_float(((unsigned)x) << 16); }
__device__ __forceinline__ bf16_t f2bf(float f) { return (bf16_t)(cvt_pk_bf16(f, 0.f) & 0xffffu); }
__device__ __forceinline__ float wave_sum(float v) {
#pragma unroll
    for (int o = 1; o < 64; o <<= 1) v += __shfl_xor(v, o);
    return v;
}
__device__ __forceinline__ float wave_max(float v) {
#pragma unroll
    for (int o = 1; o < 64; o <<= 1) v = fmaxf(v, __shfl_xor(v, o));
    return v;
}
__device__ __forceinline__ void lds_barrier() { asm volatile("s_waitcnt lgkmcnt(0)" ::: "memory"); __builtin_amdgcn_s_barrier(); asm volatile("" ::: "memory"); }
__device__ __forceinline__ float silu_f(float g) { return g * __builtin_amdgcn_rcpf(1.0f + __builtin_amdgcn_exp2f(-1.44269504f * g)); }
__device__ __forceinline__ f32x4 mfma16(bf16x8 a, bf16x8 b, f32x4 c) { return __builtin_amdgcn_mfma_f32_16x16x32_bf16(a, b, c, 0, 0, 0); }
__device__ __forceinline__ bf16x8 ldsfrag(const LAS unsigned char* p) { return *(const LAS bf16x8*)p; }
__device__ __forceinline__ u32x2 pack4(f32x4 v) { u32x2 w; w.x = cvt_pk_bf16(v[0], v[1]); w.y = cvt_pk_bf16(v[2], v[3]); return w; }
__device__ __forceinline__ void unpack8(u32x4 v, float* f) {
    f[0] = bf_lo(v.x); f[1] = bf_hi(v.x); f[2] = bf_lo(v.y); f[3] = bf_hi(v.y); f[4] = bf_lo(v.z); f[5] = bf_hi(v.z); f[6] = bf_lo(v.w); f[7] = bf_hi(v.w);
}
__device__ __forceinline__ float log2gamma(int h) { return h == 0 ? -0.04580368961312479f : (h == 1 ? -0.02272007650008353f : (h == 2 ? -0.011315313227834146f : -0.005646563141142063f)); }

namespace pg8 {
constexpr int BM = 256, BK = 64, HALF = 128, HTB = HALF * BK * 2, STAGE_BYTES = 8 * HTB, NXCD = 8, WGM = 8;
__host__ __device__ __forceinline__ int lds_byte(int r, int c) { const int st = (r >> 4) * 2 + (c >> 5), rr = r & 15, cc = c & 31, ob = rr * 64 + cc * 2; return st * 1024 + (ob ^ (((ob >> 9) & 1) << 5)); }
__host__ __device__ __forceinline__ void stage_rc(int b, int& R, int& C) { const int st = b / 1024, sb = b % 1024, swz = sb ^ (((sb >> 9) & 1) << 5); R = (st >> 1) * 16 + swz / 64; C = (st & 1) * 32 + (swz % 64) / 2; }
__host__ __device__ __forceinline__ int perm32(int rho) { const int n = rho >> 4, i = rho & 15; return 8 * (i >> 2) + 4 * n + (i & 3); }
struct Unit { int pm, pn; };
struct Gemm { const bf16_t* A; const bf16_t* Bt; int M, N, K, lda; };
struct StaticOrder {
    int nM, nN, nwg, G, c;
    __device__ void init(int M, int N, int G_, int c_) { nM = M / BM; nN = N / BM; nwg = nM * nN; G = G_; c = c_; }
    __device__ bool next(int i, Unit& u) const {
        const long L = (long)i * G + c; if (L >= nwg) return false;
        int wgid = (int)L; { const int q = nwg / NXCD, r = nwg % NXCD, xcd = wgid % NXCD, off = wgid / NXCD; wgid = (xcd < r ? xcd * (q + 1) : r * (q + 1) + (xcd - r) * q) + off; }
        const int nig = WGM * nN, gid = wgid / nig, fm = gid * WGM, gsz = (nM - fm) < WGM ? (nM - fm) : WGM;
        u.pm = fm + ((wgid % nig) % gsz); u.pn = (wgid % nig) / gsz; return true;
    }
};
struct EpiBf16 {
    bf16_t* O; int ldc;
    __device__ __forceinline__ void operator()(const f32x4 (&acc)[2][2][4][2], const Unit& u, int wr, int wc, int fr, int fq) const {
        const int row0 = u.pm * BM + wr * 64 + fr, col0 = u.pn * BM + wc * 32 + 8 * fq;
#pragma unroll
        for (int ai = 0; ai < 2; ++ai)
#pragma unroll
            for (int m = 0; m < 4; ++m) { bf16_t* rowp = O + (size_t)(2 * u.pn) * PLANE + (size_t)(row0 + ai * HALF + m * 16) * 128 + wc * 32 + 8 * fq;
#pragma unroll
                for (int bj = 0; bj < 2; ++bj) { const f32x4 v0 = acc[ai][bj][m][0], v1 = acc[ai][bj][m][1];
                    u32x4 w; w.x = cvt_pk_bf16(v0[0], v0[1]); w.y = cvt_pk_bf16(v0[2], v0[3]); w.z = cvt_pk_bf16(v1[0], v1[1]); w.w = cvt_pk_bf16(v1[2], v1[3]);
                    *(GAS u32x4*)(rowp + bj * PLANE) = w; } }
    }
};
struct EpiSwiGLU {
    bf16_t* O; int ldo;
    __device__ __forceinline__ void operator()(const f32x4 (&acc)[2][2][4][2], const Unit& u, int wr, int wc, int fr, int fq) const {
        const int row0 = u.pm * BM + wr * 64 + fr, col0 = u.pn * HALF + wc * 32 + 8 * fq;
#pragma unroll
        for (int ai = 0; ai < 2; ++ai)
#pragma unroll
            for (int m = 0; m < 4; ++m) { bf16_t* rowp = O + (size_t)(row0 + ai * HALF + m * 16) * ldo + col0;
                float hv[8];
#pragma unroll
                for (int n = 0; n < 2; ++n)
#pragma unroll
                    for (int i = 0; i < 4; ++i) hv[4 * n + i] = silu_f(acc[ai][0][m][n][i]) * acc[ai][1][m][n][i];
                u32x4 w; w.x = cvt_pk_bf16(hv[0], hv[1]); w.y = cvt_pk_bf16(hv[2], hv[3]); w.z = cvt_pk_bf16(hv[4], hv[5]); w.w = cvt_pk_bf16(hv[6], hv[7]);
                *(GAS u32x4*)rowp = w; }
    }
};
struct EpiResid {
    bf16_t* hb; const float* gate; float cmul;
    __device__ __forceinline__ void operator()(const f32x4 (&acc)[2][2][4][2], const Unit& u, int wr, int wc, int fr, int fq) const {
        const int row0 = u.pm * BM + wr * 64 + fr, col0 = u.pn * BM + wc * 32 + 8 * fq;
        const int b = (u.pm * BM) >> 13;
        f32x4 gm[2][2];
#pragma unroll
        for (int bj = 0; bj < 2; ++bj)
#pragma unroll
            for (int n = 0; n < 2; ++n) { const f32x4 g = *(const GAS f32x4*)(gate + (size_t)b * 9216 + col0 + bj * HALF + 4 * n); gm[bj][n] = (g + 1.0f) * cmul; }
#pragma unroll
        for (int ai = 0; ai < 2; ++ai) {
            u32x4 hv[4][2];
#pragma unroll
            for (int m = 0; m < 4; ++m) { const size_t off = (size_t)(row0 + ai * HALF + m * 16) * DM + col0;
#pragma unroll
                for (int bj = 0; bj < 2; ++bj) hv[m][bj] = *(const GAS u32x4*)(hb + off + bj * HALF); }
#pragma unroll
            for (int m = 0; m < 4; ++m) { const size_t off = (size_t)(row0 + ai * HALF + m * 16) * DM + col0;
#pragma unroll
                for (int bj = 0; bj < 2; ++bj) { const u32x4 hh = hv[m][bj];
                    const f32x4 h0 = (f32x4){bf_lo(hh.x), bf_hi(hh.x), bf_lo(hh.y), bf_hi(hh.y)}, h1 = (f32x4){bf_lo(hh.z), bf_hi(hh.z), bf_lo(hh.w), bf_hi(hh.w)};
                    const f32x4 v0 = h0 + gm[bj][0] * acc[ai][bj][m][0], v1 = h1 + gm[bj][1] * acc[ai][bj][m][1];
                    u32x4 w; w.x = cvt_pk_bf16(v0[0], v0[1]); w.y = cvt_pk_bf16(v0[2], v0[3]); w.z = cvt_pk_bf16(v1[0], v1[1]); w.w = cvt_pk_bf16(v1[2], v1[3]);
                    *(GAS u32x4*)(hb + off + bj * HALF) = w; } }
        }
    }
};

template <class Epi, bool APL = false>
__device__ __forceinline__ void gemm_phase(LAS unsigned char* lds, const int tid, const Gemm g, const StaticOrder& S, const Epi& E) {
    const int wid = __builtin_amdgcn_readfirstlane(tid >> 6), lane = tid & 63, wr = wid >> 2, wc = wid & 3, fr = lane & 15, fq = lane >> 4;
    const int K = g.K, nt = K / BK, lda = g.lda;
    unsigned voffA[2], voffB[2];
#pragma unroll
    for (int i = 0; i < 2; ++i) { int R, C; stage_rc(tid * 16 + i * 8192, R, C); const int Rb = (R & ~31) + perm32(R & 31);
        voffA[i] = (unsigned)(R * (APL ? 128 : lda) + C) * 2u; voffB[i] = (unsigned)(Rb * K + C) * 2u; }
    const size_t kstep = (size_t)(BK * 2);
    const size_t hstepA = (size_t)HALF * (APL ? 128 : lda) * 2, hstepB = (size_t)HALF * K * 2;
#define PG8_KA(t) (APL ? ((size_t)((t) >> 1) * (PLANE * 2) + (size_t)((t) & 1) * 128) : (size_t)(t) * kstep)
    const size_t tstepA = 2 * hstepA, tstepB = 2 * hstepB;
    const unsigned ldsw = (unsigned)wid * 1024u;
    const int aoff = lds_byte(wr * 64 + fr, fq * 8), boff = lds_byte(wc * 32 + fr, fq * 8);
#define PG8_SA(b, h) (((b) * 2 + (h)) * HTB)
#define PG8_SB(b, h) ((4 + (b) * 2 + (h)) * HTB)
#define PG8_STAGE(bufoff, gbase, voff) do { _Pragma("unroll") for (int _i = 0; _i < 2; ++_i) \
        __builtin_amdgcn_global_load_lds((const unsigned*)((const char*)(gbase) + (voff)[_i]), (LAS unsigned*)(lds + (bufoff) + ldsw + _i * 8192), 16, 0, 0); } while (0)
#define PG8_LDA(dst, b, h) do { _Pragma("unroll") for (int m = 0; m < 4; ++m) _Pragma("unroll") for (int k = 0; k < 2; ++k) dst[m][k] = *(const LAS bf16x8*)(lds + PG8_SA(b, h) + aoff + m * 2048 + k * 1024); } while (0)
#define PG8_LDB(dst, b, h) do { _Pragma("unroll") for (int n = 0; n < 2; ++n) _Pragma("unroll") for (int k = 0; k < 2; ++k) dst[n][k] = *(const LAS bf16x8*)(lds + PG8_SB(b, h) + boff + n * 2048 + k * 1024); } while (0)
#define PG8_MMA(ai, bj, At, Bt) do { __builtin_amdgcn_s_setprio(1); _Pragma("unroll") for (int m = 0; m < 4; ++m) _Pragma("unroll") for (int n = 0; n < 2; ++n) _Pragma("unroll") for (int k = 0; k < 2; ++k) \
        acc[ai][bj][m][n] = __builtin_amdgcn_mfma_f32_16x16x32_bf16(Bt[n][k], At[m][k], acc[ai][bj][m][n], 0, 0, 0); __builtin_amdgcn_s_setprio(0); } while (0)
#define PG8_WAIT_V(n) asm volatile("s_waitcnt vmcnt(" #n ")" ::: "memory")
#define PG8_WAIT_L(n) asm volatile("s_waitcnt lgkmcnt(" #n ")" ::: "memory")
#define PG8_BAR __builtin_amdgcn_s_barrier()
#define PG8_SCHED __builtin_amdgcn_sched_barrier(0)
    Unit cur, nxt; int ui = 0;
    if (!S.next(0, cur)) return;
    f32x4 acc[2][2][4][2];
#pragma unroll
    for (int a = 0; a < 2; ++a)
#pragma unroll
        for (int b = 0; b < 2; ++b)
#pragma unroll
            for (int m = 0; m < 4; ++m)
#pragma unroll
                for (int n = 0; n < 2; ++n) acc[a][b][m][n] = (f32x4){0.f, 0.f, 0.f, 0.f};
    bf16x8 At[4][2], B0[2][2], B1[2][2];
    const char* cA = (const char*)g.A + (size_t)cur.pm * tstepA; const char* cB = (const char*)g.Bt + (size_t)cur.pn * tstepB;
    PG8_STAGE(PG8_SB(0, 0), cB, voffB); PG8_STAGE(PG8_SB(0, 1), cB + hstepB, voffB); PG8_STAGE(PG8_SA(0, 0), cA, voffA); PG8_STAGE(PG8_SA(0, 1), cA + hstepA, voffA);
    if (wr == 1) PG8_BAR;
    PG8_WAIT_V(2); PG8_BAR;
    PG8_STAGE(PG8_SB(1, 0), cB + kstep, voffB); PG8_STAGE(PG8_SA(1, 0), cA + PG8_KA(1), voffA); PG8_STAGE(PG8_SB(1, 1), cB + hstepB + kstep, voffB);
    PG8_WAIT_V(6); PG8_BAR;
    for (;;) {
        const bool has_next = S.next(ui + 1, nxt);
        const char* nA = has_next ? (const char*)g.A + (size_t)nxt.pm * tstepA : cA; const char* nB = has_next ? (const char*)g.Bt + (size_t)nxt.pn * tstepB : cB;
        for (int t = 0; t < nt; t += 2) {
            const bool last = (t == nt - 2);
            const char* a1 = cA + PG8_KA(t + 1);
            const char* a2 = last ? nA : cA + PG8_KA(t + 2); const char* b2 = last ? nB : cB + (size_t)(t + 2) * kstep;
            const char* a3 = last ? nA + PG8_KA(1) : cA + PG8_KA(t + 3); const char* b3 = b2 + kstep;
            PG8_LDB(B0, 0, 0); PG8_LDB(B1, 0, 1); PG8_SCHED; PG8_LDA(At, 0, 0); PG8_STAGE(PG8_SA(1, 1), a1 + hstepA, voffA);
            PG8_WAIT_V(8); PG8_WAIT_L(0); PG8_BAR; PG8_MMA(0, 0, At, B0); PG8_MMA(0, 1, At, B1); PG8_BAR; PG8_SCHED;
            PG8_LDA(At, 0, 1); PG8_STAGE(PG8_SB(0, 0), b2, voffB); PG8_STAGE(PG8_SB(0, 1), b2 + hstepB, voffB); PG8_STAGE(PG8_SA(0, 0), a2, voffA);
            PG8_WAIT_V(8); PG8_WAIT_L(0); PG8_BAR; PG8_MMA(1, 0, At, B0); PG8_MMA(1, 1, At, B1); PG8_BAR; PG8_SCHED;
            PG8_LDB(B0, 1, 0); PG8_LDB(B1, 1, 1); PG8_SCHED; PG8_LDA(At, 1, 0); PG8_STAGE(PG8_SA(0, 1), a2 + hstepA, voffA);
            PG8_WAIT_V(8); PG8_WAIT_L(0); PG8_BAR; PG8_MMA(0, 0, At, B0); PG8_MMA(0, 1, At, B1); PG8_BAR; PG8_SCHED;
            PG8_LDA(At, 1, 1); PG8_STAGE(PG8_SB(1, 0), b3, voffB); PG8_STAGE(PG8_SB(1, 1), b3 + hstepB, voffB); PG8_STAGE(PG8_SA(1, 0), a3, voffA);
            PG8_WAIT_V(8); PG8_WAIT_L(0); PG8_BAR; PG8_MMA(1, 0, At, B0); PG8_MMA(1, 1, At, B1); PG8_BAR; PG8_SCHED;
        }
        if (wr == 0) PG8_BAR;
        E(acc, cur, wr, wc, fr, fq);
        if (!has_next) break;
#pragma unroll
        for (int a = 0; a < 2; ++a)
#pragma unroll
            for (int b = 0; b < 2; ++b)
#pragma unroll
                for (int m = 0; m < 4; ++m)
#pragma unroll
                    for (int n = 0; n < 2; ++n) acc[a][b][m][n] = (f32x4){0.f, 0.f, 0.f, 0.f};
        cur = nxt; cA = nA; cB = nB; ++ui;
        if (wr == 1) PG8_BAR;
    }
    PG8_WAIT_V(0);
    PG8_BAR;
#undef PG8_KA
#undef PG8_SA
#undef PG8_SB
#undef PG8_STAGE
#undef PG8_LDA
#undef PG8_LDB
#undef PG8_MMA
#undef PG8_WAIT_V
#undef PG8_WAIT_L
#undef PG8_BAR
#undef PG8_SCHED
}
}

struct Frame {
    LAS unsigned char* lds;
    int tid, lane, wave, G, bid;
};

__device__ __forceinline__ void conv_item(const float* W, int Nsrc, int K, int src_col0, bf16_t* WT, int dst_row0, int k0, LAS float* scr, int lane) {
    (void)scr;
    const int kg = lane >> 3, ng = lane & 7;
    const float* src = W + (size_t)(k0 + 8 * kg) * Nsrc + src_col0 + 4 * ng;
    f32x4 wv[8];
#pragma unroll
    for (int kk = 0; kk < 8; ++kk) wv[kk] = *(const GAS f32x4*)(src + (size_t)kk * Nsrc);
    bf16_t* dst = WT + (size_t)(dst_row0 + 4 * ng) * K + k0 + 8 * kg;
#pragma unroll
    for (int c = 0; c < 4; ++c) { u32x4 o;
        o.x = cvt_pk_bf16(wv[0][c], wv[1][c]); o.y = cvt_pk_bf16(wv[2][c], wv[3][c]); o.z = cvt_pk_bf16(wv[4][c], wv[5][c]); o.w = cvt_pk_bf16(wv[6][c], wv[7][c]);
        *(GAS u32x4*)(dst + (size_t)c * K) = o; }
}
__device__ __forceinline__ void convert_ffn(const Frame& F, const float* wg, const float* wu, const float* wd, bf16_t* WFU, bf16_t* WFD) {
    LAS float* scr = (LAS float*)(F.lds + F.wave * 16384);
    const int gw = F.bid * NWAVE + F.wave, NGW = F.G * NWAVE;
    constexpr int I_U = 16 * 176, I_D = 44 * 32;
    for (int it = gw; it < I_U + I_D; it += NGW) {
        if (it < I_U) { const int kb = it / 176, nb = it % 176, r0 = nb * 32, pn = r0 >> 8, i0 = r0 & 255;
            conv_item(i0 < 128 ? wg : wu, DFF, DM, pn * 128 + (i0 & 127), WFU, r0, kb * 64, scr, F.lane); }
        else { const int r = it - I_U, kb = r / 32, nb = r % 32; conv_item(wd, DM, DFF, nb * 32, WFD, nb * 32, kb * 64, scr, F.lane); }
    }
}
__device__ __forceinline__ void convert_mix(const Frame& F, const float* w_in, const float* w_out, bf16_t* WIN, bf16_t* WOUT) {
    LAS float* scr = (LAS float*)(F.lds + F.wave * 16384);
    const int gw = F.bid * NWAVE + F.wave, NGW = F.G * NWAVE;
    constexpr int I_I = 16 * 160, I_O = 24 * 32;
    for (int it = gw; it < I_I + I_O; it += NGW) {
        if (it < I_I) { const int kb = it / 160, nb = it % 160, r0 = nb * 32, blk = r0 >> 9;
            const int sb = blk == 0 ? 0 : blk == 1 ? 4 : blk == 2 ? 7 : blk == 3 ? 1 : blk == 4 ? 2 : blk == 5 ? 3 : blk == 6 ? 5 : blk == 7 ? 6 : blk;
            conv_item(w_in, INW, DM, sb * 512 + (r0 & 511), WIN, r0, kb * 64, scr, F.lane); }
        else { const int r = it - I_I, kb = r / 32, nb = r % 32; conv_item(w_out, DM, 1536, nb * 32, WOUT, nb * 32, kb * 64, scr, F.lane); }
    }
}

__device__ __forceinline__ void sincos_d(double x, double& s, double& c) {
    const double k = rint(x * 0.63661977236758134308);
    double r = fma(-k, 1.57079632679489655800e+00, x); r = fma(-k, 6.12323399573676603587e-17, r);
    const double r2 = r * r;
    double sp = -7.6471637318198164759e-13; sp = sp * r2 + 1.6059043836821614599e-10; sp = sp * r2 - 2.5052108385441718775e-08; sp = sp * r2 + 2.7557319223985890653e-06;
    sp = sp * r2 - 1.9841269841269841270e-04; sp = sp * r2 + 8.3333333333333333333e-03; sp = sp * r2 - 1.6666666666666666667e-01; const double sn = r + r * r2 * sp;
    double cp = 4.7794773323873852974e-14; cp = cp * r2 - 1.1470745597729724714e-11; cp = cp * r2 + 2.0876756987868098979e-09; cp = cp * r2 - 2.7557319223985890653e-07;
    cp = cp * r2 + 2.4801587301587301587e-05; cp = cp * r2 - 1.3888888888888888889e-03; cp = cp * r2 + 4.1666666666666666667e-02; cp = cp * r2 - 0.5; const double cs = 1.0 + r2 * cp;
    const int q = ((int)k) & 3;
    s = (q == 0) ? sn : (q == 1) ? cs : (q == 2) ? -sn : -cs;
    c = (q == 0) ? cs : (q == 1) ? -sn : (q == 2) ? -cs : sn;
}
__device__ __forceinline__ void prologue(const Frame& F, const Params& p, unsigned char* ws, int zi) {
    LAS float* cs = (LAS float*)F.lds;
    LAS float* red = (LAS float*)(F.lds + 16384);
    const float* c = as_global(p.in[1 + zi]);
    for (int i = F.tid; i < 4096; i += NTHR) cs[i] = silu_f(c[i]);
    __syncthreads();
    float* MOD = (float*)(ws + WS_MOD);
    for (int task = F.bid; task < 320; task += F.G) {
        const float* W; const float* bias; int N, n0; float* dst; int dstride;
        if (task < 288) { const int l = task / 144, t = task % 144; W = as_global(p.in[2 + zi]) + (size_t)l * DM * 9216; bias = as_global(p.in[3 + zi]) + l * 9216; N = 9216; n0 = t * 64; dst = MOD + (size_t)l * 4 * 9216; dstride = 9216; }
        else { const int t = task - 288; W = as_global(p.in[22 + zi]); bias = as_global(p.in[23 + zi]); N = 2048; n0 = t * 64; dst = MOD + FMOD_OFF; dstride = 2048; }
        float a0 = 0.f, a1 = 0.f, a2 = 0.f, a3 = 0.f;
        const int kb = F.wave * 128;
#pragma unroll 32
        for (int k = 0; k < 128; ++k) { const float w = ((const GAS float*)W)[(size_t)(kb + k) * N + n0 + F.lane];
            a0 += cs[kb + k] * w; a1 += cs[1024 + kb + k] * w; a2 += cs[2048 + kb + k] * w; a3 += cs[3072 + kb + k] * w; }
        red[(F.wave * 4 + 0) * 64 + F.lane] = a0; red[(F.wave * 4 + 1) * 64 + F.lane] = a1; red[(F.wave * 4 + 2) * 64 + F.lane] = a2; red[(F.wave * 4 + 3) * 64 + F.lane] = a3;
        __syncthreads();
        if (F.tid < 256) { const int b = F.tid >> 6, col = F.tid & 63; float s = bias[n0 + col];
#pragma unroll
            for (int w = 0; w < 8; ++w) s += red[(w * 4 + b) * 64 + col];
            dst[(size_t)b * dstride + n0 + col] = s; }
        __syncthreads();
    }
    f32x2* ROPE = (f32x2*)(ws + WS_ROPE);
    for (int idx = F.bid * NTHR + F.tid; idx < SEQ * 64; idx += F.G * NTHR) {
        const int pos = idx >> 6, i = idx & 63;
        const float invf = (float)exp(-(double)i * (9.210340371976184 / 64.0));
        const float ang = (float)pos * invf;
        double s, cc; sincos_d((double)ang, s, cc);
        ROPE[idx] = (f32x2){(float)cc, (float)s};
    }
}

__device__ __forceinline__ void norm_phase(const Frame& F, const float* xin, bf16_t* hb, const float* gain, const float* shift0, const float* scale0, int bstride, bf16_t* U) {
    const int gw = F.bid * NWAVE + F.wave, NGW = F.G * NWAVE;
    for (int m0 = gw; m0 < T_TOK; m0 += 4 * NGW) {
        f32x4 v[4][4];
#pragma unroll
        for (int r = 0; r < 4; ++r) { const int m = m0 + r * NGW; if (m < T_TOK) {
            if (xin != nullptr) { const GAS f32x4* xr = (const GAS f32x4*)(xin + (size_t)m * DM) + F.lane; GAS u32x2* hs = (GAS u32x2*)(hb + (size_t)m * DM) + F.lane;
#pragma unroll
                for (int j = 0; j < 4; ++j) { v[r][j] = xr[64 * j]; hs[64 * j] = pack4(v[r][j]); } }
            else { const GAS u32x2* xr = (const GAS u32x2*)(hb + (size_t)m * DM) + F.lane;
#pragma unroll
                for (int j = 0; j < 4; ++j) { const u32x2 t = xr[64 * j]; v[r][j] = (f32x4){bf_lo(t.x), bf_hi(t.x), bf_lo(t.y), bf_hi(t.y)}; } } } }
        const bool same_b = (4 * NGW == SEQ);
        f32x4 gp[4], shv[4];
        if (same_b) { const int b0 = m0 >> 13;
#pragma unroll
            for (int j = 0; j < 4; ++j) { const f32x4 g = ((const GAS f32x4*)gain)[F.lane + 64 * j], sc = ((const GAS f32x4*)(scale0 + (size_t)b0 * bstride))[F.lane + 64 * j];
                gp[j] = g * (sc + 1.0f); shv[j] = ((const GAS f32x4*)(shift0 + (size_t)b0 * bstride))[F.lane + 64 * j]; } }
#pragma unroll
        for (int r = 0; r < 4; ++r) { const int m = m0 + r * NGW; if (m < T_TOK) {
            const int b = m >> 13; float s = 0.f;
#pragma unroll
            for (int j = 0; j < 4; ++j) s += (v[r][j].x * v[r][j].x + v[r][j].y * v[r][j].y) + (v[r][j].z * v[r][j].z + v[r][j].w * v[r][j].w);
            const float rstd = rsqrtf(wave_sum(s) * (1.f / DM) + EPS);
            GAS u32x2* o8 = (GAS u32x2*)(U + (size_t)m * DM) + F.lane;
            if (!same_b) {
#pragma unroll
                for (int j = 0; j < 4; ++j) { const f32x4 g = ((const GAS f32x4*)gain)[F.lane + 64 * j], sc = ((const GAS f32x4*)(scale0 + (size_t)b * bstride))[F.lane + 64 * j];
                    gp[j] = g * (sc + 1.0f); shv[j] = ((const GAS f32x4*)(shift0 + (size_t)b * bstride))[F.lane + 64 * j]; } }
#pragma unroll
            for (int j = 0; j < 4; ++j) o8[64 * j] = pack4(v[r][j] * rstd * gp[j] + shv[j]); } }
    }
}
__device__ __forceinline__ void dt_gemv(const Frame& F, const bf16_t* U, const float* w_in, float* DT) {
    LAS float* Wd = (LAS float*)F.lds;
    __syncthreads();
    for (int idx = F.tid; idx < 8192; idx += NTHR) { const int k = idx >> 3, j = idx & 7; Wd[8 * k + 4 * (k >> 3) + j] = ((const GAS float*)w_in)[(size_t)k * INW + 5120 + j]; }
    __syncthreads();
    const int gw = F.bid * NWAVE + F.wave, NGW = F.G * NWAVE;
    for (int m0 = gw; m0 < T_TOK; m0 += 4 * NGW) {
      u32x4 uvr[4][2];
#pragma unroll
      for (int r = 0; r < 4; ++r) { const int mm = (m0 + r * NGW < T_TOK) ? m0 + r * NGW : m0;
#pragma unroll
          for (int hf = 0; hf < 2; ++hf) uvr[r][hf] = *(const GAS u32x4*)(U + (size_t)mm * DM + 512 * hf + 8 * F.lane); }
#pragma unroll
      for (int r = 0; r < 4; ++r) { const int m = m0 + r * NGW; if (m < T_TOK) {
        float acc[8];
#pragma unroll
        for (int j = 0; j < 8; ++j) acc[j] = 0.f;
#pragma unroll
        for (int hf = 0; hf < 2; ++hf) {
            const u32x4 uv = uvr[r][hf];
            float uf[8]; unpack8(uv, uf);
#pragma unroll
            for (int kk = 0; kk < 8; ++kk) { const int k = 512 * hf + 8 * F.lane + kk; const LAS float* wp = Wd + 8 * k + 4 * (k >> 3);
                const f32x4 w0 = *(const LAS f32x4*)wp, w1 = *(const LAS f32x4*)(wp + 4);
                acc[0] += uf[kk] * w0.x; acc[1] += uf[kk] * w0.y; acc[2] += uf[kk] * w0.z; acc[3] += uf[kk] * w0.w;
                acc[4] += uf[kk] * w1.x; acc[5] += uf[kk] * w1.y; acc[6] += uf[kk] * w1.z; acc[7] += uf[kk] * w1.w; }
        }
#pragma unroll
        for (int j = 0; j < 8; ++j) acc[j] = wave_sum(acc[j]);
        if (F.lane < 8) { float v = acc[0];
#pragma unroll
            for (int j = 1; j < 8; ++j) v = (F.lane == j) ? acc[j] : v;
            ((GAS float*)DT)[(size_t)m * 8 + F.lane] = v; }
      } }
    }
    __syncthreads();
}

template <bool MASKED>
__device__ __forceinline__ void sb_elem(const f32x4 (&sc)[4], int key0, int trow, float (&nk)[4][4], float (&lb)[4][4], float (&Tj)[4]) {
#pragma unroll
    for (int j = 0; j < 4; ++j) { float t = 0.f;
#pragma unroll
        for (int i = 0; i < 4; ++i) { const float z2 = sc[j][i] * (0.08838834764831845f * 1.4426950408889634f);
            const float sp2 = fmaxf(z2, 0.f) + __builtin_amdgcn_logf(1.0f + __builtin_amdgcn_exp2f(-fabsf(z2)));
            if (MASKED) { const bool vis = (key0 + 16 * j + i) < trow; nk[j][i] = vis ? sp2 : 0.f; lb[j][i] = vis ? (z2 - sp2) : -1e30f; }
            else { nk[j][i] = sp2; lb[j][i] = z2 - sp2; }
            t += nk[j][i]; }
        Tj[j] = t; }
}
__device__ __forceinline__ void sb_task(const Frame& F, bf16_t* P, int b, int h, int qb) {
    LAS unsigned char* Ks = F.lds;
    LAS unsigned char* Vt = F.lds + 17408;
    LAS unsigned char* Pw = F.lds + 35840 + F.wave * 2304;
    LAS float* red = (LAS float*)(F.lds + 54272);
    int lane = F.lane; asm volatile("" : "+v"(lane)); const int wid = F.wave, fr = lane & 15, fq = lane >> 4;
    const size_t rowbase = (size_t)b * SEQ;
    const int q0 = qb * 128, trow = q0 + 16 * wid + fr;
    bf16x8 qf[4];
    { const bf16_t* qp = P + pidx(rowbase + trow, C_SQ + h * 128) + 8 * fq;
#pragma unroll
      for (int s = 0; s < 4; ++s) qf[s] = *(const GAS bf16x8*)(qp + 32 * s); }
    f32x4 o[8];
#pragma unroll
    for (int i = 0; i < 8; ++i) o[i] = (f32x4){0.f, 0.f, 0.f, 0.f};
    float R = 0.f;
    u32x4 kvr[2], vvr[2];
#pragma unroll
    for (int i = 0; i < 2; ++i) { const int idx = F.tid + NTHR * i, key = idx >> 4, c8 = idx & 15; const size_t kt0 = rowbase + 64 * (2 * qb + 1);
        kvr[i] = *(const GAS u32x4*)(P + pidx(kt0 + key, C_SK + h * 128) + 8 * c8); vvr[i] = *(const GAS u32x4*)(P + pidx(kt0 + lane, C_SV + h * 128) + 8 * (2 * wid + i)); }
    lds_barrier();
    for (int kt = 2 * qb + 1; kt >= 0; --kt) {
#pragma unroll
        for (int i = 0; i < 2; ++i) { const int idx = F.tid + NTHR * i, key = idx >> 4, c8 = idx & 15;
            const u32x4 kv = kvr[i], vv = vvr[i];
            *(LAS u32x4*)(Ks + key * 272 + c8 * 16) = kv;
            LAS bf16_t* vd = (LAS bf16_t*)(Vt + (8 * (2 * wid + i)) * 144 + lane * 2);
            vd[0 * 72] = (bf16_t)(vv.x & 0xffff); vd[1 * 72] = (bf16_t)(vv.x >> 16); vd[2 * 72] = (bf16_t)(vv.y & 0xffff); vd[3 * 72] = (bf16_t)(vv.y >> 16);
            vd[4 * 72] = (bf16_t)(vv.z & 0xffff); vd[5 * 72] = (bf16_t)(vv.z >> 16); vd[6 * 72] = (bf16_t)(vv.w & 0xffff); vd[7 * 72] = (bf16_t)(vv.w >> 16); }
        if (kt > 0) {
#pragma unroll
            for (int i = 0; i < 2; ++i) { const int idx = F.tid + NTHR * i, key = idx >> 4, c8 = idx & 15; const size_t kt1 = rowbase + 64 * (kt - 1);
                kvr[i] = *(const GAS u32x4*)(P + pidx(kt1 + key, C_SK + h * 128) + 8 * c8); vvr[i] = *(const GAS u32x4*)(P + pidx(kt1 + lane, C_SV + h * 128) + 8 * (2 * wid + i)); } }
        lds_barrier();
        if (64 * kt < q0 + 16 * wid + 15) {
            f32x4 sc[4];
#pragma unroll
            for (int j = 0; j < 4; ++j) { sc[j] = (f32x4){0.f, 0.f, 0.f, 0.f};
#pragma unroll
                for (int s = 0; s < 4; ++s) sc[j] = mfma16(ldsfrag(Ks + (16 * j + fr) * 272 + (32 * s + 8 * fq) * 2), qf[s], sc[j]); }
            float nk[4][4], lb[4][4], Tj[4], Wj[4], Gj[4];
            if (64 * kt + 64 <= q0 + 16 * wid) sb_elem<false>(sc, 64 * kt + 4 * fq, trow, nk, lb, Tj);
            else sb_elem<true>(sc, 64 * kt + 4 * fq, trow, nk, lb, Tj);
#pragma unroll
            for (int j = 0; j < 4; ++j) { const float a1 = __shfl_xor(Tj[j], 16), a2 = __shfl_xor(Tj[j], 32), a3 = __shfl_xor(Tj[j], 48);
                Wj[j] = Tj[j] + a1 + a2 + a3;
                Gj[j] = (((fq ^ 1) > fq) ? a1 : 0.f) + (((fq ^ 2) > fq) ? a2 : 0.f) + (((fq ^ 3) > fq) ? a3 : 0.f); }
            float suf = 0.f;
#pragma unroll
            for (int j = 3; j >= 0; --j) { float tl = R - suf - Gj[j]; f32x4 w;
                w[3] = __builtin_amdgcn_exp2f(lb[j][3] + tl); tl -= nk[j][3];
                w[2] = __builtin_amdgcn_exp2f(lb[j][2] + tl); tl -= nk[j][2];
                w[1] = __builtin_amdgcn_exp2f(lb[j][1] + tl); tl -= nk[j][1];
                w[0] = __builtin_amdgcn_exp2f(lb[j][0] + tl);
                *(LAS u32x2*)(Pw + fr * 144 + (16 * j + 4 * fq) * 2) = pack4(w);
                suf += Wj[j]; }
            R -= suf;
#pragma unroll
            for (int ks = 0; ks < 2; ++ks) { const bf16x8 pf = ldsfrag(Pw + fr * 144 + (32 * ks + 8 * fq) * 2);
#pragma unroll
                for (int dt = 0; dt < 8; ++dt) o[dt] = mfma16(ldsfrag(Vt + (16 * dt + fr) * 144 + (32 * ks + 8 * fq) * 2), pf, o[dt]); }
        }
        const float rm = wave_max(R);
        if (lane == 0) red[wid] = rm;
        lds_barrier();
        float mx = red[0];
#pragma unroll
        for (int w = 1; w < 8; ++w) mx = fmaxf(mx, red[w]);
        if (mx < -173.2f) break;
    }
    bf16_t* op = P + pidx(rowbase + trow, C_SQ + h * 128) + 4 * fq;
#pragma unroll
    for (int dt = 0; dt < 8; ++dt) *(GAS u32x2*)(op + 16 * dt) = pack4(o[dt]);
}

__device__ __forceinline__ void ret_kv_task(const Frame& F, const bf16_t* P, const f32x2* ROPE, bf16_t* RST, int b, int c, int h) {
    LAS unsigned char* KT = F.lds;
    LAS unsigned char* VT = F.lds + 18432;
    int lane = F.lane; asm volatile("" : "+v"(lane)); const int fr = lane & 15, fq = lane >> 4;
    const float l2g = log2gamma(h);
    lds_barrier();
    { const int s = lane, g8 = F.wave;     const size_t row = (size_t)b * SEQ + c * 64 + s; const int pos = c * 64 + s;
      const bf16_t* kp = P + pidx(row, C_RK + h * 128) + 8 * g8;
      const u32x4 k1 = *(const GAS u32x4*)kp, k2 = *(const GAS u32x4*)(kp + 64);
      float x1[8], x2[8]; unpack8(k1, x1); unpack8(k2, x2);
      const GAS f32x4* cp = (const GAS f32x4*)(ROPE + pos * 64 + 8 * g8);
      const float dec = __builtin_amdgcn_exp2f(l2g * (float)(63 - s)) * 0.08838834764831845f;
      LAS bf16_t* kd = (LAS bf16_t*)(KT + (8 * g8) * 144 + s * 2);
#pragma unroll
      for (int jj = 0; jj < 4; ++jj) { const f32x4 cs = cp[jj];
          { const int j = 2 * jj; const float y1 = (x1[j] * cs.x - x2[j] * cs.y) * dec, y2 = (x1[j] * cs.y + x2[j] * cs.x) * dec; kd[j * 72] = f2bf(y1); kd[(64 + j) * 72] = f2bf(y2); }
          { const int j = 2 * jj + 1; const float y1 = (x1[j] * cs.z - x2[j] * cs.w) * dec, y2 = (x1[j] * cs.w + x2[j] * cs.z) * dec; kd[j * 72] = f2bf(y1); kd[(64 + j) * 72] = f2bf(y2); } }
      const bf16_t* vp = P + pidx(row, C_RV + h * 128) + 16 * g8;
#pragma unroll
      for (int hh = 0; hh < 2; ++hh) { const u32x4 vv = *(const GAS u32x4*)(vp + 8 * hh);
          LAS bf16_t* vd = (LAS bf16_t*)(VT + (16 * g8 + 8 * hh) * 144 + s * 2);
          vd[0 * 72] = (bf16_t)(vv.x & 0xffff); vd[1 * 72] = (bf16_t)(vv.x >> 16); vd[2 * 72] = (bf16_t)(vv.y & 0xffff); vd[3 * 72] = (bf16_t)(vv.y >> 16);
          vd[4 * 72] = (bf16_t)(vv.z & 0xffff); vd[5 * 72] = (bf16_t)(vv.z >> 16); vd[6 * 72] = (bf16_t)(vv.w & 0xffff); vd[7 * 72] = (bf16_t)(vv.w >> 16); } }
    lds_barrier();
    const int w = F.wave;
    bf16x8 xf[2];
#pragma unroll
    for (int ks = 0; ks < 2; ++ks) xf[ks] = ldsfrag(KT + (16 * w + fr) * 144 + (32 * ks + 8 * fq) * 2);
    bf16_t* dst = RST + (size_t)((b * 128 + c) * 4 + h) * 16384;
#pragma unroll
    for (int et = 0; et < 8; ++et) { f32x4 acc = (f32x4){0.f, 0.f, 0.f, 0.f};
#pragma unroll
        for (int ks = 0; ks < 2; ++ks) acc = mfma16(xf[ks], ldsfrag(VT + (16 * et + fr) * 144 + (32 * ks + 8 * fq) * 2), acc);
        *(GAS u32x2*)(dst + (16 * et + fr) * 128 + 16 * w + 4 * fq) = pack4(acc); }
}

__device__ __forceinline__ void ret_out_task(const Frame& F, bf16_t* P, const f32x2* ROPE, const bf16_t* RST, const float* gn, int b, int c, int h, int xm = 0) {
    LAS unsigned char* Kr = F.lds;
    LAS unsigned char* VT = F.lds + 17408;
    LAS unsigned char* Sx = F.lds + 35840;
    LAS unsigned char* Pw = F.lds + 70656 + F.wave * 2304;
    LAS float* ssq = (LAS float*)(F.lds + 89088);
    int lane = F.lane; asm volatile("" : "+v"(lane)); const int fr = lane & 15, fq = lane >> 4, w = F.wave, lt = w & 3, eh = w >> 2;
    const float l2g = log2gamma(h);
    const int unit = (b * 128 + c) * 4 + h;
    lds_barrier();
    { const int s = F.tid >> 3, g8 = F.tid & 7; const size_t row = (size_t)b * SEQ + c * 64 + s; const int pos = c * 64 + s;
      const bf16_t* kp = P + pidx(row, C_RK + h * 128) + 8 * g8;
      const u32x4 k1 = *(const GAS u32x4*)kp, k2 = *(const GAS u32x4*)(kp + 64);
      float x1[8], x2[8], y1[8], y2[8]; unpack8(k1, x1); unpack8(k2, x2);
      const GAS f32x4* cp = (const GAS f32x4*)(ROPE + pos * 64 + 8 * g8);
#pragma unroll
      for (int jj = 0; jj < 4; ++jj) { const f32x4 cs = cp[jj];
          { const int j = 2 * jj; y1[j] = (x1[j] * cs.x - x2[j] * cs.y) * 0.08838834764831845f; y2[j] = (x1[j] * cs.y + x2[j] * cs.x) * 0.08838834764831845f; }
          { const int j = 2 * jj + 1; y1[j] = (x1[j] * cs.z - x2[j] * cs.w) * 0.08838834764831845f; y2[j] = (x1[j] * cs.w + x2[j] * cs.z) * 0.08838834764831845f; } }
      u32x4 o1, o2; o1.x = cvt_pk_bf16(y1[0], y1[1]); o1.y = cvt_pk_bf16(y1[2], y1[3]); o1.z = cvt_pk_bf16(y1[4], y1[5]); o1.w = cvt_pk_bf16(y1[6], y1[7]);
      o2.x = cvt_pk_bf16(y2[0], y2[1]); o2.y = cvt_pk_bf16(y2[2], y2[3]); o2.z = cvt_pk_bf16(y2[4], y2[5]); o2.w = cvt_pk_bf16(y2[6], y2[7]);
      *(LAS u32x4*)(Kr + s * 272 + (8 * g8) * 2) = o1; *(LAS u32x4*)(Kr + s * 272 + (64 + 8 * g8) * 2) = o2;
      const bf16_t* vp = P + pidx((size_t)b * SEQ + c * 64 + lane, C_RV + h * 128) + 16 * F.wave;
#pragma unroll
      for (int hh = 0; hh < 2; ++hh) { const u32x4 vv = *(const GAS u32x4*)(vp + 8 * hh);
          LAS bf16_t* vd = (LAS bf16_t*)(VT + (16 * F.wave + 8 * hh) * 144 + lane * 2);
          vd[0 * 72] = (bf16_t)(vv.x & 0xffff); vd[1 * 72] = (bf16_t)(vv.x >> 16); vd[2 * 72] = (bf16_t)(vv.y & 0xffff); vd[3 * 72] = (bf16_t)(vv.y >> 16);
          vd[4 * 72] = (bf16_t)(vv.z & 0xffff); vd[5 * 72] = (bf16_t)(vv.z >> 16); vd[6 * 72] = (bf16_t)(vv.w & 0xffff); vd[7 * 72] = (bf16_t)(vv.w >> 16); }
      const bf16_t* sp = RST + (size_t)unit * 16384;
#pragma unroll
      for (int i = 0; i < 4; ++i) { const int idx = F.tid + NTHR * i, e = idx >> 4, c16 = idx & 15;
          *(LAS u32x4*)(Sx + e * 272 + c16 * 16) = *(const GAS u32x4*)(sp + e * 128 + 8 * c16); } }
    const int l = 16 * lt + fr; const size_t qrow = (size_t)b * SEQ + c * 64 + l; const int qpos = c * 64 + l;
    bf16x8 qf[4];
    { const bf16_t* qp = P + pidx(qrow, C_RQ + h * 128) + 8 * fq;
      u32x4 qv[4];
#pragma unroll
      for (int s = 0; s < 4; ++s) qv[s] = *(const GAS u32x4*)(qp + 32 * s);
#pragma unroll
      for (int s = 0; s < 2; ++s) { float x1[8], x2[8], y1[8], y2[8]; unpack8(qv[s], x1); unpack8(qv[s + 2], x2);
          const GAS f32x4* cp = (const GAS f32x4*)(ROPE + qpos * 64 + 32 * s + 8 * fq);
#pragma unroll
          for (int jj = 0; jj < 4; ++jj) { const f32x4 cs = cp[jj];
              { const int j = 2 * jj; y1[j] = x1[j] * cs.x - x2[j] * cs.y; y2[j] = x1[j] * cs.y + x2[j] * cs.x; }
              { const int j = 2 * jj + 1; y1[j] = x1[j] * cs.z - x2[j] * cs.w; y2[j] = x1[j] * cs.w + x2[j] * cs.z; } }
          u32x4 o1, o2; o1.x = cvt_pk_bf16(y1[0], y1[1]); o1.y = cvt_pk_bf16(y1[2], y1[3]); o1.z = cvt_pk_bf16(y1[4], y1[5]); o1.w = cvt_pk_bf16(y1[6], y1[7]);
          o2.x = cvt_pk_bf16(y2[0], y2[1]); o2.y = cvt_pk_bf16(y2[2], y2[3]); o2.z = cvt_pk_bf16(y2[4], y2[5]); o2.w = cvt_pk_bf16(y2[6], y2[7]);
          qf[s] = __builtin_bit_cast(bf16x8, o1); qf[s + 2] = __builtin_bit_cast(bf16x8, o2); } }
    u32x2 gvr[4]; f32x4 ggr[4];
#pragma unroll
    for (int et = 0; et < 4; ++et) { const int e0 = 64 * eh + 16 * et + 4 * fq;
        gvr[et] = *(const GAS u32x2*)(P + pidx(qrow, C_RG + h * 128) + e0); ggr[et] = *(const GAS f32x4*)(gn + h * 128 + e0); }
    lds_barrier();
    if (xm == 1) return;
#pragma unroll
    for (int j = 0; j < 4; ++j) { f32x4 acc = (f32x4){0.f, 0.f, 0.f, 0.f};
#pragma unroll
        for (int ks = 0; ks < 4; ++ks) acc = mfma16(ldsfrag(Kr + (16 * j + fr) * 272 + (32 * ks + 8 * fq) * 2), qf[ks], acc);
#pragma unroll
        for (int i = 0; i < 4; ++i) { const int s = 16 * j + 4 * fq + i; acc[i] *= __builtin_amdgcn_exp2f(l2g * fabsf((float)(l - s))); }
        *(LAS u32x2*)(Pw + fr * 144 + (16 * j + 4 * fq) * 2) = pack4(acc); }
    f32x4 y[4];
    const float qdec = __builtin_amdgcn_exp2f(l2g * (float)(l + 1));
#pragma unroll
    for (int et = 0; et < 4; ++et) { y[et] = (f32x4){0.f, 0.f, 0.f, 0.f};
#pragma unroll
        for (int ks = 0; ks < 4; ++ks) y[et] = mfma16(ldsfrag(Sx + (64 * eh + 16 * et + fr) * 272 + (32 * ks + 8 * fq) * 2), qf[ks], y[et]);
        y[et] = y[et] * qdec; }
#pragma unroll
    for (int ks = 0; ks < 2; ++ks) { const bf16x8 pf = ldsfrag(Pw + fr * 144 + (32 * ks + 8 * fq) * 2);
#pragma unroll
        for (int et = 0; et < 4; ++et) y[et] = mfma16(ldsfrag(VT + (64 * eh + 16 * et + fr) * 144 + (32 * ks + 8 * fq) * 2), pf, y[et]); }
    float ss = 0.f;
#pragma unroll
    for (int et = 0; et < 4; ++et) ss += (y[et][0] * y[et][0] + y[et][1] * y[et][1]) + (y[et][2] * y[et][2] + y[et][3] * y[et][3]);
    ss += __shfl_xor(ss, 16); ss += __shfl_xor(ss, 32);
    if (fq == 0) ssq[w * 16 + fr] = ss;
    lds_barrier();
    const float rstd = rsqrtf((ssq[w * 16 + fr] + ssq[(w ^ 4) * 16 + fr]) * (1.f / 128.f) + EPS);
#pragma unroll
    for (int et = 0; et < 4; ++et) { const int e0 = 64 * eh + 16 * et + 4 * fq;
        const u32x2 gv = gvr[et]; const f32x4 gg = ggr[et];
        f32x4 r;
        r[0] = y[et][0] * rstd * gg[0] * silu_f(bf_lo(gv.x)); r[1] = y[et][1] * rstd * gg[1] * silu_f(bf_hi(gv.x));
        r[2] = y[et][2] * rstd * gg[2] * silu_f(bf_lo(gv.y)); r[3] = y[et][3] * rstd * gg[3] * silu_f(bf_hi(gv.y));
        *(GAS u32x2*)(P + pidx(qrow, C_RQ + h * 128) + e0) = pack4(r); }
}

__device__ __forceinline__ float softplus_f(float x) { return fmaxf(x, 0.f) + log1pf(__expf(-fabsf(x))); }
__device__ __forceinline__ void conv8(const bf16_t* P, const float* cw, const float* cb, int b, int tpos, int col, float* v) {
    const int chan = col - C_XBC;
    { const f32x4 b0 = *(const GAS f32x4*)(cb + chan), b1 = *(const GAS f32x4*)(cb + chan + 4);
      v[0] = b0.x; v[1] = b0.y; v[2] = b0.z; v[3] = b0.w; v[4] = b1.x; v[5] = b1.y; v[6] = b1.z; v[7] = b1.w; }
#pragma unroll
    for (int j = 0; j < 4; ++j) { const int ts = tpos - 3 + j;
        if (ts >= 0) { const u32x4 xv = *(const GAS u32x4*)(P + pidx((size_t)b * SEQ + ts, col)); float xf[8]; unpack8(xv, xf);
            const f32x4 w0 = *(const GAS f32x4*)(cw + j * 1024 + chan), w1 = *(const GAS f32x4*)(cw + j * 1024 + chan + 4);
            v[0] += xf[0] * w0.x; v[1] += xf[1] * w0.y; v[2] += xf[2] * w0.z; v[3] += xf[3] * w0.w; v[4] += xf[4] * w1.x; v[5] += xf[5] * w1.y; v[6] += xf[6] * w1.z; v[7] += xf[7] * w1.w; } }
#pragma unroll
    for (int i = 0; i < 8; ++i) v[i] = silu_f(v[i]);
}

__device__ __forceinline__ void conv_load(const bf16_t* P, const float* cw, const float* cb, int b, int tpos0, int col, float (&w)[4][8], float (&bias)[8], u32x4 (&rows)[11]) {
    const int chan = col - C_XBC;
#pragma unroll
    for (int j = 0; j < 4; ++j) { const f32x4 w0 = *(const GAS f32x4*)(cw + j * 1024 + chan), w1 = *(const GAS f32x4*)(cw + j * 1024 + chan + 4);
        w[j][0] = w0.x; w[j][1] = w0.y; w[j][2] = w0.z; w[j][3] = w0.w; w[j][4] = w1.x; w[j][5] = w1.y; w[j][6] = w1.z; w[j][7] = w1.w; }
    { const f32x4 b0 = *(const GAS f32x4*)(cb + chan), b1 = *(const GAS f32x4*)(cb + chan + 4);
      bias[0] = b0.x; bias[1] = b0.y; bias[2] = b0.z; bias[3] = b0.w; bias[4] = b1.x; bias[5] = b1.y; bias[6] = b1.z; bias[7] = b1.w; }
    const bf16_t* base = P + pidx((size_t)b * SEQ + tpos0, col);
#pragma unroll
    for (int r = 0; r < 11; ++r) { rows[r] = (u32x4){0u, 0u, 0u, 0u}; if (tpos0 - 3 + r >= 0) rows[r] = *(const GAS u32x4*)(base + (long)(r - 3) * 128); }
}
template <bool TR, bool HASF>
__device__ __forceinline__ void conv_compute(const float (&w)[4][8], const float (&bias)[8], const u32x4 (&rows)[11], const float (&f)[8], u32x4 (&pk)[8]) {
    float prev[8];
#pragma unroll
    for (int t = 0; t < 8; ++t) {
        float a[8];
#pragma unroll
        for (int i = 0; i < 8; ++i) a[i] = bias[i];
#pragma unroll
        for (int j = 0; j < 4; ++j) { float xf[8]; unpack8(rows[t + j], xf);
#pragma unroll
            for (int i = 0; i < 8; ++i) a[i] += xf[i] * w[j][i]; }
#pragma unroll
        for (int i = 0; i < 8; ++i) { a[i] = silu_f(a[i]); if (HASF) a[i] *= f[t]; }
        if (TR) {
            if (t & 1) {
#pragma unroll
                for (int i = 0; i < 8; ++i) { const unsigned u = cvt_pk_bf16(prev[i], a[i]);
                    if ((t >> 1) == 0) pk[i].x = u; else if ((t >> 1) == 1) pk[i].y = u; else if ((t >> 1) == 2) pk[i].z = u; else pk[i].w = u; }
            } else {
#pragma unroll
                for (int i = 0; i < 8; ++i) prev[i] = a[i];
            }
        } else {
            pk[t].x = cvt_pk_bf16(a[0], a[1]); pk[t].y = cvt_pk_bf16(a[2], a[3]); pk[t].z = cvt_pk_bf16(a[4], a[5]); pk[t].w = cvt_pk_bf16(a[6], a[7]);
        }
    }
}
template <bool TR, bool HASF>
__device__ __forceinline__ void conv_tile(const bf16_t* P, const float* cw, const float* cb, int b, int tpos0, int col, const float (&f)[8], u32x4 (&pk)[8]) {
    float w[4][8], bias[8]; u32x4 rows[11];
    conv_load(P, cw, cb, b, tpos0, col, w, bias, rows);
    conv_compute<TR, HASF>(w, bias, rows, f, pk);
}
__device__ __forceinline__ float dt_scan(const float* DT, const float* dt_bias, const float* a_log, int b, int c, int hd, int lane, float& dtv) {
    const size_t t = (size_t)b * SEQ + c * 64 + lane;
    dtv = softplus_f(((const GAS float*)DT)[t * 8 + hd] + ((const GAS float*)dt_bias)[hd]);
    float x = dtv * (-__expf(((const GAS float*)a_log)[hd]));
#pragma unroll
    for (int o = 1; o < 64; o <<= 1) { const float y = __shfl_up(x, o); if (lane >= o) x += y; }
    return x;
}

__device__ __forceinline__ void ssd_state_task(const Frame& F, const bf16_t* P, const float* DT, const float* cw, const float* cb, const float* dt_bias, const float* a_log,
                                               bf16_t* SST, float* CD, int b, int c, int g) {
    LAS unsigned char* XT = F.lds;
    LAS unsigned char* BT = F.lds + 36864;
    LAS float* dtl = (LAS float*)(F.lds + 55296);
    LAS float* acl = (LAS float*)(F.lds + 56320);
    int lane = F.lane; asm volatile("" : "+v"(lane)); const int fr = lane & 15, fq = lane >> 4, w = F.wave;
    lds_barrier();
    int tt = F.tid; asm volatile("" : "+v"(tt)); const int cgi = tt % 48, seg = tt / 48, s0 = 8 * seg;
    const int ccol = (cgi < 32) ? (C_XBC + g * 256 + 8 * cgi) : (C_XBC + 512 + g * 128 + 8 * (cgi - 32));
    float cwr[4][8], cbr[8]; u32x4 crow[11];
    if (tt < 384) conv_load(P, cw, cb, b, c * 64 + s0, ccol, cwr, cbr, crow);
    if (w < 4) { float dtv; const float cum = dt_scan(DT, dt_bias, a_log, b, c, 4 * g + w, lane, dtv);
        dtl[lane * 4 + w] = dtv; acl[lane * 4 + w] = cum;
        if (lane == 63) ((GAS float*)CD)[(b * 128 + c) * 8 + 4 * g + w] = __expf(cum); }
    lds_barrier();
    if (tt < 384) {
        float f[8]; u32x4 pk[8];
        if (cgi < 32) { const int hl = cgi >> 3; const float ae = acl[63 * 4 + hl];
#pragma unroll
            for (int t = 0; t < 8; ++t) f[t] = dtl[(s0 + t) * 4 + hl] * __expf(ae - acl[(s0 + t) * 4 + hl]); }
        else {
#pragma unroll
            for (int t = 0; t < 8; ++t) f[t] = 1.0f; }
        conv_compute<true, true>(cwr, cbr, crow, f, pk);
        LAS unsigned char* d = (cgi < 32) ? (XT + (8 * cgi) * 144 + s0 * 2) : (BT + (8 * (cgi - 32)) * 144 + s0 * 2);
#pragma unroll
        for (int i = 0; i < 8; ++i) *(LAS u32x4*)(d + i * 144) = pk[i]; }
    lds_barrier();
    const int hl = w >> 1, ph = w & 1;
    bf16x8 yf[2][2];
#pragma unroll
    for (int pt = 0; pt < 2; ++pt)
#pragma unroll
        for (int ks = 0; ks < 2; ++ks) yf[pt][ks] = ldsfrag(XT + (hl * 64 + ph * 32 + 16 * pt + fr) * 144 + (32 * ks + 8 * fq) * 2);
    bf16_t* dst = SST + (size_t)((b * 128 + c) * 8 + 4 * g + hl) * 8192;
#pragma unroll
    for (int nt = 0; nt < 8; ++nt) { f32x4 a0 = (f32x4){0.f, 0.f, 0.f, 0.f}, a1 = a0;
#pragma unroll
        for (int ks = 0; ks < 2; ++ks) { const bf16x8 xf = ldsfrag(BT + (16 * nt + fr) * 144 + (32 * ks + 8 * fq) * 2); a0 = mfma16(xf, yf[0][ks], a0); a1 = mfma16(xf, yf[1][ks], a1); }
#ifdef PROBE_CONST
        a0 = (f32x4){0.01f, 0.02f, 0.03f, 0.04f}; a1 = a0;
#endif
        *(GAS u32x2*)(dst + (ph * 32 + fr) * 128 + 16 * nt + 4 * fq) = pack4(a0);
        *(GAS u32x2*)(dst + (ph * 32 + 16 + fr) * 128 + 16 * nt + 4 * fq) = pack4(a1); }
}

__device__ __forceinline__ void ssd_out_task(const Frame& F, bf16_t* P, const float* DT, const float* cw, const float* cb, const float* dt_bias, const float* a_log,
                                             const float* d_skip, const float* nrm, const bf16_t* SST, int b, int c) {
    LAS unsigned char* Bs = F.lds;
    LAS unsigned char* Cs = F.lds + 17408;
    LAS unsigned char* XT = F.lds + 34816;
    LAS unsigned char* Pw = F.lds + 71680 + F.wave * 2304;
    LAS float* dtl = (LAS float*)(F.lds + 90112);
    LAS float* acl = (LAS float*)(F.lds + 92160);
    LAS float* ssq = (LAS float*)(F.lds + 94208);
    int lane = F.lane; asm volatile("" : "+v"(lane)); const int fr = lane & 15, fq = lane >> 4, w = F.wave, hl = w >> 1, half = w & 1;
    lds_barrier();
    { float dtv; const float cum = dt_scan(DT, dt_bias, a_log, b, c, w, lane, dtv); dtl[lane * 8 + w] = dtv; acl[lane * 8 + w] = cum; }
    float ssl[2] = {0.f, 0.f};
#pragma unroll 1
    for (int g = 0; g < 2; ++g) {
        const int head = 4 * g + hl;
        const bf16_t* hsrc = SST + (size_t)((b * 128 + c) * 8 + head) * 8192;
        bf16x8 hfr[4][4];
#pragma unroll
        for (int ks = 0; ks < 4; ++ks)
#pragma unroll
            for (int pt = 0; pt < 4; ++pt) hfr[ks][pt] = *(const GAS bf16x8*)(hsrc + (16 * pt + fr) * 128 + 32 * ks + 8 * fq);
        lds_barrier();
        { int tt = F.tid; asm volatile("" : "+v"(tt)); const int cgi = tt & 63, seg = tt >> 6, s0 = 8 * seg;
            const int col = (cgi < 32) ? (C_XBC + g * 256 + 8 * cgi) : (cgi < 48) ? (C_XBC + 512 + g * 128 + 8 * (cgi - 32)) : (C_XBC + 768 + g * 128 + 8 * (cgi - 48));
            const float f[8] = {1.f, 1.f, 1.f, 1.f, 1.f, 1.f, 1.f, 1.f}; u32x4 pk[8];
            if (cgi < 32) { conv_tile<true, false>(P, cw, cb, b, c * 64 + s0, col, f, pk);
                LAS unsigned char* d = XT + (8 * cgi) * 144 + s0 * 2;
#pragma unroll
                for (int i = 0; i < 8; ++i) *(LAS u32x4*)(d + i * 144) = pk[i]; }
            else { conv_tile<false, false>(P, cw, cb, b, c * 64 + s0, col, f, pk);
                LAS unsigned char* d = ((cgi < 48) ? (Bs + (8 * (cgi - 32)) * 2) : (Cs + (8 * (cgi - 48)) * 2)) + s0 * 272;
#pragma unroll
                for (int i = 0; i < 8; ++i) *(LAS u32x4*)(d + i * 272) = pk[i]; } }
        u32x2 zvr[2][4];
#pragma unroll
        for (int li = 0; li < 2; ++li)
#pragma unroll
            for (int pt = 0; pt < 4; ++pt) zvr[li][pt] = *(const GAS u32x2*)(P + pidx((size_t)b * SEQ + c * 64 + 16 * (2 * half + li) + fr, C_MZ + head * 64 + 16 * pt + 4 * fq));
        lds_barrier();
        const float dsk = ((const GAS float*)d_skip)[head];
#pragma unroll
        for (int li = 0; li < 2; ++li) {
            asm volatile("" ::: "memory"); __builtin_amdgcn_sched_barrier(0);
            const int lt = 2 * half + li, l = 16 * lt + fr;
            const float al = acl[l * 8 + head];
            bf16x8 cf[4];
#pragma unroll
            for (int ks = 0; ks < 4; ++ks) cf[ks] = ldsfrag(Cs + (16 * lt + fr) * 272 + (32 * ks + 8 * fq) * 2);
            f32x4 y[4];
#pragma unroll
            for (int pt = 0; pt < 4; ++pt) y[pt] = (f32x4){0.f, 0.f, 0.f, 0.f};
#pragma unroll
            for (int ks = 0; ks < 4; ++ks) {
#pragma unroll
                for (int pt = 0; pt < 4; ++pt) y[pt] = mfma16(hfr[ks][pt], cf[ks], y[pt]); }
            { const float eal = __expf(al);
#pragma unroll
              for (int pt = 0; pt < 4; ++pt) y[pt] = y[pt] * eal; }
#pragma unroll
            for (int st = 0; st < 4; ++st) { f32x4 acc = (f32x4){0.f, 0.f, 0.f, 0.f};
#pragma unroll
                for (int ks = 0; ks < 4; ++ks) acc = mfma16(ldsfrag(Bs + (16 * st + fr) * 272 + (32 * ks + 8 * fq) * 2), cf[ks], acc);
#pragma unroll
                for (int i = 0; i < 4; ++i) { const int s = 16 * st + 4 * fq + i;
                    acc[i] = (s <= l) ? acc[i] * __expf(al - acl[s * 8 + head]) * dtl[s * 8 + head] : 0.f; }
                *(LAS u32x2*)(Pw + fr * 144 + (16 * st + 4 * fq) * 2) = pack4(acc); }
#pragma unroll
            for (int ks = 0; ks < 2; ++ks) { if (2 * ks <= lt) { const bf16x8 pf = ldsfrag(Pw + fr * 144 + (32 * ks + 8 * fq) * 2);
#pragma unroll
                for (int pt = 0; pt < 4; ++pt) y[pt] = mfma16(ldsfrag(XT + (hl * 64 + 16 * pt + fr) * 144 + (32 * ks + 8 * fq) * 2), pf, y[pt]); } }
            const size_t row = (size_t)b * SEQ + c * 64 + l;
#pragma unroll
            for (int pt = 0; pt < 4; ++pt) { const int p0 = 16 * pt + 4 * fq;
                const u32x2 zv = zvr[li][pt];
                const LAS bf16_t* xp = (const LAS bf16_t*)(XT + (hl * 64 + p0) * 144 + l * 2);
                f32x4 r;
                r[0] = (y[pt][0] + bf2f(xp[0 * 72]) * dsk) * silu_f(bf_lo(zv.x)); r[1] = (y[pt][1] + bf2f(xp[1 * 72]) * dsk) * silu_f(bf_hi(zv.x));
                r[2] = (y[pt][2] + bf2f(xp[2 * 72]) * dsk) * silu_f(bf_lo(zv.y)); r[3] = (y[pt][3] + bf2f(xp[3 * 72]) * dsk) * silu_f(bf_hi(zv.y));
                ssl[li] += (r[0] * r[0] + r[1] * r[1]) + (r[2] * r[2] + r[3] * r[3]);
                *(GAS u32x2*)(P + pidx(row, C_MZ + head * 64 + p0)) = pack4(r); }
        }
    }
#pragma unroll
    for (int li = 0; li < 2; ++li) { float ss = ssl[li];
        ss += __shfl_xor(ss, 16); ss += __shfl_xor(ss, 32);
        if (fq == 0) ssq[hl * 64 + 16 * (2 * half + li) + fr] = ss; }
    asm volatile("s_waitcnt vmcnt(0)" ::: "memory");
    u32x2 ypk[2][2][4]; f32x4 ngv[2][4];
#pragma unroll
    for (int g = 0; g < 2; ++g)
#pragma unroll
        for (int pt = 0; pt < 4; ++pt) { const int ch = (4 * g + hl) * 64 + 16 * pt + 4 * fq; ngv[g][pt] = *(const GAS f32x4*)(nrm + ch);
#pragma unroll
            for (int li = 0; li < 2; ++li) ypk[li][g][pt] = *(const GAS u32x2*)(P + pidx((size_t)b * SEQ + c * 64 + 16 * (2 * half + li) + fr, C_MZ + ch)); }
    lds_barrier();
#pragma unroll
    for (int li = 0; li < 2; ++li) { const int l = 16 * (2 * half + li) + fr;
        const float rstd = rsqrtf((ssq[l] + ssq[64 + l] + ssq[128 + l] + ssq[192 + l]) * (1.f / 512.f) + EPS);
        const size_t row = (size_t)b * SEQ + c * 64 + l;
#pragma unroll
        for (int g = 0; g < 2; ++g)
#pragma unroll
            for (int pt = 0; pt < 4; ++pt) { const int ch = (4 * g + hl) * 64 + 16 * pt + 4 * fq;
                const u32x2 pk = ypk[li][g][pt]; const f32x4 r = (f32x4){bf_lo(pk.x), bf_hi(pk.x), bf_lo(pk.y), bf_hi(pk.y)};
                *(GAS u32x2*)(P + pidx(row, C_MZ + ch)) = pack4(r * rstd * ngv[g][pt]); } }
}

__device__ __forceinline__ void scan_phase(const Frame& F, bf16_t* RST, bf16_t* SST, const float* CD) {
    for (int task = F.bid * NTHR + F.tid; task < 131072; task += F.G * NTHR) {
        {
          const int pr = task & 8191, bh = task >> 13, b = bh >> 2, h = bh & 3;
          GAS unsigned* p = (GAS unsigned*)(RST + (size_t)((b * 128) * 4 + h) * 16384) + pr;
          const float dec = __builtin_amdgcn_exp2f(64.f * log2gamma(h));
          float s0 = 0.f, s1 = 0.f;
#pragma unroll 1
          for (int c0 = 0; c0 < 128; c0 += 32) { unsigned v[32];
#pragma unroll
              for (int i = 0; i < 32; ++i) v[i] = p[(size_t)(c0 + i) * 32768];
#pragma unroll
              for (int i = 0; i < 32; ++i) { p[(size_t)(c0 + i) * 32768] = cvt_pk_bf16(s0, s1); s0 = s0 * dec + bf_lo(v[i]); s1 = s1 * dec + bf_hi(v[i]); } } }
        {
          const int pr = task & 4095, bh = task >> 12, b = bh >> 3, hd = bh & 7;
          GAS unsigned* p = (GAS unsigned*)(SST + (size_t)((b * 128) * 8 + hd) * 8192) + pr;
          const GAS float* cd = (const GAS float*)(CD + (b * 128) * 8 + hd);
          float s0 = 0.f, s1 = 0.f;
#pragma unroll 1
          for (int c0 = 0; c0 < 128; c0 += 32) { unsigned v[32]; float d[32];
#pragma unroll
              for (int i = 0; i < 32; ++i) { v[i] = p[(size_t)(c0 + i) * 32768]; d[i] = cd[(c0 + i) * 8]; }
#pragma unroll
              for (int i = 0; i < 32; ++i) { p[(size_t)(c0 + i) * 32768] = cvt_pk_bf16(s0, s1); s0 = s0 * d[i] + bf_lo(v[i]); s1 = s1 * d[i] + bf_hi(v[i]); } } }
    }
}


#define XB_TMO      128
#define XB_XCNT(j)  (256  + 64 * (j))
#define XB_XSUB(j)  (1280 + 64 * (j))
#define XB_XGEN(j)  (2304 + 64 * (j))
#define XB_TOP      3328
#define XB_TOPGEN   3392
#define XB_SPIN_CAP (1u << 22)
__device__ __forceinline__ unsigned xb_ld(unsigned* p)              { return __hip_atomic_load(p, __ATOMIC_RELAXED, __HIP_MEMORY_SCOPE_AGENT); }
__device__ __forceinline__ unsigned xb_add(unsigned* p, unsigned v) { return __hip_atomic_fetch_add(p, v, __ATOMIC_RELAXED, __HIP_MEMORY_SCOPE_AGENT); }
__device__ __forceinline__ unsigned xb_xcc_id() { return (unsigned)__builtin_amdgcn_s_getreg((3 << 11) | 20) & 0xFu; }
#define XB_SPIN(cond, bar) do { unsigned _sp = 0; while (cond) { __builtin_amdgcn_s_sleep(1); \
    if ((++_sp & 255u) == 0u) { if (xb_ld(&(bar)[XB_TMO])) break; if (_sp > XB_SPIN_CAP) { atomicAdd(&(bar)[XB_TMO], 1u); break; } } } } while (0)
struct XcdBarrier { unsigned* bar; unsigned x; volatile LAS unsigned* st; };
__device__ __forceinline__ XcdBarrier xcd_barrier_post(unsigned* bar, volatile LAS unsigned* st) {
    XcdBarrier b; b.bar = bar; b.x = xb_xcc_id(); b.st = st;
    if (threadIdx.x == 0) (void)xb_add(&bar[XB_XCNT(b.x)], 1u);
    return b;
}
__device__ __forceinline__ void xcd_barrier_complete(unsigned* bar, unsigned x, unsigned& nloc, unsigned& nx) {
    const unsigned G = gridDim.x * gridDim.y * gridDim.z;
    unsigned sum, cnt, mine, sp = 0u;
    for (;;) {
        sum = 0u; cnt = 0u; mine = 0u;
#pragma unroll
        for (unsigned j = 0; j < 16; ++j) { const unsigned c = xb_ld(&bar[XB_XCNT(j)]); sum += c; cnt += (c > 0u) ? 1u : 0u; mine = (j == x) ? c : mine; }
        if (sum == G) break;
        __builtin_amdgcn_s_sleep(1);
        if ((++sp & 255u) == 0u) { if (xb_ld(&bar[XB_TMO])) break; if (sp > XB_SPIN_CAP) { atomicAdd(&bar[XB_TMO], 1u); break; } }
    }
    nloc = mine > 0u ? mine : 1u; nx = cnt > 0u ? cnt : 1u;
}
__device__ __forceinline__ void xcd_barrier(const XcdBarrier& b) {
    asm volatile("s_waitcnt vmcnt(0)" ::: "memory");
    __syncthreads();
    if (threadIdx.x == 0) {
        unsigned* bar = b.bar;
        __builtin_amdgcn_s_waitcnt(0);
        unsigned nloc = b.st[0], nx = b.st[1];
        if (nloc == 0u) { xcd_barrier_complete(bar, b.x, nloc, nx); b.st[0] = nloc; b.st[1] = nx; }
        const unsigned old = xb_add(&bar[XB_XSUB(b.x)], 1u);
        const unsigned gen = old / nloc;
        if (old + 1u == (gen + 1u) * nloc) {
            __builtin_amdgcn_fence(__ATOMIC_RELEASE, "agent");
            asm volatile("s_waitcnt vmcnt(0)" ::: "memory");
            const unsigned og = xb_add(&bar[XB_TOP], 1u);
            const unsigned tg = og / nx;
            if (og + 1u == (tg + 1u) * nx) xb_add(&bar[XB_TOPGEN], 1u);
            else XB_SPIN(xb_ld(&bar[XB_TOPGEN]) == tg, bar);
            __builtin_amdgcn_fence(__ATOMIC_ACQUIRE, "agent");
            xb_add(&bar[XB_XGEN(b.x)], 1u);
            asm volatile("s_waitcnt vmcnt(0)" ::: "memory");
        } else {
            XB_SPIN(xb_ld(&bar[XB_XGEN(b.x)]) == gen, bar);
            __builtin_amdgcn_fence(__ATOMIC_ACQUIRE, "agent");
            asm volatile("s_waitcnt vmcnt(0)" ::: "memory");
        }
    }
    __syncthreads();
}

__device__ __forceinline__ void final_phase(const Frame& F, const bf16_t* hb, float* out, const float* gain, const float* fmod, const XcdBarrier& xbar) {
    const int gw = F.bid * NWAVE + F.wave, NGW = F.G * NWAVE;
    u32x2 hv[16][4];
#pragma unroll
    for (int r = 0; r < 16; ++r) { const int m = gw + r * NGW; const int mm = m < T_TOK ? m : gw;
        const GAS u32x2* xr = (const GAS u32x2*)(hb + (size_t)mm * DM) + F.lane;
#pragma unroll
        for (int j = 0; j < 4; ++j) hv[r][j] = xr[64 * j]; }
    xcd_barrier(xbar);
    f32x4 gp[4], shv[4]; int bcur = -1;
#pragma unroll
    for (int r = 0; r < 16; ++r) { const int m = gw + r * NGW; if (m < T_TOK) {
        const int b = m >> 13; f32x4 v[4]; float s = 0.f;
        if (b != bcur) { bcur = b;
#pragma unroll
            for (int j = 0; j < 4; ++j) { const f32x4 g = ((const GAS f32x4*)gain)[F.lane + 64 * j], sc = ((const GAS f32x4*)(fmod + (size_t)b * 2048 + 1024))[F.lane + 64 * j];
                gp[j] = g * (sc + 1.0f); shv[j] = ((const GAS f32x4*)(fmod + (size_t)b * 2048))[F.lane + 64 * j]; } }
#pragma unroll
        for (int j = 0; j < 4; ++j) { const u32x2 t = hv[r][j]; v[j] = (f32x4){bf_lo(t.x), bf_hi(t.x), bf_lo(t.y), bf_hi(t.y)};
            s += (v[j].x * v[j].x + v[j].y * v[j].y) + (v[j].z * v[j].z + v[j].w * v[j].w); }
        const float rstd = rsqrtf(wave_sum(s) * (1.f / DM) + EPS);
        GAS f32x4* xo = (GAS f32x4*)(out + (size_t)m * DM) + F.lane;
#pragma unroll
        for (int j = 0; j < 4; ++j) xo[64 * j] = v[j] * rstd * gp[j] + shv[j]; } }
}

constexpr int NPH = 26;
__global__ void __launch_bounds__(NTHR, 2) fwd_kernel(Params p) {
    extern __shared__ __attribute__((aligned(16))) unsigned char lds_raw[];
    volatile LAS unsigned* xb_st = (volatile LAS unsigned*)((LAS unsigned char*)lds_raw + LDS_BYTES - 64);
    if (threadIdx.x == 0) { xb_st[0] = 0u; xb_st[1] = 0u; }
    __syncthreads();
    const XcdBarrier xbar = xcd_barrier_post((unsigned*)p.ws, xb_st);
    if (p.ph_lo == 0) {
        Frame F0; F0.lds = (LAS unsigned char*)lds_raw; F0.tid = threadIdx.x; F0.lane = F0.tid & 63; F0.wave = __builtin_amdgcn_readfirstlane(F0.tid >> 6); F0.G = gridDim.x; F0.bid = blockIdx.x;
        if (EN_PRO) prologue(F0, p, as_global(p.ws), 0);
        if (p.ph_hi > 1) cg::this_grid().sync();
    }
#ifdef TPROBE
    unsigned long long tA = 0, tB = 0;
#endif
    for (int ph_ = (p.ph_lo < 1 ? 1 : p.ph_lo); ph_ < p.ph_hi; ++ph_) {
#ifdef TPROBE
    const unsigned long long tp0 = __builtin_amdgcn_s_memrealtime();
#endif
    int ph = __builtin_amdgcn_readfirstlane(ph_);
#ifdef PH_LIMIT
    if (ph > PH_LIMIT && ph < NPH - 1) continue;
#endif
    int tid_ = threadIdx.x; asm volatile("" : "+v"(tid_));
    unsigned char* ws_ = p.ws; asm volatile("" : "+s"(ws_)); unsigned char* ws = as_global(ws_);
    int zi = 0; asm volatile("" : "+s"(zi));
    Frame F;
    F.lds = (LAS unsigned char*)lds_raw;
    F.tid = tid_; F.lane = F.tid & 63; F.wave = __builtin_amdgcn_readfirstlane(F.tid >> 6); { int g_ = gridDim.x, b_ = blockIdx.x; asm volatile("" : "+s"(g_), "+s"(b_)); F.G = g_; F.bid = b_; }
    float* MOD = (float*)(ws + WS_MOD);
    const f32x2* ROPE = (const f32x2*)(ws + WS_ROPE);
    float* DT = (float*)(ws + WS_DT);
    float* CD = (float*)(ws + WS_CD);
    bf16_t* WFU = (bf16_t*)(ws + WS_WFU); bf16_t* WFD = (bf16_t*)(ws + WS_WFD); bf16_t* WIN = (bf16_t*)(ws + WS_WIN); bf16_t* WOUT = (bf16_t*)(ws + WS_WOUT);
    bf16_t* U = (bf16_t*)(ws + WS_U); bf16_t* RST = (bf16_t*)(ws + WS_RST); bf16_t* SST = (bf16_t*)(ws + WS_SST);
    bf16_t* PROJ = (bf16_t*)(ws + WS_PROJ); bf16_t* HID = PROJ;
    float* hbuf_ = p.out; asm volatile("" : "+s"(hbuf_)); float* hbuf = as_global(hbuf_);
    bf16_t* HB = (bf16_t*)((unsigned char*)hbuf + 64 * MiB);
        if (ph == NPH - 1) {
            if (EN_FIN) final_phase(F, HB, hbuf, as_global(p.in[24 + zi]), MOD + FMOD_OFF, xbar);
        } else {
#ifdef XTRA_LIST
            static constexpr int xtra[] = XTRA_LIST;
            const int l = (ph >= NPH) ? 1 : (ph - 1) / 12, j = (ph >= NPH) ? xtra[ph - NPH] : (ph - 1) % 12;
#else
            const int l = (ph - 1) / 12, j = (ph - 1) % 12;
#endif
            const float* modl = MOD + (size_t)l * 4 * 9216;
            if (j == 0 || j == 3 || j == 9) {
                const float* hin = (l == 0 && j == 0) ? as_global(p.in[0 + zi]) : nullptr;
                const int gi = (j == 0) ? 4 : (j == 3) ? 8 : 18;
                const int mi = (j == 0) ? 0 : (j == 3) ? 3 : 6;
                if (EN_NORM) norm_phase(F, hin, HB, as_global(p.in[gi + zi]) + l * DM, modl + mi * 1024, modl + (mi + 1) * 1024, 9216, U);
                __syncthreads();
                if (!EN_CONV) {} else if (j == 0) convert_ffn(F, as_global(p.in[5 + zi]) + (size_t)l * DM * DFF, as_global(p.in[6 + zi]) + (size_t)l * DM * DFF, as_global(p.in[7 + zi]) + (size_t)l * DM * DFF, WFU, WFD);
                else if (j == 9) convert_ffn(F, as_global(p.in[19 + zi]) + (size_t)l * DM * DFF, as_global(p.in[20 + zi]) + (size_t)l * DM * DFF, as_global(p.in[21 + zi]) + (size_t)l * DM * DFF, WFU, WFD);
                else convert_mix(F, as_global(p.in[9 + zi]) + (size_t)l * DM * INW, as_global(p.in[17 + zi]) + (size_t)l * 1536 * DM, WIN, WOUT);
            } else if (j == 1 || j == 10) {
                pg8::Gemm g{U, WFU, T_TOK, 2 * DFF, DM, DM}; pg8::StaticOrder S; S.init(T_TOK, 2 * DFF, F.G, F.bid);
                pg8::EpiSwiGLU E{HID, DFF};
                if (EN_G1) pg8::gemm_phase<pg8::EpiSwiGLU>(F.lds, F.tid, g, S, E);
            } else if (j == 2 || j == 11 || j == 8) {
                pg8::Gemm g; pg8::EpiResid E;
                if (j == 8) { g = pg8::Gemm{PROJ, WOUT, T_TOK, DM, 1536, PW}; E = pg8::EpiResid{HB, modl + 5 * 1024, 1.0f}; }
                else { g = pg8::Gemm{HID, WFD, T_TOK, DM, DFF, DFF}; E = pg8::EpiResid{HB, modl + (j == 2 ? 2 : 8) * 1024, 0.5f}; }
                pg8::StaticOrder S; S.init(T_TOK, DM, F.G, F.bid);
                if (EN_G2) { if (j == 8) pg8::gemm_phase<pg8::EpiResid, true>(F.lds, F.tid, g, S, E); else pg8::gemm_phase<pg8::EpiResid, false>(F.lds, F.tid, g, S, E); }
            } else if (j == 4) {
                pg8::Gemm g{U, WIN, T_TOK, PW, DM, DM}; pg8::StaticOrder S; S.init(T_TOK, PW, F.G, F.bid);
                pg8::EpiBf16 E{PROJ, PW};
                if (EN_G3) pg8::gemm_phase<pg8::EpiBf16>(F.lds, F.tid, g, S, E);
                if (EN_DT) dt_gemv(F, U, as_global(p.in[9 + zi]) + (size_t)l * DM * INW, DT);
            } else if (j == 5) {
                if (EN_SB && XS(1)) for (int t = F.bid; t < 1024; t += F.G) { const int qb = 63 - (t >> 4), bh = t & 15; sb_task(F, PROJ, bh >> 2, bh & 3, qb); }
                if (EN_RKV && XS(2)) for (int t = F.bid; t < 2048; t += F.G) { const int h = t & 3, bc = t >> 2; ret_kv_task(F, PROJ, ROPE, RST, bc >> 7, bc & 127, h); }
                if (EN_SST && XS(4)) for (int t = F.bid; t < 1024; t += F.G) { const int g = t & 1, bc = t >> 1;
                    ssd_state_task(F, PROJ, DT, as_global(p.in[10 + zi]) + l * 4096, as_global(p.in[11 + zi]) + l * 1024, as_global(p.in[12 + zi]) + l * 8, as_global(p.in[13 + zi]) + l * 8, SST, CD, bc >> 7, bc & 127, g); }
            } else if (j == 6) {
                if (EN_SCAN) scan_phase(F, RST, SST, CD);
            } else if (j == 7) {
                if (EN_ROUT && XS(8)) for (int t = F.bid; t < 2048; t += F.G) { const int h = t & 3, bc = t >> 2; ret_out_task(F, PROJ, ROPE, RST, as_global(p.in[15 + zi]) + l * 512, bc >> 7, bc & 127, h, ph >= NPH ? XMODE : 0); }
                if (EN_SOUT && XS(16)) for (int t = F.bid; t < 512; t += F.G) {
                    ssd_out_task(F, PROJ, DT, as_global(p.in[10 + zi]) + l * 4096, as_global(p.in[11 + zi]) + l * 1024, as_global(p.in[12 + zi]) + l * 8, as_global(p.in[13 + zi]) + l * 8, as_global(p.in[14 + zi]) + l * 8, as_global(p.in[16 + zi]) + l * 512, SST, t >> 7, t & 127); }
            }
        }
        if (ph + 1 < p.ph_hi) { xcd_barrier(xbar); }
#ifdef TPROBE
        { const unsigned long long tp1 = __builtin_amdgcn_s_memrealtime(); const int jj = (ph - 1) % 12;
          if (ph < NPH - 1) { if (TPROBE_A(jj)) tA += tp1 - tp0; if (TPROBE_B(jj)) tB += tp1 - tp0; } }
#endif
    }
#ifdef TPROBE
    cg::this_grid().sync();
    if (blockIdx.x == 0) { const float a = (float)tA * 0.01f, b = (float)tB * 0.01f * TPROBE_BS;
        if (threadIdx.x == 0) p.out[0] += a;
        for (int i = threadIdx.x; i < (1 << 20); i += NTHR) p.out[1024 + i] += b; }
#endif
}

extern "C" void kernel_launch(void* const* d_in, const int* in_sizes, int n_in, void* d_out, int out_size, void* d_ws, size_t ws_size, hipStream_t stream) {
    static int grid = 0;
    if (grid == 0) {
        if (n_in != 25 || out_size != T_TOK * DM || ws_size < WS_END) { fprintf(stderr, "kernel_launch: unexpected shapes (n_in %d out %d ws %zu)\n", n_in, out_size, ws_size); grid = -1; return; }
        int dev = 0, cus = 0, per_cu = 0;
        hipGetDevice(&dev);
        hipDeviceGetAttribute(&cus, hipDeviceAttributeMultiprocessorCount, dev);
        hipFuncSetAttribute((const void*)fwd_kernel, hipFuncAttributeMaxDynamicSharedMemorySize, LDS_BYTES);
        hipOccupancyMaxActiveBlocksPerMultiprocessor(&per_cu, (const void*)fwd_kernel, NTHR, LDS_BYTES);
        if (per_cu < 1) per_cu = 1;
        (void)hipGetLastError();
        grid = cus * per_cu;
    }
    if (grid < 0) return;
    (void)hipMemsetAsync(d_ws, 0, 65536, stream);
    Params p{};
    for (int i = 0; i < 25; ++i) p.in[i] = (const float*)d_in[i];
    p.out = (float*)d_out; p.ws = (unsigned char*)d_ws;
#if ONE_LAUNCH
#ifdef XTRA_LIST
    p.ph_lo = 0; p.ph_hi = NPH + XTRA_N;
#else
    p.ph_lo = 0; p.ph_hi = NPH;
#endif
    void* args[] = {&p};
    hipError_t e = hipLaunchCooperativeKernel((const void*)fwd_kernel, dim3(grid), dim3(NTHR), args, LDS_BYTES, stream);
    if (e != hipSuccess) fprintf(stderr, "cooperative launch failed: %s (grid %d)\n", hipGetErrorString(e), grid);
#else
    for (int ph = 0; ph < NPH; ++ph) { p.ph_lo = ph; p.ph_hi = ph + 1; hipLaunchKernelGGL(fwd_kernel, dim3(grid), dim3(NTHR), LDS_BYTES, stream, p); }
#endif
}
```

```cpp
#include <hip/hip_runtime.h>
#include <hip/hip_cooperative_groups.h>
#include <cstdint>
#include <cstdio>
namespace cg = cooperative_groups;

#ifndef ONE_LAUNCH
#define ONE_LAUNCH 1
#endif

#ifndef EN_ALL
#define EN_ALL 1
#endif
#ifndef EN_PRO
#define EN_PRO EN_ALL
#endif
#ifndef EN_FIN
#define EN_FIN EN_ALL
#endif
#ifndef EN_NORM
#define EN_NORM EN_ALL
#endif
#ifndef EN_CONV
#define EN_CONV EN_ALL
#endif
#ifndef EN_G1
#define EN_G1 EN_ALL
#endif
#ifndef EN_G2
#define EN_G2 EN_ALL
#endif
#ifndef EN_G3
#define EN_G3 EN_ALL
#endif
#ifndef EN_DT
#define EN_DT EN_ALL
#endif
#ifndef EN_SB
#define EN_SB EN_ALL
#endif
#ifndef EN_RKV
#define EN_RKV EN_ALL
#endif
#ifndef EN_SST
#define EN_SST EN_ALL
#endif
#ifndef EN_SCAN
#define EN_SCAN EN_ALL
#endif
#ifndef EN_ROUT
#define EN_ROUT EN_ALL
#endif
#ifndef EN_SOUT
#define EN_SOUT EN_ALL
#endif
#ifndef EN_SINTER
#define EN_SINTER 1
#endif
#ifndef XSEL
#define XSEL 31
#endif
#define XS(m) (ph < NPH || (XSEL & (m)))
#ifndef XMODE
#define XMODE 0
#endif
#define LAS __attribute__((address_space(3)))
#define GAS __attribute__((address_space(1)))
template <class T> __device__ __forceinline__ T* as_global(T* p) {
#if defined(__HIP_DEVICE_COMPILE__)
    __builtin_assume(!__builtin_amdgcn_is_shared((const void*)p)); __builtin_assume(!__builtin_amdgcn_is_private((const void*)p));
#endif
    return p; }
typedef unsigned short bf16_t;
typedef short bf16x8 __attribute__((ext_vector_type(8)));
typedef float f32x4 __attribute__((ext_vector_type(4)));
typedef float f32x2 __attribute__((ext_vector_type(2)));
typedef unsigned u32x4 __attribute__((ext_vector_type(4)));
typedef unsigned u32x2 __attribute__((ext_vector_type(2)));

constexpr int T_TOK = 32768, SEQ = 8192, DM = 1024, DFF = 2816, INW = 5128, PW = 5120;
constexpr int NTHR = 512, NWAVE = 8;
constexpr float EPS = 1e-6f;
constexpr int C_RQ = 0, C_SQ = 512, C_MZ = 1024, C_RK = 1536, C_RV = 2048, C_RG = 2560, C_SK = 3072, C_SV = 3584, C_XBC = 4096;

constexpr size_t MiB = 1u << 20;
constexpr size_t WS_MOD = 1 * MiB, WS_ROPE = 2 * MiB, WS_DT = 6 * MiB, WS_CD = 7 * MiB;
constexpr size_t WS_WFU = 8 * MiB, WS_WFD = 19 * MiB, WS_WIN = 25 * MiB, WS_WOUT = 35 * MiB;
constexpr size_t WS_U = 38 * MiB, WS_RST = 38 * MiB, WS_SST = 102 * MiB, WS_PROJ = 166 * MiB, WS_END = 486 * MiB;
constexpr int FMOD_OFF = 2 * 4 * 9 * 1024;

constexpr size_t PLANE = (size_t)T_TOK * 128;
__device__ __forceinline__ size_t pidx(size_t row, int col) { return (size_t)(col >> 7) * PLANE + row * 128 + (col & 127); }
constexpr int LDS_BYTES = 147456;

struct Params {
    const float* in[25];
    float* out;
    unsigned char* ws;
    int ph_lo, ph_hi;
};

typedef __bf16 bf16x2_t __attribute__((ext_vector_type(2)));
__device__ __forceinline__ unsigned cvt_pk_bf16(float lo, float hi) { const f32x2 v = {lo, hi}; const bf16x2_t b = __builtin_convertvector(v, bf16x2_t); return __builtin_bit_cast(unsigned, b); }
__device__ __forceinline__ float bf_lo(unsigned u) { return __uint_as_float(u << 16); }
__device__ __forceinline__ float bf_hi(unsigned u) { return __uint_as_float(u & 0xffff0000u); }
__device__ __forceinline__ float bf2f(bf16_t x) { return __uint_as_float(((unsigned)x) << 16); }
__device__ __forceinline__ bf16_t f2bf(float f) { return (bf16_t)(cvt_pk_bf16(f, 0.f) & 0xffffu); }
__device__ __forceinline__ float wave_sum(float v) {
#pragma unroll
    for (int o = 1; o < 64; o <<= 1) v += __shfl_xor(v, o);
    return v;
}
__device__ __forceinline__ float wave_max(float v) {
#pragma unroll
    for (int o = 1; o < 64; o <<= 1) v = fmaxf(v, __shfl_xor(v, o));
    return v;
}
__device__ __forceinline__ void lds_barrier() { asm volatile("s_waitcnt lgkmcnt(0)" ::: "memory"); __builtin_amdgcn_s_barrier(); asm volatile("" ::: "memory"); }
__device__ __forceinline__ float silu_f(float g) { return g * __builtin_amdgcn_rcpf(1.0f + __builtin_amdgcn_exp2f(-1.44269504f * g)); }
__device__ __forceinline__ f32x4 mfma16(bf16x8 a, bf16x8 b, f32x4 c) { return __builtin_amdgcn_mfma_f32_16x16x32_bf16(a, b, c, 0, 0, 0); }
__device__ __forceinline__ bf16x8 ldsfrag(const LAS unsigned char* p) { return *(const LAS bf16x8*)p; }
__device__ __forceinline__ u32x2 pack4(f32x4 v) { u32x2 w; w.x = cvt_pk_bf16(v[0], v[1]); w.y = cvt_pk_bf16(v[2], v[3]); return w; }
__device__ __forceinline__ void unpack8(u32x4 v, float* f) {
    f[0] = bf_lo(v.x); f[1] = bf_hi(v.x); f[2] = bf_lo(v.y); f[3] = bf_hi(v.y); f[4] = bf_lo(v.z); f[5] = bf_hi(v.z); f[6] = bf_lo(v.w); f[7] = bf_hi(v.w);
}
__device__ __forceinline__ float log2gamma(int h) { return h == 0 ? -0.04580368961312479f : (h == 1 ? -0.02272007650008353f : (h == 2 ? -0.011315313227834146f : -0.005646563141142063f)); }

namespace pg8 {
constexpr int BM = 256, BK = 64, HALF = 128, HTB = HALF * BK * 2, STAGE_BYTES = 8 * HTB, NXCD = 8, WGM = 8;
__host__ __device__ __forceinline__ int lds_byte(int r, int c) { const int st = (r >> 4) * 2 + (c >> 5), rr = r & 15, cc = c & 31, ob = rr * 64 + cc * 2; return st * 1024 + (ob ^ (((ob >> 9) & 1) << 5)); }
__host__ __device__ __forceinline__ void stage_rc(int b, int& R, int& C) { const int st = b / 1024, sb = b % 1024, swz = sb ^ (((sb >> 9) & 1) << 5); R = (st >> 1) * 16 + swz / 64; C = (st & 1) * 32 + (swz % 64) / 2; }
__host__ __device__ __forceinline__ int perm32(int rho) { const int n = rho >> 4, i = rho & 15; return 8 * (i >> 2) + 4 * n + (i & 3); }
struct Unit { int pm, pn; };
struct Gemm { const bf16_t* A; const bf16_t* Bt; int M, N, K, lda; };
struct StaticOrder {
    int nM, nN, nwg, G, c;
    __device__ void init(int M, int N, int G_, int c_) { nM = M / BM; nN = N / BM; nwg = nM * nN; G = G_; c = c_; }
    __device__ bool next(int i, Unit& u) const {
        const long L = (long)i * G + c; if (L >= nwg) return false;
        int wgid = (int)L; { const int q = nwg / NXCD, r = nwg % NXCD, xcd = wgid % NXCD, off = wgid / NXCD; wgid = (xcd < r ? xcd * (q + 1) : r * (q + 1) + (xcd - r) * q) + off; }
        const int nig = WGM * nN, gid = wgid / nig, fm = gid * WGM, gsz = (nM - fm) < WGM ? (nM - fm) : WGM;
        u.pm = fm + ((wgid % nig) % gsz); u.pn = (wgid % nig) / gsz; return true;
    }
};
struct EpiBf16 {
    bf16_t* O; int ldc;
    __device__ __forceinline__ void operator()(const f32x4 (&acc)[2][2][4][2], const Unit& u, int wr, int wc, int fr, int fq) const {
        const int row0 = u.pm * BM + wr * 64 + fr, col0 = u.pn * BM + wc * 32 + 8 * fq;
#pragma unroll
        for (int ai = 0; ai < 2; ++ai)
#pragma unroll
            for (int m = 0; m < 4; ++m) { bf16_t* rowp = O + (size_t)(2 * u.pn) * PLANE + (size_t)(row0 + ai * HALF + m * 16) * 128 + wc * 32 + 8 * fq;
#pragma unroll
                for (int bj = 0; bj < 2; ++bj) { const f32x4 v0 = acc[ai][bj][m][0], v1 = acc[ai][bj][m][1];
                    u32x4 w; w.x = cvt_pk_bf16(v0[0], v0[1]); w.y = cvt_pk_bf16(v0[2], v0[3]); w.z = cvt_pk_bf16(v1[0], v1[1]); w.w = cvt_pk_bf16(v1[2], v1[3]);
                    *(GAS u32x4*)(rowp + bj * PLANE) = w; } }
    }
};
struct EpiSwiGLU {
    bf16_t* O; int ldo;
    __device__ __forceinline__ void operator()(const f32x4 (&acc)[2][2][4][2], const Unit& u, int wr, int wc, int fr, int fq) const {
        const int row0 = u.pm * BM + wr * 64 + fr, col0 = u.pn * HALF + wc * 32 + 8 * fq;
#pragma unroll
        for (int ai = 0; ai < 2; ++ai)
#pragma unroll
            for (int m = 0; m < 4; ++m) { bf16_t* rowp = O + (size_t)(row0 + ai * HALF + m * 16) * ldo + col0;
                float hv[8];
#pragma unroll
                for (int n = 0; n < 2; ++n)
#pragma unroll
                    for (int i = 0; i < 4; ++i) hv[4 * n + i] = silu_f(acc[ai][0][m][n][i]) * acc[ai][1][m][n][i];
                u32x4 w; w.x = cvt_pk_bf16(hv[0], hv[1]); w.y = cvt_pk_bf16(hv[2], hv[3]); w.z = cvt_pk_bf16(hv[4], hv[5]); w.w = cvt_pk_bf16(hv[6], hv[7]);
                *(GAS u32x4*)rowp = w; }
    }
};
struct EpiResid {
    bf16_t* hb; const float* gate; float cmul;
    __device__ __forceinline__ void operator()(const f32x4 (&acc)[2][2][4][2], const Unit& u, int wr, int wc, int fr, int fq) const {
        const int row0 = u.pm * BM + wr * 64 + fr, col0 = u.pn * BM + wc * 32 + 8 * fq;
        const int b = (u.pm * BM) >> 13;
        f32x4 gm[2][2];
#pragma unroll
        for (int bj = 0; bj < 2; ++bj)
#pragma unroll
            for (int n = 0; n < 2; ++n) { const f32x4 g = *(const GAS f32x4*)(gate + (size_t)b * 9216 + col0 + bj * HALF + 4 * n); gm[bj][n] = (g + 1.0f) * cmul; }
#pragma unroll
        for (int ai = 0; ai < 2; ++ai) {
            u32x4 hv[4][2];
#pragma unroll
            for (int m = 0; m < 4; ++m) { const size_t off = (size_t)(row0 + ai * HALF + m * 16) * DM + col0;
#pragma unroll
                for (int bj = 0; bj < 2; ++bj) hv[m][bj] = *(const GAS u32x4*)(hb + off + bj * HALF); }
#pragma unroll
            for (int m = 0; m < 4; ++m) { const size_t off = (size_t)(row0 + ai * HALF + m * 16) * DM + col0;
#pragma unroll
                for (int bj = 0; bj < 2; ++bj) { const u32x4 hh = hv[m][bj];
                    const f32x4 h0 = (f32x4){bf_lo(hh.x), bf_hi(hh.x), bf_lo(hh.y), bf_hi(hh.y)}, h1 = (f32x4){bf_lo(hh.z), bf_hi(hh.z), bf_lo(hh.w), bf_hi(hh.w)};
                    const f32x4 v0 = h0 + gm[bj][0] * acc[ai][bj][m][0], v1 = h1 + gm[bj][1] * acc[ai][bj][m][1];
                    u32x4 w; w.x = cvt_pk_bf16(v0[0], v0[1]); w.y = cvt_pk_bf16(v0[2], v0[3]); w.z = cvt_pk_bf16(v1[0], v1[1]); w.w = cvt_pk_bf16(v1[2], v1[3]);
                    *(GAS u32x4*)(hb + off + bj * HALF) = w; } }
        }
    }
};

template <class Epi, bool APL = false>
__device__ __forceinline__ void gemm_phase(LAS unsigned char* lds, const int tid, const Gemm g, const StaticOrder& S, const Epi& E) {
    const int wid = __builtin_amdgcn_readfirstlane(tid >> 6), lane = tid & 63, wr = wid >> 2, wc = wid & 3, fr = lane & 15, fq = lane >> 4;
    const int K = g.K, nt = K / BK, lda = g.lda;
    unsigned voffA[2], voffB[2];
#pragma unroll
    for (int i = 0; i < 2; ++i) { int R, C; stage_rc(tid * 16 + i * 8192, R, C); const int Rb = (R & ~31) + perm32(R & 31);
        voffA[i] = (unsigned)(R * (APL ? 128 : lda) + C) * 2u; voffB[i] = (unsigned)(Rb * K + C) * 2u; }
    const size_t kstep = (size_t)(BK * 2);
    const size_t hstepA = (size_t)HALF * (APL ? 128 : lda) * 2, hstepB = (size_t)HALF * K * 2;
#define PG8_KA(t) (APL ? ((size_t)((t) >> 1) * (PLANE * 2) + (size_t)((t) & 1) * 128) : (size_t)(t) * kstep)
    const size_t tstepA = 2 * hstepA, tstepB = 2 * hstepB;
    const unsigned ldsw = (unsigned)wid * 1024u;
    const int aoff = lds_byte(wr * 64 + fr, fq * 8), boff = lds_byte(wc * 32 + fr, fq * 8);
#define PG8_SA(b, h) (((b) * 2 + (h)) * HTB)
#define PG8_SB(b, h) ((4 + (b) * 2 + (h)) * HTB)
#define PG8_STAGE(bufoff, gbase, voff) do { _Pragma("unroll") for (int _i = 0; _i < 2; ++_i) \
        __builtin_amdgcn_global_load_lds((const unsigned*)((const char*)(gbase) + (voff)[_i]), (LAS unsigned*)(lds + (bufoff) + ldsw + _i * 8192), 16, 0, 0); } while (0)
#define PG8_LDA(dst, b, h) do { _Pragma("unroll") for (int m = 0; m < 4; ++m) _Pragma("unroll") for (int k = 0; k < 2; ++k) dst[m][k] = *(const LAS bf16x8*)(lds + PG8_SA(b, h) + aoff + m * 2048 + k * 1024); } while (0)
#define PG8_LDB(dst, b, h) do { _Pragma("unroll") for (int n = 0; n < 2; ++n) _Pragma("unroll") for (int k = 0; k < 2; ++k) dst[n][k] = *(const LAS bf16x8*)(lds + PG8_SB(b, h) + boff + n * 2048 + k * 1024); } while (0)
#define PG8_MMA(ai, bj, At, Bt) do { __builtin_amdgcn_s_setprio(1); _Pragma("unroll") for (int m = 0; m < 4; ++m) _Pragma("unroll") for (int n = 0; n < 2; ++n) _Pragma("unroll") for (int k = 0; k < 2; ++k) \
        acc[ai][bj][m][n] = __builtin_amdgcn_mfma_f32_16x16x32_bf16(Bt[n][k], At[m][k], acc[ai][bj][m][n], 0, 0, 0); __builtin_amdgcn_s_setprio(0); } while (0)
#define PG8_WAIT_V(n) asm volatile("s_waitcnt vmcnt(" #n ")" ::: "memory")
#define PG8_WAIT_L(n) asm volatile("s_waitcnt lgkmcnt(" #n ")" ::: "memory")
#define PG8_BAR __builtin_amdgcn_s_barrier()
#define PG8_SCHED __builtin_amdgcn_sched_barrier(0)
    Unit cur, nxt; int ui = 0;
    if (!S.next(0, cur)) return;
    f32x4 acc[2][2][4][2];
#pragma unroll
    for (int a = 0; a < 2; ++a)
#pragma unroll
        for (int b = 0; b < 2; ++b)
#pragma unroll
            for (int m = 0; m < 4; ++m)
#pragma unroll
                for (int n = 0; n < 2; ++n) acc[a][b][m][n] = (f32x4){0.f, 0.f, 0.f, 0.f};
    bf16x8 At[4][2], B0[2][2], B1[2][2];
    const char* cA = (const char*)g.A + (size_t)cur.pm * tstepA; const char* cB = (const char*)g.Bt + (size_t)cur.pn * tstepB;
    PG8_STAGE(PG8_SB(0, 0), cB, voffB); PG8_STAGE(PG8_SB(0, 1), cB + hstepB, voffB); PG8_STAGE(PG8_SA(0, 0), cA, voffA); PG8_STAGE(PG8_SA(0, 1), cA + hstepA, voffA);
    if (wr == 1) PG8_BAR;
    PG8_WAIT_V(2); PG8_BAR;
    PG8_STAGE(PG8_SB(1, 0), cB + kstep, voffB); PG8_STAGE(PG8_SA(1, 0), cA + PG8_KA(1), voffA); PG8_STAGE(PG8_SB(1, 1), cB + hstepB + kstep, voffB);
    PG8_WAIT_V(6); PG8_BAR;
    for (;;) {
        const bool has_next = S.next(ui + 1, nxt);
        const char* nA = has_next ? (const char*)g.A + (size_t)nxt.pm * tstepA : cA; const char* nB = has_next ? (const char*)g.Bt + (size_t)nxt.pn * tstepB : cB;
        for (int t = 0; t < nt; t += 2) {
            const bool last = (t == nt - 2);
            const char* a1 = cA + PG8_KA(t + 1);
            const char* a2 = last ? nA : cA + PG8_KA(t + 2); const char* b2 = last ? nB : cB + (size_t)(t + 2) * kstep;
            const char* a3 = last ? nA + PG8_KA(1) : cA + PG8_KA(t + 3); const char* b3 = b2 + kstep;
            PG8_LDB(B0, 0, 0); PG8_LDB(B1, 0, 1); PG8_SCHED; PG8_LDA(At, 0, 0); PG8_STAGE(PG8_SA(1, 1), a1 + hstepA, voffA);
            PG8_WAIT_V(8); PG8_WAIT_L(0); PG8_BAR; PG8_MMA(0, 0, At, B0); PG8_MMA(0, 1, At, B1); PG8_BAR; PG8_SCHED;
            PG8_LDA(At, 0, 1); PG8_STAGE(PG8_SB(0, 0), b2, voffB); PG8_STAGE(PG8_SB(0, 1), b2 + hstepB, voffB); PG8_STAGE(PG8_SA(0, 0), a2, voffA);
            PG8_WAIT_V(8); PG8_WAIT_L(0); PG8_BAR; PG8_MMA(1, 0, At, B0); PG8_MMA(1, 1, At, B1); PG8_BAR; PG8_SCHED;
            PG8_LDB(B0, 1, 0); PG8_LDB(B1, 1, 1); PG8_SCHED; PG8_LDA(At, 1, 0); PG8_STAGE(PG8_SA(0, 1), a2 + hstepA, voffA);
            PG8_WAIT_V(8); PG8_WAIT_L(0); PG8_BAR; PG8_MMA(0, 0, At, B0); PG8_MMA(0, 1, At, B1); PG8_BAR; PG8_SCHED;
            PG8_LDA(At, 1, 1); PG8_STAGE(PG8_SB(1, 0), b3, voffB); PG8_STAGE(PG8_SB(1, 1), b3 + hstepB, voffB); PG8_STAGE(PG8_SA(1, 0), a3, voffA);
            PG8_WAIT_V(8); PG8_WAIT_L(0); PG8_BAR; PG8_MMA(1, 0, At, B0); PG8_MMA(1, 1, At, B1); PG8_BAR; PG8_SCHED;
        }
        if (wr == 0) PG8_BAR;
        E(acc, cur, wr, wc, fr, fq);
        if (!has_next) break;
#pragma unroll
        for (int a = 0; a < 2; ++a)
#pragma unroll
            for (int b = 0; b < 2; ++b)
#pragma unroll
                for (int m = 0; m < 4; ++m)
#pragma unroll
                    for (int n = 0; n < 2; ++n) acc[a][b][m][n] = (f32x4){0.f, 0.f, 0.f, 0.f};
        cur = nxt; cA = nA; cB = nB; ++ui;
        if (wr == 1) PG8_BAR;
    }
    PG8_WAIT_V(0);
    PG8_BAR;
#undef PG8_KA
#undef PG8_SA
#undef PG8_SB
#undef PG8_STAGE
#undef PG8_LDA
#undef PG8_LDB
#undef PG8_MMA
#undef PG8_WAIT_V
#undef PG8_WAIT_L
#undef PG8_BAR
#undef PG8_SCHED
}
}

struct Frame {
    LAS unsigned char* lds;
    int tid, lane, wave, G, bid;
};

__device__ __forceinline__ void conv_item(const float* W, int Nsrc, int K, int src_col0, bf16_t* WT, int dst_row0, int k0, LAS float* scr, int lane) {
    (void)scr;
    const int kg = lane >> 3, ng = lane & 7;
    const float* src = W + (size_t)(k0 + 8 * kg) * Nsrc + src_col0 + 4 * ng;
    f32x4 wv[8];
#pragma unroll
    for (int kk = 0; kk < 8; ++kk) wv[kk] = *(const GAS f32x4*)(src + (size_t)kk * Nsrc);
    bf16_t* dst = WT + (size_t)(dst_row0 + 4 * ng) * K + k0 + 8 * kg;
#pragma unroll
    for (int c = 0; c < 4; ++c) { u32x4 o;
        o.x = cvt_pk_bf16(wv[0][c], wv[1][c]); o.y = cvt_pk_bf16(wv[2][c], wv[3][c]); o.z = cvt_pk_bf16(wv[4][c], wv[5][c]); o.w = cvt_pk_bf16(wv[6][c], wv[7][c]);
        *(GAS u32x4*)(dst + (size_t)c * K) = o; }
}
__device__ __forceinline__ void convert_ffn(const Frame& F, const float* wg, const float* wu, const float* wd, bf16_t* WFU, bf16_t* WFD) {
    LAS float* scr = (LAS float*)(F.lds + F.wave * 16384);
    const int gw = F.bid * NWAVE + F.wave, NGW = F.G * NWAVE;
    constexpr int I_U = 16 * 176, I_D = 44 * 32;
    for (int it = gw; it < I_U + I_D; it += NGW) {
        if (it < I_U) { const int kb = it / 176, nb = it % 176, r0 = nb * 32, pn = r0 >> 8, i0 = r0 & 255;
            conv_item(i0 < 128 ? wg : wu, DFF, DM, pn * 128 + (i0 & 127), WFU, r0, kb * 64, scr, F.lane); }
        else { const int r = it - I_U, kb = r / 32, nb = r % 32; conv_item(wd, DM, DFF, nb * 32, WFD, nb * 32, kb * 64, scr, F.lane); }
    }
}
__device__ __forceinline__ void convert_mix(const Frame& F, const float* w_in, const float* w_out, bf16_t* WIN, bf16_t* WOUT) {
    LAS float* scr = (LAS float*)(F.lds + F.wave * 16384);
    const int gw = F.bid * NWAVE + F.wave, NGW = F.G * NWAVE;
    constexpr int I_I = 16 * 160, I_O = 24 * 32;
    for (int it = gw; it < I_I + I_O; it += NGW) {
        if (it < I_I) { const int kb = it / 160, nb = it % 160, r0 = nb * 32, blk = r0 >> 9;
            const int sb = blk == 0 ? 0 : blk == 1 ? 4 : blk == 2 ? 7 : blk == 3 ? 1 : blk == 4 ? 2 : blk == 5 ? 3 : blk == 6 ? 5 : blk == 7 ? 6 : blk;
            conv_item(w_in, INW, DM, sb * 512 + (r0 & 511), WIN, r0, kb * 64, scr, F.lane); }
        else { const int r = it - I_I, kb = r / 32, nb = r % 32; conv_item(w_out, DM, 1536, nb * 32, WOUT, nb * 32, kb * 64, scr, F.lane); }
    }
}

__device__ __forceinline__ void sincos_d(double x, double& s, double& c) {
    const double k = rint(x * 0.63661977236758134308);
    double r = fma(-k, 1.57079632679489655800e+00, x); r = fma(-k, 6.12323399573676603587e-17, r);
    const double r2 = r * r;
    double sp = -7.6471637318198164759e-13; sp = sp * r2 + 1.6059043836821614599e-10; sp = sp * r2 - 2.5052108385441718775e-08; sp = sp * r2 + 2.7557319223985890653e-06;
    sp = sp * r2 - 1.9841269841269841270e-04; sp = sp * r2 + 8.3333333333333333333e-03; sp = sp * r2 - 1.6666666666666666667e-01; const double sn = r + r * r2 * sp;
    double cp = 4.7794773323873852974e-14; cp = cp * r2 - 1.1470745597729724714e-11; cp = cp * r2 + 2.0876756987868098979e-09; cp = cp * r2 - 2.7557319223985890653e-07;
    cp = cp * r2 + 2.4801587301587301587e-05; cp = cp * r2 - 1.3888888888888888889e-03; cp = cp * r2 + 4.1666666666666666667e-02; cp = cp * r2 - 0.5; const double cs = 1.0 + r2 * cp;
    const int q = ((int)k) & 3;
    s = (q == 0) ? sn : (q == 1) ? cs : (q == 2) ? -sn : -cs;
    c = (q == 0) ? cs : (q == 1) ? -sn : (q == 2) ? -cs : sn;
}
__device__ __forceinline__ void prologue(const Frame& F, const Params& p, unsigned char* ws, int zi) {
    LAS float* cs = (LAS float*)F.lds;
    LAS float* red = (LAS float*)(F.lds + 16384);
    const float* c = as_global(p.in[1 + zi]);
    for (int i = F.tid; i < 4096; i += NTHR) cs[i] = silu_f(c[i]);
    __syncthreads();
    float* MOD = (float*)(ws + WS_MOD);
    for (int task = F.bid; task < 320; task += F.G) {
        const float* W; const float* bias; int N, n0; float* dst; int dstride;
        if (task < 288) { const int l = task / 144, t = task % 144; W = as_global(p.in[2 + zi]) + (size_t)l * DM * 9216; bias = as_global(p.in[3 + zi]) + l * 9216; N = 9216; n0 = t * 64; dst = MOD + (size_t)l * 4 * 9216; dstride = 9216; }
        else { const int t = task - 288; W = as_global(p.in[22 + zi]); bias = as_global(p.in[23 + zi]); N = 2048; n0 = t * 64; dst = MOD + FMOD_OFF; dstride = 2048; }
        float a0 = 0.f, a1 = 0.f, a2 = 0.f, a3 = 0.f;
        const int kb = F.wave * 128;
#pragma unroll 32
        for (int k = 0; k < 128; ++k) { const float w = ((const GAS float*)W)[(size_t)(kb + k) * N + n0 + F.lane];
            a0 += cs[kb + k] * w; a1 += cs[1024 + kb + k] * w; a2 += cs[2048 + kb + k] * w; a3 += cs[3072 + kb + k] * w; }
        red[(F.wave * 4 + 0) * 64 + F.lane] = a0; red[(F.wave * 4 + 1) * 64 + F.lane] = a1; red[(F.wave * 4 + 2) * 64 + F.lane] = a2; red[(F.wave * 4 + 3) * 64 + F.lane] = a3;
        __syncthreads();
        if (F.tid < 256) { const int b = F.tid >> 6, col = F.tid & 63; float s = bias[n0 + col];
#pragma unroll
            for (int w = 0; w < 8; ++w) s += red[(w * 4 + b) * 64 + col];
            dst[(size_t)b * dstride + n0 + col] = s; }
        __syncthreads();
    }
    f32x2* ROPE = (f32x2*)(ws + WS_ROPE);
    for (int idx = F.bid * NTHR + F.tid; idx < SEQ * 64; idx += F.G * NTHR) {
        const int pos = idx >> 6, i = idx & 63;
        const float invf = (float)exp(-(double)i * (9.210340371976184 / 64.0));
        const float ang = (float)pos * invf;
        double s, cc; sincos_d((double)ang, s, cc);
        ROPE[idx] = (f32x2){(float)cc, (float)s};
    }
}

__device__ __forceinline__ void norm_phase(const Frame& F, const float* xin, bf16_t* hb, const float* gain, const float* shift0, const float* scale0, int bstride, bf16_t* U) {
    const int gw = F.bid * NWAVE + F.wave, NGW = F.G * NWAVE;
    for (int m0 = gw; m0 < T_TOK; m0 += 4 * NGW) {
        f32x4 v[4][4];
#pragma unroll
        for (int r = 0; r < 4; ++r) { const int m = m0 + r * NGW; if (m < T_TOK) {
            if (xin != nullptr) { const GAS f32x4* xr = (const GAS f32x4*)(xin + (size_t)m * DM) + F.lane; GAS u32x2* hs = (GAS u32x2*)(hb + (size_t)m * DM) + F.lane;
#pragma unroll
                for (int j = 0; j < 4; ++j) { v[r][j] = xr[64 * j]; hs[64 * j] = pack4(v[r][j]); } }
            else { const GAS u32x2* xr = (const GAS u32x2*)(hb + (size_t)m * DM) + F.lane;
#pragma unroll
                for (int j = 0; j < 4; ++j) { const u32x2 t = xr[64 * j]; v[r][j] = (f32x4){bf_lo(t.x), bf_hi(t.x), bf_lo(t.y), bf_hi(t.y)}; } } } }
        const bool same_b = (4 * NGW == SEQ);
        f32x4 gp[4], shv[4];
        if (same_b) { const int b0 = m0 >> 13;
#pragma unroll
            for (int j = 0; j < 4; ++j) { const f32x4 g = ((const GAS f32x4*)gain)[F.lane + 64 * j], sc = ((const GAS f32x4*)(scale0 + (size_t)b0 * bstride))[F.lane + 64 * j];
                gp[j] = g * (sc + 1.0f); shv[j] = ((const GAS f32x4*)(shift0 + (size_t)b0 * bstride))[F.lane + 64 * j]; } }
#pragma unroll
        for (int r = 0; r < 4; ++r) { const int m = m0 + r * NGW; if (m < T_TOK) {
            const int b = m >> 13; float s = 0.f;
#pragma unroll
            for (int j = 0; j < 4; ++j) s += (v[r][j].x * v[r][j].x + v[r][j].y * v[r][j].y) + (v[r][j].z * v[r][j].z + v[r][j].w * v[r][j].w);
            const float rstd = rsqrtf(wave_sum(s) * (1.f / DM) + EPS);
            GAS u32x2* o8 = (GAS u32x2*)(U + (size_t)m * DM) + F.lane;
            if (!same_b) {
#pragma unroll
                for (int j = 0; j < 4; ++j) { const f32x4 g = ((const GAS f32x4*)gain)[F.lane + 64 * j], sc = ((const GAS f32x4*)(scale0 + (size_t)b * bstride))[F.lane + 64 * j];
                    gp[j] = g * (sc + 1.0f); shv[j] = ((const GAS f32x4*)(shift0 + (size_t)b * bstride))[F.lane + 64 * j]; } }
#pragma unroll
            for (int j = 0; j < 4; ++j) o8[64 * j] = pack4(v[r][j] * rstd * gp[j] + shv[j]); } }
    }
}
__device__ __forceinline__ void dt_gemv(const Frame& F, const bf16_t* U, const float* w_in, float* DT) {
    LAS float* Wd = (LAS float*)F.lds;
    __syncthreads();
    for (int idx = F.tid; idx < 8192; idx += NTHR) { const int k = idx >> 3, j = idx & 7; Wd[8 * k + 4 * (k >> 3) + j] = ((const GAS float*)w_in)[(size_t)k * INW + 5120 + j]; }
    __syncthreads();
    const int gw = F.bid * NWAVE + F.wave, NGW = F.G * NWAVE;
    for (int m0 = gw; m0 < T_TOK; m0 += 4 * NGW) {
      u32x4 uvr[4][2];
#pragma unroll
      for (int r = 0; r < 4; ++r) { const int mm = (m0 + r * NGW < T_TOK) ? m0 + r * NGW : m0;
#pragma unroll
          for (int hf = 0; hf < 2; ++hf) uvr[r][hf] = *(const GAS u32x4*)(U + (size_t)mm * DM + 512 * hf + 8 * F.lane); }
#pragma unroll
      for (int r = 0; r < 4; ++r) { const int m = m0 + r * NGW; if (m < T_TOK) {
        float acc[8];
#pragma unroll
        for (int j = 0; j < 8; ++j) acc[j] = 0.f;
#pragma unroll
        for (int hf = 0; hf < 2; ++hf) {
            const u32x4 uv = uvr[r][hf];
            float uf[8]; unpack8(uv, uf);
#pragma unroll
            for (int kk = 0; kk < 8; ++kk) { const int k = 512 * hf + 8 * F.lane + kk; const LAS float* wp = Wd + 8 * k + 4 * (k >> 3);
                const f32x4 w0 = *(const LAS f32x4*)wp, w1 = *(const LAS f32x4*)(wp + 4);
                acc[0] += uf[kk] * w0.x; acc[1] += uf[kk] * w0.y; acc[2] += uf[kk] * w0.z; acc[3] += uf[kk] * w0.w;
                acc[4] += uf[kk] * w1.x; acc[5] += uf[kk] * w1.y; acc[6] += uf[kk] * w1.z; acc[7] += uf[kk] * w1.w; }
        }
#pragma unroll
        for (int j = 0; j < 8; ++j) acc[j] = wave_sum(acc[j]);
        if (F.lane < 8) { float v = acc[0];
#pragma unroll
            for (int j = 1; j < 8; ++j) v = (F.lane == j) ? acc[j] : v;
            ((GAS float*)DT)[(size_t)m * 8 + F.lane] = v; }
      } }
    }
    __syncthreads();
}

template <bool MASKED>
__device__ __forceinline__ void sb_elem(const f32x4 (&sc)[4], int key0, int trow, float (&nk)[4][4], float (&lb)[4][4], float (&Tj)[4]) {
#pragma unroll
    for (int j = 0; j < 4; ++j) { float t = 0.f;
#pragma unroll
        for (int i = 0; i < 4; ++i) { const float z2 = sc[j][i] * (0.08838834764831845f * 1.4426950408889634f);
            const float sp2 = fmaxf(z2, 0.f) + __builtin_amdgcn_logf(1.0f + __builtin_amdgcn_exp2f(-fabsf(z2)));
            if (MASKED) { const bool vis = (key0 + 16 * j + i) < trow; nk[j][i] = vis ? sp2 : 0.f; lb[j][i] = vis ? (z2 - sp2) : -1e30f; }
            else { nk[j][i] = sp2; lb[j][i] = z2 - sp2; }
            t += nk[j][i]; }
        Tj[j] = t; }
}
__device__ __forceinline__ void sb_task(const Frame& F, bf16_t* P, int b, int h, int qb) {
    LAS unsigned char* Ks = F.lds;
    LAS unsigned char* Vt = F.lds + 17408;
    LAS unsigned char* Pw = F.lds + 35840 + F.wave * 2304;
    LAS float* red = (LAS float*)(F.lds + 54272);
    int lane = F.lane; asm volatile("" : "+v"(lane)); const int wid = F.wave, fr = lane & 15, fq = lane >> 4;
    const size_t rowbase = (size_t)b * SEQ;
    const int q0 = qb * 128, trow = q0 + 16 * wid + fr;
    bf16x8 qf[4];
    { const bf16_t* qp = P + pidx(rowbase + trow, C_SQ + h * 128) + 8 * fq;
#pragma unroll
      for (int s = 0; s < 4; ++s) qf[s] = *(const GAS bf16x8*)(qp + 32 * s); }
    f32x4 o[8];
#pragma unroll
    for (int i = 0; i < 8; ++i) o[i] = (f32x4){0.f, 0.f, 0.f, 0.f};
    float R = 0.f;
    u32x4 kvr[2], vvr[2];
#pragma unroll
    for (int i = 0; i < 2; ++i) { const int idx = F.tid + NTHR * i, key = idx >> 4, c8 = idx & 15; const size_t kt0 = rowbase + 64 * (2 * qb + 1);
        kvr[i] = *(const GAS u32x4*)(P + pidx(kt0 + key, C_SK + h * 128) + 8 * c8); vvr[i] = *(const GAS u32x4*)(P + pidx(kt0 + lane, C_SV + h * 128) + 8 * (2 * wid + i)); }
    lds_barrier();
    for (int kt = 2 * qb + 1; kt >= 0; --kt) {
#pragma unroll
        for (int i = 0; i < 2; ++i) { const int idx = F.tid + NTHR * i, key = idx >> 4, c8 = idx & 15;
            const u32x4 kv = kvr[i], vv = vvr[i];
            *(LAS u32x4*)(Ks + key * 272 + c8 * 16) = kv;
            LAS bf16_t* vd = (LAS bf16_t*)(Vt + (8 * (2 * wid + i)) * 144 + lane * 2);
            vd[0 * 72] = (bf16_t)(vv.x & 0xffff); vd[1 * 72] = (bf16_t)(vv.x >> 16); vd[2 * 72] = (bf16_t)(vv.y & 0xffff); vd[3 * 72] = (bf16_t)(vv.y >> 16);
            vd[4 * 72] = (bf16_t)(vv.z & 0xffff); vd[5 * 72] = (bf16_t)(vv.z >> 16); vd[6 * 72] = (bf16_t)(vv.w & 0xffff); vd[7 * 72] = (bf16_t)(vv.w >> 16); }
        if (kt > 0) {
#pragma unroll
            for (int i = 0; i < 2; ++i) { const int idx = F.tid + NTHR * i, key = idx >> 4, c8 = idx & 15; const size_t kt1 = rowbase + 64 * (kt - 1);
                kvr[i] = *(const GAS u32x4*)(P + pidx(kt1 + key, C_SK + h * 128) + 8 * c8); vvr[i] = *(const GAS u32x4*)(P + pidx(kt1 + lane, C_SV + h * 128) + 8 * (2 * wid + i)); } }
        lds_barrier();
        if (64 * kt < q0 + 16 * wid + 15) {
            f32x4 sc[4];
#pragma unroll
            for (int j = 0; j < 4; ++j) { sc[j] = (f32x4){0.f, 0.f, 0.f, 0.f};
#pragma unroll
                for (int s = 0; s < 4; ++s) sc[j] = mfma16(ldsfrag(Ks + (16 * j + fr) * 272 + (32 * s + 8 * fq) * 2), qf[s], sc[j]); }
            float nk[4][4], lb[4][4], Tj[4], Wj[4], Gj[4];
            if (64 * kt + 64 <= q0 + 16 * wid) sb_elem<false>(sc, 64 * kt + 4 * fq, trow, nk, lb, Tj);
            else sb_elem<true>(sc, 64 * kt + 4 * fq, trow, nk, lb, Tj);
#pragma unroll
            for (int j = 0; j < 4; ++j) { const float a1 = __shfl_xor(Tj[j], 16), a2 = __shfl_xor(Tj[j], 32), a3 = __shfl_xor(Tj[j], 48);
                Wj[j] = Tj[j] + a1 + a2 + a3;
                Gj[j] = (((fq ^ 1) > fq) ? a1 : 0.f) + (((fq ^ 2) > fq) ? a2 : 0.f) + (((fq ^ 3) > fq) ? a3 : 0.f); }
            float suf = 0.f;
#pragma unroll
            for (int j = 3; j >= 0; --j) { float tl = R - suf - Gj[j]; f32x4 w;
                w[3] = __builtin_amdgcn_exp2f(lb[j][3] + tl); tl -= nk[j][3];
                w[2] = __builtin_amdgcn_exp2f(lb[j][2] + tl); tl -= nk[j][2];
                w[1] = __builtin_amdgcn_exp2f(lb[j][1] + tl); tl -= nk[j][1];
                w[0] = __builtin_amdgcn_exp2f(lb[j][0] + tl);
                *(LAS u32x2*)(Pw + fr * 144 + (16 * j + 4 * fq) * 2) = pack4(w);
                suf += Wj[j]; }
            R -= suf;
#pragma unroll
            for (int ks = 0; ks < 2; ++ks) { const bf16x8 pf = ldsfrag(Pw + fr * 144 + (32 * ks + 8 * fq) * 2);
#pragma unroll
                for (int dt = 0; dt < 8; ++dt) o[dt] = mfma16(ldsfrag(Vt + (16 * dt + fr) * 144 + (32 * ks + 8 * fq) * 2), pf, o[dt]); }
        }
        const float rm = wave_max(R);
        if (lane == 0) red[wid] = rm;
        lds_barrier();
        float mx = red[0];
#pragma unroll
        for (int w = 1; w < 8; ++w) mx = fmaxf(mx, red[w]);
        if (mx < -173.2f) break;
    }
    bf16_t* op = P + pidx(rowbase + trow, C_SQ + h * 128) + 4 * fq;
#pragma unroll
    for (int dt = 0; dt < 8; ++dt) *(GAS u32x2*)(op + 16 * dt) = pack4(o[dt]);
}

__device__ __forceinline__ void ret_kv_task(const Frame& F, const bf16_t* P, const f32x2* ROPE, bf16_t* RST, int b, int c, int h, f32x4 (&kcs)[4], bool load_rope) {
    LAS unsigned char* KT = F.lds;
    LAS unsigned char* VT = F.lds + 18432;
    int lane = F.lane; asm volatile("" : "+v"(lane)); const int fr = lane & 15, fq = lane >> 4;
    const float l2g = log2gamma(h);
    lds_barrier();
    { const int s = lane, g8 = F.wave;     const size_t row = (size_t)b * SEQ + c * 64 + s; const int pos = c * 64 + s;
      const bf16_t* kp = P + pidx(row, C_RK + h * 128) + 8 * g8;
      const u32x4 k1 = *(const GAS u32x4*)kp, k2 = *(const GAS u32x4*)(kp + 64);
      float x1[8], x2[8]; unpack8(k1, x1); unpack8(k2, x2);
      if (load_rope) { const GAS f32x4* cp = (const GAS f32x4*)(ROPE + pos * 64 + 8 * g8);
#pragma unroll
          for (int jj = 0; jj < 4; ++jj) kcs[jj] = cp[jj]; }
      const float dec = __builtin_amdgcn_exp2f(l2g * (float)(63 - s)) * 0.08838834764831845f;
      LAS bf16_t* kd = (LAS bf16_t*)(KT + (8 * g8) * 144 + s * 2);
#pragma unroll
      for (int jj = 0; jj < 4; ++jj) { const f32x4 cs = kcs[jj];
          { const int j = 2 * jj; const float y1 = (x1[j] * cs.x - x2[j] * cs.y) * dec, y2 = (x1[j] * cs.y + x2[j] * cs.x) * dec; kd[j * 72] = f2bf(y1); kd[(64 + j) * 72] = f2bf(y2); }
          { const int j = 2 * jj + 1; const float y1 = (x1[j] * cs.z - x2[j] * cs.w) * dec, y2 = (x1[j] * cs.w + x2[j] * cs.z) * dec; kd[j * 72] = f2bf(y1); kd[(64 + j) * 72] = f2bf(y2); } }
      const bf16_t* vp = P + pidx(row, C_RV + h * 128) + 16 * g8;
#pragma unroll
      for (int hh = 0; hh < 2; ++hh) { const u32x4 vv = *(const GAS u32x4*)(vp + 8 * hh);
          LAS bf16_t* vd = (LAS bf16_t*)(VT + (16 * g8 + 8 * hh) * 144 + s * 2);
          vd[0 * 72] = (bf16_t)(vv.x & 0xffff); vd[1 * 72] = (bf16_t)(vv.x >> 16); vd[2 * 72] = (bf16_t)(vv.y & 0xffff); vd[3 * 72] = (bf16_t)(vv.y >> 16);
          vd[4 * 72] = (bf16_t)(vv.z & 0xffff); vd[5 * 72] = (bf16_t)(vv.z >> 16); vd[6 * 72] = (bf16_t)(vv.w & 0xffff); vd[7 * 72] = (bf16_t)(vv.w >> 16); } }
    lds_barrier();
    const int w = F.wave;
    bf16x8 xf[2];
#pragma unroll
    for (int ks = 0; ks < 2; ++ks) xf[ks] = ldsfrag(KT + (16 * w + fr) * 144 + (32 * ks + 8 * fq) * 2);
    bf16_t* dst = RST + (size_t)((b * 128 + c) * 4 + h) * 16384;
#pragma unroll
    for (int et = 0; et < 8; ++et) { f32x4 acc = (f32x4){0.f, 0.f, 0.f, 0.f};
#pragma unroll
        for (int ks = 0; ks < 2; ++ks) acc = mfma16(xf[ks], ldsfrag(VT + (16 * et + fr) * 144 + (32 * ks + 8 * fq) * 2), acc);
        *(GAS u32x2*)(dst + (16 * et + fr) * 128 + 16 * w + 4 * fq) = pack4(acc); }
}

__device__ __forceinline__ void ret_out_task(const Frame& F, bf16_t* P, const f32x2* ROPE, const bf16_t* RST, const float* gn, int b, int c, int h, f32x4 (&kcs)[4], f32x4 (&qcs)[2][4], bool load_rope) {
    LAS unsigned char* Kr = F.lds;
    LAS unsigned char* VT = F.lds + 17408;
    LAS unsigned char* Sx = F.lds + 35840;
    LAS unsigned char* Pw = F.lds + 70656 + F.wave * 2304;
    LAS float* ssq = (LAS float*)(F.lds + 89088);
    int lane = F.lane; asm volatile("" : "+v"(lane)); const int fr = lane & 15, fq = lane >> 4, w = F.wave, lt = w & 3, eh = w >> 2;
    const float l2g = log2gamma(h);
    const int unit = (b * 128 + c) * 4 + h;
    lds_barrier();
    { const int s = F.tid >> 3, g8 = F.tid & 7; const size_t row = (size_t)b * SEQ + c * 64 + s; const int pos = c * 64 + s;
      const bf16_t* kp = P + pidx(row, C_RK + h * 128) + 8 * g8;
      const u32x4 k1 = *(const GAS u32x4*)kp, k2 = *(const GAS u32x4*)(kp + 64);
      float x1[8], x2[8], y1[8], y2[8]; unpack8(k1, x1); unpack8(k2, x2);
      if (load_rope) { const GAS f32x4* cp = (const GAS f32x4*)(ROPE + pos * 64 + 8 * g8);
#pragma unroll
          for (int jj = 0; jj < 4; ++jj) kcs[jj] = cp[jj]; }
#pragma unroll
      for (int jj = 0; jj < 4; ++jj) { const f32x4 cs = kcs[jj];
          { const int j = 2 * jj; y1[j] = (x1[j] * cs.x - x2[j] * cs.y) * 0.08838834764831845f; y2[j] = (x1[j] * cs.y + x2[j] * cs.x) * 0.08838834764831845f; }
          { const int j = 2 * jj + 1; y1[j] = (x1[j] * cs.z - x2[j] * cs.w) * 0.08838834764831845f; y2[j] = (x1[j] * cs.w + x2[j] * cs.z) * 0.08838834764831845f; } }
      u32x4 o1, o2; o1.x = cvt_pk_bf16(y1[0], y1[1]); o1.y = cvt_pk_bf16(y1[2], y1[3]); o1.z = cvt_pk_bf16(y1[4], y1[5]); o1.w = cvt_pk_bf16(y1[6], y1[7]);
      o2.x = cvt_pk_bf16(y2[0], y2[1]); o2.y = cvt_pk_bf16(y2[2], y2[3]); o2.z = cvt_pk_bf16(y2[4], y2[5]); o2.w = cvt_pk_bf16(y2[6], y2[7]);
      *(LAS u32x4*)(Kr + s * 272 + (8 * g8) * 2) = o1; *(LAS u32x4*)(Kr + s * 272 + (64 + 8 * g8) * 2) = o2;
      const bf16_t* vp = P + pidx((size_t)b * SEQ + c * 64 + lane, C_RV + h * 128) + 16 * F.wave;
#pragma unroll
      for (int hh = 0; hh < 2; ++hh) { const u32x4 vv = *(const GAS u32x4*)(vp + 8 * hh);
          LAS bf16_t* vd = (LAS bf16_t*)(VT + (16 * F.wave + 8 * hh) * 144 + lane * 2);
          vd[0 * 72] = (bf16_t)(vv.x & 0xffff); vd[1 * 72] = (bf16_t)(vv.x >> 16); vd[2 * 72] = (bf16_t)(vv.y & 0xffff); vd[3 * 72] = (bf16_t)(vv.y >> 16);
          vd[4 * 72] = (bf16_t)(vv.z & 0xffff); vd[5 * 72] = (bf16_t)(vv.z >> 16); vd[6 * 72] = (bf16_t)(vv.w & 0xffff); vd[7 * 72] = (bf16_t)(vv.w >> 16); }
      const bf16_t* sp = RST + (size_t)unit * 16384;
#pragma unroll
      for (int i = 0; i < 4; ++i) { const int idx = F.tid + NTHR * i, e = idx >> 4, c16 = idx & 15;
          *(LAS u32x4*)(Sx + e * 272 + c16 * 16) = *(const GAS u32x4*)(sp + e * 128 + 8 * c16); } }
    const int l = 16 * lt + fr; const size_t qrow = (size_t)b * SEQ + c * 64 + l; const int qpos = c * 64 + l;
    bf16x8 qf[4];
    { const bf16_t* qp = P + pidx(qrow, C_RQ + h * 128) + 8 * fq;
      u32x4 qv[4];
#pragma unroll
      for (int s = 0; s < 4; ++s) qv[s] = *(const GAS u32x4*)(qp + 32 * s);
#pragma unroll
      for (int s = 0; s < 2; ++s) { float x1[8], x2[8], y1[8], y2[8]; unpack8(qv[s], x1); unpack8(qv[s + 2], x2);
          if (load_rope) { const GAS f32x4* cp = (const GAS f32x4*)(ROPE + qpos * 64 + 32 * s + 8 * fq);
#pragma unroll
              for (int jj = 0; jj < 4; ++jj) qcs[s][jj] = cp[jj]; }
#pragma unroll
          for (int jj = 0; jj < 4; ++jj) { const f32x4 cs = qcs[s][jj];
              { const int j = 2 * jj; y1[j] = x1[j] * cs.x - x2[j] * cs.y; y2[j] = x1[j] * cs.y + x2[j] * cs.x; }
              { const int j = 2 * jj + 1; y1[j] = x1[j] * cs.z - x2[j] * cs.w; y2[j] = x1[j] * cs.w + x2[j] * cs.z; } }
          u32x4 o1, o2; o1.x = cvt_pk_bf16(y1[0], y1[1]); o1.y = cvt_pk_bf16(y1[2], y1[3]); o1.z = cvt_pk_bf16(y1[4], y1[5]); o1.w = cvt_pk_bf16(y1[6], y1[7]);
          o2.x = cvt_pk_bf16(y2[0], y2[1]); o2.y = cvt_pk_bf16(y2[2], y2[3]); o2.z = cvt_pk_bf16(y2[4], y2[5]); o2.w = cvt_pk_bf16(y2[6], y2[7]);
          qf[s] = __builtin_bit_cast(bf16x8, o1); qf[s + 2] = __builtin_bit_cast(bf16x8, o2); } }
    u32x2 gvr[4]; f32x4 ggr[4];
#pragma unroll
    for (int et = 0; et < 4; ++et) { const int e0 = 64 * eh + 16 * et + 4 * fq;
        gvr[et] = *(const GAS u32x2*)(P + pidx(qrow, C_RG + h * 128) + e0); ggr[et] = *(const GAS f32x4*)(gn + h * 128 + e0); }
    lds_barrier();
#pragma unroll
    for (int j = 0; j < 4; ++j) { f32x4 acc = (f32x4){0.f, 0.f, 0.f, 0.f};
#pragma unroll
        for (int ks = 0; ks < 4; ++ks) acc = mfma16(ldsfrag(Kr + (16 * j + fr) * 272 + (32 * ks + 8 * fq) * 2), qf[ks], acc);
#pragma unroll
        for (int i = 0; i < 4; ++i) { const int s = 16 * j + 4 * fq + i; acc[i] *= __builtin_amdgcn_exp2f(l2g * fabsf((float)(l - s))); }
        *(LAS u32x2*)(Pw + fr * 144 + (16 * j + 4 * fq) * 2) = pack4(acc); }
    f32x4 y[4];
    const float qdec = __builtin_amdgcn_exp2f(l2g * (float)(l + 1));
#pragma unroll
    for (int et = 0; et < 4; ++et) { y[et] = (f32x4){0.f, 0.f, 0.f, 0.f};
#pragma unroll
        for (int ks = 0; ks < 4; ++ks) y[et] = mfma16(ldsfrag(Sx + (64 * eh + 16 * et + fr) * 272 + (32 * ks + 8 * fq) * 2), qf[ks], y[et]);
        y[et] = y[et] * qdec; }
#pragma unroll
    for (int ks = 0; ks < 2; ++ks) { const bf16x8 pf = ldsfrag(Pw + fr * 144 + (32 * ks + 8 * fq) * 2);
#pragma unroll
        for (int et = 0; et < 4; ++et) y[et] = mfma16(ldsfrag(VT + (64 * eh + 16 * et + fr) * 144 + (32 * ks + 8 * fq) * 2), pf, y[et]); }
    float ss = 0.f;
#pragma unroll
    for (int et = 0; et < 4; ++et) ss += (y[et][0] * y[et][0] + y[et][1] * y[et][1]) + (y[et][2] * y[et][2] + y[et][3] * y[et][3]);
    ss += __shfl_xor(ss, 16); ss += __shfl_xor(ss, 32);
    if (fq == 0) ssq[w * 16 + fr] = ss;
    lds_barrier();
    const float rstd = rsqrtf((ssq[w * 16 + fr] + ssq[(w ^ 4) * 16 + fr]) * (1.f / 128.f) + EPS);
#pragma unroll
    for (int et = 0; et < 4; ++et) { const int e0 = 64 * eh + 16 * et + 4 * fq;
        const u32x2 gv = gvr[et]; const f32x4 gg = ggr[et];
        f32x4 r;
        r[0] = y[et][0] * rstd * gg[0] * silu_f(bf_lo(gv.x)); r[1] = y[et][1] * rstd * gg[1] * silu_f(bf_hi(gv.x));
        r[2] = y[et][2] * rstd * gg[2] * silu_f(bf_lo(gv.y)); r[3] = y[et][3] * rstd * gg[3] * silu_f(bf_hi(gv.y));
        *(GAS u32x2*)(P + pidx(qrow, C_RQ + h * 128) + e0) = pack4(r); }
}

__device__ __forceinline__ float softplus_f(float x) { return fmaxf(x, 0.f) + log1pf(__expf(-fabsf(x))); }
__device__ __forceinline__ void conv8(const bf16_t* P, const float* cw, const float* cb, int b, int tpos, int col, float* v) {
    const int chan = col - C_XBC;
    { const f32x4 b0 = *(const GAS f32x4*)(cb + chan), b1 = *(const GAS f32x4*)(cb + chan + 4);
      v[0] = b0.x; v[1] = b0.y; v[2] = b0.z; v[3] = b0.w; v[4] = b1.x; v[5] = b1.y; v[6] = b1.z; v[7] = b1.w; }
#pragma unroll
    for (int j = 0; j < 4; ++j) { const int ts = tpos - 3 + j;
        if (ts >= 0) { const u32x4 xv = *(const GAS u32x4*)(P + pidx((size_t)b * SEQ + ts, col)); float xf[8]; unpack8(xv, xf);
            const f32x4 w0 = *(const GAS f32x4*)(cw + j * 1024 + chan), w1 = *(const GAS f32x4*)(cw + j * 1024 + chan + 4);
            v[0] += xf[0] * w0.x; v[1] += xf[1] * w0.y; v[2] += xf[2] * w0.z; v[3] += xf[3] * w0.w; v[4] += xf[4] * w1.x; v[5] += xf[5] * w1.y; v[6] += xf[6] * w1.z; v[7] += xf[7] * w1.w; } }
#pragma unroll
    for (int i = 0; i < 8; ++i) v[i] = silu_f(v[i]);
}

__device__ __forceinline__ void conv_load(const bf16_t* P, const float* cw, const float* cb, int b, int tpos0, int col, float (&w)[4][8], float (&bias)[8], u32x4 (&rows)[11]) {
    const int chan = col - C_XBC;
#pragma unroll
    for (int j = 0; j < 4; ++j) { const f32x4 w0 = *(const GAS f32x4*)(cw + j * 1024 + chan), w1 = *(const GAS f32x4*)(cw + j * 1024 + chan + 4);
        w[j][0] = w0.x; w[j][1] = w0.y; w[j][2] = w0.z; w[j][3] = w0.w; w[j][4] = w1.x; w[j][5] = w1.y; w[j][6] = w1.z; w[j][7] = w1.w; }
    { const f32x4 b0 = *(const GAS f32x4*)(cb + chan), b1 = *(const GAS f32x4*)(cb + chan + 4);
      bias[0] = b0.x; bias[1] = b0.y; bias[2] = b0.z; bias[3] = b0.w; bias[4] = b1.x; bias[5] = b1.y; bias[6] = b1.z; bias[7] = b1.w; }
    const bf16_t* base = P + pidx((size_t)b * SEQ + tpos0, col);
#pragma unroll
    for (int r = 0; r < 11; ++r) { rows[r] = (u32x4){0u, 0u, 0u, 0u}; if (tpos0 - 3 + r >= 0) rows[r] = *(const GAS u32x4*)(base + (long)(r - 3) * 128); }
}
template <bool TR, bool HASF>
__device__ __forceinline__ void conv_compute(const float (&w)[4][8], const float (&bias)[8], const u32x4 (&rows)[11], const float (&f)[8], u32x4 (&pk)[8]) {
    float prev[8];
#pragma unroll
    for (int t = 0; t < 8; ++t) {
        float a[8];
#pragma unroll
        for (int i = 0; i < 8; ++i) a[i] = bias[i];
#pragma unroll
        for (int j = 0; j < 4; ++j) { float xf[8]; unpack8(rows[t + j], xf);
#pragma unroll
            for (int i = 0; i < 8; ++i) a[i] += xf[i] * w[j][i]; }
#pragma unroll
        for (int i = 0; i < 8; ++i) { a[i] = silu_f(a[i]); if (HASF) a[i] *= f[t]; }
        if (TR) {
            if (t & 1) {
#pragma unroll
                for (int i = 0; i < 8; ++i) { const unsigned u = cvt_pk_bf16(prev[i], a[i]);
                    if ((t >> 1) == 0) pk[i].x = u; else if ((t >> 1) == 1) pk[i].y = u; else if ((t >> 1) == 2) pk[i].z = u; else pk[i].w = u; }
            } else {
#pragma unroll
                for (int i = 0; i < 8; ++i) prev[i] = a[i];
            }
        } else {
            pk[t].x = cvt_pk_bf16(a[0], a[1]); pk[t].y = cvt_pk_bf16(a[2], a[3]); pk[t].z = cvt_pk_bf16(a[4], a[5]); pk[t].w = cvt_pk_bf16(a[6], a[7]);
        }
    }
}
template <bool TR, bool HASF>
__device__ __forceinline__ void conv_tile(const bf16_t* P, const float* cw, const float* cb, int b, int tpos0, int col, const float (&f)[8], u32x4 (&pk)[8]) {
    float w[4][8], bias[8]; u32x4 rows[11];
    conv_load(P, cw, cb, b, tpos0, col, w, bias, rows);
    conv_compute<TR, HASF>(w, bias, rows, f, pk);
}
__device__ __forceinline__ float dt_scan(const float* DT, const float* dt_bias, const float* a_log, int b, int c, int hd, int lane, float& dtv) {
    const size_t t = (size_t)b * SEQ + c * 64 + lane;
    dtv = softplus_f(((const GAS float*)DT)[t * 8 + hd] + ((const GAS float*)dt_bias)[hd]);
    float x = dtv * (-__expf(((const GAS float*)a_log)[hd]));
#pragma unroll
    for (int o = 1; o < 64; o <<= 1) { const float y = __shfl_up(x, o); if (lane >= o) x += y; }
    return x;
}

__device__ __forceinline__ void ssd_state_task(const Frame& F, const bf16_t* P, const float* DT, const float* cw, const float* cb, const float* dt_bias, const float* a_log,
                                               bf16_t* SST, float* CD, int b, int c, int g) {
    LAS unsigned char* XT = F.lds;
    LAS unsigned char* BT = F.lds + 36864;
    LAS float* dtl = (LAS float*)(F.lds + 55296);
    LAS float* acl = (LAS float*)(F.lds + 56320);
    int lane = F.lane; asm volatile("" : "+v"(lane)); const int fr = lane & 15, fq = lane >> 4, w = F.wave;
    lds_barrier();
    int tt = F.tid; asm volatile("" : "+v"(tt)); const int cgi = tt % 48, seg = tt / 48, s0 = 8 * seg;
    const int ccol = (cgi < 32) ? (C_XBC + g * 256 + 8 * cgi) : (C_XBC + 512 + g * 128 + 8 * (cgi - 32));
    float cwr[4][8], cbr[8]; u32x4 crow[11];
    if (tt < 384) conv_load(P, cw, cb, b, c * 64 + s0, ccol, cwr, cbr, crow);
    if (w < 4) { float dtv; const float cum = dt_scan(DT, dt_bias, a_log, b, c, 4 * g + w, lane, dtv);
        dtl[lane * 4 + w] = dtv; acl[lane * 4 + w] = cum;
        if (lane == 63) ((GAS float*)CD)[(b * 128 + c) * 8 + 4 * g + w] = __expf(cum); }
    lds_barrier();
    if (tt < 384) {
        float f[8]; u32x4 pk[8];
        if (cgi < 32) { const int hl = cgi >> 3; const float ae = acl[63 * 4 + hl];
#pragma unroll
            for (int t = 0; t < 8; ++t) f[t] = dtl[(s0 + t) * 4 + hl] * __expf(ae - acl[(s0 + t) * 4 + hl]); }
        else {
#pragma unroll
            for (int t = 0; t < 8; ++t) f[t] = 1.0f; }
        conv_compute<true, true>(cwr, cbr, crow, f, pk);
        LAS unsigned char* d = (cgi < 32) ? (XT + (8 * cgi) * 144 + s0 * 2) : (BT + (8 * (cgi - 32)) * 144 + s0 * 2);
#pragma unroll
        for (int i = 0; i < 8; ++i) *(LAS u32x4*)(d + i * 144) = pk[i]; }
    lds_barrier();
    const int hl = w >> 1, ph = w & 1;
    bf16x8 yf[2][2];
#pragma unroll
    for (int pt = 0; pt < 2; ++pt)
#pragma unroll
        for (int ks = 0; ks < 2; ++ks) yf[pt][ks] = ldsfrag(XT + (hl * 64 + ph * 32 + 16 * pt + fr) * 144 + (32 * ks + 8 * fq) * 2);
    bf16_t* dst = SST + (size_t)((b * 128 + c) * 8 + 4 * g + hl) * 8192;
#pragma unroll
    for (int nt = 0; nt < 8; ++nt) { f32x4 a0 = (f32x4){0.f, 0.f, 0.f, 0.f}, a1 = a0;
#pragma unroll
        for (int ks = 0; ks < 2; ++ks) { const bf16x8 xf = ldsfrag(BT + (16 * nt + fr) * 144 + (32 * ks + 8 * fq) * 2); a0 = mfma16(xf, yf[0][ks], a0); a1 = mfma16(xf, yf[1][ks], a1); }
#ifdef PROBE_CONST
        a0 = (f32x4){0.01f, 0.02f, 0.03f, 0.04f}; a1 = a0;
#endif
        *(GAS u32x2*)(dst + (ph * 32 + fr) * 128 + 16 * nt + 4 * fq) = pack4(a0);
        *(GAS u32x2*)(dst + (ph * 32 + 16 + fr) * 128 + 16 * nt + 4 * fq) = pack4(a1); }
}

__device__ __forceinline__ void ssd_out_task(const Frame& F, bf16_t* P, const float* DT, const float* cw, const float* cb, const float* dt_bias, const float* a_log,
                                             const float* d_skip, const float* nrm, const bf16_t* SST, int b, int c) {
    LAS unsigned char* Bs = F.lds;
    LAS unsigned char* Cs = F.lds + 17408;
    LAS unsigned char* XT = F.lds + 34816;
    LAS unsigned char* Pw = F.lds + 71680 + F.wave * 2304;
    LAS float* dtl = (LAS float*)(F.lds + 90112);
    LAS float* acl = (LAS float*)(F.lds + 92160);
    LAS float* ssq = (LAS float*)(F.lds + 94208);
    int lane = F.lane; asm volatile("" : "+v"(lane)); const int fr = lane & 15, fq = lane >> 4, w = F.wave, hl = w >> 1, half = w & 1;
    lds_barrier();
    { float dtv; const float cum = dt_scan(DT, dt_bias, a_log, b, c, w, lane, dtv); dtl[lane * 8 + w] = dtv; acl[lane * 8 + w] = cum; }
    float ssl[2] = {0.f, 0.f};
#pragma unroll 1
    for (int g = 0; g < 2; ++g) {
        const int head = 4 * g + hl;
        const bf16_t* hsrc = SST + (size_t)((b * 128 + c) * 8 + head) * 8192;
        bf16x8 hfr[4][4];
#pragma unroll
        for (int ks = 0; ks < 4; ++ks)
#pragma unroll
            for (int pt = 0; pt < 4; ++pt) hfr[ks][pt] = *(const GAS bf16x8*)(hsrc + (16 * pt + fr) * 128 + 32 * ks + 8 * fq);
        lds_barrier();
        { int tt = F.tid; asm volatile("" : "+v"(tt)); const int cgi = tt & 63, seg = tt >> 6, s0 = 8 * seg;
            const int col = (cgi < 32) ? (C_XBC + g * 256 + 8 * cgi) : (cgi < 48) ? (C_XBC + 512 + g * 128 + 8 * (cgi - 32)) : (C_XBC + 768 + g * 128 + 8 * (cgi - 48));
            const float f[8] = {1.f, 1.f, 1.f, 1.f, 1.f, 1.f, 1.f, 1.f}; u32x4 pk[8];
            if (cgi < 32) { conv_tile<true, false>(P, cw, cb, b, c * 64 + s0, col, f, pk);
                LAS unsigned char* d = XT + (8 * cgi) * 144 + s0 * 2;
#pragma unroll
                for (int i = 0; i < 8; ++i) *(LAS u32x4*)(d + i * 144) = pk[i]; }
            else { conv_tile<false, false>(P, cw, cb, b, c * 64 + s0, col, f, pk);
                LAS unsigned char* d = ((cgi < 48) ? (Bs + (8 * (cgi - 32)) * 2) : (Cs + (8 * (cgi - 48)) * 2)) + s0 * 272;
#pragma unroll
                for (int i = 0; i < 8; ++i) *(LAS u32x4*)(d + i * 272) = pk[i]; } }
        u32x2 zvr[2][4];
#pragma unroll
        for (int li = 0; li < 2; ++li)
#pragma unroll
            for (int pt = 0; pt < 4; ++pt) zvr[li][pt] = *(const GAS u32x2*)(P + pidx((size_t)b * SEQ + c * 64 + 16 * (2 * half + li) + fr, C_MZ + head * 64 + 16 * pt + 4 * fq));
        lds_barrier();
        const float dsk = ((const GAS float*)d_skip)[head];
#pragma unroll
        for (int li = 0; li < 2; ++li) {
            asm volatile("" ::: "memory"); __builtin_amdgcn_sched_barrier(0);
            const int lt = 2 * half + li, l = 16 * lt + fr;
            const float al = acl[l * 8 + head];
            bf16x8 cf[4];
#pragma unroll
            for (int ks = 0; ks < 4; ++ks) cf[ks] = ldsfrag(Cs + (16 * lt + fr) * 272 + (32 * ks + 8 * fq) * 2);
            f32x4 y[4];
#pragma unroll
            for (int pt = 0; pt < 4; ++pt) y[pt] = (f32x4){0.f, 0.f, 0.f, 0.f};
#pragma unroll
            for (int ks = 0; ks < 4; ++ks) {
#pragma unroll
                for (int pt = 0; pt < 4; ++pt) y[pt] = mfma16(hfr[ks][pt], cf[ks], y[pt]); }
            { const float eal = __expf(al);
#pragma unroll
              for (int pt = 0; pt < 4; ++pt) y[pt] = y[pt] * eal; }
#pragma unroll
            for (int st = 0; st < 4; ++st) { f32x4 acc = (f32x4){0.f, 0.f, 0.f, 0.f};
#pragma unroll
                for (int ks = 0; ks < 4; ++ks) acc = mfma16(ldsfrag(Bs + (16 * st + fr) * 272 + (32 * ks + 8 * fq) * 2), cf[ks], acc);
#pragma unroll
                for (int i = 0; i < 4; ++i) { const int s = 16 * st + 4 * fq + i;
                    acc[i] = (s <= l) ? acc[i] * __expf(al - acl[s * 8 + head]) * dtl[s * 8 + head] : 0.f; }
                *(LAS u32x2*)(Pw + fr * 144 + (16 * st + 4 * fq) * 2) = pack4(acc); }
#pragma unroll
            for (int ks = 0; ks < 2; ++ks) { if (2 * ks <= lt) { const bf16x8 pf = ldsfrag(Pw + fr * 144 + (32 * ks + 8 * fq) * 2);
#pragma unroll
                for (int pt = 0; pt < 4; ++pt) y[pt] = mfma16(ldsfrag(XT + (hl * 64 + 16 * pt + fr) * 144 + (32 * ks + 8 * fq) * 2), pf, y[pt]); } }
            const size_t row = (size_t)b * SEQ + c * 64 + l;
#pragma unroll
            for (int pt = 0; pt < 4; ++pt) { const int p0 = 16 * pt + 4 * fq;
                const u32x2 zv = zvr[li][pt];
                const LAS bf16_t* xp = (const LAS bf16_t*)(XT + (hl * 64 + p0) * 144 + l * 2);
                f32x4 r;
                r[0] = (y[pt][0] + bf2f(xp[0 * 72]) * dsk) * silu_f(bf_lo(zv.x)); r[1] = (y[pt][1] + bf2f(xp[1 * 72]) * dsk) * silu_f(bf_hi(zv.x));
                r[2] = (y[pt][2] + bf2f(xp[2 * 72]) * dsk) * silu_f(bf_lo(zv.y)); r[3] = (y[pt][3] + bf2f(xp[3 * 72]) * dsk) * silu_f(bf_hi(zv.y));
                ssl[li] += (r[0] * r[0] + r[1] * r[1]) + (r[2] * r[2] + r[3] * r[3]);
                *(GAS u32x2*)(P + pidx(row, C_MZ + head * 64 + p0)) = pack4(r); }
        }
    }
#pragma unroll
    for (int li = 0; li < 2; ++li) { float ss = ssl[li];
        ss += __shfl_xor(ss, 16); ss += __shfl_xor(ss, 32);
        if (fq == 0) ssq[hl * 64 + 16 * (2 * half + li) + fr] = ss; }
    asm volatile("s_waitcnt vmcnt(0)" ::: "memory");
    u32x2 ypk[2][2][4]; f32x4 ngv[2][4];
#pragma unroll
    for (int g = 0; g < 2; ++g)
#pragma unroll
        for (int pt = 0; pt < 4; ++pt) { const int ch = (4 * g + hl) * 64 + 16 * pt + 4 * fq; ngv[g][pt] = *(const GAS f32x4*)(nrm + ch);
#pragma unroll
            for (int li = 0; li < 2; ++li) ypk[li][g][pt] = *(const GAS u32x2*)(P + pidx((size_t)b * SEQ + c * 64 + 16 * (2 * half + li) + fr, C_MZ + ch)); }
    lds_barrier();
#pragma unroll
    for (int li = 0; li < 2; ++li) { const int l = 16 * (2 * half + li) + fr;
        const float rstd = rsqrtf((ssq[l] + ssq[64 + l] + ssq[128 + l] + ssq[192 + l]) * (1.f / 512.f) + EPS);
        const size_t row = (size_t)b * SEQ + c * 64 + l;
#pragma unroll
        for (int g = 0; g < 2; ++g)
#pragma unroll
            for (int pt = 0; pt < 4; ++pt) { const int ch = (4 * g + hl) * 64 + 16 * pt + 4 * fq;
                const u32x2 pk = ypk[li][g][pt]; const f32x4 r = (f32x4){bf_lo(pk.x), bf_hi(pk.x), bf_lo(pk.y), bf_hi(pk.y)};
                *(GAS u32x2*)(P + pidx(row, C_MZ + ch)) = pack4(r * rstd * ngv[g][pt]); } }
}

__device__ __forceinline__ void scan_phase(const Frame& F, bf16_t* RST, bf16_t* SST, const float* CD) {
    for (int task = F.bid * NTHR + F.tid; task < 131072; task += F.G * NTHR) {
        {
          const int pr = task & 8191, bh = task >> 13, b = bh >> 2, h = bh & 3;
          GAS unsigned* p = (GAS unsigned*)(RST + (size_t)((b * 128) * 4 + h) * 16384) + pr;
          const float dec = __builtin_amdgcn_exp2f(64.f * log2gamma(h));
          float s0 = 0.f, s1 = 0.f;
#pragma unroll 1
          for (int c0 = 0; c0 < 128; c0 += 32) { unsigned v[32];
#pragma unroll
              for (int i = 0; i < 32; ++i) v[i] = p[(size_t)(c0 + i) * 32768];
#pragma unroll
              for (int i = 0; i < 32; ++i) { p[(size_t)(c0 + i) * 32768] = cvt_pk_bf16(s0, s1); s0 = s0 * dec + bf_lo(v[i]); s1 = s1 * dec + bf_hi(v[i]); } } }
        {
          const int pr = task & 4095, bh = task >> 12, b = bh >> 3, hd = bh & 7;
          GAS unsigned* p = (GAS unsigned*)(SST + (size_t)((b * 128) * 8 + hd) * 8192) + pr;
          const GAS float* cd = (const GAS float*)(CD + (b * 128) * 8 + hd);
          float s0 = 0.f, s1 = 0.f;
#pragma unroll 1
          for (int c0 = 0; c0 < 128; c0 += 32) { unsigned v[32]; float d[32];
#pragma unroll
              for (int i = 0; i < 32; ++i) { v[i] = p[(size_t)(c0 + i) * 32768]; d[i] = cd[(c0 + i) * 8]; }
#pragma unroll
              for (int i = 0; i < 32; ++i) { p[(size_t)(c0 + i) * 32768] = cvt_pk_bf16(s0, s1); s0 = s0 * d[i] + bf_lo(v[i]); s1 = s1 * d[i] + bf_hi(v[i]); } } }
    }
}


#define XB_TMO      128
#define XB_XCNT(j)  (256  + 64 * (j))
#define XB_XSUB(j)  (1280 + 64 * (j))
#define XB_XGEN(j)  (2304 + 64 * (j))
#define XB_TOP      3328
#define XB_TOPGEN   3392
#define XB_SPIN_CAP (1u << 22)
__device__ __forceinline__ unsigned xb_ld(unsigned* p)              { return __hip_atomic_load(p, __ATOMIC_RELAXED, __HIP_MEMORY_SCOPE_AGENT); }
__device__ __forceinline__ unsigned xb_add(unsigned* p, unsigned v) { return __hip_atomic_fetch_add(p, v, __ATOMIC_RELAXED, __HIP_MEMORY_SCOPE_AGENT); }
__device__ __forceinline__ unsigned xb_xcc_id() { return (unsigned)__builtin_amdgcn_s_getreg((3 << 11) | 20) & 0xFu; }
#define XB_SPIN(cond, bar) do { unsigned _sp = 0; while (cond) { __builtin_amdgcn_s_sleep(1); \
    if ((++_sp & 255u) == 0u) { if (xb_ld(&(bar)[XB_TMO])) break; if (_sp > XB_SPIN_CAP) { atomicAdd(&(bar)[XB_TMO], 1u); break; } } } } while (0)
struct XcdBarrier { unsigned* bar; unsigned x; volatile LAS unsigned* st; };
__device__ __forceinline__ XcdBarrier xcd_barrier_post(unsigned* bar, volatile LAS unsigned* st) {
    XcdBarrier b; b.bar = bar; b.x = xb_xcc_id(); b.st = st;
    if (threadIdx.x == 0) (void)xb_add(&bar[XB_XCNT(b.x)], 1u);
    return b;
}
__device__ __forceinline__ void xcd_barrier_complete(unsigned* bar, unsigned x, unsigned& nloc, unsigned& nx) {
    const unsigned G = gridDim.x * gridDim.y * gridDim.z;
    unsigned sum, cnt, mine, sp = 0u;
    for (;;) {
        sum = 0u; cnt = 0u; mine = 0u;
#pragma unroll
        for (unsigned j = 0; j < 16; ++j) { const unsigned c = xb_ld(&bar[XB_XCNT(j)]); sum += c; cnt += (c > 0u) ? 1u : 0u; mine = (j == x) ? c : mine; }
        if (sum == G) break;
        __builtin_amdgcn_s_sleep(1);
        if ((++sp & 255u) == 0u) { if (xb_ld(&bar[XB_TMO])) break; if (sp > XB_SPIN_CAP) { atomicAdd(&bar[XB_TMO], 1u); break; } }
    }
    nloc = mine > 0u ? mine : 1u; nx = cnt > 0u ? cnt : 1u;
}
__device__ __forceinline__ void xcd_barrier(const XcdBarrier& b) {
    asm volatile("s_waitcnt vmcnt(0)" ::: "memory");
    __syncthreads();
    if (threadIdx.x == 0) {
        unsigned* bar = b.bar;
        __builtin_amdgcn_s_waitcnt(0);
        unsigned nloc = b.st[0], nx = b.st[1];
        if (nloc == 0u) { xcd_barrier_complete(bar, b.x, nloc, nx); b.st[0] = nloc; b.st[1] = nx; }
        const unsigned old = xb_add(&bar[XB_XSUB(b.x)], 1u);
        const unsigned gen = old / nloc;
        if (old + 1u == (gen + 1u) * nloc) {
            __builtin_amdgcn_fence(__ATOMIC_RELEASE, "agent");
            asm volatile("s_waitcnt vmcnt(0)" ::: "memory");
            const unsigned og = xb_add(&bar[XB_TOP], 1u);
            const unsigned tg = og / nx;
            if (og + 1u == (tg + 1u) * nx) xb_add(&bar[XB_TOPGEN], 1u);
            else XB_SPIN(xb_ld(&bar[XB_TOPGEN]) == tg, bar);
            __builtin_amdgcn_fence(__ATOMIC_ACQUIRE, "agent");
            xb_add(&bar[XB_XGEN(b.x)], 1u);
            asm volatile("s_waitcnt vmcnt(0)" ::: "memory");
        } else {
            XB_SPIN(xb_ld(&bar[XB_XGEN(b.x)]) == gen, bar);
            __builtin_amdgcn_fence(__ATOMIC_ACQUIRE, "agent");
            asm volatile("s_waitcnt vmcnt(0)" ::: "memory");
        }
    }
    __syncthreads();
}

__device__ __forceinline__ void final_phase(const Frame& F, const bf16_t* hb, float* out, const float* gain, const float* fmod, const XcdBarrier& xbar) {
    const int gw = F.bid * NWAVE + F.wave, NGW = F.G * NWAVE;
    u32x2 hv[16][4];
#pragma unroll
    for (int r = 0; r < 16; ++r) { const int m = gw + r * NGW; const int mm = m < T_TOK ? m : gw;
        const GAS u32x2* xr = (const GAS u32x2*)(hb + (size_t)mm * DM) + F.lane;
#pragma unroll
        for (int j = 0; j < 4; ++j) hv[r][j] = xr[64 * j]; }
    xcd_barrier(xbar);
    f32x4 gp[4], shv[4]; int bcur = -1;
#pragma unroll
    for (int r = 0; r < 16; ++r) { const int m = gw + r * NGW; if (m < T_TOK) {
        const int b = m >> 13; f32x4 v[4]; float s = 0.f;
        if (b != bcur) { bcur = b;
#pragma unroll
            for (int j = 0; j < 4; ++j) { const f32x4 g = ((const GAS f32x4*)gain)[F.lane + 64 * j], sc = ((const GAS f32x4*)(fmod + (size_t)b * 2048 + 1024))[F.lane + 64 * j];
                gp[j] = g * (sc + 1.0f); shv[j] = ((const GAS f32x4*)(fmod + (size_t)b * 2048))[F.lane + 64 * j]; } }
#pragma unroll
        for (int j = 0; j < 4; ++j) { const u32x2 t = hv[r][j]; v[j] = (f32x4){bf_lo(t.x), bf_hi(t.x), bf_lo(t.y), bf_hi(t.y)};
            s += (v[j].x * v[j].x + v[j].y * v[j].y) + (v[j].z * v[j].z + v[j].w * v[j].w); }
        const float rstd = rsqrtf(wave_sum(s) * (1.f / DM) + EPS);
        GAS f32x4* xo = (GAS f32x4*)(out + (size_t)m * DM) + F.lane;
#pragma unroll
        for (int j = 0; j < 4; ++j) xo[64 * j] = v[j] * rstd * gp[j] + shv[j]; } }
}

constexpr int NPH = 26;
__global__ void __launch_bounds__(NTHR, 2) fwd_kernel(Params p) {
    extern __shared__ __attribute__((aligned(16))) unsigned char lds_raw[];
    volatile LAS unsigned* xb_st = (volatile LAS unsigned*)((LAS unsigned char*)lds_raw + LDS_BYTES - 64);
    if (threadIdx.x == 0) { xb_st[0] = 0u; xb_st[1] = 0u; }
    __syncthreads();
    const XcdBarrier xbar = xcd_barrier_post((unsigned*)p.ws, xb_st);
    if (p.ph_lo == 0) {
        Frame F0; F0.lds = (LAS unsigned char*)lds_raw; F0.tid = threadIdx.x; F0.lane = F0.tid & 63; F0.wave = __builtin_amdgcn_readfirstlane(F0.tid >> 6); F0.G = gridDim.x; F0.bid = blockIdx.x;
        if (EN_PRO) prologue(F0, p, as_global(p.ws), 0);
        if (p.ph_hi > 1) cg::this_grid().sync();
    }
#ifdef TPROBE
    unsigned long long tA = 0, tB = 0;
#endif
    for (int ph_ = (p.ph_lo < 1 ? 1 : p.ph_lo); ph_ < p.ph_hi; ++ph_) {
#ifdef TPROBE
    const unsigned long long tp0 = __builtin_amdgcn_s_memrealtime();
#endif
    int ph = __builtin_amdgcn_readfirstlane(ph_);
#ifdef PH_LIMIT
    if (ph > PH_LIMIT && ph < NPH - 1) continue;
#endif
    int tid_ = threadIdx.x; asm volatile("" : "+v"(tid_));
    unsigned char* ws_ = p.ws; asm volatile("" : "+s"(ws_)); unsigned char* ws = as_global(ws_);
    int zi = 0; asm volatile("" : "+s"(zi));
    Frame F;
    F.lds = (LAS unsigned char*)lds_raw;
    F.tid = tid_; F.lane = F.tid & 63; F.wave = __builtin_amdgcn_readfirstlane(F.tid >> 6); { int g_ = gridDim.x, b_ = blockIdx.x; asm volatile("" : "+s"(g_), "+s"(b_)); F.G = g_; F.bid = b_; }
    float* MOD = (float*)(ws + WS_MOD);
    const f32x2* ROPE = (const f32x2*)(ws + WS_ROPE);
    float* DT = (float*)(ws + WS_DT);
    float* CD = (float*)(ws + WS_CD);
    bf16_t* WFU = (bf16_t*)(ws + WS_WFU); bf16_t* WFD = (bf16_t*)(ws + WS_WFD); bf16_t* WIN = (bf16_t*)(ws + WS_WIN); bf16_t* WOUT = (bf16_t*)(ws + WS_WOUT);
    bf16_t* U = (bf16_t*)(ws + WS_U); bf16_t* RST = (bf16_t*)(ws + WS_RST); bf16_t* SST = (bf16_t*)(ws + WS_SST);
    bf16_t* PROJ = (bf16_t*)(ws + WS_PROJ); bf16_t* HID = PROJ;
    float* hbuf_ = p.out; asm volatile("" : "+s"(hbuf_)); float* hbuf = as_global(hbuf_);
    bf16_t* HB = (bf16_t*)((unsigned char*)hbuf + 64 * MiB);
        if (ph == NPH - 1) {
            if (EN_FIN) final_phase(F, HB, hbuf, as_global(p.in[24 + zi]), MOD + FMOD_OFF, xbar);
        } else {
#ifdef XTRA_LIST
            static constexpr int xtra[] = XTRA_LIST;
            const int l = (ph >= NPH) ? 1 : (ph - 1) / 12, j = (ph >= NPH) ? xtra[ph - NPH] : (ph - 1) % 12;
#else
            const int l = (ph - 1) / 12, j = (ph - 1) % 12;
#endif
            const float* modl = MOD + (size_t)l * 4 * 9216;
            if (j == 0 || j == 3 || j == 9) {
                const float* hin = (l == 0 && j == 0) ? as_global(p.in[0 + zi]) : nullptr;
                const int gi = (j == 0) ? 4 : (j == 3) ? 8 : 18;
                const int mi = (j == 0) ? 0 : (j == 3) ? 3 : 6;
                if (EN_NORM) norm_phase(F, hin, HB, as_global(p.in[gi + zi]) + l * DM, modl + mi * 1024, modl + (mi + 1) * 1024, 9216, U);
                __syncthreads();
                if (!EN_CONV) {} else if (j == 0) convert_ffn(F, as_global(p.in[5 + zi]) + (size_t)l * DM * DFF, as_global(p.in[6 + zi]) + (size_t)l * DM * DFF, as_global(p.in[7 + zi]) + (size_t)l * DM * DFF, WFU, WFD);
                else if (j == 9) convert_ffn(F, as_global(p.in[19 + zi]) + (size_t)l * DM * DFF, as_global(p.in[20 + zi]) + (size_t)l * DM * DFF, as_global(p.in[21 + zi]) + (size_t)l * DM * DFF, WFU, WFD);
                else convert_mix(F, as_global(p.in[9 + zi]) + (size_t)l * DM * INW, as_global(p.in[17 + zi]) + (size_t)l * 1536 * DM, WIN, WOUT);
            } else if (j == 1 || j == 10) {
                pg8::Gemm g{U, WFU, T_TOK, 2 * DFF, DM, DM}; pg8::StaticOrder S; S.init(T_TOK, 2 * DFF, F.G, F.bid);
                pg8::EpiSwiGLU E{HID, DFF};
                if (EN_G1) pg8::gemm_phase<pg8::EpiSwiGLU>(F.lds, F.tid, g, S, E);
            } else if (j == 2 || j == 11 || j == 8) {
                pg8::Gemm g; pg8::EpiResid E;
                if (j == 8) { g = pg8::Gemm{PROJ, WOUT, T_TOK, DM, 1536, PW}; E = pg8::EpiResid{HB, modl + 5 * 1024, 1.0f}; }
                else { g = pg8::Gemm{HID, WFD, T_TOK, DM, DFF, DFF}; E = pg8::EpiResid{HB, modl + (j == 2 ? 2 : 8) * 1024, 0.5f}; }
                pg8::StaticOrder S; S.init(T_TOK, DM, F.G, F.bid);
                if (EN_G2) { if (j == 8) pg8::gemm_phase<pg8::EpiResid, true>(F.lds, F.tid, g, S, E); else pg8::gemm_phase<pg8::EpiResid, false>(F.lds, F.tid, g, S, E); }
            } else if (j == 4) {
                pg8::Gemm g{U, WIN, T_TOK, PW, DM, DM}; pg8::StaticOrder S; S.init(T_TOK, PW, F.G, F.bid);
                pg8::EpiBf16 E{PROJ, PW};
                if (EN_G3) pg8::gemm_phase<pg8::EpiBf16>(F.lds, F.tid, g, S, E);
                if (EN_DT) dt_gemv(F, U, as_global(p.in[9 + zi]) + (size_t)l * DM * INW, DT);
            } else if (j == 5) {
                if (EN_SB && XS(1)) for (int t = F.bid; t < 1024; t += F.G) { const int qb = 63 - (t >> 4), bh = t & 15; sb_task(F, PROJ, bh >> 2, bh & 3, qb); }
                if (EN_RKV && XS(2)) { f32x4 kcs[4] = {}; int ccur = -1; const bool fm = (F.G * 8 == 2048);
                    for (int i = 0, t = F.bid; t < 2048; t += F.G, ++i) {
                        const int c = fm ? (F.bid >> 1) : ((t >> 2) & 127), bh = fm ? ((F.bid & 1) * 8 + i) : (((t >> 2) >> 7) * 4 + (t & 3));
                        ret_kv_task(F, PROJ, ROPE, RST, bh >> 2, c, bh & 3, kcs, c != ccur); ccur = c; } }
                if (EN_SST && XS(4)) for (int t = F.bid; t < 1024; t += F.G) { const int g = t & 1, bc = t >> 1;
                    ssd_state_task(F, PROJ, DT, as_global(p.in[10 + zi]) + l * 4096, as_global(p.in[11 + zi]) + l * 1024, as_global(p.in[12 + zi]) + l * 8, as_global(p.in[13 + zi]) + l * 8, SST, CD, bc >> 7, bc & 127, g); }
            } else if (j == 6) {
                if (EN_SCAN) scan_phase(F, RST, SST, CD);
            } else if (j == 7) {
                if (EN_ROUT && XS(8)) { f32x4 kcs[4] = {}, qcs[2][4] = {}; int ccur = -1; const bool fm = (F.G * 8 == 2048); const float* gnp = as_global(p.in[15 + zi]) + l * 512;
                    for (int i = 0, t = F.bid; t < 2048; t += F.G, ++i) {
                        const int c = fm ? (F.bid >> 1) : ((t >> 2) & 127), bh = fm ? ((F.bid & 1) * 8 + i) : (((t >> 2) >> 7) * 4 + (t & 3));
                        ret_out_task(F, PROJ, ROPE, RST, gnp, bh >> 2, c, bh & 3, kcs, qcs, c != ccur); ccur = c; } }
                if (EN_SOUT && XS(16)) for (int t = F.bid; t < 512; t += F.G) {
                    ssd_out_task(F, PROJ, DT, as_global(p.in[10 + zi]) + l * 4096, as_global(p.in[11 + zi]) + l * 1024, as_global(p.in[12 + zi]) + l * 8, as_global(p.in[13 + zi]) + l * 8, as_global(p.in[14 + zi]) + l * 8, as_global(p.in[16 + zi]) + l * 512, SST, t >> 7, t & 127); }
            }
        }
        if (ph + 1 < p.ph_hi) { xcd_barrier(xbar); }
#ifdef TPROBE
        { const unsigned long long tp1 = __builtin_amdgcn_s_memrealtime(); const int jj = (ph - 1) % 12;
          if (ph < NPH - 1) { if (TPROBE_A(jj)) tA += tp1 - tp0; if (TPROBE_B(jj)) tB += tp1 - tp0; } }
#endif
    }
#ifdef TPROBE
    cg::this_grid().sync();
    if (blockIdx.x == 0) { const float a = (float)tA * 0.01f, b = (float)tB * 0.01f * TPROBE_BS;
        if (threadIdx.x == 0) p.out[0] += a;
        for (int i = threadIdx.x; i < (1 << 20); i += NTHR) p.out[1024 + i] += b; }
#endif
}

extern "C" void kernel_launch(void* const* d_in, const int* in_sizes, int n_in, void* d_out, int out_size, void* d_ws, size_t ws_size, hipStream_t stream) {
    static int grid = 0;
    if (grid == 0) {
        if (n_in != 25 || out_size != T_TOK * DM || ws_size < WS_END) { fprintf(stderr, "kernel_launch: unexpected shapes (n_in %d out %d ws %zu)\n", n_in, out_size, ws_size); grid = -1; return; }
        int dev = 0, cus = 0, per_cu = 0;
        hipGetDevice(&dev);
        hipDeviceGetAttribute(&cus, hipDeviceAttributeMultiprocessorCount, dev);
        hipFuncSetAttribute((const void*)fwd_kernel, hipFuncAttributeMaxDynamicSharedMemorySize, LDS_BYTES);
        hipOccupancyMaxActiveBlocksPerMultiprocessor(&per_cu, (const void*)fwd_kernel, NTHR, LDS_BYTES);
        if (per_cu < 1) per_cu = 1;
        (void)hipGetLastError();
        grid = cus * per_cu;
    }
    if (grid < 0) return;
    (void)hipMemsetAsync(d_ws, 0, 65536, stream);
    Params p{};
    for (int i = 0; i < 25; ++i) p.in[i] = (const float*)d_in[i];
    p.out = (float*)d_out; p.ws = (unsigned char*)d_ws;
#if ONE_LAUNCH
#ifdef XTRA_LIST
    p.ph_lo = 0; p.ph_hi = NPH + XTRA_N;
#else
    p.ph_lo = 0; p.ph_hi = NPH;
#endif
    void* args[] = {&p};
    hipError_t e = hipLaunchCooperativeKernel((const void*)fwd_kernel, dim3(grid), dim3(NTHR), args, LDS_BYTES, stream);
    if (e != hipSuccess) fprintf(stderr, "cooperative launch failed: %s (grid %d)\n", hipGetErrorString(e), grid);
#else
    for (int ph = 0; ph < NPH; ++ph) { p.ph_lo = ph; p.ph_hi = ph + 1; hipLaunchKernelGGL(fwd_kernel, dim3(grid), dim3(NTHR), LDS_BYTES, stream, p); }
#endif
}
```

```cpp
#include <hip/hip_runtime.h>
#include <hip/hip_cooperative_groups.h>
#include <cstdint>
#include <cstdio>
namespace cg = cooperative_groups;

#ifndef ONE_LAUNCH
#define ONE_LAUNCH 1
#endif

#ifndef EN_ALL
#define EN_ALL 1
#endif
#ifndef EN_PRO
#define EN_PRO EN_ALL
#endif
#ifndef EN_FIN
#define EN_FIN EN_ALL
#endif
#ifndef EN_NORM
#define EN_NORM EN_ALL
#endif
#ifndef EN_CONV
#define EN_CONV EN_ALL
#endif
#ifndef EN_G1
#define EN_G1 EN_ALL
#endif
#ifndef EN_G2
#define EN_G2 EN_ALL
#endif
#ifndef EN_G3
#define EN_G3 EN_ALL
#endif
#ifndef EN_DT
#define EN_DT EN_ALL
#endif
#ifndef EN_SB
#define EN_SB EN_ALL
#endif
#ifndef EN_RKV
#define EN_RKV EN_ALL
#endif
#ifndef EN_SST
#define EN_SST EN_ALL
#endif
#ifndef EN_SCAN
#define EN_SCAN EN_ALL
#endif
#ifndef EN_ROUT
#define EN_ROUT EN_ALL
#endif
#ifndef EN_SOUT
#define EN_SOUT EN_ALL
#endif
#ifndef EN_SINTER
#define EN_SINTER 1
#endif
#ifndef XSEL
#define XSEL 31
#endif
#define XS(m) (ph < NPH || (XSEL & (m)))
#ifndef XMODE
#define XMODE 0
#endif
#define LAS __attribute__((address_space(3)))
#define GAS __attribute__((address_space(1)))
template <class T> __device__ __forceinline__ T* as_global(T* p) {
#if defined(__HIP_DEVICE_COMPILE__)
    __builtin_assume(!__builtin_amdgcn_is_shared((const void*)p)); __builtin_assume(!__builtin_amdgcn_is_private((const void*)p));
#endif
    return p; }
typedef unsigned short bf16_t;
typedef short bf16x8 __attribute__((ext_vector_type(8)));
typedef float f32x4 __attribute__((ext_vector_type(4)));
typedef float f32x2 __attribute__((ext_vector_type(2)));
typedef unsigned u32x4 __attribute__((ext_vector_type(4)));
typedef unsigned u32x2 __attribute__((ext_vector_type(2)));

constexpr int T_TOK = 32768, SEQ = 8192, DM = 1024, DFF = 2816, INW = 5128, PW = 5120;
constexpr int NTHR = 512, NWAVE = 8;
constexpr float EPS = 1e-6f;
constexpr int C_RQ = 0, C_SQ = 512, C_MZ = 1024, C_RK = 1536, C_RV = 2048, C_RG = 2560, C_SK = 3072, C_SV = 3584, C_XBC = 4096;

constexpr size_t MiB = 1u << 20;
constexpr size_t WS_MOD = 1 * MiB, WS_ROPE = 2 * MiB, WS_DT = 6 * MiB, WS_CD = 7 * MiB;
constexpr size_t WS_WFU = 8 * MiB, WS_WFD = 19 * MiB, WS_WIN = 25 * MiB, WS_WOUT = 35 * MiB;
constexpr size_t WS_U = 38 * MiB, WS_RST = 38 * MiB, WS_SST = 102 * MiB, WS_PROJ = 166 * MiB, WS_END = 486 * MiB;
constexpr int FMOD_OFF = 2 * 4 * 9 * 1024;

constexpr size_t PLANE = (size_t)T_TOK * 128;
__device__ __forceinline__ size_t pidx(size_t row, int col) { return (size_t)(col >> 7) * PLANE + row * 128 + (col & 127); }
constexpr int LDS_BYTES = 147456;

struct Params {
    const float* in[25];
    float* out;
    unsigned char* ws;
    int ph_lo, ph_hi;
};

typedef __bf16 bf16x2_t __attribute__((ext_vector_type(2)));
__device__ __forceinline__ unsigned cvt_pk_bf16(float lo, float hi) { const f32x2 v = {lo, hi}; const bf16x2_t b = __builtin_convertvector(v, bf16x2_t); return __builtin_bit_cast(unsigned, b); }
__device__ __forceinline__ float bf_lo(unsigned u) { return __uint_as_float(u << 16); }
__device__ __forceinline__ float bf_hi(unsigned u) { return __uint_as_float(u & 0xffff0000u); }
__device__ __forceinline__ float bf2f(bf16_t x) { return __uint_as_float(((unsigned)x) << 16); }
__device__ __forceinline__ bf16_t f2bf(float f) { return (bf16_t)(cvt_pk_bf16(f, 0.f) & 0xffffu); }
__device__ __forceinline__ float wave_sum(float v) {
#pragma unroll
    for (int o = 1; o < 64; o <<= 1) v += __shfl_xor(v, o);
    return v;
}
__device__ __forceinline__ float wave_max(float v) {
#pragma unroll
    for (int o = 1; o < 64; o <<= 1) v = fmaxf(v, __shfl_xor(v, o));
    return v;
}
__device__ __forceinline__ void lds_barrier() { asm volatile("s_waitcnt lgkmcnt(0)" ::: "memory"); __builtin_amdgcn_s_barrier(); asm volatile("" ::: "memory"); }
__device__ __forceinline__ float silu_f(float g) { return g * __builtin_amdgcn_rcpf(1.0f + __builtin_amdgcn_exp2f(-1.44269504f * g)); }
__device__ __forceinline__ f32x4 mfma16(bf16x8 a, bf16x8 b, f32x4 c) { return __builtin_amdgcn_mfma_f32_16x16x32_bf16(a, b, c, 0, 0, 0); }
__device__ __forceinline__ bf16x8 ldsfrag(const LAS unsigned char* p) { return *(const LAS bf16x8*)p; }
__device__ __forceinline__ u32x2 pack4(f32x4 v) { u32x2 w; w.x = cvt_pk_bf16(v[0], v[1]); w.y = cvt_pk_bf16(v[2], v[3]); return w; }
__device__ __forceinline__ void unpack8(u32x4 v, float* f) {
    f[0] = bf_lo(v.x); f[1] = bf_hi(v.x); f[2] = bf_lo(v.y); f[3] = bf_hi(v.y); f[4] = bf_lo(v.z); f[5] = bf_hi(v.z); f[6] = bf_lo(v.w); f[7] = bf_hi(v.w);
}
__device__ __forceinline__ float log2gamma(int h) { return h == 0 ? -0.04580368961312479f : (h == 1 ? -0.02272007650008353f : (h == 2 ? -0.011315313227834146f : -0.005646563141142063f)); }

namespace pg8 {
constexpr int BM = 256, BK = 64, HALF = 128, HTB = HALF * BK * 2, STAGE_BYTES = 8 * HTB, NXCD = 8, WGM = 8;
__host__ __device__ __forceinline__ int lds_byte(int r, int c) { const int st = (r >> 4) * 2 + (c >> 5), rr = r & 15, cc = c & 31, ob = rr * 64 + cc * 2; return st * 1024 + (ob ^ (((ob >> 9) & 1) << 5)); }
__host__ __device__ __forceinline__ void stage_rc(int b, int& R, int& C) { const int st = b / 1024, sb = b % 1024, swz = sb ^ (((sb >> 9) & 1) << 5); R = (st >> 1) * 16 + swz / 64; C = (st & 1) * 32 + (swz % 64) / 2; }
__host__ __device__ __forceinline__ int perm32(int rho) { const int n = rho >> 4, i = rho & 15; return 8 * (i >> 2) + 4 * n + (i & 3); }
struct Unit { int pm, pn; };
struct Gemm { const bf16_t* A; const bf16_t* Bt; int M, N, K, lda; };
struct StaticOrder {
    int nM, nN, nwg, G, c;
    __device__ void init(int M, int N, int G_, int c_) { nM = M / BM; nN = N / BM; nwg = nM * nN; G = G_; c = c_; }
    __device__ bool next(int i, Unit& u) const {
        const long L = (long)i * G + c; if (L >= nwg) return false;
        int wgid = (int)L; { const int q = nwg / NXCD, r = nwg % NXCD, xcd = wgid % NXCD, off = wgid / NXCD; wgid = (xcd < r ? xcd * (q + 1) : r * (q + 1) + (xcd - r) * q) + off; }
        const int nig = WGM * nN, gid = wgid / nig, fm = gid * WGM, gsz = (nM - fm) < WGM ? (nM - fm) : WGM;
        u.pm = fm + ((wgid % nig) % gsz); u.pn = (wgid % nig) / gsz; return true;
    }
};
struct EpiBf16 {
    bf16_t* O; int ldc;
    __device__ __forceinline__ void operator()(const f32x4 (&acc)[2][2][4][2], const Unit& u, int wr, int wc, int fr, int fq) const {
        const int row0 = u.pm * BM + wr * 64 + fr, col0 = u.pn * BM + wc * 32 + 8 * fq;
#pragma unroll
        for (int ai = 0; ai < 2; ++ai)
#pragma unroll
            for (int m = 0; m < 4; ++m) { bf16_t* rowp = O + (size_t)(2 * u.pn) * PLANE + (size_t)(row0 + ai * HALF + m * 16) * 128 + wc * 32 + 8 * fq;
#pragma unroll
                for (int bj = 0; bj < 2; ++bj) { const f32x4 v0 = acc[ai][bj][m][0], v1 = acc[ai][bj][m][1];
                    u32x4 w; w.x = cvt_pk_bf16(v0[0], v0[1]); w.y = cvt_pk_bf16(v0[2], v0[3]); w.z = cvt_pk_bf16(v1[0], v1[1]); w.w = cvt_pk_bf16(v1[2], v1[3]);
                    *(GAS u32x4*)(rowp + bj * PLANE) = w; } }
    }
};
struct EpiSwiGLU {
    bf16_t* O; int ldo;
    __device__ __forceinline__ void operator()(const f32x4 (&acc)[2][2][4][2], const Unit& u, int wr, int wc, int fr, int fq) const {
        const int row0 = u.pm * BM + wr * 64 + fr, col0 = u.pn * HALF + wc * 32 + 8 * fq;
#pragma unroll
        for (int ai = 0; ai < 2; ++ai)
#pragma unroll
            for (int m = 0; m < 4; ++m) { bf16_t* rowp = O + (size_t)(row0 + ai * HALF + m * 16) * ldo + col0;
                float hv[8];
#pragma unroll
                for (int n = 0; n < 2; ++n)
#pragma unroll
                    for (int i = 0; i < 4; ++i) hv[4 * n + i] = silu_f(acc[ai][0][m][n][i]) * acc[ai][1][m][n][i];
                u32x4 w; w.x = cvt_pk_bf16(hv[0], hv[1]); w.y = cvt_pk_bf16(hv[2], hv[3]); w.z = cvt_pk_bf16(hv[4], hv[5]); w.w = cvt_pk_bf16(hv[6], hv[7]);
                *(GAS u32x4*)rowp = w; }
    }
};
struct EpiResid {
    bf16_t* hb; const float* gate; float cmul;
    __device__ __forceinline__ void operator()(const f32x4 (&acc)[2][2][4][2], const Unit& u, int wr, int wc, int fr, int fq) const {
        const int row0 = u.pm * BM + wr * 64 + fr, col0 = u.pn * BM + wc * 32 + 8 * fq;
        const int b = (u.pm * BM) >> 13;
        f32x4 gm[2][2];
#pragma unroll
        for (int bj = 0; bj < 2; ++bj)
#pragma unroll
            for (int n = 0; n < 2; ++n) { const f32x4 g = *(const GAS f32x4*)(gate + (size_t)b * 9216 + col0 + bj * HALF + 4 * n); gm[bj][n] = (g + 1.0f) * cmul; }
#pragma unroll
        for (int ai = 0; ai < 2; ++ai) {
            u32x4 hv[4][2];
#pragma unroll
            for (int m = 0; m < 4; ++m) { const size_t off = (size_t)(row0 + ai * HALF + m * 16) * DM + col0;
#pragma unroll
                for (int bj = 0; bj < 2; ++bj) hv[m][bj] = *(const GAS u32x4*)(hb + off + bj * HALF); }
#pragma unroll
            for (int m = 0; m < 4; ++m) { const size_t off = (size_t)(row0 + ai * HALF + m * 16) * DM + col0;
#pragma unroll
                for (int bj = 0; bj < 2; ++bj) { const u32x4 hh = hv[m][bj];
                    const f32x4 h0 = (f32x4){bf_lo(hh.x), bf_hi(hh.x), bf_lo(hh.y), bf_hi(hh.y)}, h1 = (f32x4){bf_lo(hh.z), bf_hi(hh.z), bf_lo(hh.w), bf_hi(hh.w)};
                    const f32x4 v0 = h0 + gm[bj][0] * acc[ai][bj][m][0], v1 = h1 + gm[bj][1] * acc[ai][bj][m][1];
                    u32x4 w; w.x = cvt_pk_bf16(v0[0], v0[1]); w.y = cvt_pk_bf16(v0[2], v0[3]); w.z = cvt_pk_bf16(v1[0], v1[1]); w.w = cvt_pk_bf16(v1[2], v1[3]);
                    *(GAS u32x4*)(hb + off + bj * HALF) = w; } }
        }
    }
};

template <class Epi, bool APL = false>
__device__ __forceinline__ void gemm_phase(LAS unsigned char* lds, const int tid, const Gemm g, const StaticOrder& S, const Epi& E) {
    const int wid = __builtin_amdgcn_readfirstlane(tid >> 6), lane = tid & 63, wr = wid >> 2, wc = wid & 3, fr = lane & 15, fq = lane >> 4;
    const int K = g.K, nt = K / BK, lda = g.lda;
    unsigned voffA[2], voffB[2];
#pragma unroll
    for (int i = 0; i < 2; ++i) { int R, C; stage_rc(tid * 16 + i * 8192, R, C); const int Rb = (R & ~31) + perm32(R & 31);
        voffA[i] = (unsigned)(R * (APL ? 128 : lda) + C) * 2u; voffB[i] = (unsigned)(Rb * K + C) * 2u; }
    const size_t kstep = (size_t)(BK * 2);
    const size_t hstepA = (size_t)HALF * (APL ? 128 : lda) * 2, hstepB = (size_t)HALF * K * 2;
#define PG8_KA(t) (APL ? ((size_t)((t) >> 1) * (PLANE * 2) + (size_t)((t) & 1) * 128) : (size_t)(t) * kstep)
    const size_t tstepA = 2 * hstepA, tstepB = 2 * hstepB;
    const unsigned ldsw = (unsigned)wid * 1024u;
    const int aoff = lds_byte(wr * 64 + fr, fq * 8), boff = lds_byte(wc * 32 + fr, fq * 8);
#define PG8_SA(b, h) (((b) * 2 + (h)) * HTB)
#define PG8_SB(b, h) ((4 + (b) * 2 + (h)) * HTB)
#define PG8_STAGE(bufoff, gbase, voff) do { _Pragma("unroll") for (int _i = 0; _i < 2; ++_i) \
        __builtin_amdgcn_global_load_lds((const unsigned*)((const char*)(gbase) + (voff)[_i]), (LAS unsigned*)(lds + (bufoff) + ldsw + _i * 8192), 16, 0, 0); } while (0)
#define PG8_LDA(dst, b, h) do { _Pragma("unroll") for (int m = 0; m < 4; ++m) _Pragma("unroll") for (int k = 0; k < 2; ++k) dst[m][k] = *(const LAS bf16x8*)(lds + PG8_SA(b, h) + aoff + m * 2048 + k * 1024); } while (0)
#define PG8_LDB(dst, b, h) do { _Pragma("unroll") for (int n = 0; n < 2; ++n) _Pragma("unroll") for (int k = 0; k < 2; ++k) dst[n][k] = *(const LAS bf16x8*)(lds + PG8_SB(b, h) + boff + n * 2048 + k * 1024); } while (0)
#define PG8_MMA(ai, bj, At, Bt) do { __builtin_amdgcn_s_setprio(1); _Pragma("unroll") for (int m = 0; m < 4; ++m) _Pragma("unroll") for (int n = 0; n < 2; ++n) _Pragma("unroll") for (int k = 0; k < 2; ++k) \
        acc[ai][bj][m][n] = __builtin_amdgcn_mfma_f32_16x16x32_bf16(Bt[n][k], At[m][k], acc[ai][bj][m][n], 0, 0, 0); __builtin_amdgcn_s_setprio(0); } while (0)
#define PG8_WAIT_V(n) asm volatile("s_waitcnt vmcnt(" #n ")" ::: "memory")
#define PG8_WAIT_L(n) asm volatile("s_waitcnt lgkmcnt(" #n ")" ::: "memory")
#define PG8_BAR __builtin_amdgcn_s_barrier()
#define PG8_SCHED __builtin_amdgcn_sched_barrier(0)
    Unit cur, nxt; int ui = 0;
    if (!S.next(0, cur)) return;
    f32x4 acc[2][2][4][2];
#pragma unroll
    for (int a = 0; a < 2; ++a)
#pragma unroll
        for (int b = 0; b < 2; ++b)
#pragma unroll
            for (int m = 0; m < 4; ++m)
#pragma unroll
                for (int n = 0; n < 2; ++n) acc[a][b][m][n] = (f32x4){0.f, 0.f, 0.f, 0.f};
    bf16x8 At[4][2], B0[2][2], B1[2][2];
    const char* cA = (const char*)g.A + (size_t)cur.pm * tstepA; const char* cB = (const char*)g.Bt + (size_t)cur.pn * tstepB;
    PG8_STAGE(PG8_SB(0, 0), cB, voffB); PG8_STAGE(PG8_SB(0, 1), cB + hstepB, voffB); PG8_STAGE(PG8_SA(0, 0), cA, voffA); PG8_STAGE(PG8_SA(0, 1), cA + hstepA, voffA);
    if (wr == 1) PG8_BAR;
    PG8_WAIT_V(2); PG8_BAR;
    PG8_STAGE(PG8_SB(1, 0), cB + kstep, voffB); PG8_STAGE(PG8_SA(1, 0), cA + PG8_KA(1), voffA); PG8_STAGE(PG8_SB(1, 1), cB + hstepB + kstep, voffB);
    PG8_WAIT_V(6); PG8_BAR;
    for (;;) {
        const bool has_next = S.next(ui + 1, nxt);
        const char* nA = has_next ? (const char*)g.A + (size_t)nxt.pm * tstepA : cA; const char* nB = has_next ? (const char*)g.Bt + (size_t)nxt.pn * tstepB : cB;
        for (int t = 0; t < nt; t += 2) {
            const bool last = (t == nt - 2);
            const char* a1 = cA + PG8_KA(t + 1);
            const char* a2 = last ? nA : cA + PG8_KA(t + 2); const char* b2 = last ? nB : cB + (size_t)(t + 2) * kstep;
            const char* a3 = last ? nA + PG8_KA(1) : cA + PG8_KA(t + 3); const char* b3 = b2 + kstep;
            PG8_LDB(B0, 0, 0); PG8_LDB(B1, 0, 1); PG8_SCHED; PG8_LDA(At, 0, 0); PG8_STAGE(PG8_SA(1, 1), a1 + hstepA, voffA);
            PG8_WAIT_V(8); PG8_WAIT_L(0); PG8_BAR; PG8_MMA(0, 0, At, B0); PG8_MMA(0, 1, At, B1); PG8_BAR; PG8_SCHED;
            PG8_LDA(At, 0, 1); PG8_STAGE(PG8_SB(0, 0), b2, voffB); PG8_STAGE(PG8_SB(0, 1), b2 + hstepB, voffB); PG8_STAGE(PG8_SA(0, 0), a2, voffA);
            PG8_WAIT_V(8); PG8_WAIT_L(0); PG8_BAR; PG8_MMA(1, 0, At, B0); PG8_MMA(1, 1, At, B1); PG8_BAR; PG8_SCHED;
            PG8_LDB(B0, 1, 0); PG8_LDB(B1, 1, 1); PG8_SCHED; PG8_LDA(At, 1, 0); PG8_STAGE(PG8_SA(0, 1), a2 + hstepA, voffA);
            PG8_WAIT_V(8); PG8_WAIT_L(0); PG8_BAR; PG8_MMA(0, 0, At, B0); PG8_MMA(0, 1, At, B1); PG8_BAR; PG8_SCHED;
            PG8_LDA(At, 1, 1); PG8_STAGE(PG8_SB(1, 0), b3, voffB); PG8_STAGE(PG8_SB(1, 1), b3 + hstepB, voffB); PG8_STAGE(PG8_SA(1, 0), a3, voffA);
            PG8_WAIT_V(8); PG8_WAIT_L(0); PG8_BAR; PG8_MMA(1, 0, At, B0); PG8_MMA(1, 1, At, B1); PG8_BAR; PG8_SCHED;
        }
        if (wr == 0) PG8_BAR;
        E(acc, cur, wr, wc, fr, fq);
        if (!has_next) break;
#pragma unroll
        for (int a = 0; a < 2; ++a)
#pragma unroll
            for (int b = 0; b < 2; ++b)
#pragma unroll
                for (int m = 0; m < 4; ++m)
#pragma unroll
                    for (int n = 0; n < 2; ++n) acc[a][b][m][n] = (f32x4){0.f, 0.f, 0.f, 0.f};
        cur = nxt; cA = nA; cB = nB; ++ui;
        if (wr == 1) PG8_BAR;
    }
    PG8_WAIT_V(0);
    PG8_BAR;
#undef PG8_KA
#undef PG8_SA
#undef PG8_SB
#undef PG8_STAGE
#undef PG8_LDA
#undef PG8_LDB
#undef PG8_MMA
#undef PG8_WAIT_V
#undef PG8_WAIT_L
#undef PG8_BAR
#undef PG8_SCHED
}
}

struct Frame {
    LAS unsigned char* lds;
    int tid, lane, wave, G, bid;
};

__device__ __forceinline__ void conv_item(const float* W, int Nsrc, int K, int src_col0, bf16_t* WT, int dst_row0, int k0, LAS float* scr, int lane) {
    (void)scr;
    const int kg = lane >> 3, ng = lane & 7;
    const float* src = W + (size_t)(k0 + 8 * kg) * Nsrc + src_col0 + 4 * ng;
    f32x4 wv[8];
#pragma unroll
    for (int kk = 0; kk < 8; ++kk) wv[kk] = *(const GAS f32x4*)(src + (size_t)kk * Nsrc);
    bf16_t* dst = WT + (size_t)(dst_row0 + 4 * ng) * K + k0 + 8 * kg;
#pragma unroll
    for (int c = 0; c < 4; ++c) { u32x4 o;
        o.x = cvt_pk_bf16(wv[0][c], wv[1][c]); o.y = cvt_pk_bf16(wv[2][c], wv[3][c]); o.z = cvt_pk_bf16(wv[4][c], wv[5][c]); o.w = cvt_pk_bf16(wv[6][c], wv[7][c]);
        *(GAS u32x4*)(dst + (size_t)c * K) = o; }
}
__device__ __forceinline__ void convert_ffn(const Frame& F, const float* wg, const float* wu, const float* wd, bf16_t* WFU, bf16_t* WFD) {
    LAS float* scr = (LAS float*)(F.lds + F.wave * 16384);
    const int gw = F.bid * NWAVE + F.wave, NGW = F.G * NWAVE;
    constexpr int I_U = 16 * 176, I_D = 44 * 32;
    for (int it = gw; it < I_U + I_D; it += NGW) {
        if (it < I_U) { const int kb = it / 176, nb = it % 176, r0 = nb * 32, pn = r0 >> 8, i0 = r0 & 255;
            conv_item(i0 < 128 ? wg : wu, DFF, DM, pn * 128 + (i0 & 127), WFU, r0, kb * 64, scr, F.lane); }
        else { const int r = it - I_U, kb = r / 32, nb = r % 32; conv_item(wd, DM, DFF, nb * 32, WFD, nb * 32, kb * 64, scr, F.lane); }
    }
}
__device__ __forceinline__ void convert_mix(const Frame& F, const float* w_in, const float* w_out, bf16_t* WIN, bf16_t* WOUT) {
    LAS float* scr = (LAS float*)(F.lds + F.wave * 16384);
    const int gw = F.bid * NWAVE + F.wave, NGW = F.G * NWAVE;
    constexpr int I_I = 16 * 160, I_O = 24 * 32;
    for (int it = gw; it < I_I + I_O; it += NGW) {
        if (it < I_I) { const int kb = it / 160, nb = it % 160, r0 = nb * 32, blk = r0 >> 9;
            const int sb = blk == 0 ? 0 : blk == 1 ? 4 : blk == 2 ? 7 : blk == 3 ? 1 : blk == 4 ? 2 : blk == 5 ? 3 : blk == 6 ? 5 : blk == 7 ? 6 : blk;
            conv_item(w_in, INW, DM, sb * 512 + (r0 & 511), WIN, r0, kb * 64, scr, F.lane); }
        else { const int r = it - I_I, kb = r / 32, nb = r % 32; conv_item(w_out, DM, 1536, nb * 32, WOUT, nb * 32, kb * 64, scr, F.lane); }
    }
}

__device__ __forceinline__ void sincos_d(double x, double& s, double& c) {
    const double k = rint(x * 0.63661977236758134308);
    double r = fma(-k, 1.57079632679489655800e+00, x); r = fma(-k, 6.12323399573676603587e-17, r);
    const double r2 = r * r;
    double sp = -7.6471637318198164759e-13; sp = sp * r2 + 1.6059043836821614599e-10; sp = sp * r2 - 2.5052108385441718775e-08; sp = sp * r2 + 2.7557319223985890653e-06;
    sp = sp * r2 - 1.9841269841269841270e-04; sp = sp * r2 + 8.3333333333333333333e-03; sp = sp * r2 - 1.6666666666666666667e-01; const double sn = r + r * r2 * sp;
    double cp = 4.7794773323873852974e-14; cp = cp * r2 - 1.1470745597729724714e-11; cp = cp * r2 + 2.0876756987868098979e-09; cp = cp * r2 - 2.7557319223985890653e-07;
    cp = cp * r2 + 2.4801587301587301587e-05; cp = cp * r2 - 1.3888888888888888889e-03; cp = cp * r2 + 4.1666666666666666667e-02; cp = cp * r2 - 0.5; const double cs = 1.0 + r2 * cp;
    const int q = ((int)k) & 3;
    s = (q == 0) ? sn : (q == 1) ? cs : (q == 2) ? -sn : -cs;
    c = (q == 0) ? cs : (q == 1) ? -sn : (q == 2) ? -cs : sn;
}
__device__ __forceinline__ void prologue(const Frame& F, const Params& p, unsigned char* ws, int zi) {
    LAS float* cs = (LAS float*)F.lds;
    LAS float* red = (LAS float*)(F.lds + 16384);
    const float* c = as_global(p.in[1 + zi]);
    for (int i = F.tid; i < 4096; i += NTHR) cs[i] = silu_f(c[i]);
    __syncthreads();
    float* MOD = (float*)(ws + WS_MOD);
    for (int task = F.bid; task < 320; task += F.G) {
        const float* W; const float* bias; int N, n0; float* dst; int dstride;
        if (task < 288) { const int l = task / 144, t = task % 144; W = as_global(p.in[2 + zi]) + (size_t)l * DM * 9216; bias = as_global(p.in[3 + zi]) + l * 9216; N = 9216; n0 = t * 64; dst = MOD + (size_t)l * 4 * 9216; dstride = 9216; }
        else { const int t = task - 288; W = as_global(p.in[22 + zi]); bias = as_global(p.in[23 + zi]); N = 2048; n0 = t * 64; dst = MOD + FMOD_OFF; dstride = 2048; }
        float a0 = 0.f, a1 = 0.f, a2 = 0.f, a3 = 0.f;
        const int kb = F.wave * 128;
#pragma unroll 32
        for (int k = 0; k < 128; ++k) { const float w = ((const GAS float*)W)[(size_t)(kb + k) * N + n0 + F.lane];
            a0 += cs[kb + k] * w; a1 += cs[1024 + kb + k] * w; a2 += cs[2048 + kb + k] * w; a3 += cs[3072 + kb + k] * w; }
        red[(F.wave * 4 + 0) * 64 + F.lane] = a0; red[(F.wave * 4 + 1) * 64 + F.lane] = a1; red[(F.wave * 4 + 2) * 64 + F.lane] = a2; red[(F.wave * 4 + 3) * 64 + F.lane] = a3;
        __syncthreads();
        if (F.tid < 256) { const int b = F.tid >> 6, col = F.tid & 63; float s = bias[n0 + col];
#pragma unroll
            for (int w = 0; w < 8; ++w) s += red[(w * 4 + b) * 64 + col];
            dst[(size_t)b * dstride + n0 + col] = s; }
        __syncthreads();
    }
    f32x2* ROPE = (f32x2*)(ws + WS_ROPE);
    for (int idx = F.bid * NTHR + F.tid; idx < SEQ * 64; idx += F.G * NTHR) {
        const int pos = idx >> 6, i = idx & 63;
        const float invf = (float)exp(-(double)i * (9.210340371976184 / 64.0));
        const float ang = (float)pos * invf;
        double s, cc; sincos_d((double)ang, s, cc);
        ROPE[idx] = (f32x2){(float)cc, (float)s};
    }
}

__device__ __forceinline__ void norm_phase(const Frame& F, const float* xin, bf16_t* hb, const float* gain, const float* shift0, const float* scale0, int bstride, bf16_t* U) {
    const int gw = F.bid * NWAVE + F.wave, NGW = F.G * NWAVE;
    for (int m0 = gw; m0 < T_TOK; m0 += 4 * NGW) {
        f32x4 v[4][4];
#pragma unroll
        for (int r = 0; r < 4; ++r) { const int m = m0 + r * NGW; if (m < T_TOK) {
            if (xin != nullptr) { const GAS f32x4* xr = (const GAS f32x4*)(xin + (size_t)m * DM) + F.lane; GAS u32x2* hs = (GAS u32x2*)(hb + (size_t)m * DM) + F.lane;
#pragma unroll
                for (int j = 0; j < 4; ++j) { v[r][j] = xr[64 * j]; hs[64 * j] = pack4(v[r][j]); } }
            else { const GAS u32x2* xr = (const GAS u32x2*)(hb + (size_t)m * DM) + F.lane;
#pragma unroll
                for (int j = 0; j < 4; ++j) { const u32x2 t = xr[64 * j]; v[r][j] = (f32x4){bf_lo(t.x), bf_hi(t.x), bf_lo(t.y), bf_hi(t.y)}; } } } }
        const bool same_b = (4 * NGW == SEQ);
        f32x4 gp[4], shv[4];
        if (same_b) { const int b0 = m0 >> 13;
#pragma unroll
            for (int j = 0; j < 4; ++j) { const f32x4 g = ((const GAS f32x4*)gain)[F.lane + 64 * j], sc = ((const GAS f32x4*)(scale0 + (size_t)b0 * bstride))[F.lane + 64 * j];
                gp[j] = g * (sc + 1.0f); shv[j] = ((const GAS f32x4*)(shift0 + (size_t)b0 * bstride))[F.lane + 64 * j]; } }
#pragma unroll
        for (int r = 0; r < 4; ++r) { const int m = m0 + r * NGW; if (m < T_TOK) {
            const int b = m >> 13; float s = 0.f;
#pragma unroll
            for (int j = 0; j < 4; ++j) s += (v[r][j].x * v[r][j].x + v[r][j].y * v[r][j].y) + (v[r][j].z * v[r][j].z + v[r][j].w * v[r][j].w);
            const float rstd = rsqrtf(wave_sum(s) * (1.f / DM) + EPS);
            GAS u32x2* o8 = (GAS u32x2*)(U + (size_t)m * DM) + F.lane;
            if (!same_b) {
#pragma unroll
                for (int j = 0; j < 4; ++j) { const f32x4 g = ((const GAS f32x4*)gain)[F.lane + 64 * j], sc = ((const GAS f32x4*)(scale0 + (size_t)b * bstride))[F.lane + 64 * j];
                    gp[j] = g * (sc + 1.0f); shv[j] = ((const GAS f32x4*)(shift0 + (size_t)b * bstride))[F.lane + 64 * j]; } }
#pragma unroll
            for (int j = 0; j < 4; ++j) o8[64 * j] = pack4(v[r][j] * rstd * gp[j] + shv[j]); } }
    }
}
__device__ __forceinline__ void dt_gemv(const Frame& F, const bf16_t* U, const float* w_in, float* DT) {
    LAS float* Wd = (LAS float*)F.lds;
    __syncthreads();
    for (int idx = F.tid; idx < 8192; idx += NTHR) { const int k = idx >> 3, j = idx & 7; Wd[8 * k + 4 * (k >> 3) + j] = ((const GAS float*)w_in)[(size_t)k * INW + 5120 + j]; }
    __syncthreads();
    const int gw = F.bid * NWAVE + F.wave, NGW = F.G * NWAVE;
    for (int m0 = gw; m0 < T_TOK; m0 += 4 * NGW) {
      u32x4 uvr[4][2];
#pragma unroll
      for (int r = 0; r < 4; ++r) { const int mm = (m0 + r * NGW < T_TOK) ? m0 + r * NGW : m0;
#pragma unroll
          for (int hf = 0; hf < 2; ++hf) uvr[r][hf] = *(const GAS u32x4*)(U + (size_t)mm * DM + 512 * hf + 8 * F.lane); }
#pragma unroll
      for (int r = 0; r < 4; ++r) { const int m = m0 + r * NGW; if (m < T_TOK) {
        float acc[8];
#pragma unroll
        for (int j = 0; j < 8; ++j) acc[j] = 0.f;
#pragma unroll
        for (int hf = 0; hf < 2; ++hf) {
            const u32x4 uv = uvr[r][hf];
            float uf[8]; unpack8(uv, uf);
#pragma unroll
            for (int kk = 0; kk < 8; ++kk) { const int k = 512 * hf + 8 * F.lane + kk; const LAS float* wp = Wd + 8 * k + 4 * (k >> 3);
                const f32x4 w0 = *(const LAS f32x4*)wp, w1 = *(const LAS f32x4*)(wp + 4);
                acc[0] += uf[kk] * w0.x; acc[1] += uf[kk] * w0.y; acc[2] += uf[kk] * w0.z; acc[3] += uf[kk] * w0.w;
                acc[4] += uf[kk] * w1.x; acc[5] += uf[kk] * w1.y; acc[6] += uf[kk] * w1.z; acc[7] += uf[kk] * w1.w; }
        }
#pragma unroll
        for (int j = 0; j < 8; ++j) acc[j] = wave_sum(acc[j]);
        if (F.lane < 8) { float v = acc[0];
#pragma unroll
            for (int j = 1; j < 8; ++j) v = (F.lane == j) ? acc[j] : v;
            ((GAS float*)DT)[(size_t)m * 8 + F.lane] = v; }
      } }
    }
    __syncthreads();
}

template <bool MASKED>
__device__ __forceinline__ void sb_elem(const f32x4 (&sc)[4], int key0, int trow, float (&nk)[4][4], float (&lb)[4][4], float (&Tj)[4]) {
#pragma unroll
    for (int j = 0; j < 4; ++j) { float t = 0.f;
#pragma unroll
        for (int i = 0; i < 4; ++i) { const float z2 = sc[j][i] * (0.08838834764831845f * 1.4426950408889634f);
            const float sp2 = fmaxf(z2, 0.f) + __builtin_amdgcn_logf(1.0f + __builtin_amdgcn_exp2f(-fabsf(z2)));
            if (MASKED) { const bool vis = (key0 + 16 * j + i) < trow; nk[j][i] = vis ? sp2 : 0.f; lb[j][i] = vis ? (z2 - sp2) : -1e30f; }
            else { nk[j][i] = sp2; lb[j][i] = z2 - sp2; }
            t += nk[j][i]; }
        Tj[j] = t; }
}
__device__ __forceinline__ void sb_task(const Frame& F, bf16_t* P, int b, int h, int qb) {
    LAS unsigned char* Ks = F.lds;
    LAS unsigned char* Vt = F.lds + 17408;
    LAS unsigned char* Pw = F.lds + 35840 + F.wave * 2304;
    LAS float* red = (LAS float*)(F.lds + 54272);
    int lane = F.lane; asm volatile("" : "+v"(lane)); const int wid = F.wave, fr = lane & 15, fq = lane >> 4;
    const size_t rowbase = (size_t)b * SEQ;
    const int q0 = qb * 128, trow = q0 + 16 * wid + fr;
    bf16x8 qf[4];
    { const bf16_t* qp = P + pidx(rowbase + trow, C_SQ + h * 128) + 8 * fq;
#pragma unroll
      for (int s = 0; s < 4; ++s) qf[s] = *(const GAS bf16x8*)(qp + 32 * s); }
    f32x4 o[8];
#pragma unroll
    for (int i = 0; i < 8; ++i) o[i] = (f32x4){0.f, 0.f, 0.f, 0.f};
    float R = 0.f;
    u32x4 kvr[2], vvr[2];
#pragma unroll
    for (int i = 0; i < 2; ++i) { const int idx = F.tid + NTHR * i, key = idx >> 4, c8 = idx & 15; const size_t kt0 = rowbase + 64 * (2 * qb + 1);
        kvr[i] = *(const GAS u32x4*)(P + pidx(kt0 + key, C_SK + h * 128) + 8 * c8); vvr[i] = *(const GAS u32x4*)(P + pidx(kt0 + lane, C_SV + h * 128) + 8 * (2 * wid + i)); }
    lds_barrier();
    for (int kt = 2 * qb + 1; kt >= 0; --kt) {
#pragma unroll
        for (int i = 0; i < 2; ++i) { const int idx = F.tid + NTHR * i, key = idx >> 4, c8 = idx & 15;
            const u32x4 kv = kvr[i], vv = vvr[i];
            *(LAS u32x4*)(Ks + key * 272 + c8 * 16) = kv;
            LAS bf16_t* vd = (LAS bf16_t*)(Vt + (8 * (2 * wid + i)) * 144 + lane * 2);
            vd[0 * 72] = (bf16_t)(vv.x & 0xffff); vd[1 * 72] = (bf16_t)(vv.x >> 16); vd[2 * 72] = (bf16_t)(vv.y & 0xffff); vd[3 * 72] = (bf16_t)(vv.y >> 16);
            vd[4 * 72] = (bf16_t)(vv.z & 0xffff); vd[5 * 72] = (bf16_t)(vv.z >> 16); vd[6 * 72] = (bf16_t)(vv.w & 0xffff); vd[7 * 72] = (bf16_t)(vv.w >> 16); }
        if (kt > 0) {
#pragma unroll
            for (int i = 0; i < 2; ++i) { const int idx = F.tid + NTHR * i, key = idx >> 4, c8 = idx & 15; const size_t kt1 = rowbase + 64 * (kt - 1);
                kvr[i] = *(const GAS u32x4*)(P + pidx(kt1 + key, C_SK + h * 128) + 8 * c8); vvr[i] = *(const GAS u32x4*)(P + pidx(kt1 + lane, C_SV + h * 128) + 8 * (2 * wid + i)); } }
        lds_barrier();
        if (64 * kt < q0 + 16 * wid + 15) {
            f32x4 sc[4];
#pragma unroll
            for (int j = 0; j < 4; ++j) { sc[j] = (f32x4){0.f, 0.f, 0.f, 0.f};
#pragma unroll
                for (int s = 0; s < 4; ++s) sc[j] = mfma16(ldsfrag(Ks + (16 * j + fr) * 272 + (32 * s + 8 * fq) * 2), qf[s], sc[j]); }
            float nk[4][4], lb[4][4], Tj[4], Wj[4], Gj[4];
            if (64 * kt + 64 <= q0 + 16 * wid) sb_elem<false>(sc, 64 * kt + 4 * fq, trow, nk, lb, Tj);
            else sb_elem<true>(sc, 64 * kt + 4 * fq, trow, nk, lb, Tj);
#pragma unroll
            for (int j = 0; j < 4; ++j) { const float a1 = __shfl_xor(Tj[j], 16), a2 = __shfl_xor(Tj[j], 32), a3 = __shfl_xor(Tj[j], 48);
                Wj[j] = Tj[j] + a1 + a2 + a3;
                Gj[j] = (((fq ^ 1) > fq) ? a1 : 0.f) + (((fq ^ 2) > fq) ? a2 : 0.f) + (((fq ^ 3) > fq) ? a3 : 0.f); }
            float suf = 0.f;
#pragma unroll
            for (int j = 3; j >= 0; --j) { float tl = R - suf - Gj[j]; f32x4 w;
                w[3] = __builtin_amdgcn_exp2f(lb[j][3] + tl); tl -= nk[j][3];
                w[2] = __builtin_amdgcn_exp2f(lb[j][2] + tl); tl -= nk[j][2];
                w[1] = __builtin_amdgcn_exp2f(lb[j][1] + tl); tl -= nk[j][1];
                w[0] = __builtin_amdgcn_exp2f(lb[j][0] + tl);
                *(LAS u32x2*)(Pw + fr * 144 + (16 * j + 4 * fq) * 2) = pack4(w);
                suf += Wj[j]; }
            R -= suf;
#pragma unroll
            for (int ks = 0; ks < 2; ++ks) { const bf16x8 pf = ldsfrag(Pw + fr * 144 + (32 * ks + 8 * fq) * 2);
#pragma unroll
                for (int dt = 0; dt < 8; ++dt) o[dt] = mfma16(ldsfrag(Vt + (16 * dt + fr) * 144 + (32 * ks + 8 * fq) * 2), pf, o[dt]); }
        }
        const float rm = wave_max(R);
        if (lane == 0) red[wid] = rm;
        lds_barrier();
        float mx = red[0];
#pragma unroll
        for (int w = 1; w < 8; ++w) mx = fmaxf(mx, red[w]);
        if (mx < -173.2f) break;
    }
    bf16_t* op = P + pidx(rowbase + trow, C_SQ + h * 128) + 4 * fq;
#pragma unroll
    for (int dt = 0; dt < 8; ++dt) *(GAS u32x2*)(op + 16 * dt) = pack4(o[dt]);
}

__device__ __forceinline__ void ret_kv_task(const Frame& F, const bf16_t* P, const f32x2* ROPE, bf16_t* RST, int b, int c, int h, f32x4 (&kcs)[4], bool load_rope) {
    LAS unsigned char* KT = F.lds;
    LAS unsigned char* VT = F.lds + 18432;
    int lane = F.lane; asm volatile("" : "+v"(lane)); const int fr = lane & 15, fq = lane >> 4;
    const float l2g = log2gamma(h);
    lds_barrier();
    { const int s = lane, g8 = F.wave;     const size_t row = (size_t)b * SEQ + c * 64 + s; const int pos = c * 64 + s;
      const bf16_t* kp = P + pidx(row, C_RK + h * 128) + 8 * g8;
      const u32x4 k1 = *(const GAS u32x4*)kp, k2 = *(const GAS u32x4*)(kp + 64);
      float x1[8], x2[8]; unpack8(k1, x1); unpack8(k2, x2);
      if (load_rope) { const GAS f32x4* cp = (const GAS f32x4*)(ROPE + pos * 64 + 8 * g8);
#pragma unroll
          for (int jj = 0; jj < 4; ++jj) kcs[jj] = cp[jj]; }
      const float dec = __builtin_amdgcn_exp2f(l2g * (float)(63 - s)) * 0.08838834764831845f;
      LAS bf16_t* kd = (LAS bf16_t*)(KT + (8 * g8) * 144 + s * 2);
#pragma unroll
      for (int jj = 0; jj < 4; ++jj) { const f32x4 cs = kcs[jj];
          { const int j = 2 * jj; const float y1 = (x1[j] * cs.x - x2[j] * cs.y) * dec, y2 = (x1[j] * cs.y + x2[j] * cs.x) * dec; kd[j * 72] = f2bf(y1); kd[(64 + j) * 72] = f2bf(y2); }
          { const int j = 2 * jj + 1; const float y1 = (x1[j] * cs.z - x2[j] * cs.w) * dec, y2 = (x1[j] * cs.w + x2[j] * cs.z) * dec; kd[j * 72] = f2bf(y1); kd[(64 + j) * 72] = f2bf(y2); } }
      const bf16_t* vp = P + pidx(row, C_RV + h * 128) + 16 * g8;
#pragma unroll
      for (int hh = 0; hh < 2; ++hh) { const u32x4 vv = *(const GAS u32x4*)(vp + 8 * hh);
          LAS bf16_t* vd = (LAS bf16_t*)(VT + (16 * g8 + 8 * hh) * 144 + s * 2);
          vd[0 * 72] = (bf16_t)(vv.x & 0xffff); vd[1 * 72] = (bf16_t)(vv.x >> 16); vd[2 * 72] = (bf16_t)(vv.y & 0xffff); vd[3 * 72] = (bf16_t)(vv.y >> 16);
          vd[4 * 72] = (bf16_t)(vv.z & 0xffff); vd[5 * 72] = (bf16_t)(vv.z >> 16); vd[6 * 72] = (bf16_t)(vv.w & 0xffff); vd[7 * 72] = (bf16_t)(vv.w >> 16); } }
    lds_barrier();
    const int w = F.wave;
    bf16x8 xf[2];
#pragma unroll
    for (int ks = 0; ks < 2; ++ks) xf[ks] = ldsfrag(KT + (16 * w + fr) * 144 + (32 * ks + 8 * fq) * 2);
    bf16_t* dst = RST + (size_t)((b * 128 + c) * 4 + h) * 16384;
#pragma unroll
    for (int et = 0; et < 8; ++et) { f32x4 acc = (f32x4){0.f, 0.f, 0.f, 0.f};
#pragma unroll
        for (int ks = 0; ks < 2; ++ks) acc = mfma16(xf[ks], ldsfrag(VT + (16 * et + fr) * 144 + (32 * ks + 8 * fq) * 2), acc);
        *(GAS u32x2*)(dst + (16 * et + fr) * 128 + 16 * w + 4 * fq) = pack4(acc); }
}

struct RoPre { u32x4 k1, k2; u32x4 vv[2]; u32x4 sx[4]; u32x4 qv[4]; u32x2 gv[4]; };
__device__ __forceinline__ void ro_load(const Frame& F, const bf16_t* P, const bf16_t* RST, int b, int c, int h, RoPre& r) {
    int lane = F.lane; asm volatile("" : "+v"(lane)); const int fr = lane & 15, fq = lane >> 4, w = F.wave, lt = w & 3, eh = w >> 2;
    { const int s = F.tid >> 3, g8 = F.tid & 7; const bf16_t* kp = P + pidx((size_t)b * SEQ + c * 64 + s, C_RK + h * 128) + 8 * g8;
      r.k1 = *(const GAS u32x4*)kp; r.k2 = *(const GAS u32x4*)(kp + 64); }
    { const bf16_t* vp = P + pidx((size_t)b * SEQ + c * 64 + lane, C_RV + h * 128) + 16 * w;
#pragma unroll
      for (int hh = 0; hh < 2; ++hh) r.vv[hh] = *(const GAS u32x4*)(vp + 8 * hh); }
    { const bf16_t* sp = RST + (size_t)((b * 128 + c) * 4 + h) * 16384;
#pragma unroll
      for (int i = 0; i < 4; ++i) { const int idx = F.tid + NTHR * i, e = idx >> 4, c16 = idx & 15; r.sx[i] = *(const GAS u32x4*)(sp + e * 128 + 8 * c16); } }
    { const size_t qrow = (size_t)b * SEQ + c * 64 + 16 * lt + fr; const bf16_t* qp = P + pidx(qrow, C_RQ + h * 128) + 8 * fq;
#pragma unroll
      for (int s = 0; s < 4; ++s) r.qv[s] = *(const GAS u32x4*)(qp + 32 * s);
#pragma unroll
      for (int et = 0; et < 4; ++et) r.gv[et] = *(const GAS u32x2*)(P + pidx(qrow, C_RG + h * 128) + 64 * eh + 16 * et + 4 * fq); }
}
__device__ __forceinline__ void ret_out_task(const Frame& F, bf16_t* P, const f32x2* ROPE, const bf16_t* RST, const float* gn, int b, int c, int h, f32x4 (&kcs)[4], f32x4 (&qcs)[2][4], bool load_rope,
                                             RoPre& pre, bool has_next, int nb, int nc, int nh) {
    LAS unsigned char* Kr = F.lds;
    LAS unsigned char* VT = F.lds + 17408;
    LAS unsigned char* Sx = F.lds + 35840;
    LAS unsigned char* Pw = F.lds + 70656 + F.wave * 2304;
    LAS float* ssq = (LAS float*)(F.lds + 89088);
    int lane = F.lane; asm volatile("" : "+v"(lane)); const int fr = lane & 15, fq = lane >> 4, w = F.wave, lt = w & 3, eh = w >> 2;
    const float l2g = log2gamma(h);
    f32x4 ggr[4];
#pragma unroll
    for (int et = 0; et < 4; ++et) ggr[et] = *(const GAS f32x4*)(gn + h * 128 + 64 * eh + 16 * et + 4 * fq);
    if (load_rope) { const GAS f32x4* cp = (const GAS f32x4*)(ROPE + (c * 64 + (F.tid >> 3)) * 64 + 8 * (F.tid & 7));
#pragma unroll
        for (int jj = 0; jj < 4; ++jj) kcs[jj] = cp[jj];
#pragma unroll
        for (int s = 0; s < 2; ++s) { const GAS f32x4* cq = (const GAS f32x4*)(ROPE + (c * 64 + 16 * lt + fr) * 64 + 32 * s + 8 * fq);
#pragma unroll
            for (int jj = 0; jj < 4; ++jj) qcs[s][jj] = cq[jj]; } }
    lds_barrier();
    { const int s = F.tid >> 3, g8 = F.tid & 7;
      float x1[8], x2[8], y1[8], y2[8]; unpack8(pre.k1, x1); unpack8(pre.k2, x2);
#pragma unroll
      for (int jj = 0; jj < 4; ++jj) { const f32x4 cs = kcs[jj];
          { const int j = 2 * jj; y1[j] = (x1[j] * cs.x - x2[j] * cs.y) * 0.08838834764831845f; y2[j] = (x1[j] * cs.y + x2[j] * cs.x) * 0.08838834764831845f; }
          { const int j = 2 * jj + 1; y1[j] = (x1[j] * cs.z - x2[j] * cs.w) * 0.08838834764831845f; y2[j] = (x1[j] * cs.w + x2[j] * cs.z) * 0.08838834764831845f; } }
      u32x4 o1, o2; o1.x = cvt_pk_bf16(y1[0], y1[1]); o1.y = cvt_pk_bf16(y1[2], y1[3]); o1.z = cvt_pk_bf16(y1[4], y1[5]); o1.w = cvt_pk_bf16(y1[6], y1[7]);
      o2.x = cvt_pk_bf16(y2[0], y2[1]); o2.y = cvt_pk_bf16(y2[2], y2[3]); o2.z = cvt_pk_bf16(y2[4], y2[5]); o2.w = cvt_pk_bf16(y2[6], y2[7]);
      *(LAS u32x4*)(Kr + s * 272 + (8 * g8) * 2) = o1; *(LAS u32x4*)(Kr + s * 272 + (64 + 8 * g8) * 2) = o2;
#pragma unroll
      for (int hh = 0; hh < 2; ++hh) { const u32x4 vv = pre.vv[hh];
          LAS bf16_t* vd = (LAS bf16_t*)(VT + (16 * w + 8 * hh) * 144 + lane * 2);
          vd[0 * 72] = (bf16_t)(vv.x & 0xffff); vd[1 * 72] = (bf16_t)(vv.x >> 16); vd[2 * 72] = (bf16_t)(vv.y & 0xffff); vd[3 * 72] = (bf16_t)(vv.y >> 16);
          vd[4 * 72] = (bf16_t)(vv.z & 0xffff); vd[5 * 72] = (bf16_t)(vv.z >> 16); vd[6 * 72] = (bf16_t)(vv.w & 0xffff); vd[7 * 72] = (bf16_t)(vv.w >> 16); }
#pragma unroll
      for (int i = 0; i < 4; ++i) { const int idx = F.tid + NTHR * i, e = idx >> 4, c16 = idx & 15; *(LAS u32x4*)(Sx + e * 272 + c16 * 16) = pre.sx[i]; } }
    const int l = 16 * lt + fr; const size_t qrow = (size_t)b * SEQ + c * 64 + l;
    bf16x8 qf[4];
#pragma unroll
    for (int s = 0; s < 2; ++s) { float x1[8], x2[8], y1[8], y2[8]; unpack8(pre.qv[s], x1); unpack8(pre.qv[s + 2], x2);
#pragma unroll
        for (int jj = 0; jj < 4; ++jj) { const f32x4 cs = qcs[s][jj];
            { const int j = 2 * jj; y1[j] = x1[j] * cs.x - x2[j] * cs.y; y2[j] = x1[j] * cs.y + x2[j] * cs.x; }
            { const int j = 2 * jj + 1; y1[j] = x1[j] * cs.z - x2[j] * cs.w; y2[j] = x1[j] * cs.w + x2[j] * cs.z; } }
        u32x4 o1, o2; o1.x = cvt_pk_bf16(y1[0], y1[1]); o1.y = cvt_pk_bf16(y1[2], y1[3]); o1.z = cvt_pk_bf16(y1[4], y1[5]); o1.w = cvt_pk_bf16(y1[6], y1[7]);
        o2.x = cvt_pk_bf16(y2[0], y2[1]); o2.y = cvt_pk_bf16(y2[2], y2[3]); o2.z = cvt_pk_bf16(y2[4], y2[5]); o2.w = cvt_pk_bf16(y2[6], y2[7]);
        qf[s] = __builtin_bit_cast(bf16x8, o1); qf[s + 2] = __builtin_bit_cast(bf16x8, o2); }
    u32x2 gvr[4];
#pragma unroll
    for (int et = 0; et < 4; ++et) gvr[et] = pre.gv[et];
    if (has_next) ro_load(F, P, RST, nb, nc, nh, pre);
    lds_barrier();
#pragma unroll
    for (int j = 0; j < 4; ++j) { f32x4 acc = (f32x4){0.f, 0.f, 0.f, 0.f};
#pragma unroll
        for (int ks = 0; ks < 4; ++ks) acc = mfma16(ldsfrag(Kr + (16 * j + fr) * 272 + (32 * ks + 8 * fq) * 2), qf[ks], acc);
#pragma unroll
        for (int i = 0; i < 4; ++i) { const int s = 16 * j + 4 * fq + i; acc[i] *= __builtin_amdgcn_exp2f(l2g * fabsf((float)(l - s))); }
        *(LAS u32x2*)(Pw + fr * 144 + (16 * j + 4 * fq) * 2) = pack4(acc); }
    f32x4 y[4];
    const float qdec = __builtin_amdgcn_exp2f(l2g * (float)(l + 1));
#pragma unroll
    for (int et = 0; et < 4; ++et) { y[et] = (f32x4){0.f, 0.f, 0.f, 0.f};
#pragma unroll
        for (int ks = 0; ks < 4; ++ks) y[et] = mfma16(ldsfrag(Sx + (64 * eh + 16 * et + fr) * 272 + (32 * ks + 8 * fq) * 2), qf[ks], y[et]);
        y[et] = y[et] * qdec; }
#pragma unroll
    for (int ks = 0; ks < 2; ++ks) { const bf16x8 pf = ldsfrag(Pw + fr * 144 + (32 * ks + 8 * fq) * 2);
#pragma unroll
        for (int et = 0; et < 4; ++et) y[et] = mfma16(ldsfrag(VT + (64 * eh + 16 * et + fr) * 144 + (32 * ks + 8 * fq) * 2), pf, y[et]); }
    float ss = 0.f;
#pragma unroll
    for (int et = 0; et < 4; ++et) ss += (y[et][0] * y[et][0] + y[et][1] * y[et][1]) + (y[et][2] * y[et][2] + y[et][3] * y[et][3]);
    ss += __shfl_xor(ss, 16); ss += __shfl_xor(ss, 32);
    if (fq == 0) ssq[w * 16 + fr] = ss;
    lds_barrier();
    const float rstd = rsqrtf((ssq[w * 16 + fr] + ssq[(w ^ 4) * 16 + fr]) * (1.f / 128.f) + EPS);
#pragma unroll
    for (int et = 0; et < 4; ++et) { const int e0 = 64 * eh + 16 * et + 4 * fq;
        const u32x2 gv = gvr[et]; const f32x4 gg = ggr[et];
        f32x4 r;
        r[0] = y[et][0] * rstd * gg[0] * silu_f(bf_lo(gv.x)); r[1] = y[et][1] * rstd * gg[1] * silu_f(bf_hi(gv.x));
        r[2] = y[et][2] * rstd * gg[2] * silu_f(bf_lo(gv.y)); r[3] = y[et][3] * rstd * gg[3] * silu_f(bf_hi(gv.y));
        *(GAS u32x2*)(P + pidx(qrow, C_RQ + h * 128) + e0) = pack4(r); }
}

__device__ __forceinline__ float softplus_f(float x) { return fmaxf(x, 0.f) + log1pf(__expf(-fabsf(x))); }
__device__ __forceinline__ void conv8(const bf16_t* P, const float* cw, const float* cb, int b, int tpos, int col, float* v) {
    const int chan = col - C_XBC;
    { const f32x4 b0 = *(const GAS f32x4*)(cb + chan), b1 = *(const GAS f32x4*)(cb + chan + 4);
      v[0] = b0.x; v[1] = b0.y; v[2] = b0.z; v[3] = b0.w; v[4] = b1.x; v[5] = b1.y; v[6] = b1.z; v[7] = b1.w; }
#pragma unroll
    for (int j = 0; j < 4; ++j) { const int ts = tpos - 3 + j;
        if (ts >= 0) { const u32x4 xv = *(const GAS u32x4*)(P + pidx((size_t)b * SEQ + ts, col)); float xf[8]; unpack8(xv, xf);
            const f32x4 w0 = *(const GAS f32x4*)(cw + j * 1024 + chan), w1 = *(const GAS f32x4*)(cw + j * 1024 + chan + 4);
            v[0] += xf[0] * w0.x; v[1] += xf[1] * w0.y; v[2] += xf[2] * w0.z; v[3] += xf[3] * w0.w; v[4] += xf[4] * w1.x; v[5] += xf[5] * w1.y; v[6] += xf[6] * w1.z; v[7] += xf[7] * w1.w; } }
#pragma unroll
    for (int i = 0; i < 8; ++i) v[i] = silu_f(v[i]);
}

__device__ __forceinline__ void conv_load(const bf16_t* P, const float* cw, const float* cb, int b, int tpos0, int col, float (&w)[4][8], float (&bias)[8], u32x4 (&rows)[11]) {
    const int chan = col - C_XBC;
#pragma unroll
    for (int j = 0; j < 4; ++j) { const f32x4 w0 = *(const GAS f32x4*)(cw + j * 1024 + chan), w1 = *(const GAS f32x4*)(cw + j * 1024 + chan + 4);
        w[j][0] = w0.x; w[j][1] = w0.y; w[j][2] = w0.z; w[j][3] = w0.w; w[j][4] = w1.x; w[j][5] = w1.y; w[j][6] = w1.z; w[j][7] = w1.w; }
    { const f32x4 b0 = *(const GAS f32x4*)(cb + chan), b1 = *(const GAS f32x4*)(cb + chan + 4);
      bias[0] = b0.x; bias[1] = b0.y; bias[2] = b0.z; bias[3] = b0.w; bias[4] = b1.x; bias[5] = b1.y; bias[6] = b1.z; bias[7] = b1.w; }
    const bf16_t* base = P + pidx((size_t)b * SEQ + tpos0, col);
#pragma unroll
    for (int r = 0; r < 11; ++r) { rows[r] = (u32x4){0u, 0u, 0u, 0u}; if (tpos0 - 3 + r >= 0) rows[r] = *(const GAS u32x4*)(base + (long)(r - 3) * 128); }
}
template <bool TR, bool HASF>
__device__ __forceinline__ void conv_compute(const float (&w)[4][8], const float (&bias)[8], const u32x4 (&rows)[11], const float (&f)[8], u32x4 (&pk)[8]) {
    float prev[8];
#pragma unroll
    for (int t = 0; t < 8; ++t) {
        float a[8];
#pragma unroll
        for (int i = 0; i < 8; ++i) a[i] = bias[i];
#pragma unroll
        for (int j = 0; j < 4; ++j) { float xf[8]; unpack8(rows[t + j], xf);
#pragma unroll
            for (int i = 0; i < 8; ++i) a[i] += xf[i] * w[j][i]; }
#pragma unroll
        for (int i = 0; i < 8; ++i) { a[i] = silu_f(a[i]); if (HASF) a[i] *= f[t]; }
        if (TR) {
            if (t & 1) {
#pragma unroll
                for (int i = 0; i < 8; ++i) { const unsigned u = cvt_pk_bf16(prev[i], a[i]);
                    if ((t >> 1) == 0) pk[i].x = u; else if ((t >> 1) == 1) pk[i].y = u; else if ((t >> 1) == 2) pk[i].z = u; else pk[i].w = u; }
            } else {
#pragma unroll
                for (int i = 0; i < 8; ++i) prev[i] = a[i];
            }
        } else {
            pk[t].x = cvt_pk_bf16(a[0], a[1]); pk[t].y = cvt_pk_bf16(a[2], a[3]); pk[t].z = cvt_pk_bf16(a[4], a[5]); pk[t].w = cvt_pk_bf16(a[6], a[7]);
        }
    }
}
template <bool TR, bool HASF>
__device__ __forceinline__ void conv_tile(const bf16_t* P, const float* cw, const float* cb, int b, int tpos0, int col, const float (&f)[8], u32x4 (&pk)[8]) {
    float w[4][8], bias[8]; u32x4 rows[11];
    conv_load(P, cw, cb, b, tpos0, col, w, bias, rows);
    conv_compute<TR, HASF>(w, bias, rows, f, pk);
}
__device__ __forceinline__ float dt_scan(const float* DT, const float* dt_bias, const float* a_log, int b, int c, int hd, int lane, float& dtv) {
    const size_t t = (size_t)b * SEQ + c * 64 + lane;
    dtv = softplus_f(((const GAS float*)DT)[t * 8 + hd] + ((const GAS float*)dt_bias)[hd]);
    float x = dtv * (-__expf(((const GAS float*)a_log)[hd]));
#pragma unroll
    for (int o = 1; o < 64; o <<= 1) { const float y = __shfl_up(x, o); if (lane >= o) x += y; }
    return x;
}

__device__ __forceinline__ void ssd_state_task(const Frame& F, const bf16_t* P, const float* DT, const float* cw, const float* cb, const float* dt_bias, const float* a_log,
                                               bf16_t* SST, float* CD, int b, int c, int g) {
    LAS unsigned char* XT = F.lds;
    LAS unsigned char* BT = F.lds + 36864;
    LAS float* dtl = (LAS float*)(F.lds + 55296);
    LAS float* acl = (LAS float*)(F.lds + 56320);
    int lane = F.lane; asm volatile("" : "+v"(lane)); const int fr = lane & 15, fq = lane >> 4, w = F.wave;
    lds_barrier();
    int tt = F.tid; asm volatile("" : "+v"(tt)); const int cgi = tt % 48, seg = tt / 48, s0 = 8 * seg;
    const int ccol = (cgi < 32) ? (C_XBC + g * 256 + 8 * cgi) : (C_XBC + 512 + g * 128 + 8 * (cgi - 32));
    float cwr[4][8], cbr[8]; u32x4 crow[11];
    if (tt < 384) conv_load(P, cw, cb, b, c * 64 + s0, ccol, cwr, cbr, crow);
    if (w < 4) { float dtv; const float cum = dt_scan(DT, dt_bias, a_log, b, c, 4 * g + w, lane, dtv);
        dtl[lane * 4 + w] = dtv; acl[lane * 4 + w] = cum;
        if (lane == 63) ((GAS float*)CD)[(b * 128 + c) * 8 + 4 * g + w] = __expf(cum); }
    lds_barrier();
    if (tt < 384) {
        float f[8]; u32x4 pk[8];
        if (cgi < 32) { const int hl = cgi >> 3; const float ae = acl[63 * 4 + hl];
#pragma unroll
            for (int t = 0; t < 8; ++t) f[t] = dtl[(s0 + t) * 4 + hl] * __expf(ae - acl[(s0 + t) * 4 + hl]); }
        else {
#pragma unroll
            for (int t = 0; t < 8; ++t) f[t] = 1.0f; }
        conv_compute<true, true>(cwr, cbr, crow, f, pk);
        LAS unsigned char* d = (cgi < 32) ? (XT + (8 * cgi) * 144 + s0 * 2) : (BT + (8 * (cgi - 32)) * 144 + s0 * 2);
#pragma unroll
        for (int i = 0; i < 8; ++i) *(LAS u32x4*)(d + i * 144) = pk[i]; }
    lds_barrier();
    const int hl = w >> 1, ph = w & 1;
    bf16x8 yf[2][2];
#pragma unroll
    for (int pt = 0; pt < 2; ++pt)
#pragma unroll
        for (int ks = 0; ks < 2; ++ks) yf[pt][ks] = ldsfrag(XT + (hl * 64 + ph * 32 + 16 * pt + fr) * 144 + (32 * ks + 8 * fq) * 2);
    bf16_t* dst = SST + (size_t)((b * 128 + c) * 8 + 4 * g + hl) * 8192;
#pragma unroll
    for (int nt = 0; nt < 8; ++nt) { f32x4 a0 = (f32x4){0.f, 0.f, 0.f, 0.f}, a1 = a0;
#pragma unroll
        for (int ks = 0; ks < 2; ++ks) { const bf16x8 xf = ldsfrag(BT + (16 * nt + fr) * 144 + (32 * ks + 8 * fq) * 2); a0 = mfma16(xf, yf[0][ks], a0); a1 = mfma16(xf, yf[1][ks], a1); }
#ifdef PROBE_CONST
        a0 = (f32x4){0.01f, 0.02f, 0.03f, 0.04f}; a1 = a0;
#endif
        *(GAS u32x2*)(dst + (ph * 32 + fr) * 128 + 16 * nt + 4 * fq) = pack4(a0);
        *(GAS u32x2*)(dst + (ph * 32 + 16 + fr) * 128 + 16 * nt + 4 * fq) = pack4(a1); }
}

__device__ __forceinline__ void ssd_out_task(const Frame& F, bf16_t* P, const float* DT, const float* cw, const float* cb, const float* dt_bias, const float* a_log,
                                             const float* d_skip, const float* nrm, const bf16_t* SST, int b, int c) {
    LAS unsigned char* Bs = F.lds;
    LAS unsigned char* Cs = F.lds + 17408;
    LAS unsigned char* XT = F.lds + 34816;
    LAS unsigned char* Pw = F.lds + 71680 + F.wave * 2304;
    LAS float* dtl = (LAS float*)(F.lds + 90112);
    LAS float* acl = (LAS float*)(F.lds + 92160);
    LAS float* ssq = (LAS float*)(F.lds + 94208);
    int lane = F.lane; asm volatile("" : "+v"(lane)); const int fr = lane & 15, fq = lane >> 4, w = F.wave, hl = w >> 1, half = w & 1;
    lds_barrier();
    { float dtv; const float cum = dt_scan(DT, dt_bias, a_log, b, c, w, lane, dtv); dtl[lane * 8 + w] = dtv; acl[lane * 8 + w] = cum; }
    float ssl[2] = {0.f, 0.f};
#pragma unroll 1
    for (int g = 0; g < 2; ++g) {
        const int head = 4 * g + hl;
        const bf16_t* hsrc = SST + (size_t)((b * 128 + c) * 8 + head) * 8192;
        bf16x8 hfr[4][4];
#pragma unroll
        for (int ks = 0; ks < 4; ++ks)
#pragma unroll
            for (int pt = 0; pt < 4; ++pt) hfr[ks][pt] = *(const GAS bf16x8*)(hsrc + (16 * pt + fr) * 128 + 32 * ks + 8 * fq);
        lds_barrier();
        { int tt = F.tid; asm volatile("" : "+v"(tt)); const int cgi = tt & 63, seg = tt >> 6, s0 = 8 * seg;
            const int col = (cgi < 32) ? (C_XBC + g * 256 + 8 * cgi) : (cgi < 48) ? (C_XBC + 512 + g * 128 + 8 * (cgi - 32)) : (C_XBC + 768 + g * 128 + 8 * (cgi - 48));
            const float f[8] = {1.f, 1.f, 1.f, 1.f, 1.f, 1.f, 1.f, 1.f}; u32x4 pk[8];
            if (cgi < 32) { conv_tile<true, false>(P, cw, cb, b, c * 64 + s0, col, f, pk);
                LAS unsigned char* d = XT + (8 * cgi) * 144 + s0 * 2;
#pragma unroll
                for (int i = 0; i < 8; ++i) *(LAS u32x4*)(d + i * 144) = pk[i]; }
            else { conv_tile<false, false>(P, cw, cb, b, c * 64 + s0, col, f, pk);
                LAS unsigned char* d = ((cgi < 48) ? (Bs + (8 * (cgi - 32)) * 2) : (Cs + (8 * (cgi - 48)) * 2)) + s0 * 272;
#pragma unroll
                for (int i = 0; i < 8; ++i) *(LAS u32x4*)(d + i * 272) = pk[i]; } }
        u32x2 zvr[2][4];
#pragma unroll
        for (int li = 0; li < 2; ++li)
#pragma unroll
            for (int pt = 0; pt < 4; ++pt) zvr[li][pt] = *(const GAS u32x2*)(P + pidx((size_t)b * SEQ + c * 64 + 16 * (2 * half + li) + fr, C_MZ + head * 64 + 16 * pt + 4 * fq));
        lds_barrier();
        const float dsk = ((const GAS float*)d_skip)[head];
#pragma unroll
        for (int li = 0; li < 2; ++li) {
            asm volatile("" ::: "memory"); __builtin_amdgcn_sched_barrier(0);
            const int lt = 2 * half + li, l = 16 * lt + fr;
            const float al = acl[l * 8 + head];
            bf16x8 cf[4];
#pragma unroll
            for (int ks = 0; ks < 4; ++ks) cf[ks] = ldsfrag(Cs + (16 * lt + fr) * 272 + (32 * ks + 8 * fq) * 2);
            f32x4 y[4];
#pragma unroll
            for (int pt = 0; pt < 4; ++pt) y[pt] = (f32x4){0.f, 0.f, 0.f, 0.f};
#pragma unroll
            for (int ks = 0; ks < 4; ++ks) {
#pragma unroll
                for (int pt = 0; pt < 4; ++pt) y[pt] = mfma16(hfr[ks][pt], cf[ks], y[pt]); }
            { const float eal = __expf(al);
#pragma unroll
              for (int pt = 0; pt < 4; ++pt) y[pt] = y[pt] * eal; }
#pragma unroll
            for (int st = 0; st < 4; ++st) { f32x4 acc = (f32x4){0.f, 0.f, 0.f, 0.f};
#pragma unroll
                for (int ks = 0; ks < 4; ++ks) acc = mfma16(ldsfrag(Bs + (16 * st + fr) * 272 + (32 * ks + 8 * fq) * 2), cf[ks], acc);
#pragma unroll
                for (int i = 0; i < 4; ++i) { const int s = 16 * st + 4 * fq + i;
                    acc[i] = (s <= l) ? acc[i] * __expf(al - acl[s * 8 + head]) * dtl[s * 8 + head] : 0.f; }
                *(LAS u32x2*)(Pw + fr * 144 + (16 * st + 4 * fq) * 2) = pack4(acc); }
#pragma unroll
            for (int ks = 0; ks < 2; ++ks) { if (2 * ks <= lt) { const bf16x8 pf = ldsfrag(Pw + fr * 144 + (32 * ks + 8 * fq) * 2);
#pragma unroll
                for (int pt = 0; pt < 4; ++pt) y[pt] = mfma16(ldsfrag(XT + (hl * 64 + 16 * pt + fr) * 144 + (32 * ks + 8 * fq) * 2), pf, y[pt]); } }
            const size_t row = (size_t)b * SEQ + c * 64 + l;
#pragma unroll
            for (int pt = 0; pt < 4; ++pt) { const int p0 = 16 * pt + 4 * fq;
                const u32x2 zv = zvr[li][pt];
                const LAS bf16_t* xp = (const LAS bf16_t*)(XT + (hl * 64 + p0) * 144 + l * 2);
                f32x4 r;
                r[0] = (y[pt][0] + bf2f(xp[0 * 72]) * dsk) * silu_f(bf_lo(zv.x)); r[1] = (y[pt][1] + bf2f(xp[1 * 72]) * dsk) * silu_f(bf_hi(zv.x));
                r[2] = (y[pt][2] + bf2f(xp[2 * 72]) * dsk) * silu_f(bf_lo(zv.y)); r[3] = (y[pt][3] + bf2f(xp[3 * 72]) * dsk) * silu_f(bf_hi(zv.y));
                ssl[li] += (r[0] * r[0] + r[1] * r[1]) + (r[2] * r[2] + r[3] * r[3]);
                *(GAS u32x2*)(P + pidx(row, C_MZ + head * 64 + p0)) = pack4(r); }
        }
    }
#pragma unroll
    for (int li = 0; li < 2; ++li) { float ss = ssl[li];
        ss += __shfl_xor(ss, 16); ss += __shfl_xor(ss, 32);
        if (fq == 0) ssq[hl * 64 + 16 * (2 * half + li) + fr] = ss; }
    asm volatile("s_waitcnt vmcnt(0)" ::: "memory");
    u32x2 ypk[2][2][4]; f32x4 ngv[2][4];
#pragma unroll
    for (int g = 0; g < 2; ++g)
#pragma unroll
        for (int pt = 0; pt < 4; ++pt) { const int ch = (4 * g + hl) * 64 + 16 * pt + 4 * fq; ngv[g][pt] = *(const GAS f32x4*)(nrm + ch);
#pragma unroll
            for (int li = 0; li < 2; ++li) ypk[li][g][pt] = *(const GAS u32x2*)(P + pidx((size_t)b * SEQ + c * 64 + 16 * (2 * half + li) + fr, C_MZ + ch)); }
    lds_barrier();
#pragma unroll
    for (int li = 0; li < 2; ++li) { const int l = 16 * (2 * half + li) + fr;
        const float rstd = rsqrtf((ssq[l] + ssq[64 + l] + ssq[128 + l] + ssq[192 + l]) * (1.f / 512.f) + EPS);
        const size_t row = (size_t)b * SEQ + c * 64 + l;
#pragma unroll
        for (int g = 0; g < 2; ++g)
#pragma unroll
            for (int pt = 0; pt < 4; ++pt) { const int ch = (4 * g + hl) * 64 + 16 * pt + 4 * fq;
                const u32x2 pk = ypk[li][g][pt]; const f32x4 r = (f32x4){bf_lo(pk.x), bf_hi(pk.x), bf_lo(pk.y), bf_hi(pk.y)};
                *(GAS u32x2*)(P + pidx(row, C_MZ + ch)) = pack4(r * rstd * ngv[g][pt]); } }
}

__device__ __forceinline__ void scan_phase(const Frame& F, bf16_t* RST, bf16_t* SST, const float* CD) {
    for (int task = F.bid * NTHR + F.tid; task < 131072; task += F.G * NTHR) {
        {
          const int pr = task & 8191, bh = task >> 13, b = bh >> 2, h = bh & 3;
          GAS unsigned* p = (GAS unsigned*)(RST + (size_t)((b * 128) * 4 + h) * 16384) + pr;
          const float dec = __builtin_amdgcn_exp2f(64.f * log2gamma(h));
          float s0 = 0.f, s1 = 0.f;
#pragma unroll 1
          for (int c0 = 0; c0 < 128; c0 += 32) { unsigned v[32];
#pragma unroll
              for (int i = 0; i < 32; ++i) v[i] = p[(size_t)(c0 + i) * 32768];
#pragma unroll
              for (int i = 0; i < 32; ++i) { p[(size_t)(c0 + i) * 32768] = cvt_pk_bf16(s0, s1); s0 = s0 * dec + bf_lo(v[i]); s1 = s1 * dec + bf_hi(v[i]); } } }
        {
          const int pr = task & 4095, bh = task >> 12, b = bh >> 3, hd = bh & 7;
          GAS unsigned* p = (GAS unsigned*)(SST + (size_t)((b * 128) * 8 + hd) * 8192) + pr;
          const GAS float* cd = (const GAS float*)(CD + (b * 128) * 8 + hd);
          float s0 = 0.f, s1 = 0.f;
#pragma unroll 1
          for (int c0 = 0; c0 < 128; c0 += 32) { unsigned v[32]; float d[32];
#pragma unroll
              for (int i = 0; i < 32; ++i) { v[i] = p[(size_t)(c0 + i) * 32768]; d[i] = cd[(c0 + i) * 8]; }
#pragma unroll
              for (int i = 0; i < 32; ++i) { p[(size_t)(c0 + i) * 32768] = cvt_pk_bf16(s0, s1); s0 = s0 * d[i] + bf_lo(v[i]); s1 = s1 * d[i] + bf_hi(v[i]); } } }
    }
}


#define XB_TMO      128
#define XB_XCNT(j)  (256  + 64 * (j))
#define XB_XSUB(j)  (1280 + 64 * (j))
#define XB_XGEN(j)  (2304 + 64 * (j))
#define XB_TOP      3328
#define XB_TOPGEN   3392
#define XB_SPIN_CAP (1u << 22)
__device__ __forceinline__ unsigned xb_ld(unsigned* p)              { return __hip_atomic_load(p, __ATOMIC_RELAXED, __HIP_MEMORY_SCOPE_AGENT); }
__device__ __forceinline__ unsigned xb_add(unsigned* p, unsigned v) { return __hip_atomic_fetch_add(p, v, __ATOMIC_RELAXED, __HIP_MEMORY_SCOPE_AGENT); }
__device__ __forceinline__ unsigned xb_xcc_id() { return (unsigned)__builtin_amdgcn_s_getreg((3 << 11) | 20) & 0xFu; }
#define XB_SPIN(cond, bar) do { unsigned _sp = 0; while (cond) { __builtin_amdgcn_s_sleep(1); \
    if ((++_sp & 255u) == 0u) { if (xb_ld(&(bar)[XB_TMO])) break; if (_sp > XB_SPIN_CAP) { atomicAdd(&(bar)[XB_TMO], 1u); break; } } } } while (0)
struct XcdBarrier { unsigned* bar; unsigned x; volatile LAS unsigned* st; };
__device__ __forceinline__ XcdBarrier xcd_barrier_post(unsigned* bar, volatile LAS unsigned* st) {
    XcdBarrier b; b.bar = bar; b.x = xb_xcc_id(); b.st = st;
    if (threadIdx.x == 0) (void)xb_add(&bar[XB_XCNT(b.x)], 1u);
    return b;
}
__device__ __forceinline__ void xcd_barrier_complete(unsigned* bar, unsigned x, unsigned& nloc, unsigned& nx) {
    const unsigned G = gridDim.x * gridDim.y * gridDim.z;
    unsigned sum, cnt, mine, sp = 0u;
    for (;;) {
        sum = 0u; cnt = 0u; mine = 0u;
#pragma unroll
        for (unsigned j = 0; j < 16; ++j) { const unsigned c = xb_ld(&bar[XB_XCNT(j)]); sum += c; cnt += (c > 0u) ? 1u : 0u; mine = (j == x) ? c : mine; }
        if (sum == G) break;
        __builtin_amdgcn_s_sleep(1);
        if ((++sp & 255u) == 0u) { if (xb_ld(&bar[XB_TMO])) break; if (sp > XB_SPIN_CAP) { atomicAdd(&bar[XB_TMO], 1u); break; } }
    }
    nloc = mine > 0u ? mine : 1u; nx = cnt > 0u ? cnt : 1u;
}
__device__ __forceinline__ void xcd_barrier(const XcdBarrier& b) {
    asm volatile("s_waitcnt vmcnt(0)" ::: "memory");
    __syncthreads();
    if (threadIdx.x == 0) {
        unsigned* bar = b.bar;
        __builtin_amdgcn_s_waitcnt(0);
        unsigned nloc = b.st[0], nx = b.st[1];
        if (nloc == 0u) { xcd_barrier_complete(bar, b.x, nloc, nx); b.st[0] = nloc; b.st[1] = nx; }
        const unsigned old = xb_add(&bar[XB_XSUB(b.x)], 1u);
        const unsigned gen = old / nloc;
        if (old + 1u == (gen + 1u) * nloc) {
            __builtin_amdgcn_fence(__ATOMIC_RELEASE, "agent");
            asm volatile("s_waitcnt vmcnt(0)" ::: "memory");
            const unsigned og = xb_add(&bar[XB_TOP], 1u);
            const unsigned tg = og / nx;
            if (og + 1u == (tg + 1u) * nx) xb_add(&bar[XB_TOPGEN], 1u);
            else XB_SPIN(xb_ld(&bar[XB_TOPGEN]) == tg, bar);
            __builtin_amdgcn_fence(__ATOMIC_ACQUIRE, "agent");
            xb_add(&bar[XB_XGEN(b.x)], 1u);
            asm volatile("s_waitcnt vmcnt(0)" ::: "memory");
        } else {
            XB_SPIN(xb_ld(&bar[XB_XGEN(b.x)]) == gen, bar);
            __builtin_amdgcn_fence(__ATOMIC_ACQUIRE, "agent");
            asm volatile("s_waitcnt vmcnt(0)" ::: "memory");
        }
    }
    __syncthreads();
}

__device__ __forceinline__ void final_phase(const Frame& F, const bf16_t* hb, float* out, const float* gain, const float* fmod, const XcdBarrier& xbar) {
    const int gw = F.bid * NWAVE + F.wave, NGW = F.G * NWAVE;
    u32x2 hv[16][4];
#pragma unroll
    for (int r = 0; r < 16; ++r) { const int m = gw + r * NGW; const int mm = m < T_TOK ? m : gw;
        const GAS u32x2* xr = (const GAS u32x2*)(hb + (size_t)mm * DM) + F.lane;
#pragma unroll
        for (int j = 0; j < 4; ++j) hv[r][j] = xr[64 * j]; }
    xcd_barrier(xbar);
    f32x4 gp[4], shv[4]; int bcur = -1;
#pragma unroll
    for (int r = 0; r < 16; ++r) { const int m = gw + r * NGW; if (m < T_TOK) {
        const int b = m >> 13; f32x4 v[4]; float s = 0.f;
        if (b != bcur) { bcur = b;
#pragma unroll
            for (int j = 0; j < 4; ++j) { const f32x4 g = ((const GAS f32x4*)gain)[F.lane + 64 * j], sc = ((const GAS f32x4*)(fmod + (size_t)b * 2048 + 1024))[F.lane + 64 * j];
                gp[j] = g * (sc + 1.0f); shv[j] = ((const GAS f32x4*)(fmod + (size_t)b * 2048))[F.lane + 64 * j]; } }
#pragma unroll
        for (int j = 0; j < 4; ++j) { const u32x2 t = hv[r][j]; v[j] = (f32x4){bf_lo(t.x), bf_hi(t.x), bf_lo(t.y), bf_hi(t.y)};
            s += (v[j].x * v[j].x + v[j].y * v[j].y) + (v[j].z * v[j].z + v[j].w * v[j].w); }
        const float rstd = rsqrtf(wave_sum(s) * (1.f / DM) + EPS);
        GAS f32x4* xo = (GAS f32x4*)(out + (size_t)m * DM) + F.lane;
#pragma unroll
        for (int j = 0; j < 4; ++j) xo[64 * j] = v[j] * rstd * gp[j] + shv[j]; } }
}

constexpr int NPH = 26;
__global__ void __launch_bounds__(NTHR, 2) fwd_kernel(Params p) {
    extern __shared__ __attribute__((aligned(16))) unsigned char lds_raw[];
    volatile LAS unsigned* xb_st = (volatile LAS unsigned*)((LAS unsigned char*)lds_raw + LDS_BYTES - 64);
    if (threadIdx.x == 0) { xb_st[0] = 0u; xb_st[1] = 0u; }
    __syncthreads();
    const XcdBarrier xbar = xcd_barrier_post((unsigned*)p.ws, xb_st);
    if (p.ph_lo == 0) {
        Frame F0; F0.lds = (LAS unsigned char*)lds_raw; F0.tid = threadIdx.x; F0.lane = F0.tid & 63; F0.wave = __builtin_amdgcn_readfirstlane(F0.tid >> 6); F0.G = gridDim.x; F0.bid = blockIdx.x;
        if (EN_PRO) prologue(F0, p, as_global(p.ws), 0);
        if (p.ph_hi > 1) cg::this_grid().sync();
    }
#ifdef TPROBE
    unsigned long long tA = 0, tB = 0;
#endif
    for (int ph_ = (p.ph_lo < 1 ? 1 : p.ph_lo); ph_ < p.ph_hi; ++ph_) {
#ifdef TPROBE
    const unsigned long long tp0 = __builtin_amdgcn_s_memrealtime();
#endif
    int ph = __builtin_amdgcn_readfirstlane(ph_);
#ifdef PH_LIMIT
    if (ph > PH_LIMIT && ph < NPH - 1) continue;
#endif
    int tid_ = threadIdx.x; asm volatile("" : "+v"(tid_));
    unsigned char* ws_ = p.ws; asm volatile("" : "+s"(ws_)); unsigned char* ws = as_global(ws_);
    int zi = 0; asm volatile("" : "+s"(zi));
    Frame F;
    F.lds = (LAS unsigned char*)lds_raw;
    F.tid = tid_; F.lane = F.tid & 63; F.wave = __builtin_amdgcn_readfirstlane(F.tid >> 6); { int g_ = gridDim.x, b_ = blockIdx.x; asm volatile("" : "+s"(g_), "+s"(b_)); F.G = g_; F.bid = b_; }
    float* MOD = (float*)(ws + WS_MOD);
    const f32x2* ROPE = (const f32x2*)(ws + WS_ROPE);
    float* DT = (float*)(ws + WS_DT);
    float* CD = (float*)(ws + WS_CD);
    bf16_t* WFU = (bf16_t*)(ws + WS_WFU); bf16_t* WFD = (bf16_t*)(ws + WS_WFD); bf16_t* WIN = (bf16_t*)(ws + WS_WIN); bf16_t* WOUT = (bf16_t*)(ws + WS_WOUT);
    bf16_t* U = (bf16_t*)(ws + WS_U); bf16_t* RST = (bf16_t*)(ws + WS_RST); bf16_t* SST = (bf16_t*)(ws + WS_SST);
    bf16_t* PROJ = (bf16_t*)(ws + WS_PROJ); bf16_t* HID = PROJ;
    float* hbuf_ = p.out; asm volatile("" : "+s"(hbuf_)); float* hbuf = as_global(hbuf_);
    bf16_t* HB = (bf16_t*)((unsigned char*)hbuf + 64 * MiB);
        if (ph == NPH - 1) {
            if (EN_FIN) final_phase(F, HB, hbuf, as_global(p.in[24 + zi]), MOD + FMOD_OFF, xbar);
        } else {
#ifdef XTRA_LIST
            static constexpr int xtra[] = XTRA_LIST;
            const int l = (ph >= NPH) ? 1 : (ph - 1) / 12, j = (ph >= NPH) ? xtra[ph - NPH] : (ph - 1) % 12;
#else
            const int l = (ph - 1) / 12, j = (ph - 1) % 12;
#endif
            const float* modl = MOD + (size_t)l * 4 * 9216;
            if (j == 0 || j == 3 || j == 9) {
                const float* hin = (l == 0 && j == 0) ? as_global(p.in[0 + zi]) : nullptr;
                const int gi = (j == 0) ? 4 : (j == 3) ? 8 : 18;
                const int mi = (j == 0) ? 0 : (j == 3) ? 3 : 6;
                if (EN_NORM) norm_phase(F, hin, HB, as_global(p.in[gi + zi]) + l * DM, modl + mi * 1024, modl + (mi + 1) * 1024, 9216, U);
                __syncthreads();
                if (!EN_CONV) {} else if (j == 0) convert_ffn(F, as_global(p.in[5 + zi]) + (size_t)l * DM * DFF, as_global(p.in[6 + zi]) + (size_t)l * DM * DFF, as_global(p.in[7 + zi]) + (size_t)l * DM * DFF, WFU, WFD);
                else if (j == 9) convert_ffn(F, as_global(p.in[19 + zi]) + (size_t)l * DM * DFF, as_global(p.in[20 + zi]) + (size_t)l * DM * DFF, as_global(p.in[21 + zi]) + (size_t)l * DM * DFF, WFU, WFD);
                else convert_mix(F, as_global(p.in[9 + zi]) + (size_t)l * DM * INW, as_global(p.in[17 + zi]) + (size_t)l * 1536 * DM, WIN, WOUT);
            } else if (j == 1 || j == 10) {
                pg8::Gemm g{U, WFU, T_TOK, 2 * DFF, DM, DM}; pg8::StaticOrder S; S.init(T_TOK, 2 * DFF, F.G, F.bid);
                pg8::EpiSwiGLU E{HID, DFF};
                if (EN_G1) pg8::gemm_phase<pg8::EpiSwiGLU>(F.lds, F.tid, g, S, E);
            } else if (j == 2 || j == 11 || j == 8) {
                pg8::Gemm g; pg8::EpiResid E;
                if (j == 8) { g = pg8::Gemm{PROJ, WOUT, T_TOK, DM, 1536, PW}; E = pg8::EpiResid{HB, modl + 5 * 1024, 1.0f}; }
                else { g = pg8::Gemm{HID, WFD, T_TOK, DM, DFF, DFF}; E = pg8::EpiResid{HB, modl + (j == 2 ? 2 : 8) * 1024, 0.5f}; }
                pg8::StaticOrder S; S.init(T_TOK, DM, F.G, F.bid);
                if (EN_G2) { if (j == 8) pg8::gemm_phase<pg8::EpiResid, true>(F.lds, F.tid, g, S, E); else pg8::gemm_phase<pg8::EpiResid, false>(F.lds, F.tid, g, S, E); }
            } else if (j == 4) {
                pg8::Gemm g{U, WIN, T_TOK, PW, DM, DM}; pg8::StaticOrder S; S.init(T_TOK, PW, F.G, F.bid);
                pg8::EpiBf16 E{PROJ, PW};
                if (EN_G3) pg8::gemm_phase<pg8::EpiBf16>(F.lds, F.tid, g, S, E);
                if (EN_DT) dt_gemv(F, U, as_global(p.in[9 + zi]) + (size_t)l * DM * INW, DT);
            } else if (j == 5) {
                if (EN_SB && XS(1)) for (int t = F.bid; t < 1024; t += F.G) { const int qb = 63 - (t >> 4), bh = t & 15; sb_task(F, PROJ, bh >> 2, bh & 3, qb); }
                if (EN_RKV && XS(2)) { f32x4 kcs[4] = {}; int ccur = -1; const bool fm = (F.G * 8 == 2048);
                    for (int i = 0, t = F.bid; t < 2048; t += F.G, ++i) {
                        const int c = fm ? (F.bid >> 1) : ((t >> 2) & 127), bh = fm ? ((F.bid & 1) * 8 + i) : (((t >> 2) >> 7) * 4 + (t & 3));
                        ret_kv_task(F, PROJ, ROPE, RST, bh >> 2, c, bh & 3, kcs, c != ccur); ccur = c; } }
                if (EN_SST && XS(4)) for (int t = F.bid; t < 1024; t += F.G) { const int g = t & 1, bc = t >> 1;
                    ssd_state_task(F, PROJ, DT, as_global(p.in[10 + zi]) + l * 4096, as_global(p.in[11 + zi]) + l * 1024, as_global(p.in[12 + zi]) + l * 8, as_global(p.in[13 + zi]) + l * 8, SST, CD, bc >> 7, bc & 127, g); }
            } else if (j == 6) {
                if (EN_SCAN) scan_phase(F, RST, SST, CD);
            } else if (j == 7) {
                if (EN_ROUT && XS(8)) { f32x4 kcs[4] = {}, qcs[2][4] = {}; RoPre pre = {}; int ccur = -1; const bool fm = (F.G * 8 == 2048); const float* gnp = as_global(p.in[15 + zi]) + l * 512;
                    if (F.bid < 2048) { const int t = F.bid, c0 = fm ? (F.bid >> 1) : ((t >> 2) & 127), bh0 = fm ? ((F.bid & 1) * 8) : (((t >> 2) >> 7) * 4 + (t & 3)); ro_load(F, PROJ, RST, bh0 >> 2, c0, bh0 & 3, pre); }
                    for (int i = 0, t = F.bid; t < 2048; t += F.G, ++i) {
                        const int c = fm ? (F.bid >> 1) : ((t >> 2) & 127), bh = fm ? ((F.bid & 1) * 8 + i) : (((t >> 2) >> 7) * 4 + (t & 3));
                        const int tn = t + F.G, cn = fm ? c : ((tn >> 2) & 127), bhn = fm ? (bh + 1) : (((tn >> 2) >> 7) * 4 + (tn & 3));
                        ret_out_task(F, PROJ, ROPE, RST, gnp, bh >> 2, c, bh & 3, kcs, qcs, c != ccur, pre, tn < 2048, bhn >> 2, cn, bhn & 3); ccur = c; } }
                if (EN_SOUT && XS(16)) for (int t = F.bid; t < 512; t += F.G) {
                    ssd_out_task(F, PROJ, DT, as_global(p.in[10 + zi]) + l * 4096, as_global(p.in[11 + zi]) + l * 1024, as_global(p.in[12 + zi]) + l * 8, as_global(p.in[13 + zi]) + l * 8, as_global(p.in[14 + zi]) + l * 8, as_global(p.in[16 + zi]) + l * 512, SST, t >> 7, t & 127); }
            }
        }
        if (ph + 1 < p.ph_hi) { xcd_barrier(xbar); }
#ifdef TPROBE
        { const unsigned long long tp1 = __builtin_amdgcn_s_memrealtime(); const int jj = (ph - 1) % 12;
          if (ph < NPH - 1) { if (TPROBE_A(jj)) tA += tp1 - tp0; if (TPROBE_B(jj)) tB += tp1 - tp0; } }
#endif
    }
#ifdef TPROBE
    cg::this_grid().sync();
    if (blockIdx.x == 0) { const float a = (float)tA * 0.01f, b = (float)tB * 0.01f * TPROBE_BS;
        if (threadIdx.x == 0) p.out[0] += a;
        for (int i = threadIdx.x; i < (1 << 20); i += NTHR) p.out[1024 + i] += b; }
#endif
}

extern "C" void kernel_launch(void* const* d_in, const int* in_sizes, int n_in, void* d_out, int out_size, void* d_ws, size_t ws_size, hipStream_t stream) {
    static int grid = 0;
    if (grid == 0) {
        if (n_in != 25 || out_size != T_TOK * DM || ws_size < WS_END) { fprintf(stderr, "kernel_launch: unexpected shapes (n_in %d out %d ws %zu)\n", n_in, out_size, ws_size); grid = -1; return; }
        int dev = 0, cus = 0, per_cu = 0;
        hipGetDevice(&dev);
        hipDeviceGetAttribute(&cus, hipDeviceAttributeMultiprocessorCount, dev);
        hipFuncSetAttribute((const void*)fwd_kernel, hipFuncAttributeMaxDynamicSharedMemorySize, LDS_BYTES);
        hipOccupancyMaxActiveBlocksPerMultiprocessor(&per_cu, (const void*)fwd_kernel, NTHR, LDS_BYTES);
        if (per_cu < 1) per_cu = 1;
        (void)hipGetLastError();
        grid = cus * per_cu;
    }
    if (grid < 0) return;
    (void)hipMemsetAsync(d_ws, 0, 65536, stream);
    Params p{};
    for (int i = 0; i < 25; ++i) p.in[i] = (const float*)d_in[i];
    p.out = (float*)d_out; p.ws = (unsigned char*)d_ws;
#if ONE_LAUNCH
#ifdef XTRA_LIST
    p.ph_lo = 0; p.ph_hi = NPH + XTRA_N;
#else
    p.ph_lo = 0; p.ph_hi = NPH;
#endif
    void* args[] = {&p};
    hipError_t e = hipLaunchCooperativeKernel((const void*)fwd_kernel, dim3(grid), dim3(NTHR), args, LDS_BYTES, stream);
    if (e != hipSuccess) fprintf(stderr, "cooperative launch failed: %s (grid %d)\n", hipGetErrorString(e), grid);
#else
    for (int ph = 0; ph < NPH; ++ph) { p.ph_lo = ph; p.ph_hi = ph + 1; hipLaunchKernelGGL(fwd_kernel, dim3(grid), dim3(NTHR), LDS_BYTES, stream, p); }
#endif
}
```
